# Optimizing an MI355X kernel written in HIP

```python
import math
import jax
import jax.numpy as jnp
from jax import lax
import numpy as np

D_MODEL = 2048
BATCH = 8
SEQ = 2048
DEPTH = 2

CTX_LEN = 256
GRID_W = 64
MIX_W = D_MODEL
HALF_W = MIX_W // 2

HY_W = HALF_W
HY_ORDER = 2
HY_SHORT = 3
HY_BANDS = 16
HY_EMB = 1 + 2 * HY_BANDS
HY_FFN = 64
HY_FAST_DECAY = 0.3
HY_SLOW_DECAY = 1.5
HY_DECAY_TARGET = 1e-2

GLA_HEADS = 4
GLA_DK = HALF_W // (2 * GLA_HEADS)
GLA_DV = HALF_W // GLA_HEADS
GLA_RANK = 16
GLA_TAU = 16.0
GLA_CHUNK = 64

ML_HEADS = 4
ML_DH = HALF_W // ML_HEADS
ML_SHORT = 3
ML_CHUNK = 64

DA_HEADS = 8
DA_DH = HALF_W // (2 * DA_HEADS)
DA_DV = 2 * DA_DH
Q_BLOCK = 128
ROPE_BASE = 10000.0

N_EXPERTS = 16
EC_CAPACITY = 2
EXPERT_FF = 2048

NORM_EPS = 1e-6

EV_IN = 3 * HY_W + 2 * GLA_HEADS * GLA_DK + 2 * GLA_HEADS * GLA_DV + 2 * GLA_RANK
ML_IN = 4 * HALF_W + 4 * ML_HEADS
DA_IN = 3 * HALF_W
OD_IN = ML_IN + DA_IN

kernel_name = 'hybrid_hyena_gla_mlstm_diffattn_ecmoe_block'


def rmsnorm(x, g):
    xf = x.astype(jnp.float32)
    y = xf * lax.rsqrt(jnp.mean(xf * xf, axis=-1, keepdims=True) + NORM_EPS)
    return (y * g.astype(jnp.float32)).astype(x.dtype)


def modulate(x, g, shift, scale):
    return rmsnorm(x, g) * (1.0 + scale[:, None]) + shift[:, None]


def split_cols(a, sizes):
    return jnp.split(a, np.cumsum(sizes)[:-1].tolist(), axis=-1)


def short_conv(u, w, b):
    pad = w.shape[0] // 2
    y = lax.conv_general_dilated(u, w[:, None, :].astype(u.dtype), (1,), [(pad, pad)],
                                 dimension_numbers=('NWC', 'WIO', 'NWC'),
                                 feature_group_count=u.shape[-1])
    return y + b.astype(u.dtype)


def to_heads(a, n_heads):
    B, L, _ = a.shape
    return jnp.swapaxes(a.reshape(B, L, n_heads, -1), 1, 2).astype(jnp.float32)


def from_heads(a):
    B, H, L, d = a.shape
    return jnp.swapaxes(a, 1, 2).reshape(B, L, H * d)


def to_chunks(a, size):
    B, H, L = a.shape[:3]
    return jnp.moveaxis(a.reshape((B, H, L // size, size) + a.shape[3:]), 2, 0)


def from_chunks(o):
    o = jnp.moveaxis(o, 0, 2)
    return o.reshape(o.shape[:2] + (-1,) + o.shape[4:])


def flip_seq(a):
    return a[:, :, ::-1]


def hyena_filters(L, w1, b1, freq, w2, b2, w3):
    pos = jnp.arange(L, dtype=jnp.float32)
    t = pos[:, None] / max(L - 1, 1)
    bands = jnp.linspace(1e-4, HY_BANDS - 1, HY_BANDS, dtype=jnp.float32)
    ang = (2.0 * math.pi / L) * pos[:, None] * bands[None, :]
    feats = jnp.concatenate([t, jnp.cos(ang), -jnp.sin(ang)], axis=-1)
    h = jnp.sin(freq[0] * (feats @ w1 + b1))
    h = jnp.sin(freq[1] * (h @ w2 + b2))
    h = (h @ w3).astype(jnp.float32)
    deltas = jnp.abs(jnp.linspace(math.log(HY_DECAY_TARGET) / HY_SLOW_DECAY,
                                  math.log(HY_DECAY_TARGET) / HY_FAST_DECAY, HY_W, dtype=jnp.float32))
    window = jnp.exp(-t * deltas[None, :])
    return h.reshape(L, HY_ORDER, 2, HY_W) * window[:, None, None, :]


def long_conv(u, h_fwd, h_bwd, skip):
    L = u.shape[1]
    filt = jnp.concatenate([h_fwd, jnp.zeros_like(h_fwd[:1]), h_bwd[:0:-1]], axis=0)
    uf = u.astype(jnp.float32)
    spec = jnp.fft.rfft(uf, n=2 * L, axis=1) * jnp.fft.rfft(filt, n=2 * L, axis=0)[None]
    y = jnp.fft.irfft(spec, n=2 * L, axis=1)[:, :L]
    return y + uf * skip.astype(jnp.float32)


def hyena_mix(cols, conv_w, conv_b, filt_params, skip):
    L = cols.shape[1]
    filt = hyena_filters(L, *filt_params)
    x1, x2, v = jnp.split(short_conv(cols, conv_w, conv_b), 3, axis=-1)
    for n, gate in enumerate((x1, x2)):
        v = gate * long_conv(v, filt[:, n, 0], filt[:, n, 1], skip[n])
    return v.astype(cols.dtype)


def gla_scan(q, k, v, logg, s0, emit):
    mask = jnp.tril(jnp.ones((GLA_CHUNK, GLA_CHUNK), dtype=bool))

    def step(S, inp):
        qc, kc, vc, gc = inp
        b = jnp.cumsum(gc, axis=-2)
        b_last = b[..., -1:, :]
        S_new = jnp.exp(b_last[..., 0, :])[..., None] * S + jnp.einsum('bhck,bhcv->bhkv', kc * jnp.exp(b_last - b), vc)
        if not emit:
            return S_new, None
        q_dec = qc * jnp.exp(b)
        att = jnp.where(mask, jnp.einsum('bhik,bhjk->bhij', q_dec, kc * jnp.exp(-b)), 0.0)
        o = jnp.einsum('bhij,bhjv->bhiv', att, vc) + jnp.einsum('bhik,bhkv->bhiv', q_dec, S)
        return S_new, o

    xs = tuple(to_chunks(a, GLA_CHUNK) for a in (q, k, v, logg))
    S_fin, o = lax.scan(step, s0, xs)
    return (from_chunks(o) if emit else None), S_fin


def gla_mix(cols, states, gate_w2, gate_b, norm_g, emit):
    B, L, _ = cols.shape
    q, k, v, r, codes = split_cols(cols, (GLA_HEADS * GLA_DK, GLA_HEADS * GLA_DK, GLA_HEADS * GLA_DV,
                                          GLA_HEADS * GLA_DV, 2 * GLA_RANK))
    qh = to_heads(q, GLA_HEADS) * GLA_DK ** -0.5
    kh = to_heads(k, GLA_HEADS)
    vh = to_heads(v, GLA_HEADS)
    codes = codes.reshape(B, L, 2, GLA_RANK)
    out, finals = None, []
    for d in range(2):
        logg = jax.nn.log_sigmoid((codes[:, :, d] @ gate_w2[d] + gate_b[d]).astype(jnp.float32)) / GLA_TAU
        seqs = (qh, kh, vh, to_heads(logg, GLA_HEADS))
        if d == 1:
            seqs = tuple(flip_seq(a) for a in seqs)
        o, sf = gla_scan(*seqs, states[d], emit)
        finals.append(sf)
        if emit:
            o = flip_seq(o) if d == 1 else o
            out = o if out is None else out + o
    if emit:
        out = (from_heads(rmsnorm(out, norm_g)) * jax.nn.silu(r.astype(jnp.float32))).astype(cols.dtype)
    return out, finals


def mlstm_scan(q, k, v, ig, lf, state, emit):
    mask = jnp.tril(jnp.ones((ML_CHUNK, ML_CHUNK), dtype=bool))

    def step(carry, inp):
        Cm, nv, m = carry
        qc, kc, vc, ic, fc = inp
        b = jnp.cumsum(fc, axis=-1)
        b_last = b[..., -1]
        w_end = b_last[..., None] - b + ic
        m_new = jnp.maximum(b_last + m, jnp.max(w_end, axis=-1))
        keep = jnp.exp(b_last + m - m_new)
        w = jnp.exp(w_end - m_new[..., None])
        C_new = keep[..., None, None] * Cm + jnp.einsum('bhc,bhcv,bhck->bhvk', w, vc, kc)
        n_new = keep[..., None] * nv + jnp.einsum('bhc,bhck->bhk', w, kc)
        if not emit:
            return (C_new, n_new, m_new), None
        a = b + m[..., None]
        dlog = jnp.where(mask, b[..., :, None] - b[..., None, :] + ic[..., None, :], -jnp.inf)
        m_t = jnp.maximum(a, jnp.max(dlog, axis=-1))
        sc = jnp.einsum('bhid,bhjd->bhij', qc, kc) * jnp.exp(dlog - m_t[..., None])
        aw = jnp.exp(a - m_t)
        num = jnp.einsum('bhij,bhjv->bhiv', sc, vc) + aw[..., None] * jnp.einsum('bhvk,bhik->bhiv', Cm, qc)
        den = jnp.sum(sc, axis=-1) + aw * jnp.einsum('bhk,bhik->bhi', nv, qc)
        h = num / jnp.maximum(jnp.abs(den), jnp.exp(-m_t))[..., None]
        return (C_new, n_new, m_new), h

    xs = tuple(to_chunks(a, ML_CHUNK) for a in (q, k, v, ig, lf))
    final, hs = lax.scan(step, state, xs)
    return (from_chunks(hs) if emit else None), final


def mlstm_mix(cols, conv_w, conv_b, igate_b, fgate_b, norm_g, states, emit):
    B, L, _ = cols.shape
    q, k, v, o, g = split_cols(cols, (HALF_W, HALF_W, HALF_W, HALF_W, 4 * ML_HEADS))
    q, k = jnp.split(jax.nn.silu(short_conv(jnp.concatenate([q, k], axis=-1), conv_w, conv_b)), 2, axis=-1)
    qh = to_heads(q, ML_HEADS)
    kh = to_heads(k, ML_HEADS) * ML_DH ** -0.5
    vh = to_heads(v, ML_HEADS)
    g = jnp.transpose(g.reshape(B, L, 2, 2, ML_HEADS).astype(jnp.float32), (0, 4, 2, 3, 1))
    hsum, finals = None, []
    for d in range(2):
        ig = g[:, :, d, 0] + igate_b[d].astype(jnp.float32)[None, :, None]
        lf = jax.nn.log_sigmoid(g[:, :, d, 1] + fgate_b[d].astype(jnp.float32)[None, :, None])
        seqs = (qh, kh, vh, ig, lf)
        if d == 1:
            seqs = tuple(flip_seq(a) for a in seqs)
        h, st = mlstm_scan(*seqs, states[d], emit)
        finals.append(st)
        if emit:
            h = flip_seq(h) if d == 1 else h
            hsum = h if hsum is None else hsum + h
    out = None
    if emit:
        out = (from_heads(rmsnorm(hsum, norm_g)) * jax.nn.sigmoid(o.astype(jnp.float32))).astype(cols.dtype)
    return out, finals


def axial_rope(x):
    n = x.shape[1]
    rows_n = n // GRID_W
    row = jnp.repeat(jnp.arange(rows_n), GRID_W).astype(jnp.float32)
    col = jnp.tile(jnp.arange(GRID_W), rows_n).astype(jnp.float32)
    nf = DA_DH // 4
    inv = ROPE_BASE ** (-jnp.arange(nf, dtype=jnp.float32) / nf)
    ang = jnp.stack([row[:, None] * inv, col[:, None] * inv], axis=1)
    cos = jnp.cos(ang)[None, :, None, None]
    sin = jnp.sin(ang)[None, :, None, None]
    xr = x.astype(jnp.float32).reshape(x.shape[:-1] + (2, 2, nf))
    xa, xb = xr[..., 0, :], xr[..., 1, :]
    out = jnp.stack([xa * cos - xb * sin, xb * cos + xa * sin], axis=-2)
    return out.reshape(x.shape).astype(x.dtype)


def diff_attention(cols_ctx, cols_lat, lam_vecs, norm_g, lam_init, emit_ctx):
    def split_qkv(cols):
        B, L, _ = cols.shape
        q, k, v = jnp.split(cols, 3, axis=-1)
        return (q.reshape(B, L, DA_HEADS, 2, DA_DH), k.reshape(B, L, DA_HEADS, 2, DA_DH),
                v.reshape(B, L, DA_HEADS, DA_DV))

    q_c, k_c, v_c = split_qkv(cols_ctx)
    q_l, k_l, v_l = split_qkv(cols_lat)
    q_l, k_l = axial_rope(q_l), axial_rope(k_l)
    lv = lam_vecs.astype(jnp.float32)
    lam = jnp.exp(jnp.sum(lv[0] * lv[1])) - jnp.exp(jnp.sum(lv[2] * lv[3])) + lam_init
    scale = DA_DH ** -0.5

    def attend(qb, keys, vals):
        s = jnp.einsum('bqhcd,bkhcd->bhcqk', qb, keys).astype(jnp.float32) * scale
        p = jax.nn.softmax(s, axis=-1)
        a = p[:, :, 0] - lam * p[:, :, 1]
        o = jnp.einsum('bhqk,bkhv->bqhv', a.astype(vals.dtype), vals)
        return rmsnorm(o, norm_g) * (1.0 - lam_init)

    B, n = q_l.shape[:2]
    keys = jnp.concatenate([k_c, k_l], axis=1)
    vals = jnp.concatenate([v_c, v_l], axis=1)
    qb = jnp.moveaxis(q_l.reshape((B, n // Q_BLOCK, Q_BLOCK) + q_l.shape[2:]), 1, 0)
    o_l = lax.map(lambda blk: attend(blk, keys, vals), qb)
    o_l = jnp.moveaxis(o_l, 0, 1).reshape(B, n, DA_HEADS * DA_DV)
    o_c = None
    if emit_ctx:
        o_c = attend(q_c, k_c, v_c).reshape(B, -1, DA_HEADS * DA_DV)
    return o_c, o_l


def expert_choice_ffn(h, router_w, w1, w3, w2):
    B, T, _ = h.shape
    cap = EC_CAPACITY * T // N_EXPERTS
    aff = jax.nn.softmax((h @ router_w).astype(jnp.float32), axis=-1)
    g, idx = lax.top_k(jnp.swapaxes(aff, 1, 2), cap)
    bidx = jnp.arange(B)[:, None, None]
    xs = h[bidx, idx]
    hid = jax.nn.silu(jnp.einsum('becd,edf->becf', xs, w1)) * jnp.einsum('becd,edf->becf', xs, w3)
    ys = jnp.einsum('becf,efd->becd', hid, w2) * g[..., None].astype(h.dtype)
    return jnp.zeros_like(h).at[bidx, idx].add(ys)


def even_mixer(h_ctx, h_lat, in_w, hy_conv_w, hy_conv_b, hy_pos_w1, hy_pos_b1, hy_sin_freq, hy_pos_w2,
               hy_pos_b2, hy_pos_w3, hy_bias, gla_gate_w2, gla_gate_b, gla_norm_g, emit_ctx):
    p_ctx, p_lat = h_ctx @ in_w, h_lat @ in_w
    hy_n = 3 * HY_W
    filt_params = (hy_pos_w1, hy_pos_b1, hy_sin_freq, hy_pos_w2, hy_pos_b2, hy_pos_w3)
    hy_lat = hyena_mix(p_lat[..., :hy_n], hy_conv_w, hy_conv_b, filt_params, hy_bias)
    B = p_ctx.shape[0]
    zero = jnp.zeros((B, GLA_HEADS, GLA_DK, GLA_DV), jnp.float32)
    gla_ctx, st = gla_mix(p_ctx[..., hy_n:], (zero, zero), gla_gate_w2, gla_gate_b, gla_norm_g, emit_ctx)
    gla_lat, _ = gla_mix(p_lat[..., hy_n:], st, gla_gate_w2, gla_gate_b, gla_norm_g, True)
    y_lat = jnp.concatenate([hy_lat, gla_lat], axis=-1)
    y_ctx = None
    if emit_ctx:
        hy_ctx = hyena_mix(p_ctx[..., :hy_n], hy_conv_w, hy_conv_b, filt_params, hy_bias)
        y_ctx = jnp.concatenate([hy_ctx, gla_ctx], axis=-1)
    return y_ctx, y_lat


def odd_mixer(h_ctx, h_lat, in_w, ml_conv_w, ml_conv_b, ml_igate_b, ml_fgate_b, ml_norm_g,
              da_lambda, da_norm_g, lam_init, emit_ctx):
    p_ctx, p_lat = h_ctx @ in_w, h_lat @ in_w
    B = p_ctx.shape[0]
    zero = (jnp.zeros((B, ML_HEADS, ML_DH, ML_DH), jnp.float32),
            jnp.zeros((B, ML_HEADS, ML_DH), jnp.float32),
            jnp.zeros((B, ML_HEADS), jnp.float32))
    ml_args = (ml_conv_w, ml_conv_b, ml_igate_b, ml_fgate_b, ml_norm_g)
    ml_ctx, st = mlstm_mix(p_ctx[..., :ML_IN], *ml_args, (zero, zero), emit_ctx)
    ml_lat, _ = mlstm_mix(p_lat[..., :ML_IN], *ml_args, st, True)
    da_ctx, da_lat = diff_attention(p_ctx[..., ML_IN:], p_lat[..., ML_IN:], da_lambda, da_norm_g,
                                    lam_init, emit_ctx)
    y_lat = jnp.concatenate([ml_lat, da_lat], axis=-1)
    y_ctx = jnp.concatenate([ml_ctx, da_ctx], axis=-1) if emit_ctx else None
    return y_ctx, y_lat


def setup_inputs(seed: int = 0) -> dict:
    key = jax.random.key(seed)
    keys = iter(jax.random.split(key, 64))

    def nrm(shape, scale=1.0):
        return scale * jax.random.normal(next(keys), shape, jnp.float32)

    D = D_MODEL
    NE = (DEPTH + 1) // 2
    NO = DEPTH // 2
    return {
        'x': nrm((BATCH, SEQ, D)),
        'c': nrm((BATCH, D)),
        'ctx': nrm((BATCH, CTX_LEN, D)),
        'c_ctx': nrm((D,)),
        'ada_w': nrm((DEPTH, D, 6 * D), 0.5 * D ** -0.5),
        'ada_b': nrm((DEPTH, 6 * D), 0.02),
        'norm1_g': 1.0 + nrm((DEPTH, D), 0.02),
        'norm2_g': 1.0 + nrm((DEPTH, D), 0.02),
        'out_w': nrm((DEPTH, MIX_W, D), MIX_W ** -0.5),
        'router_w': nrm((DEPTH, D, N_EXPERTS), D ** -0.5),
        'moe_w1': nrm((DEPTH, N_EXPERTS, D, EXPERT_FF), D ** -0.5),
        'moe_w3': nrm((DEPTH, N_EXPERTS, D, EXPERT_FF), D ** -0.5),
        'moe_w2': nrm((DEPTH, N_EXPERTS, EXPERT_FF, D), EXPERT_FF ** -0.5),
        'final_g': 1.0 + nrm((D,), 0.02),
        'ev_in_w': nrm((NE, D, EV_IN), D ** -0.5),
        'hy_conv_w': nrm((NE, HY_SHORT, 3 * HY_W), HY_SHORT ** -0.5),
        'hy_conv_b': nrm((NE, 3 * HY_W), 0.02),
        'hy_pos_w1': nrm((NE, HY_EMB, HY_FFN), HY_EMB ** -0.5),
        'hy_pos_b1': nrm((NE, HY_FFN), 0.02),
        'hy_sin_freq': 1.0 + nrm((NE, 2, HY_FFN), 0.1),
        'hy_pos_w2': nrm((NE, HY_FFN, HY_FFN), HY_FFN ** -0.5),
        'hy_pos_b2': nrm((NE, HY_FFN), 0.02),
        'hy_pos_w3': nrm((NE, HY_FFN, HY_ORDER * 2 * HY_W), 0.05 * HY_FFN ** -0.5),
        'hy_bias': nrm((NE, HY_ORDER, HY_W), 0.1),
        'gla_gate_w2': nrm((NE, 2, GLA_RANK, GLA_HEADS * GLA_DK), GLA_RANK ** -0.5),
        'gla_gate_b': nrm((NE, 2, GLA_HEADS * GLA_DK), 0.1),
        'gla_norm_g': 1.0 + nrm((NE, GLA_DV), 0.02),
        'od_in_w': nrm((NO, D, OD_IN), D ** -0.5),
        'ml_conv_w': nrm((NO, ML_SHORT, 2 * HALF_W), ML_SHORT ** -0.5),
        'ml_conv_b': nrm((NO, 2 * HALF_W), 0.02),
        'ml_igate_b': nrm((NO, 2, ML_HEADS), 0.1),
        'ml_fgate_b': jnp.linspace(3.0, 6.0, ML_HEADS, dtype=jnp.float32) + nrm((NO, 2, ML_HEADS), 0.1),
        'ml_norm_g': 1.0 + nrm((NO, ML_DH), 0.02),
        'da_lambda': nrm((NO, 4, DA_DH), 0.1),
        'da_norm_g': 1.0 + nrm((NO, DA_DV), 0.02),
    }


def reference(x, c, ctx, c_ctx, ada_w, ada_b, norm1_g, norm2_g, out_w, router_w, moe_w1, moe_w3, moe_w2,
              final_g, ev_in_w, hy_conv_w, hy_conv_b, hy_pos_w1, hy_pos_b1, hy_sin_freq, hy_pos_w2, hy_pos_b2,
              hy_pos_w3, hy_bias, gla_gate_w2, gla_gate_b, gla_norm_g, od_in_w, ml_conv_w, ml_conv_b,
              ml_igate_b, ml_fgate_b, ml_norm_g, da_lambda, da_norm_g):
    cond_lat = jax.nn.silu(c)
    cond_ctx = jax.nn.silu(c_ctx)[None]
    h_x, h_c = x, ctx
    for l in range(DEPTH):
        last = l == DEPTH - 1
        m_lat = jnp.split(cond_lat @ ada_w[l] + ada_b[l], 6, axis=-1)
        m_ctx = jnp.split(cond_ctx @ ada_w[l] + ada_b[l], 6, axis=-1)
        a_lat = modulate(h_x, norm1_g[l], m_lat[0], m_lat[1])
        a_ctx = modulate(h_c, norm1_g[l], m_ctx[0], m_ctx[1])
        if l % 2 == 0:
            e = l // 2
            y_ctx, y_lat = even_mixer(a_ctx, a_lat, ev_in_w[e], hy_conv_w[e], hy_conv_b[e], hy_pos_w1[e],
                                      hy_pos_b1[e], hy_sin_freq[e], hy_pos_w2[e], hy_pos_b2[e], hy_pos_w3[e],
                                      hy_bias[e], gla_gate_w2[e], gla_gate_b[e], gla_norm_g[e], not last)
        else:
            o = l // 2
            lam_init = 0.8 - 0.6 * math.exp(-0.3 * l)
            y_ctx, y_lat = odd_mixer(a_ctx, a_lat, od_in_w[o], ml_conv_w[o], ml_conv_b[o], ml_igate_b[o],
                                     ml_fgate_b[o], ml_norm_g[o], da_lambda[o], da_norm_g[o], lam_init, not last)
        h_x = h_x + m_lat[2][:, None] * (y_lat @ out_w[l])
        h_x = h_x + m_lat[5][:, None] * expert_choice_ffn(modulate(h_x, norm2_g[l], m_lat[3], m_lat[4]),
                                                          router_w[l], moe_w1[l], moe_w3[l], moe_w2[l])
        if not last:
            h_c = h_c + m_ctx[2][:, None] * (y_ctx @ out_w[l])
            h_c = h_c + m_ctx[5][:, None] * expert_choice_ffn(modulate(h_c, norm2_g[l], m_ctx[3], m_ctx[4]),
                                                              router_w[l], moe_w1[l], moe_w3[l], moe_w2[l])
    return rmsnorm(h_x, final_g)
```

```cpp
#include <hip/hip_runtime.h>
#include <cstdio>
#include <cstdint>
namespace pg8 {
#define PG8_LAS __attribute__((address_space(3)))
typedef unsigned short bf16_t;
typedef short bf16x8 __attribute__((ext_vector_type(8)));
typedef float f32x4 __attribute__((ext_vector_type(4)));
typedef unsigned u32x4 __attribute__((ext_vector_type(4)));
constexpr int BM = 256, BK = 64, HALF = 128, HTB = HALF * BK * 2  , STAGE_BYTES = 8 * HTB, NXCD = 8, WGM = 8;

__host__ __device__ __forceinline__ int lds_byte(int r, int c) { const int st = (r >> 4) * 2 + (c >> 5), rr = r & 15, cc = c & 31, ob = rr * 64 + cc * 2; return st * 1024 + (ob ^ (((ob >> 9) & 1) << 5)); }
__host__ __device__ __forceinline__ void stage_rc(int b, int& R, int& C) { const int st = b / 1024, sb = b % 1024, swz = sb ^ (((sb >> 9) & 1) << 5); R = (st >> 1) * 16 + swz / 64; C = (st & 1) * 32 + (swz % 64) / 2; }
__host__ __device__ __forceinline__ int perm32(int rho) { const int n = rho >> 4, i = rho & 15; return 8 * (i >> 2) + 4 * n + (i & 3); }

struct Unit { int pm, pn; };
struct Gemm { const bf16_t* A; const bf16_t* Bt; int M, N, K; };

struct StaticOrder {
    int nM, nN, nwg, G, c;
    __host__ __device__ void init(int M, int N, int G_, int c_) { nM = M / BM; nN = N / BM; nwg = nM * nN; G = G_; c = c_; }
    __host__ __device__ bool next(int i, Unit& u) const {
        const long L = (long)i * G + c; if (L >= nwg) return false;
        int wgid = (int)L; { const int q = nwg / NXCD, r = nwg % NXCD, xcd = wgid % NXCD, off = wgid / NXCD; wgid = (xcd < r ? xcd * (q + 1) : r * (q + 1) + (xcd - r) * q) + off; }
        const int nig = WGM * nN, gid = wgid / nig, fm = gid * WGM, gsz = (nM - fm) < WGM ? (nM - fm) : WGM;
        u.pm = fm + ((wgid % nig) % gsz); u.pn = (wgid % nig) / gsz; return true;
    }
    __device__ __forceinline__ void a_ready(const Unit&) const {}
    __device__ __forceinline__ void done(const Unit&) const {}
};

__device__ __forceinline__ unsigned cvt_pk_bf16(float lo, float hi) { unsigned r; asm volatile("v_cvt_pk_bf16_f32 %0, %1, %2" : "=v"(r) : "v"(lo), "v"(hi)); return r; }
typedef float f32x2 __attribute__((ext_vector_type(2)));
__device__ __forceinline__ f32x2 gelu_pk(f32x2 v) {
    const f32x2 av = __builtin_elementwise_abs(v), d = av * 0.2316418882f + 1.0f;
    f32x2 t; t.x = __builtin_amdgcn_rcpf(d.x); t.y = __builtin_amdgcn_rcpf(d.y);
    f32x2 q = t * 0.5307027145f + (-0.7265760135f); q = q * t + 0.7107068705f; q = q * t + (-0.142248368f); q = q * t + 0.127414796f; q = q * t;
    const f32x2 s = (v * v) * (-0.72134752044f);
    f32x2 e; e.x = __builtin_amdgcn_exp2f(s.x); e.y = __builtin_amdgcn_exp2f(s.y);
    const f32x2 m = v * (q * e), r = v - m;
    f32x2 o; o.x = v.x < 0.f ? m.x : r.x; o.y = v.y < 0.f ? m.y : r.y; return o;
}

typedef int v8i32 __attribute__((ext_vector_type(8)));
template <class Epi, class Sched, bool ALIGN_EPI = false, bool SP2 = false, bool FP8 = false>
__device__ __forceinline__ void gemm_phase(PG8_LAS unsigned char* lds, const Gemm g, const Sched& S, const Epi& E) {
    int tid_ = threadIdx.x; asm volatile("" : "+v"(tid_));
    const int tid = tid_, wid = __builtin_amdgcn_readfirstlane(tid >> 6), lane = tid & 63, wr = wid >> 2, wc = wid & 3, fr = lane & 15, fq = lane >> 4;
    const int K = FP8 ? g.K / 2 : g.K, nt = K / BK;
    unsigned voffA[2], voffB[2];
#pragma unroll
    for (int i = 0; i < 2; ++i) { int R, C; stage_rc(tid * 16 + i * 8192, R, C); const int Rb = Epi::PERM ? ((R & ~31) + perm32(R & 31)) : R;
        voffA[i] = (unsigned)(R * K + C) * 2u; voffB[i] = (unsigned)(Rb * K + C) * 2u; }
    const size_t kstep = (size_t)(BK * 2);
    const size_t hstep = (size_t)HALF * K * 2;
    const size_t tstep = 2 * hstep;
    const unsigned ldsw = (unsigned)wid * 1024u;
    const int aoff = lds_byte(wr * 64 + fr, fq * 8), boff = lds_byte(wc * 32 + fr, fq * 8);
#define PG8_SA(b, h) (((b) * 2 + (h)) * HTB)
#define PG8_SB(b, h) ((4 + (b) * 2 + (h)) * HTB)
#define PG8_STAGE(bufoff, gbase, voff) do { _Pragma("unroll") for (int _i = 0; _i < 2; ++_i) \
        __builtin_amdgcn_global_load_lds((const unsigned*)((const char*)(gbase) + (voff)[_i]), (PG8_LAS unsigned*)(lds + (bufoff) + ldsw + _i * 8192), 16, 0, 0); } while (0)
#define PG8_LDA(dst, b, h) do { _Pragma("unroll") for (int m = 0; m < 4; ++m) _Pragma("unroll") for (int k = 0; k < 2; ++k) dst[m][k] = *(const PG8_LAS bf16x8*)(lds + PG8_SA(b, h) + aoff + m * 2048 + k * 1024); } while (0)
#define PG8_LDB(dst, b, h) do { _Pragma("unroll") for (int n = 0; n < 2; ++n) _Pragma("unroll") for (int k = 0; k < 2; ++k) dst[n][k] = *(const PG8_LAS bf16x8*)(lds + PG8_SB(b, h) + boff + n * 2048 + k * 1024); } while (0)
#define PG8_MMA(ai, bj, At, Bt) do { __builtin_amdgcn_s_setprio(1); _Pragma("unroll") for (int m = 0; m < 4; ++m) _Pragma("unroll") for (int n = 0; n < 2; ++n) { \
        if constexpr (FP8) { typedef int i32x4_ __attribute__((ext_vector_type(4))); \
            const v8i32 _bv = __builtin_shufflevector(__builtin_bit_cast(i32x4_, Bt[n][0]), __builtin_bit_cast(i32x4_, Bt[n][1]), 0, 1, 2, 3, 4, 5, 6, 7); \
            const v8i32 _av = __builtin_shufflevector(__builtin_bit_cast(i32x4_, At[m][0]), __builtin_bit_cast(i32x4_, At[m][1]), 0, 1, 2, 3, 4, 5, 6, 7); \
            asm volatile("s_nop 1\n\tv_mfma_scale_f32_16x16x128_f8f6f4 %0, %1, %2, %0, %3, %3 op_sel_hi:[0,0,0]" : "+v"(acc[ai][bj][m][n]) : "v"(_bv), "v"(_av), "v"(0x7f7f7f7f)); } \
        else { _Pragma("unroll") for (int k = 0; k < 2; ++k) acc[ai][bj][m][n] = __builtin_amdgcn_mfma_f32_16x16x32_bf16(Bt[n][k], At[m][k], acc[ai][bj][m][n], 0, 0, 0); } } \
        __builtin_amdgcn_s_setprio(0); } while (0)
#define PG8_WAIT_V(n) asm volatile("s_waitcnt vmcnt(" #n ")" ::: "memory")
#define PG8_WAIT_L(n) asm volatile("s_waitcnt lgkmcnt(" #n ")" ::: "memory")
#define PG8_BAR __builtin_amdgcn_s_barrier()
#define PG8_SCHED __builtin_amdgcn_sched_barrier(0)
    Unit cur, nxt; int ui = 0;
    if (!S.next(0, cur)) return;
    f32x4 acc[2][2][4][2];
#pragma unroll
    for (int a = 0; a < 2; ++a)
#pragma unroll
        for (int b = 0; b < 2; ++b)
#pragma unroll
            for (int m = 0; m < 4; ++m)
#pragma unroll
                for (int n = 0; n < 2; ++n) acc[a][b][m][n] = (f32x4){0.f, 0.f, 0.f, 0.f};
    bf16x8 At[4][2], B0[2][2], B1[2][2];
    const char* cA = (const char*)g.A + (size_t)cur.pm * tstep; const char* cB = (const char*)g.Bt + (size_t)cur.pn * tstep;
    S.a_ready(cur);
    if constexpr (SP2) {
        PG8_STAGE(PG8_SB(0, 0), cB, voffB); PG8_STAGE(PG8_SB(0, 1), cB + hstep, voffB); PG8_STAGE(PG8_SA(0, 0), cA, voffA); PG8_STAGE(PG8_SA(0, 1), cA + hstep, voffA);
        if (wr == 1) PG8_BAR;
        PG8_WAIT_V(2); PG8_BAR;
        PG8_STAGE(PG8_SB(1, 0), cB + kstep, voffB); PG8_STAGE(PG8_SA(1, 0), cA + kstep, voffA); PG8_STAGE(PG8_SB(1, 1), cB + hstep + kstep, voffB);
        PG8_WAIT_V(6); PG8_BAR;
    } else {
        PG8_STAGE(PG8_SB(0, 0), cB, voffB); PG8_STAGE(PG8_SA(0, 0), cA, voffA); PG8_STAGE(PG8_SB(0, 1), cB + hstep, voffB); PG8_STAGE(PG8_SA(0, 1), cA + hstep, voffA);
        if (wr == 1) PG8_BAR;
        PG8_WAIT_V(4); PG8_BAR;
        PG8_STAGE(PG8_SB(1, 0), cB + kstep, voffB); PG8_STAGE(PG8_SA(1, 0), cA + kstep, voffA); PG8_STAGE(PG8_SB(1, 1), cB + hstep + kstep, voffB);
        PG8_WAIT_V(6); PG8_BAR;
    }
    for (;;) {
        const bool has_next = S.next(ui + 1, nxt);
        const char* nA = has_next ? (const char*)g.A + (size_t)nxt.pm * tstep : cA; const char* nB = has_next ? (const char*)g.Bt + (size_t)nxt.pn * tstep : cB;
        for (int t = 0; t < nt; t += 2) {
            const bool last = (t == nt - 2);
            const char* a1 = cA + (size_t)(t + 1) * kstep;
            const char* a2 = last ? nA : cA + (size_t)(t + 2) * kstep; const char* b2 = last ? nB : cB + (size_t)(t + 2) * kstep;
            const char* a3 = a2 + kstep; const char* b3 = b2 + kstep;
            if (last && has_next) S.a_ready(nxt);
            if constexpr (SP2) {
            PG8_LDB(B0, 0, 0); PG8_LDB(B1, 0, 1); PG8_SCHED; PG8_LDA(At, 0, 0); PG8_STAGE(PG8_SA(1, 1), a1 + hstep, voffA);
            PG8_WAIT_V(8); PG8_WAIT_L(0); PG8_BAR; PG8_MMA(0, 0, At, B0); PG8_MMA(0, 1, At, B1); PG8_BAR; PG8_SCHED;
            PG8_LDA(At, 0, 1); PG8_STAGE(PG8_SB(0, 0), b2, voffB); PG8_STAGE(PG8_SB(0, 1), b2 + hstep, voffB); PG8_STAGE(PG8_SA(0, 0), a2, voffA);
            PG8_WAIT_V(8); PG8_WAIT_L(0); PG8_BAR; PG8_MMA(1, 0, At, B0); PG8_MMA(1, 1, At, B1); PG8_BAR; PG8_SCHED;
            PG8_LDB(B0, 1, 0); PG8_LDB(B1, 1, 1); PG8_SCHED; PG8_LDA(At, 1, 0); PG8_STAGE(PG8_SA(0, 1), a2 + hstep, voffA);
            PG8_WAIT_V(8); PG8_WAIT_L(0); PG8_BAR; PG8_MMA(0, 0, At, B0); PG8_MMA(0, 1, At, B1); PG8_BAR; PG8_SCHED;
            PG8_LDA(At, 1, 1); PG8_STAGE(PG8_SB(1, 0), b3, voffB); PG8_STAGE(PG8_SB(1, 1), b3 + hstep, voffB); PG8_STAGE(PG8_SA(1, 0), a3, voffA);
            PG8_WAIT_V(8); PG8_WAIT_L(0); PG8_BAR; PG8_MMA(1, 0, At, B0); PG8_MMA(1, 1, At, B1); PG8_BAR; PG8_SCHED;
            } else {
            PG8_LDB(B0, 0, 0); PG8_SCHED; PG8_LDA(At, 0, 0); PG8_STAGE(PG8_SA(1, 1), a1 + hstep, voffA);
            PG8_WAIT_L(8); PG8_BAR; PG8_WAIT_L(0); PG8_MMA(0, 0, At, B0); PG8_BAR; PG8_SCHED;
            PG8_LDB(B1, 0, 1); PG8_STAGE(PG8_SB(0, 0), b2, voffB);
            PG8_BAR; PG8_WAIT_L(0); PG8_MMA(0, 1, At, B1); PG8_BAR;
            PG8_LDA(At, 0, 1); PG8_STAGE(PG8_SA(0, 0), a2, voffA);
            PG8_BAR; PG8_WAIT_L(0); PG8_MMA(1, 0, At, B0); PG8_BAR; PG8_SCHED;
            PG8_STAGE(PG8_SB(0, 1), b2 + hstep, voffB);
            PG8_WAIT_V(6); PG8_BAR; PG8_MMA(1, 1, At, B1); PG8_BAR;
            PG8_LDB(B0, 1, 0); PG8_SCHED; PG8_LDA(At, 1, 0); PG8_STAGE(PG8_SA(0, 1), a2 + hstep, voffA);
            PG8_WAIT_L(8); PG8_BAR; PG8_WAIT_L(0); PG8_MMA(0, 0, At, B0); PG8_BAR; PG8_SCHED;
            PG8_LDB(B1, 1, 1); PG8_STAGE(PG8_SB(1, 0), b3, voffB);
            PG8_BAR; PG8_WAIT_L(0); PG8_MMA(0, 1, At, B1); PG8_BAR;
            PG8_LDA(At, 1, 1); PG8_STAGE(PG8_SA(1, 0), a3, voffA);
            PG8_BAR; PG8_WAIT_L(0); PG8_MMA(1, 0, At, B0); PG8_BAR; PG8_SCHED;
            PG8_STAGE(PG8_SB(1, 1), b3 + hstep, voffB);
            PG8_WAIT_V(6); PG8_BAR; PG8_MMA(1, 1, At, B1); PG8_BAR;
            }
        }
        if constexpr (FP8) asm volatile("s_nop 15" ::: "memory");
        if constexpr (ALIGN_EPI) { if (wr == 0) PG8_BAR; }
        if constexpr (!Epi::AFTER_DRAIN) { E(acc, cur, wr, wc, fr, fq); S.done(cur); }
        if (!has_next) break;
#pragma unroll
        for (int a = 0; a < 2; ++a)
#pragma unroll
            for (int b = 0; b < 2; ++b)
#pragma unroll
                for (int m = 0; m < 4; ++m)
#pragma unroll
                    for (int n = 0; n < 2; ++n) acc[a][b][m][n] = (f32x4){0.f, 0.f, 0.f, 0.f};
        cur = nxt; cA = nA; cB = nB; ++ui;
        if constexpr (ALIGN_EPI) { if (wr == 1) PG8_BAR; }
    }
    PG8_WAIT_V(0);
    if constexpr (!ALIGN_EPI) { if (wr == 0) PG8_BAR; }
    PG8_BAR;
    if constexpr (Epi::AFTER_DRAIN) { E.fused(acc, cur, wr, wc, fr, fq, lds, wid, lane); S.done(cur); }
#undef PG8_SA
#undef PG8_SB
#undef PG8_STAGE
#undef PG8_LDA
#undef PG8_LDB
#undef PG8_MMA
#undef PG8_WAIT_V
#undef PG8_WAIT_L
#undef PG8_BAR
#undef PG8_SCHED
}
}
namespace pg8 {
struct GroupedOrder {
    int nMe, nNe, per, nwg, G, c;
    __host__ __device__ void init(int nMe_, int nNe_, int G_, int c_) { nMe = nMe_; nNe = nNe_; per = nMe * nNe; nwg = 16 * per; G = G_; c = c_; }
    __host__ __device__ bool next(int i, Unit& u) const {
        const long L = (long)i * G + c; if (L >= nwg) return false;
        int wgid = (int)L; { const int q = nwg / NXCD, r = nwg % NXCD, xcd = wgid % NXCD, off = wgid / NXCD; wgid = (xcd < r ? xcd * (q + 1) : r * (q + 1) + (xcd - r) * q) + off; }
        const int e = wgid / per, l = wgid % per;
        u.pm = e * nMe + (l % nMe); u.pn = e * nNe + (l / nMe); return true;
    }
    __device__ __forceinline__ void a_ready(const Unit&) const {}
    __device__ __forceinline__ void done(const Unit&) const {}
};
struct In1Order {
    StaticOrder S0; int G, c;
    __host__ __device__ void init(int G_, int c_) { S0.init(16384, 29 * 256, G_, c_); G = G_; c = c_; }
    __host__ __device__ bool next(int i, Unit& u) const {
        const long L = (long)i * G + c;
        if (L < 1856) return S0.next(i, u);
        const int q = (int)L - 1856; if (q >= 136) return false;
        const int t = q % 17; u.pm = 64 + q / 17; u.pn = (t < 8) ? 4 + t : ((t < 16) ? 12 + t : 28); return true;
    }
    __device__ __forceinline__ void a_ready(const Unit&) const {}
    __device__ __forceinline__ void done(const Unit&) const {}
};
struct EpiStore {
    static constexpr bool PERM = true, AFTER_DRAIN = false;
    bf16_t* O; int ldc; int nNt; float sc;
    __device__ __forceinline__ void operator()(const f32x4 (&acc)[2][2][4][2], const Unit& u, int wr, int wc, int fr, int fq) const {
        const int row0 = u.pm * BM + wr * 64 + fr; const int col0 = (u.pn % nNt) * BM + wc * 32 + 8 * fq;
#pragma unroll
        for (int ai = 0; ai < 2; ++ai)
#pragma unroll
            for (int m = 0; m < 4; ++m) { bf16_t* rowp = O + (size_t)(row0 + ai * HALF + m * 16) * ldc + col0;
#pragma unroll
                for (int bj = 0; bj < 2; ++bj) { const f32x4 v0 = acc[ai][bj][m][0] * sc, v1 = acc[ai][bj][m][1] * sc;
                    u32x4 w; w.x = cvt_pk_bf16(v0[0], v0[1]); w.y = cvt_pk_bf16(v0[2], v0[3]); w.z = cvt_pk_bf16(v1[0], v1[1]); w.w = cvt_pk_bf16(v1[2], v1[3]);
                    *(u32x4*)(rowp + bj * HALF) = w; } }
    }
};
struct EpiSwiglu {
    static constexpr bool PERM = true, AFTER_DRAIN = false;
    unsigned char* O;
    __device__ __forceinline__ float sg(float a, float b) const { const float x = a * (1.f / 64.f); const float r = x * __builtin_amdgcn_rcpf(1.f + __expf(-x)) * (b * (1.f / 64.f)); return fminf(fmaxf(r, -448.f), 448.f); }
    __device__ __forceinline__ void operator()(const f32x4 (&acc)[2][2][4][2], const Unit& u, int wr, int wc, int fr, int fq) const {
        const int row0 = u.pm * BM + wr * 64 + fr; const int col0 = (u.pn % 16) * HALF + wc * 32 + 8 * fq;
#pragma unroll
        for (int ai = 0; ai < 2; ++ai)
#pragma unroll
            for (int m = 0; m < 4; ++m) { unsigned char* rowp = O + (size_t)(row0 + ai * HALF + m * 16) * 2048 + col0;
                const f32x4 a0 = acc[ai][0][m][0], a1 = acc[ai][0][m][1], b0 = acc[ai][1][m][0], b1 = acc[ai][1][m][1];
                int lo = 0, hi = 0;
                lo = __builtin_amdgcn_cvt_pk_fp8_f32(sg(a0[0], b0[0]), sg(a0[1], b0[1]), lo, false); lo = __builtin_amdgcn_cvt_pk_fp8_f32(sg(a0[2], b0[2]), sg(a0[3], b0[3]), lo, true);
                hi = __builtin_amdgcn_cvt_pk_fp8_f32(sg(a1[0], b1[0]), sg(a1[1], b1[1]), hi, false); hi = __builtin_amdgcn_cvt_pk_fp8_f32(sg(a1[2], b1[2]), sg(a1[3], b1[3]), hi, true);
                typedef unsigned u32x2 __attribute__((ext_vector_type(2)));
                *(u32x2*)rowp = (u32x2){(unsigned)lo, (unsigned)hi}; }
    }
};
struct EpiRes {
    static constexpr bool PERM = false, AFTER_DRAIN = false;
    const float* Xlat; const float* Xctx; float* H; const float* gate;
    __device__ __forceinline__ void operator()(const f32x4 (&acc)[2][2][4][2], const Unit& u, int wr, int wc, int fr, int fq) const {
        const int row0 = u.pm * BM + wr * 64 + fr, col0 = u.pn * BM + wc * 32 + 4 * fq;
        const float* gp = gate + (size_t)((u.pm < 64) ? (u.pm >> 3) : 8) * 12288 + col0;
        f32x4 g[2][2];
#pragma unroll
        for (int bj = 0; bj < 2; ++bj)
#pragma unroll
            for (int n = 0; n < 2; ++n) g[bj][n] = *(const f32x4*)(gp + bj * HALF + n * 16);
        const float* sbase = (u.pm < 64) ? Xlat : Xctx - (size_t)16384 * 2048;
#pragma unroll
        for (int ai = 0; ai < 2; ++ai)
#pragma unroll
            for (int m = 0; m < 4; ++m) { const int row = row0 + ai * HALF + m * 16;
                const float* src = sbase + (size_t)row * 2048 + col0; float* dst = H + (size_t)row * 2048 + col0;
#pragma unroll
                for (int bj = 0; bj < 2; ++bj)
#pragma unroll
                    for (int n = 0; n < 2; ++n) { const int c = bj * HALF + n * 16;
                        const f32x4 x = *(const f32x4*)(src + c);
                        *(f32x4*)(dst + c) = x + g[bj][n] * acc[ai][bj][m][n]; } }
    }
};
}
#ifndef PG8_SP2
#define PG8_SP2 true
#endif
#ifndef PG8_ALIGN
#define PG8_ALIGN true
#endif
constexpr int NWAVES = 8;
constexpr int NTHR = NWAVES * 64;
#ifndef MK_ONE_LAUNCH
#define MK_ONE_LAUNCH 1
#endif
constexpr int D = 2048, NB = 8, SEQ = 2048, CTXL = 256;
constexpr int M_LAT = NB * SEQ, M_CTX = NB * CTXL, M_ALL = M_LAT + M_CTX;
constexpr int LD0 = 6400, LD1 = 7424;
constexpr int EV_IN = 6176, OD_IN = 7184;
constexpr int NE_ = 16, FF = 2048;
constexpr int ME0 = 2304, ME1 = 2048;
constexpr float EPS = 1e-6f;
constexpr int C0_X1 = 0, C0_X2 = 1024, C0_V = 2048, C0_GQ = 3072, C0_GK = 3584, C0_GV = 4096, C0_GR = 5120, C0_CODE = 6144;
constexpr int C1_MQ = 0, C1_MK = 1024, C1_MV = 2048, C1_MO = 3072, C1_DQ = 4096, C1_DK = 5120, C1_DV = 6144, C1_G = 7168;
constexpr size_t MiB = 1u << 20;
constexpr size_t WS_CTL = 0, CTL_ZERO_BYTES = 1 * MiB;
constexpr size_t WS_MOD = 1 * MiB;
constexpr size_t WS_AFF = 2 * MiB;
constexpr size_t WS_SEL = 4 * MiB;
constexpr size_t WS_TOK = 6 * MiB;
constexpr size_t WS_GW  = 7 * MiB;
constexpr size_t WS_FTL = 8 * MiB;
constexpr size_t WS_FTC = 40 * MiB;
constexpr size_t WS_WIN0 = 44 * MiB;
constexpr size_t WS_WIN1 = 69 * MiB;
constexpr size_t WS_WOUT = 98 * MiB;
constexpr size_t WS_W13 = 114 * MiB;
constexpr size_t WS_W2 = 626 * MiB;
constexpr size_t WS_H = 882 * MiB;
constexpr size_t WS_A = 1026 * MiB;
constexpr size_t WS_Y = 1098 * MiB;
constexpr size_t WS_P = 1170 * MiB;
constexpr size_t WS_XS = WS_P, WS_YS = WS_P;
constexpr size_t WS_MIX = 1431 * MiB;
constexpr size_t WS_XV = WS_MIX, WS_Z = WS_MIX + 108 * MiB, WS_OG = WS_MIX + 144 * MiB;
constexpr size_t WS_HID = WS_MIX;
constexpr size_t WS_XT = 1719 * MiB;
constexpr size_t WS_YT = 1815 * MiB;
constexpr size_t WS_FTT = 1847 * MiB;
constexpr size_t WS_GQ = 1864 * MiB;
constexpr size_t WS_GDEC = 1972 * MiB;
constexpr size_t WS_MQK = WS_GQ;
constexpr size_t WS_MLS = WS_GQ + 80 * MiB;
constexpr size_t WS_END = 1974 * MiB;
constexpr int CW_BAR = 4096;
constexpr int RING_OFF = 0, RING_BYTES = 131072;
constexpr int LDSCTL_OFF = 146432, MISC_OFF = LDSCTL_OFF + 320;
constexpr int LDS_BYTES = 147456;
#define GAS __attribute__((address_space(1)))
#define LAS __attribute__((address_space(3)))
typedef unsigned short bf16;
typedef unsigned v4u __attribute__((ext_vector_type(4)));
typedef unsigned v2u __attribute__((ext_vector_type(2)));
typedef float f32x4 __attribute__((ext_vector_type(4)));
typedef short bf16x8 __attribute__((ext_vector_type(8)));
typedef GAS unsigned gu32;
#define RLX_AGENT __ATOMIC_RELAXED, __HIP_MEMORY_SCOPE_AGENT
#define LDS_WAIT() asm volatile("s_waitcnt lgkmcnt(0)" ::: "memory")
#define VM_WAIT() asm volatile("s_waitcnt vmcnt(0)" ::: "memory")
typedef float f32x2v_ __attribute__((ext_vector_type(2)));
typedef __bf16 bf16x2v_ __attribute__((ext_vector_type(2)));
__device__ __forceinline__ unsigned pk2(float lo, float hi) { return __builtin_bit_cast(unsigned, __builtin_convertvector((f32x2v_){lo, hi}, bf16x2v_)); }
__device__ __forceinline__ unsigned f2bf(float f) { return pk2(f, 0.f) & 0xffffu; }
__device__ __forceinline__ unsigned pk4_fp8(float a, float b, float c, float d) { int r = 0; r = __builtin_amdgcn_cvt_pk_fp8_f32(a, b, r, false); r = __builtin_amdgcn_cvt_pk_fp8_f32(c, d, r, true); return (unsigned)r; }
__device__ __forceinline__ float bf2f(unsigned short b) { return __builtin_bit_cast(float, ((unsigned)b) << 16); }
__device__ __forceinline__ float bflo(unsigned w) { return __builtin_bit_cast(float, w << 16); }
__device__ __forceinline__ float bfhi(unsigned w) { return __builtin_bit_cast(float, w & 0xffff0000u); }
__device__ __forceinline__ float siluf(float x) { return x * __builtin_amdgcn_rcpf(1.f + __expf(-x)); }
__device__ __forceinline__ float sigmoidf_(float x) { return __builtin_amdgcn_rcpf(1.f + __expf(-x)); }
__device__ __forceinline__ float logsigmoidf_(float x) { return fminf(x, 0.f) - __logf(1.f + __expf(-fabsf(x))); }
template <int CTRL> __device__ __forceinline__ float dppmov(float v) { return __builtin_bit_cast(float, __builtin_amdgcn_update_dpp(0, __builtin_bit_cast(int, v), CTRL, 0xf, 0xf, true)); }
__device__ __forceinline__ float row16_sum(float v) { v += dppmov<0xB1>(v); v += dppmov<0x4E>(v); v += dppmov<0x124>(v); v += dppmov<0x128>(v); return v; }
__device__ __forceinline__ float row16_max(float v) { v = fmaxf(v, dppmov<0xB1>(v)); v = fmaxf(v, dppmov<0x4E>(v)); v = fmaxf(v, dppmov<0x124>(v)); v = fmaxf(v, dppmov<0x128>(v)); return v; }
__device__ __forceinline__ float xrow_sum(float v) {
    float a = v, b = v; asm volatile("s_nop 1\n\tv_permlane16_swap_b32 %0, %1" : "+v"(a), "+v"(b)); v = a + b; a = v; b = v;
    asm volatile("s_nop 1\n\tv_permlane32_swap_b32 %0, %1" : "+v"(a), "+v"(b)); return a + b; }
__device__ __forceinline__ float xrow_max(float v) {
    float a = v, b = v; asm volatile("s_nop 1\n\tv_permlane16_swap_b32 %0, %1" : "+v"(a), "+v"(b)); v = fmaxf(a, b); a = v; b = v;
    asm volatile("s_nop 1\n\tv_permlane32_swap_b32 %0, %1" : "+v"(a), "+v"(b)); return fmaxf(a, b); }
__device__ __forceinline__ float wave_sum(float v) { return xrow_sum(row16_sum(v)); }
#define XB_TMO      128
#define XB_XCNT(j)  (256  + 64 * (j))
#define XB_XSUB(j)  (1280 + 64 * (j))
#define XB_XGEN(j)  (2304 + 64 * (j))
#define XB_TOP      3328
#define XB_TOPGEN   3392
#define XCD_BAR_WORDS 3456
#define XB_SPIN_CAP (1u << 18)

__device__ __forceinline__ unsigned xb_ld(unsigned* p)              { return __hip_atomic_load(p, __ATOMIC_RELAXED, __HIP_MEMORY_SCOPE_AGENT); }
__device__ __forceinline__ unsigned xb_add(unsigned* p, unsigned v) { return __hip_atomic_fetch_add(p, v, __ATOMIC_RELAXED, __HIP_MEMORY_SCOPE_AGENT); }
__device__ __forceinline__ unsigned xb_xcc_id() { return (unsigned)__builtin_amdgcn_s_getreg((3 << 11) | 20) & 0xFu; }
#define XB_SPIN(cond, bar) do { unsigned _sp = 0; while (cond) { __builtin_amdgcn_s_sleep(1); \
    if ((++_sp & 255u) == 0u) { if (xb_ld(&(bar)[XB_TMO])) break; if (_sp > XB_SPIN_CAP) { atomicAdd(&(bar)[XB_TMO], 1u); break; } } } } while (0)

struct XcdBarrier {
    unsigned* bar; unsigned x;
    volatile LAS unsigned* st;
};

__device__ __forceinline__ XcdBarrier xcd_barrier_post(unsigned* bar, volatile LAS unsigned* st) {
    XcdBarrier b; b.bar = bar; b.x = xb_xcc_id(); b.st = st;
    if (threadIdx.x == 0) (void)xb_add(&bar[XB_XCNT(b.x)], 1u);
    return b;
}
__device__ __forceinline__ void xcd_barrier_complete(unsigned* bar, unsigned x, unsigned& nloc, unsigned& nx) {
    const unsigned G = gridDim.x * gridDim.y * gridDim.z;
    unsigned sum, cnt, mine, sp = 0u;
    for (;;) {
        sum = 0u; cnt = 0u; mine = 0u;
#pragma unroll
        for (unsigned j = 0; j < 16; ++j) { const unsigned c = xb_ld(&bar[XB_XCNT(j)]); sum += c; cnt += (c > 0u) ? 1u : 0u; mine = (j == x) ? c : mine; }
        if (sum == G) break;
        __builtin_amdgcn_s_sleep(1);
        if ((++sp & 255u) == 0u) { if (xb_ld(&bar[XB_TMO])) break; if (sp > XB_SPIN_CAP) { atomicAdd(&bar[XB_TMO], 1u); break; } }
    }
    nloc = mine > 0u ? mine : 1u; nx = cnt > 0u ? cnt : 1u;
}

__device__ __forceinline__ void xcd_barrier(const XcdBarrier& b) {
    asm volatile("s_waitcnt vmcnt(0)" ::: "memory");
    __syncthreads();
    if (threadIdx.x == 0) {
        unsigned* bar = b.bar;
        __builtin_amdgcn_s_waitcnt(0);
        unsigned nloc = b.st[0], nx = b.st[1];
        if (nloc == 0u) { xcd_barrier_complete(bar, b.x, nloc, nx); b.st[0] = nloc; b.st[1] = nx; }
        const unsigned old = xb_add(&bar[XB_XSUB(b.x)], 1u);
        const unsigned gen = old / nloc;
        if (old + 1u == (gen + 1u) * nloc) {
            __builtin_amdgcn_fence(__ATOMIC_RELEASE, "agent");
            asm volatile("s_waitcnt vmcnt(0)" ::: "memory");
            const unsigned og = xb_add(&bar[XB_TOP], 1u);
            const unsigned tg = og / nx;
            if (og + 1u == (tg + 1u) * nx) xb_add(&bar[XB_TOPGEN], 1u);
            else XB_SPIN(xb_ld(&bar[XB_TOPGEN]) == tg, bar);
            __builtin_amdgcn_fence(__ATOMIC_ACQUIRE, "agent");
            xb_add(&bar[XB_XGEN(b.x)], 1u);
            asm volatile("s_waitcnt vmcnt(0)" ::: "memory");
        } else {
            XB_SPIN(xb_ld(&bar[XB_XGEN(b.x)]) == gen, bar);
            __builtin_amdgcn_fence(__ATOMIC_ACQUIRE, "agent");
            asm volatile("s_waitcnt vmcnt(0)" ::: "memory");
        }
    }
    __syncthreads();
}

typedef short s16x4 __attribute__((ext_vector_type(4)));
__device__ __forceinline__ bf16x8 tr_frag(const LAS bf16* T, int ld, int r0, int c0, int lane) {
    const int g = lane >> 4, q = (lane & 15) >> 2, p = lane & 3;
    const LAS bf16* a = T + (r0 + 8 * g + q) * ld + c0 + 4 * p;
    const s16x4 lo = __builtin_amdgcn_ds_read_tr16_b64_v4i16((LAS s16x4*)a);
    const s16x4 hi = __builtin_amdgcn_ds_read_tr16_b64_v4i16((LAS s16x4*)(a + 4 * ld));
    return (bf16x8){lo[0], lo[1], lo[2], lo[3], hi[0], hi[1], hi[2], hi[3]};
}
__device__ __forceinline__ float wave_incl_sum(float v, int lane) {
#pragma unroll
    for (int o = 1; o < 64; o <<= 1) { const float t = __shfl_up(v, o); v = (lane >= o) ? v + t : v; }
    return v;
}
__device__ __forceinline__ float wave_incl_max(float v, int lane) {
#pragma unroll
    for (int o = 1; o < 64; o <<= 1) { const float t = __shfl_up(v, o); v = (lane >= o) ? fmaxf(v, t) : v; }
    return v;
}
__device__ __forceinline__ float wave_max(float v) { return xrow_max(row16_max(v)); }
struct Frame {
    LAS unsigned char* lds;
    volatile LAS unsigned* MISC;
    gu32* ctl;
    int tid, lane, wave;
    int bid, G;
    const float* in[35];
    float* out;
    unsigned char* ws;
};
enum { I_X = 0, I_C, I_CTX, I_CCTX, I_ADAW, I_ADAB, I_N1G, I_N2G, I_OUTW, I_RTW, I_W1, I_W3, I_W2, I_FING, I_EVW, I_HCW, I_HCB, I_HPW1, I_HPB1, I_HFREQ, I_HPW2, I_HPB2, I_HPW3, I_HBIAS,
       I_GGW2, I_GGB, I_GNG, I_ODW, I_MCW, I_MCB, I_MIGB, I_MFGB, I_MNG, I_DLAM, I_DNG };

__device__ __forceinline__ float grp16_max(float v) { return row16_max(v); }
__device__ __forceinline__ float grp16_sum(float v) { return row16_sum(v); }
constexpr int CW_CVT = 64;
typedef unsigned u32x4_ __attribute__((ext_vector_type(4)));
struct CvtItem { const float* src; int ldn, c0, ncols, k0; bf16* dst; int d0, dstep, fp8; };
__device__ __forceinline__ CvtItem cvt_decode(Frame& F, int it) {
    CvtItem c; c.dstep = 128; c.ncols = 256; c.fp8 = 0;
    bf16* Win0 = (bf16*)(F.ws + WS_WIN0); bf16* Win1 = (bf16*)(F.ws + WS_WIN1); bf16* Wout = (bf16*)(F.ws + WS_WOUT); bf16* W13 = (bf16*)(F.ws + WS_W13); bf16* W2t = (bf16*)(F.ws + WS_W2);
    constexpr int N_IN0 = 16 * 25, N_IN1 = 16 * 29, N_OUT = 2 * 16 * 8;
    if (it < N_IN0) { const int kb = it / 25, cb = it % 25; c.src = F.in[I_EVW]; c.ldn = EV_IN; c.k0 = kb * 128; c.dst = Win0; c.c0 = cb * 256; c.d0 = cb * 256; if (cb == 24) c.ncols = 32; return c; }
    it -= N_IN0;
    if (it < N_IN1) { const int kb = it / 29, cb = it % 29; c.src = F.in[I_ODW]; c.ldn = OD_IN; c.k0 = kb * 128; c.dst = Win1;
        if (cb < 16) { c.c0 = cb * 256; c.d0 = cb * 256; } else if (cb < 28) { c.c0 = 4112 + (cb - 16) * 256; c.d0 = 4096 + (cb - 16) * 256; } else { c.c0 = 4096; c.d0 = 7168; c.ncols = 16; }
        return c; }
    it -= N_IN1;
    if (it < N_OUT) { const int l = it >> 7, q = it & 127, kb = q >> 3, cb = q & 7; c.src = F.in[I_OUTW] + (size_t)l * 2048 * 2048; c.ldn = 2048; c.k0 = kb * 128; c.dst = Wout + (size_t)l * 2048 * 2048; c.c0 = cb * 256; c.d0 = cb * 256; return c; }
    it -= N_OUT;
    { const int cb = it & 7; it >>= 3; const int kb = it & 15; it >>= 4; const int which = it % 3; it /= 3; const int e = it & 15, l = it >> 4;
      const size_t so = ((size_t)l * 16 + e) * 2048 * 2048; c.ldn = 2048; c.k0 = kb * 128; c.c0 = cb * 256; c.fp8 = 1;
      if (which == 0) { c.src = F.in[I_W1] + so; c.dst = W13 + ((size_t)l * 16 + e) * 4096 * 1024; c.d0 = cb * 512; c.dstep = 256; }
      else if (which == 1) { c.src = F.in[I_W3] + so; c.dst = W13 + ((size_t)l * 16 + e) * 4096 * 1024; c.d0 = cb * 512 + 128; c.dstep = 256; }
      else { c.src = F.in[I_W2] + so; c.dst = W2t + ((size_t)l * 16 + e) * 2048 * 1024; c.d0 = cb * 256; }
      return c; }
}
__device__ __forceinline__ void cvt_load(const CvtItem& c, int wave, int lane, f32x4 (&v)[16]) {
    const bool ok = 4 * lane < c.ncols;
#pragma unroll
    for (int i = 0; i < 16; ++i) v[i] = ok ? *(const GAS f32x4*)(c.src + (size_t)(c.k0 + 16 * wave + i) * c.ldn + c.c0 + 4 * lane) : (f32x4){0.f, 0.f, 0.f, 0.f};
}
constexpr int CVT_NPRE = 16 * 25 + 16 * 29 + 2 * 16 * 8, CVT_L0_END = CVT_NPRE + 6144, CVT_L1_END = CVT_NPRE + 12288;
constexpr int CVT_LATE0 = 64 * 10 + 192 * 14, CVT_LATE1 = 128 * 5 + 56 * 10;
constexpr int CVT_NEARLY = CVT_NPRE + 12288 - CVT_LATE0 - CVT_LATE1;
__device__ __forceinline__ int cvt_early_item(int j) {
    if (j < CVT_L0_END - CVT_LATE0) return j;
    return j + CVT_LATE0;
}
template <bool DYN> __device__ __forceinline__ void cvt_run(Frame& F, int first, int cnt) {
    constexpr int TLD = 264;
    LAS bf16* T = (LAS bf16*)(F.lds);
    LAS int* nxt = (LAS int*)(F.lds + 128 * TLD * 2);
    const int NIT = DYN ? CVT_NEARLY : cnt;
    __syncthreads();
    int jn = 0;
    if (DYN) { if (F.tid == 0) nxt[0] = (int)__hip_atomic_fetch_add((unsigned*)(F.ctl + CW_CVT), 1u, __ATOMIC_RELAXED, __HIP_MEMORY_SCOPE_AGENT);
        __syncthreads(); jn = nxt[0]; }
    int j = jn;
    f32x4 v[16];
    CvtItem cur = cvt_decode(F, j < NIT ? (DYN ? cvt_early_item(j) : first + j) : 0);
    if (j < NIT) cvt_load(cur, F.wave, F.lane, v);
    while (j < NIT) {
        __syncthreads();
        if (DYN) { if (F.tid == 0) nxt[0] = (int)__hip_atomic_fetch_add((unsigned*)(F.ctl + CW_CVT), 1u, __ATOMIC_RELAXED, __HIP_MEMORY_SCOPE_AGENT); }
        { const float wsc = cur.fp8 ? 64.f : 1.f;
#pragma unroll
        for (int i = 0; i < 16; ++i) { v2u w; w.x = pk2(v[i][0] * wsc, v[i][1] * wsc); w.y = pk2(v[i][2] * wsc, v[i][3] * wsc); *(LAS v2u*)(T + (16 * F.wave + i) * TLD + 4 * F.lane) = w; } }
        __syncthreads();
        const int jnext = DYN ? nxt[0] : j + 1;
        const CvtItem me = cur;
        if (jnext < NIT) { cur = cvt_decode(F, DYN ? cvt_early_item(jnext) : first + jnext); cvt_load(cur, F.wave, F.lane, v); }
        const int fr = F.lane & 15, fq = F.lane >> 4;
#pragma unroll
        for (int x = 0; x < 2; ++x) { const int jc = 32 * F.wave + 16 * x + fr; const int drow = me.d0 + (jc >> 7) * me.dstep + (jc & 127);
#pragma unroll
            for (int r = 0; r < 4; ++r) { const bf16x8 f = tr_frag(T, TLD, 32 * r, 32 * F.wave + 16 * x, F.lane);
                if (me.fp8) { const u32x4_ fw = __builtin_bit_cast(u32x4_, f); v2u o8; o8.x = pk4_fp8(bflo(fw.x), bfhi(fw.x), bflo(fw.y), bfhi(fw.y)); o8.y = pk4_fp8(bflo(fw.z), bfhi(fw.z), bflo(fw.w), bfhi(fw.w));
                    *(GAS v2u*)((unsigned char*)me.dst + (size_t)drow * 2048 + me.k0 + 32 * r + 8 * fq) = o8; }
                else if (jc < me.ncols) *(GAS bf16x8*)(me.dst + (size_t)drow * 2048 + me.k0 + 32 * r + 8 * fq) = f; } }
        j = jnext;
    }
    __syncthreads();
}
__device__ __forceinline__ void p0_convert(Frame& F) {
    { bf16* Win0 = (bf16*)(F.ws + WS_WIN0); bf16* Win1 = (bf16*)(F.ws + WS_WIN1);
      const int gt = F.bid * NTHR + F.tid, NT = F.G * NTHR; const v4u z = {0u, 0u, 0u, 0u};
      for (int i = gt; i < (LD0 - EV_IN) * 256; i += NT) *(GAS v4u*)(Win0 + (size_t)EV_IN * 2048 + (size_t)i * 8) = z;
      for (int i = gt; i < (LD1 - OD_IN) * 256; i += NT) *(GAS v4u*)(Win1 + (size_t)OD_IN * 2048 + (size_t)i * 8) = z; }
    if (F.G == 256) cvt_run<true>(F, 0, 0);
    else { cvt_run<true>(F, 0, 0); if (F.bid == 0) { cvt_run<false>(F, CVT_L0_END - CVT_LATE0, CVT_LATE0); cvt_run<false>(F, CVT_L1_END - CVT_LATE1, CVT_LATE1); } }
}
__device__ __forceinline__ void cvt_late(Frame& F, int first, int w0, int per) {
    if (F.G != 256 || F.bid < w0) return;
    cvt_run<false>(F, first + (F.bid - w0) * per, per);
}
__device__ __forceinline__ void p0_adaln(Frame& F) {
    if (F.bid >= 192) return;
    LAS float* s = (LAS float*)(F.lds);
    LAS float* red = (LAS float*)(F.lds + 9 * 2048 * 4);
    for (int i = F.tid; i < 9 * 2048; i += NTHR) { const float v = (i < 8 * 2048) ? F.in[I_C][i] : F.in[I_CCTX][i - 8 * 2048]; s[i] = siluf(v); }
    __syncthreads();
    float* MOD = (float*)(F.ws + WS_MOD);
    for (int u = F.bid; u < 192; u += F.G) {
        const int l = u / 96, j0 = (u % 96) * 128, jj = F.tid & 127, kq = F.tid >> 7;
        const float* W = F.in[I_ADAW] + (size_t)l * 2048 * 12288 + j0 + jj;
        float acc[9];
#pragma unroll
        for (int r = 0; r < 9; ++r) acc[r] = 0.f;
        for (int k = kq * 512; k < kq * 512 + 512; k += 4) {
            float w[4];
#pragma unroll
            for (int q = 0; q < 4; ++q) w[q] = W[(size_t)(k + q) * 12288];
#pragma unroll
            for (int r = 0; r < 9; ++r) { const f32x4 sv = *(const LAS f32x4*)(s + r * 2048 + k); acc[r] += sv[0] * w[0] + sv[1] * w[1] + sv[2] * w[2] + sv[3] * w[3]; }
        }
#pragma unroll
        for (int r = 0; r < 9; ++r) red[(kq * 9 + r) * 128 + jj] = acc[r];
        __syncthreads();
        for (int i = F.tid; i < 9 * 128; i += NTHR) { const int r = i >> 7, j = i & 127;
            MOD[((size_t)l * 9 + r) * 12288 + j0 + j] = red[(0 * 9 + r) * 128 + j] + red[(1 * 9 + r) * 128 + j] + red[(2 * 9 + r) * 128 + j] + red[(3 * 9 + r) * 128 + j] + F.in[I_ADAB][l * 12288 + j0 + j]; }
        __syncthreads();
    }
}
__device__ __forceinline__ void p0_filters(Frame& F) {
    LAS float* h1 = (LAS float*)(F.lds);
    LAS float* h2 = h1 + 512;
    LAS float* ft = h2 + 512;
    for (int uu = F.bid; uu < 2304; uu += F.G) {
        const int jb = uu & 7, u = uu >> 3;
        const bool lat = u < 256; const int L = lat ? 2048 : 256; const int p0 = (lat ? u : u - 256) * 8;
        float* FT = (float*)(F.ws + (lat ? WS_FTL : WS_FTC));
        __syncthreads();
        if (F.tid < 8 * 33) { const int pp = F.tid / 33, i = F.tid % 33; const float pos = (float)(p0 + pp);
            float v;
            if (i == 0) v = pos / (float)(L - 1);
            else { const int bi = (i - 1) & 15; const float band = 1e-4f + (float)bi * ((15.f - 1e-4f) / 15.f); const float ang = (6.283185307179586f / (float)L) * pos * band; v = (i <= 16) ? cosf(ang) : -sinf(ang); }
            ft[pp * 36 + i] = v; }
        __syncthreads();
        { const int pp = F.tid >> 6, j = F.tid & 63; float a = F.in[I_HPB1][j];
#pragma unroll 11
          for (int i = 0; i < 33; ++i) a += ft[pp * 36 + i] * F.in[I_HPW1][i * 64 + j];
          h1[pp * 64 + j] = sinf(F.in[I_HFREQ][j] * a); }
        __syncthreads();
        { const int pp = F.tid >> 6, j = F.tid & 63; float a = F.in[I_HPB2][j];
#pragma unroll 16
          for (int i = 0; i < 64; ++i) a += h1[pp * 64 + i] * F.in[I_HPW2][i * 64 + j];
          h2[pp * 64 + j] = sinf(F.in[I_HFREQ][64 + j] * a); }
        __syncthreads();
        { const int j = jb * 512 + F.tid;
            float acc[8];
#pragma unroll
            for (int pp = 0; pp < 8; ++pp) acc[pp] = 0.f;
#pragma unroll 16
            for (int i = 0; i < 64; ++i) { const float w = F.in[I_HPW3][(size_t)i * 4096 + j];
#pragma unroll
                for (int pp = 0; pp < 8; ++pp) acc[pp] += h2[pp * 64 + i] * w; }
            const int order = j >> 11, dir = (j >> 10) & 1, ch = j & 1023;
            const float da = -3.0701134573253945f, db = -15.350567286626973f;
            const float delta = fabsf(da + (float)ch * ((db - da) / 1023.f));
#pragma unroll
            for (int pp = 0; pp < 8; ++pp) { const int p = p0 + pp; const float t = (float)p / (float)(L - 1); const float val = acc[pp] * __expf(-t * delta);
                if (dir == 0) FT[((size_t)order * (2 * L - 1) + (L - 1 + p)) * 1024 + ch] = val;
                else if (p >= 1) FT[((size_t)order * (2 * L - 1) + (L - 1 - p)) * 1024 + ch] = val; }
        }
    }
    __syncthreads();
}

__device__ __forceinline__ void load_row(const float* p, int lane, f32x4 (&v)[8]) {
#pragma unroll
    for (int i = 0; i < 8; ++i) v[i] = *(const GAS f32x4*)(p + 4 * (lane + 64 * i));
}
__device__ __forceinline__ float row_rstd(const f32x4 (&v)[8]) {
    float s = 0.f;
#pragma unroll
    for (int i = 0; i < 8; ++i) s += (v[i][0] * v[i][0] + v[i][1] * v[i][1]) + (v[i][2] * v[i][2] + v[i][3] * v[i][3]);
    return 1.f / sqrtf(wave_sum(s) * (1.f / 2048.f) + EPS);
}
__device__ __forceinline__ void modulate_store(f32x4 (&v)[8], float rstd, const float* g, const float* shift, const float* scale, bf16* orow, int lane) {
#pragma unroll
    for (int i = 0; i < 8; ++i) { const int c = 4 * (lane + 64 * i);
        const f32x4 gg = *(const GAS f32x4*)(g + c), sh = *(const GAS f32x4*)(shift + c), sc = *(const GAS f32x4*)(scale + c);
        v[i] = (v[i] * rstd * gg) * (sc + 1.f) + sh;
        v2u w; w.x = pk2(v[i][0], v[i][1]); w.y = pk2(v[i][2], v[i][3]);
        *(GAS v2u*)(orow + c) = w; }
}
__device__ __forceinline__ void modulate_store8(f32x4 (&v)[8], float rstd, const float* g, const float* shift, const float* scale, unsigned char* orow, int lane) {
#pragma unroll
    for (int i = 0; i < 8; ++i) { const int c = 4 * (lane + 64 * i);
        const f32x4 gg = *(const GAS f32x4*)(g + c), sh = *(const GAS f32x4*)(shift + c), sc = *(const GAS f32x4*)(scale + c);
        v[i] = (v[i] * rstd * gg) * (sc + 1.f) + sh;
        *(GAS unsigned*)(orow + c) = pk4_fp8(v[i][0], v[i][1], v[i][2], v[i][3]); }
}
__device__ __forceinline__ const float* xrow_ptr(Frame& F, int r) { return (r < M_LAT) ? F.in[I_X] + (size_t)r * D : F.in[I_CTX] + (size_t)(r - M_LAT) * D; }
__device__ __forceinline__ int row_b(int r) { return (r < M_LAT) ? (r >> 11) : 8; }

__device__ __forceinline__ void mod_params(const float* g, const float* shift, const float* scale, int lane, f32x4 (&gs)[8], f32x4 (&sh)[8]) {
#pragma unroll
    for (int i = 0; i < 8; ++i) { const int c = 4 * (lane + 64 * i); gs[i] = *(const GAS f32x4*)(g + c) * (*(const GAS f32x4*)(scale + c) + 1.f); sh[i] = *(const GAS f32x4*)(shift + c); }
}
__device__ __forceinline__ void ph_norm1_l0(Frame& F) {
    const int gw = F.bid * NWAVES + F.wave, NGW = F.G * NWAVES;
    const float* MOD = (const float*)(F.ws + WS_MOD); bf16* A = (bf16*)(F.ws + WS_A);
    const int per = (M_ALL + NGW - 1) / NGW, r0 = gw * per, r1 = (r0 + per < M_ALL) ? r0 + per : M_ALL;
    f32x4 v[8], gs[8], sh[8]; int curb = -1;
    if (r0 < r1) load_row(xrow_ptr(F, r0), F.lane, v);
    for (int r = r0; r < r1; ++r) { f32x4 nv[8]; if (r + 1 < r1) load_row(xrow_ptr(F, r + 1), F.lane, nv);
        const int bb = row_b(r); if (bb != curb) { const float* m = MOD + (size_t)bb * 12288; mod_params(F.in[I_N1G], m, m + 2048, F.lane, gs, sh); curb = bb; }
        const float rs = row_rstd(v);
        bf16* orow = A + (size_t)r * D;
#pragma unroll
        for (int i = 0; i < 8; ++i) { const f32x4 o = (v[i] * rs) * gs[i] + sh[i]; v2u w; w.x = pk2(o[0], o[1]); w.y = pk2(o[2], o[3]); *(GAS v2u*)(orow + 4 * (F.lane + 64 * i)) = w; }
#pragma unroll
        for (int i = 0; i < 8; ++i) v[i] = nv[i]; }
}
__device__ __forceinline__ void ph_codes_skinny(Frame& F) {
    constexpr int WLD = 2056;
    LAS bf16* W = (LAS bf16*)(F.lds);
    const bf16* A = (const bf16*)(F.ws + WS_A); const bf16* Wc = (const bf16*)(F.ws + WS_WIN0) + (size_t)6144 * 2048; bf16* P = (bf16*)(F.ws + WS_P);
    __syncthreads();
    for (int i = F.tid; i < 32 * 256; i += NTHR) { const int r = i >> 8, ch = i & 255; *(LAS v4u*)(W + r * WLD + ch * 8) = *(const GAS v4u*)(Wc + (size_t)r * 2048 + ch * 8); }
    __syncthreads();
    const int gw = F.bid * NWAVES + F.wave, NGW = F.G * NWAVES; const int fr = F.lane & 15, fq = F.lane >> 4;
    for (int task = gw; task < M_ALL / 16; task += NGW) { const int r0 = task * 16;
        f32x4 acc[2] = {(f32x4){0.f, 0.f, 0.f, 0.f}, (f32x4){0.f, 0.f, 0.f, 0.f}};
        const bf16* ap = A + (size_t)(r0 + fr) * 2048 + 8 * fq;
#pragma unroll 8
        for (int ks = 0; ks < 64; ++ks) { const bf16x8 af = *(const GAS bf16x8*)(ap + 32 * ks);
#pragma unroll
            for (int nt = 0; nt < 2; ++nt) { const bf16x8 bf = *(const LAS bf16x8*)(W + (16 * nt + fr) * WLD + 32 * ks + 8 * fq); acc[nt] = __builtin_amdgcn_mfma_f32_16x16x32_bf16(af, bf, acc[nt], 0, 0, 0); } }
#pragma unroll
        for (int nt = 0; nt < 2; ++nt)
#pragma unroll
            for (int j = 0; j < 4; ++j) P[(size_t)(r0 + 4 * fq + j) * LD0 + C0_CODE + 16 * nt + fr] = (bf16)f2bf(acc[nt][j]);
    }
    __syncthreads();
}
__device__ __forceinline__ void ph_norm2_router(Frame& F, int l, int nrows) {
    LAS float* rwT = (LAS float*)(F.lds);
    __syncthreads();
    for (int i = F.tid; i < 2048 * 16; i += NTHR) { const int j = i >> 4, e = i & 15; rwT[e * 2048 + j] = F.in[I_RTW][(size_t)l * 2048 * 16 + i]; }
    __syncthreads();
    const int gw = F.bid * NWAVES + F.wave, NGW = F.G * NWAVES;
    const float* MOD = (const float*)(F.ws + WS_MOD) + (size_t)l * 9 * 12288; const float* H = (const float*)(F.ws + WS_H);
    bf16* A = (bf16*)(F.ws + WS_A); float* AFF = (float*)(F.ws + WS_AFF); int* SEL = (int*)(F.ws + WS_SEL);
    const int per = (nrows + NGW - 1) / NGW, r0 = gw * per, r1 = (r0 + per < nrows) ? r0 + per : nrows;
    f32x4 v[8], gs[8], sh[8]; int curb = -1;
    if (r0 < r1) load_row(H + (size_t)r0 * D, F.lane, v);
    for (int r = r0; r < r1; ++r) { f32x4 nv[8]; if (r + 1 < r1) load_row(H + (size_t)(r + 1) * D, F.lane, nv);
        const int bb = row_b(r); if (bb != curb) { const float* m = MOD + (size_t)bb * 12288; mod_params(F.in[I_N2G] + l * 2048, m + 3 * 2048, m + 4 * 2048, F.lane, gs, sh); curb = bb; }
        const float rs = row_rstd(v);
        { unsigned char* orow = (unsigned char*)A + (size_t)r * D;
#pragma unroll
          for (int i = 0; i < 8; ++i) { v[i] = (v[i] * rs) * gs[i] + sh[i]; *(GAS unsigned*)(orow + 4 * (F.lane + 64 * i)) = pk4_fp8(v[i][0], v[i][1], v[i][2], v[i][3]); } }
        float pa[16];
#pragma unroll
        for (int e = 0; e < 16; ++e) { const LAS float* wp = rwT + e * 2048 + 4 * F.lane; f32x4 a4 = {0.f, 0.f, 0.f, 0.f};
#pragma unroll
            for (int i = 0; i < 8; ++i) { const f32x4 w = *(const LAS f32x4*)(wp + 256 * i); a4 += v[i] * w; }
            pa[e] = (a4[0] + a4[1]) + (a4[2] + a4[3]); }
        float s1[8], s2[4];
#pragma unroll
        for (int e = 0; e < 8; ++e) { float x = pa[e], y = pa[e + 8]; asm volatile("s_nop 1\n\tv_permlane32_swap_b32 %0, %1" : "+v"(x), "+v"(y)); s1[e] = x + y; }
#pragma unroll
        for (int e = 0; e < 4; ++e) { float x = s1[e], y = s1[e + 4]; asm volatile("s_nop 1\n\tv_permlane16_swap_b32 %0, %1" : "+v"(x), "+v"(y)); s2[e] = row16_sum(x + y); }
        { float mx = fmaxf(fmaxf(s2[0], s2[1]), fmaxf(s2[2], s2[3])); mx = xrow_max(mx);
          float ex[4], se = 0.f;
#pragma unroll
          for (int e = 0; e < 4; ++e) { ex[e] = expf(s2[e] - mx); se += ex[e]; }
          se = xrow_sum(se); const float inv = 1.f / se;
          if ((F.lane & 15) == 0) { const int R = F.lane >> 4; const int eb = 4 * (R & 1) + 8 * (R >> 1);
#pragma unroll
              for (int e = 0; e < 4; ++e) AFF[(size_t)(eb + e) * M_ALL + r] = ex[e] * inv; }
          if (F.lane < 16) SEL[(size_t)r * 16 + F.lane] = -1; }
#pragma unroll
        for (int i = 0; i < 8; ++i) v[i] = nv[i];
    }
    __syncthreads();
}
__device__ __forceinline__ void ph_norm2_router2(Frame& F, int l, int nrows) {
    constexpr int WLD = 2064;
    LAS bf16* Wh = (LAS bf16*)(F.lds); LAS bf16* Wl = Wh + 16 * WLD;
    LAS float* red = (LAS float*)(F.lds + 4 * 16 * WLD);
    LAS float* ssq = red + 8 * 256;
    LAS float* cb = ssq + 128;
    const float* MOD = (const float*)(F.ws + WS_MOD) + (size_t)l * 9 * 12288; const float* H = (const float*)(F.ws + WS_H);
    unsigned char* A8 = (unsigned char*)(F.ws + WS_A); float* AFF = (float*)(F.ws + WS_AFF); int* SEL = (int*)(F.ws + WS_SEL);
    float* GSB = (float*)(F.ws + WS_XT) + (size_t)F.bid * 4 * 4096;
    const int fr = F.lane & 15, fq = F.lane >> 4;
    const int ntile = nrows >> 4; const int t0 = (int)(((long)F.bid * ntile) / F.G), t1 = (int)(((long)(F.bid + 1) * ntile) / F.G);
    const int colw = 256 * F.wave + 8 * fq;
    int curb = -1, nreb = 0; const float* gsb = GSB;
    f32x4 x[8][2];
#define RT_LOAD(dst, tile) do { const float* p_ = H + (size_t)((tile) * 16 + fr) * D + colw; _Pragma("unroll") for (int ks = 0; ks < 8; ++ks) { dst[ks][0] = *(const GAS f32x4*)(p_ + 32 * ks); dst[ks][1] = *(const GAS f32x4*)(p_ + 32 * ks + 4); } } while (0)
    if (t0 < t1) RT_LOAD(x, t0);
    for (int t = t0; t < t1; ++t) {
        const int rbase = t * 16; const int bb = row_b(rbase);
        if (bb != curb) {
            const float* m = MOD + (size_t)bb * 12288; const float* g = F.in[I_N2G] + l * 2048; const float* shp = m + 3 * 2048; const float* scp = m + 4 * 2048;
            float* gw_ = GSB + (size_t)(nreb & 3) * 4096;
            __syncthreads();
            for (int k = F.tid; k < 2048; k += NTHR) { gw_[k] = g[k] * (scp[k] + 1.f); gw_[2048 + k] = shp[k]; }
            const float* rw = F.in[I_RTW] + (size_t)l * 2048 * 16; const int e = F.tid & 15; float cacc = 0.f;
            for (int i = F.tid; i < 2048 * 16; i += NTHR) { const int k = i >> 4; const float wv = rw[i]; const float val = wv * (g[k] * (scp[k] + 1.f));
                const unsigned short hi = (unsigned short)f2bf(val); const unsigned short lo = (unsigned short)f2bf(val - bf2f(hi)); Wh[e * WLD + k] = (bf16)hi; Wl[e * WLD + k] = (bf16)lo; cacc += shp[k] * wv; }
            cacc = xrow_sum(cacc);
            if (F.lane < 16) red[F.wave * 16 + F.lane] = cacc;
            __syncthreads();
            if (F.tid < 16) { float c_ = 0.f;
#pragma unroll
                for (int ww = 0; ww < 8; ++ww) c_ += red[ww * 16 + F.tid];
                cb[F.tid] = c_; }
            __syncthreads();
            curb = bb; gsb = gw_; ++nreb; }
        f32x4 nx[8][2];
        if (t + 1 < t1) RT_LOAD(nx, t + 1);
        float ss = 0.f; f32x4 acc = {0.f, 0.f, 0.f, 0.f};
#pragma unroll
        for (int ks = 0; ks < 8; ++ks) { const f32x4 a = x[ks][0], b = x[ks][1];
            ss += (a[0] * a[0] + a[1] * a[1]) + (a[2] * a[2] + a[3] * a[3]) + (b[0] * b[0] + b[1] * b[1]) + (b[2] * b[2] + b[3] * b[3]);
            v4u h, lo_; h.x = pk2(a[0], a[1]); h.y = pk2(a[2], a[3]); h.z = pk2(b[0], b[1]); h.w = pk2(b[2], b[3]);
            lo_.x = pk2(a[0] - bflo(h.x), a[1] - bfhi(h.x)); lo_.y = pk2(a[2] - bflo(h.y), a[3] - bfhi(h.y)); lo_.z = pk2(b[0] - bflo(h.z), b[1] - bfhi(h.z)); lo_.w = pk2(b[2] - bflo(h.w), b[3] - bfhi(h.w));
            const bf16x8 ah = __builtin_bit_cast(bf16x8, h), al = __builtin_bit_cast(bf16x8, lo_);
            const bf16x8 bh = *(const LAS bf16x8*)(Wh + fr * WLD + colw + 32 * ks), bl = *(const LAS bf16x8*)(Wl + fr * WLD + colw + 32 * ks);
            acc = __builtin_amdgcn_mfma_f32_16x16x32_bf16(ah, bh, acc, 0, 0, 0); acc = __builtin_amdgcn_mfma_f32_16x16x32_bf16(al, bh, acc, 0, 0, 0); acc = __builtin_amdgcn_mfma_f32_16x16x32_bf16(ah, bl, acc, 0, 0, 0); }
        ss = xrow_sum(ss);
        if (fq == 0) ssq[F.wave * 16 + fr] = ss;
#pragma unroll
        for (int j = 0; j < 4; ++j) red[(F.wave * 16 + 4 * fq + j) * 16 + fr] = acc[j];
        __syncthreads();
        { float tot = 0.f;
#pragma unroll
          for (int ww = 0; ww < 8; ++ww) tot += ssq[ww * 16 + fr];
          const float rs = 1.f / sqrtf(tot * (1.f / 2048.f) + EPS);
          unsigned char* orow = A8 + (size_t)(rbase + fr) * D + colw;
#pragma unroll
          for (int ks = 0; ks < 8; ++ks) { const f32x4 g0 = *(const GAS f32x4*)(gsb + colw + 32 * ks), g1 = *(const GAS f32x4*)(gsb + colw + 32 * ks + 4), s0 = *(const GAS f32x4*)(gsb + 2048 + colw + 32 * ks), s1 = *(const GAS f32x4*)(gsb + 2048 + colw + 32 * ks + 4);
              const f32x4 o0 = (x[ks][0] * rs) * g0 + s0, o1 = (x[ks][1] * rs) * g1 + s1;
              v2u w8; w8.x = pk4_fp8(o0[0], o0[1], o0[2], o0[3]); w8.y = pk4_fp8(o1[0], o1[1], o1[2], o1[3]);
              *(GAS v2u*)(orow + 32 * ks) = w8; } }
        if (F.lane < 32) {
            const int row = 2 * F.wave + (F.lane >> 4), e = F.lane & 15; float lg = 0.f, tot = 0.f;
#pragma unroll
            for (int ww = 0; ww < 8; ++ww) { lg += red[(ww * 16 + row) * 16 + e]; tot += ssq[ww * 16 + row]; }
            lg = lg * (1.f / sqrtf(tot * (1.f / 2048.f) + EPS)) + cb[e];
            const float mx = row16_max(lg); const float ex = expf(lg - mx); const float se = row16_sum(ex);
            AFF[(size_t)e * M_ALL + rbase + row] = ex / se; SEL[(size_t)(rbase + row) * 16 + e] = -1; }
        __syncthreads();
#pragma unroll
        for (int ks = 0; ks < 8; ++ks) { x[ks][0] = nx[ks][0]; x[ks][1] = nx[ks][1]; }
    }
#undef RT_LOAD
    __syncthreads();
}
__device__ __forceinline__ void ph_topk(Frame& F, int nprob, int Me) {
    typedef unsigned long long u64; typedef u64 u64x2 __attribute__((ext_vector_type(2)));
    LAS u64* keys = (LAS u64*)(F.lds);
    LAS int* lst = (LAS int*)(F.lds + 16384);
    LAS int* lcnt = (LAS int*)(F.lds + 16384 + 4096);
    const float* AFF = (const float*)(F.ws + WS_AFF); int* SEL = (int*)(F.ws + WS_SEL); float* GW = (float*)(F.ws + WS_GW);
    const unsigned char* A8 = (const unsigned char*)(F.ws + WS_A); unsigned char* XS8 = (unsigned char*)(F.ws + WS_XS);
    const int nunits = 512 + (nprob - 128);
    for (int u = F.bid; u < nunits; u += F.G) {
        const bool lat = u < 512; const int q = lat ? (u >> 2) : (u - 512); const int part = lat ? (u & 3) : 0; const int b = q >> 4, e = q & 15;
        const int T = lat ? 2048 : 256, cap = lat ? 256 : 32, r0 = lat ? b * 2048 : M_LAT + b * 256;
        __syncthreads();
        for (int i = F.tid; i < T; i += NTHR) keys[i] = ((u64)__builtin_bit_cast(unsigned, AFF[(size_t)e * M_ALL + r0 + i]) << 32) | (u64)(0xFFFFFFFFu - (unsigned)i);
        if (F.tid == 0) lcnt[0] = 0;
        __syncthreads();
        const int i = part * 512 + F.tid;
        if (i < T) { const u64 ki = keys[i]; int rank = 0;
#pragma unroll 8
            for (int j = 0; j < T; j += 2) { const u64x2 kj = *(const LAS u64x2*)(keys + j); rank += (kj.x > ki) ? 1 : 0; rank += (kj.y > ki) ? 1 : 0; }
            if (rank < cap) { const int slot = e * Me + (lat ? b * 256 + rank : 2048 + b * 32 + rank);
                GW[slot] = __builtin_bit_cast(float, (unsigned)(ki >> 32)); SEL[(size_t)(r0 + i) * 16 + e] = slot;
                const int p = __hip_atomic_fetch_add(lcnt, 1, __ATOMIC_RELAXED, __HIP_MEMORY_SCOPE_WORKGROUP); lst[2 * p] = slot; lst[2 * p + 1] = r0 + i; } }
        __syncthreads();
        const int n = lcnt[0];
        for (int p = F.wave; p < n; p += NWAVES) { const int slot = lst[2 * p], row = lst[2 * p + 1];
            const GAS v4u* src = (const GAS v4u*)(A8 + (size_t)row * D); GAS v4u* dst = (GAS v4u*)(XS8 + (size_t)slot * D);
#pragma unroll
            for (int x = 0; x < 2; ++x) dst[F.lane + 64 * x] = src[F.lane + 64 * x]; }
    }
    __syncthreads();
}
__device__ __forceinline__ void ph_gather(Frame& F, int nslots) {
    const int gw = F.bid * NWAVES + F.wave, NGW = F.G * NWAVES;
    const unsigned char* A = (const unsigned char*)(F.ws + WS_A); unsigned char* XS = (unsigned char*)(F.ws + WS_XS); const int* TOK = (const int*)(F.ws + WS_TOK);
    for (int s = gw; s < nslots; s += NGW) { const int r = TOK[s];
        const GAS v4u* src = (const GAS v4u*)(A + (size_t)r * D); GAS v4u* dst = (GAS v4u*)(XS + (size_t)s * D);
#pragma unroll
        for (int i = 0; i < 2; ++i) dst[F.lane + 64 * i] = src[F.lane + 64 * i]; }
}
template <int MODE> __device__ __forceinline__ void ph_combine(Frame& F, int l, int nrows) {
    const int gw = F.bid * NWAVES + F.wave, NGW = F.G * NWAVES;
    const float* MODl = (const float*)(F.ws + WS_MOD) + (size_t)l * 9 * 12288; const float* MODn = (const float*)(F.ws + WS_MOD) + (size_t)1 * 9 * 12288;
    float* H = (float*)(F.ws + WS_H); const bf16* YS = (const bf16*)(F.ws + WS_YS); const int* SEL = (const int*)(F.ws + WS_SEL); const float* GW = (const float*)(F.ws + WS_GW);
    bf16* A = (bf16*)(F.ws + WS_A);
    f32x4 v[8]; int sel = -1;
    if (gw < nrows) { load_row(H + (size_t)gw * D, F.lane, v); sel = SEL[(size_t)gw * 16 + (F.lane & 15)]; }
    for (int r = gw; r < nrows; r += NGW) { f32x4 nv[8]; int nsel = -1; const int rn = r + NGW;
        if (rn < nrows) { load_row(H + (size_t)rn * D, F.lane, nv); nsel = SEL[(size_t)rn * 16 + (F.lane & 15)]; }
        f32x4 acc[8];
#pragma unroll
        for (int i = 0; i < 8; ++i) acc[i] = (f32x4){0.f, 0.f, 0.f, 0.f};
        const float gsel = (sel >= 0) ? GW[sel] : 0.f;
        unsigned long long mask = __ballot(sel >= 0) & 0xffffull;
        while (mask) { const int e = __builtin_ctzll(mask); mask &= mask - 1;
            const int s = __shfl(sel, e); const float g = __shfl(gsel, e); const bf16* yr = YS + (size_t)s * D;
#pragma unroll
            for (int i = 0; i < 8; ++i) { const v2u w = *(const GAS v2u*)(yr + 4 * (F.lane + 64 * i));
                acc[i][0] += g * bflo(w.x); acc[i][1] += g * bfhi(w.x); acc[i][2] += g * bflo(w.y); acc[i][3] += g * bfhi(w.y); } }
        const float* m5 = MODl + (size_t)row_b(r) * 12288 + 5 * 2048;
#pragma unroll
        for (int i = 0; i < 8; ++i) { const f32x4 g5 = *(const GAS f32x4*)(m5 + 4 * (F.lane + 64 * i)); v[i] = v[i] + g5 * acc[i]; }
        const float rs = row_rstd(v);
        if (MODE == 0) {
#pragma unroll
            for (int i = 0; i < 8; ++i) *(GAS f32x4*)(H + (size_t)r * D + 4 * (F.lane + 64 * i)) = v[i];
            const float* m = MODn + (size_t)row_b(r) * 12288;
            modulate_store(v, rs, F.in[I_N1G] + 2048, m, m + 2048, A + (size_t)r * D, F.lane);
        } else {
#pragma unroll
            for (int i = 0; i < 8; ++i) { const int c = 4 * (F.lane + 64 * i); const f32x4 gg = *(const GAS f32x4*)(F.in[I_FING] + c);
                *(GAS f32x4*)(F.out + (size_t)r * D + c) = v[i] * rs * gg; }
        }
#pragma unroll
        for (int i = 0; i < 8; ++i) v[i] = nv[i];
        sel = nsel;
    }
}
__device__ __forceinline__ void ph_hy_shortconv(Frame& F) {
    const int gw = F.bid * NWAVES + F.wave, NGW = F.G * NWAVES;
    const bf16* P = (const bf16*)(F.ws + WS_P); bf16* XV = (bf16*)(F.ws + WS_XV);
    const float* cw = F.in[I_HCW]; const float* cb = F.in[I_HCB];
    for (int r = M_LAT + gw; r < M_ALL; r += NGW) {
        const int t = (r < M_LAT) ? (r & 2047) : ((r - M_LAT) & 255); const int L = (r < M_LAT) ? 2048 : 256;
        const bool hp = t > 0, hn = t < L - 1;
        for (int i = 0; i < 6; ++i) { const int c = 8 * (F.lane + 64 * i);
            const v4u z = {0u, 0u, 0u, 0u};
            const v4u a = hp ? *(const GAS v4u*)(P + (size_t)(r - 1) * LD0 + c) : z;
            const v4u b = *(const GAS v4u*)(P + (size_t)r * LD0 + c);
            const v4u d = hn ? *(const GAS v4u*)(P + (size_t)(r + 1) * LD0 + c) : z;
            float o[8];
#pragma unroll
            for (int q = 0; q < 4; ++q) { const int cc = c + 2 * q;
                o[2 * q] = cb[cc] + cw[cc] * bflo(a[q]) + cw[3072 + cc] * bflo(b[q]) + cw[6144 + cc] * bflo(d[q]);
                o[2 * q + 1] = cb[cc + 1] + cw[cc + 1] * bfhi(a[q]) + cw[3072 + cc + 1] * bfhi(b[q]) + cw[6144 + cc + 1] * bfhi(d[q]); }
            v4u w; w.x = pk2(o[0], o[1]); w.y = pk2(o[2], o[3]); w.z = pk2(o[4], o[5]); w.w = pk2(o[6], o[7]);
            *(GAS v4u*)(XV + (size_t)r * 3072 + c) = w; }
    }
}
__device__ __forceinline__ void ph_hy_longconv(Frame& F, int order) {
    const bf16* XV = (const bf16*)(F.ws + WS_XV); bf16* Z = (bf16*)(F.ws + WS_Z); bf16* Y = (bf16*)(F.ws + WS_Y);
    const bf16* U = (order == 0) ? XV + C0_V : Z; const int ldu = (order == 0) ? 3072 : 1024;
    const bf16* Gt = XV + ((order == 0) ? C0_X1 : C0_X2);
    bf16* O = (order == 0) ? Z : Y; const int ldo = (order == 0) ? 1024 : 2048;
    const float* skip = F.in[I_HBIAS] + order * 1024;
    for (int u = 2048 + F.bid; u < 2304; u += F.G) {
        const bool lat = u < 2048; const int q = lat ? u : u - 2048;
        int b, cbk, tb, L, r0;
        if (lat) { tb = q & 127; cbk = (q >> 7) & 1; b = q >> 8; L = 2048; r0 = b * 2048; } else { tb = q & 15; cbk = (q >> 4) & 1; b = q >> 5; L = 256; r0 = M_LAT + b * 256; }
        const float* FT = (const float*)(F.ws + (lat ? WS_FTL : WS_FTC)) + (size_t)order * (2 * L - 1) * 1024;
        const int c = cbk * 512 + F.tid, t0 = tb * 16;
        float acc[16];
#pragma unroll
        for (int a = 0; a < 16; ++a) acc[a] = 0.f;
        for (int s0 = 0; s0 < L; s0 += 16) {
            float uu[16], ff[31];
#pragma unroll
            for (int i = 0; i < 16; ++i) uu[i] = bf2f(U[(size_t)(r0 + s0 + i) * ldu + c]);
            const int base = t0 - s0 + L - 1 - 15;
#pragma unroll
            for (int j = 0; j < 31; ++j) ff[j] = FT[(size_t)(base + j) * 1024 + c];
#pragma unroll
            for (int a = 0; a < 16; ++a)
#pragma unroll
                for (int i = 0; i < 16; ++i) acc[a] += ff[a - i + 15] * uu[i];
        }
        const float sk = skip[c];
#pragma unroll
        for (int a = 0; a < 16; ++a) { const size_t r = (size_t)(r0 + t0 + a);
            const float uv = bf2f(U[r * ldu + c]), g = bf2f(Gt[r * 3072 + c]);
            O[r * ldo + c] = (bf16)f2bf(g * (acc[a] + sk * uv)); }
    }
}
__device__ __forceinline__ int scan_row(int b, int dir, int n) {
    if (n < 256) { const int tc = dir ? 255 - n : n; return M_LAT + b * 256 + tc; }
    const int tl = n - 256; const int t = dir ? 2047 - tl : tl; return b * 2048 + t;
}
__device__ __forceinline__ void ph_gla_scan(Frame& F) {
    LAS float* W2s = (LAS float*)(F.lds);
    LAS float* gbs = W2s + 2048;
    LAS float* cds = gbs + 128;
    LAS float* as_ = cds + 256;
    LAS float* ks = as_ + 2048;
    LAS float* qs = ks + 2048;
    LAS float* vs_ = qs + 2048;
    LAS float* red = vs_ + 1024;
    const bf16* P = (const bf16*)(F.ws + WS_P); float* OG = (float*)(F.ws + WS_OG);
    for (int u = F.bid; u < 256; u += F.G) {
        const int vsl = u & 3, dir = (u >> 2) & 1, h = (u >> 3) & 3, b = u >> 5;
        const int v = F.tid & 63, kg = F.tid >> 6;
        __syncthreads();
        for (int i = F.tid; i < 2048; i += NTHR) W2s[i] = F.in[I_GGW2][(size_t)(dir * 16 + (i >> 7)) * 512 + h * 128 + (i & 127)];
        if (F.tid < 128) gbs[F.tid] = F.in[I_GGB][dir * 512 + h * 128 + F.tid];
        float S[16];
#pragma unroll
        for (int j = 0; j < 16; ++j) S[j] = 0.f;
        for (int n0 = 0; n0 < 2304; n0 += 16) {
            __syncthreads();
            if (F.tid < 256) { const int tk = F.tid >> 4, rr = F.tid & 15; const int row = scan_row(b, dir, n0 + tk); cds[F.tid] = bf2f(P[(size_t)row * LD0 + C0_CODE + dir * 16 + rr]); }
            for (int i = F.tid; i < 1024; i += NTHR) { const int tk = i >> 6, vx = i & 63; const int row = scan_row(b, dir, n0 + tk); vs_[i] = bf2f(P[(size_t)row * LD0 + C0_GV + h * 256 + vsl * 64 + vx]); }
            __syncthreads();
            for (int i = F.tid; i < 2048; i += NTHR) { const int tk = i >> 7, kx = i & 127; const int row = scan_row(b, dir, n0 + tk);
                qs[i] = bf2f(P[(size_t)row * LD0 + C0_GQ + h * 128 + kx]) * 0.08838834764831845f;
                ks[i] = bf2f(P[(size_t)row * LD0 + C0_GK + h * 128 + kx]);
                float lg = gbs[kx];
#pragma unroll
                for (int rr = 0; rr < 16; ++rr) lg += cds[tk * 16 + rr] * W2s[rr * 128 + kx];
                as_[i] = __expf(logsigmoidf_(lg) * (1.f / 16.f)); }
            __syncthreads();
            for (int tk = 0; tk < 16; ++tk) {
                const float vv = vs_[tk * 64 + v]; float part = 0.f;
#pragma unroll
                for (int j = 0; j < 16; ++j) { const int k = tk * 128 + kg * 16 + j; S[j] = as_[k] * S[j] + ks[k] * vv; part += qs[k] * S[j]; }
                red[((tk & 1) * 8 + kg) * 64 + v] = part;
                __syncthreads();
                if (kg == 0) { float o = 0.f;
#pragma unroll
                    for (int g = 0; g < 8; ++g) o += red[((tk & 1) * 8 + g) * 64 + v];
                    const int row = scan_row(b, dir, n0 + tk);
                    OG[((size_t)dir * M_ALL + row) * 1024 + h * 256 + vsl * 64 + v] = o; }
            }
        }
    }
    __syncthreads();
}
template <int ACT> __device__ __forceinline__ void ph_mix_combine(Frame& F, int nrows, const bf16* O0, const bf16* O1, const bf16* P, int ldp, int gcol, const float* ng, int ycol) {
    const int gw = F.bid * NWAVES + F.wave, NGW = F.G * NWAVES;
    bf16* Y = (bf16*)(F.ws + WS_Y);
    for (int r = gw; r < nrows; r += NGW) {
#pragma unroll
        for (int h = 0; h < 4; ++h) { const int c = h * 256 + 4 * F.lane;
            const v2u a = *(const GAS v2u*)(O0 + (size_t)r * 1024 + c), b2 = *(const GAS v2u*)(O1 + (size_t)r * 1024 + c);
            const f32x4 o = {bflo(a.x) + bflo(b2.x), bfhi(a.x) + bfhi(b2.x), bflo(a.y) + bflo(b2.y), bfhi(a.y) + bfhi(b2.y)};
            const float ss = wave_sum((o[0] * o[0] + o[1] * o[1]) + (o[2] * o[2] + o[3] * o[3]));
            const float rs = 1.f / sqrtf(ss * (1.f / 256.f) + EPS);
            const f32x4 gg = *(const GAS f32x4*)(ng + 4 * F.lane);
            const v2u gw2 = *(const GAS v2u*)(P + (size_t)r * ldp + gcol + c);
            float gt[4] = {bflo(gw2.x), bfhi(gw2.x), bflo(gw2.y), bfhi(gw2.y)};
            float y[4];
#pragma unroll
            for (int q = 0; q < 4; ++q) y[q] = o[q] * rs * gg[q] * (ACT == 0 ? siluf(gt[q]) : sigmoidf_(gt[q]));
            v2u w; w.x = pk2(y[0], y[1]); w.y = pk2(y[2], y[3]);
            *(GAS v2u*)(Y + (size_t)r * D + ycol + c) = w; }
    }
}
__device__ __forceinline__ void ph_ml_scan(Frame& F) {
    LAS float* qs = (LAS float*)(F.lds);
    LAS float* ks = qs + 2048;
    LAS float* vs_ = ks + 2048;
    LAS float* gts = vs_ + 512;
    LAS float* red = gts + 16;
    LAS float* redd = red + 1024;
    const bf16* P = (const bf16*)(F.ws + WS_P); float* OM = (float*)(F.ws + WS_OG);
    const float* cw = F.in[I_MCW]; const float* cb = F.in[I_MCB];
    for (int u = F.bid; u < 256; u += F.G) {
        const int vsl = u & 3, dir = (u >> 2) & 1, h = (u >> 3) & 3, b = u >> 5;
        const int v = F.tid & 63, kg = F.tid >> 6;
        float C[32], nn[32]; float m = 0.f;
#pragma unroll
        for (int j = 0; j < 32; ++j) { C[j] = 0.f; nn[j] = 0.f; }
        const float igb = F.in[I_MIGB][dir * 4 + h], fgb = F.in[I_MFGB][dir * 4 + h];
        for (int n0 = 0; n0 < 2304; n0 += 8) {
            __syncthreads();
            for (int i = F.tid; i < 4096; i += NTHR) { const int tk = i >> 9, col = i & 511; const int row = scan_row(b, dir, n0 + tk);
                const int pc = (col < 256) ? (h * 256 + col) : (1024 + h * 256 + (col - 256));
                const int t = (row < M_LAT) ? (row & 2047) : ((row - M_LAT) & 255); const int L = (row < M_LAT) ? 2048 : 256;
                float a = cb[pc] + cw[2048 + pc] * bf2f(P[(size_t)row * LD1 + pc]);
                if (t > 0) a += cw[pc] * bf2f(P[(size_t)(row - 1) * LD1 + pc]);
                if (t < L - 1) a += cw[4096 + pc] * bf2f(P[(size_t)(row + 1) * LD1 + pc]);
                a = siluf(a);
                if (col < 256) qs[tk * 256 + col] = a; else ks[tk * 256 + col - 256] = a * 0.0625f; }
            { const int tk = F.tid >> 6, vx = F.tid & 63; const int row = scan_row(b, dir, n0 + tk); vs_[F.tid] = bf2f(P[(size_t)row * LD1 + C1_MV + h * 256 + vsl * 64 + vx]); }
            if (F.tid < 8) { const int row = scan_row(b, dir, n0 + F.tid);
                gts[F.tid * 2 + 0] = bf2f(P[(size_t)row * LD1 + C1_G + dir * 8 + h]) + igb;
                gts[F.tid * 2 + 1] = logsigmoidf_(bf2f(P[(size_t)row * LD1 + C1_G + dir * 8 + 4 + h]) + fgb); }
            __syncthreads();
            for (int tk = 0; tk < 8; ++tk) {
                const float ig = gts[tk * 2], lf = gts[tk * 2 + 1];
                const float mn = fmaxf(lf + m, ig); const float fk = __expf(lf + m - mn), ik = __expf(ig - mn); m = mn;
                const float vv = vs_[tk * 64 + v] * ik; float part = 0.f, dpart = 0.f;
#pragma unroll
                for (int j = 0; j < 32; ++j) { const int k = tk * 256 + kg * 32 + j; const float kv = ks[k], qv = qs[k];
                    C[j] = fk * C[j] + vv * kv; nn[j] = fk * nn[j] + ik * kv; part += C[j] * qv; dpart += nn[j] * qv; }
                red[((tk & 1) * 8 + kg) * 64 + v] = part; if (v == 0) redd[(tk & 1) * 8 + kg] = dpart;
                __syncthreads();
                if (kg == 0 && n0 >= 256) { float num = 0.f, den = 0.f;
#pragma unroll
                    for (int g = 0; g < 8; ++g) { num += red[((tk & 1) * 8 + g) * 64 + v]; den += redd[(tk & 1) * 8 + g]; }
                    const int row = scan_row(b, dir, n0 + tk);
                    OM[((size_t)dir * M_LAT + row) * 1024 + h * 256 + vsl * 64 + v] = num / fmaxf(fabsf(den), __expf(-m)); }
            }
        }
    }
    __syncthreads();
}
__device__ __forceinline__ void ph_da_rope(Frame& F) {
    const int gw = F.bid * NWAVES + F.wave, NGW = F.G * NWAVES;
    bf16* P = (bf16*)(F.ws + WS_P);
    for (int r = gw; r < M_LAT; r += NGW) { const int t = r & 2047;
        for (int i = 0; i < 16; ++i) { const int pi = F.lane + 64 * i; const int which = pi >> 9, vec = (pi >> 5) & 15, axis = (pi >> 4) & 1, f = pi & 15;
            const int col = (which ? C1_DK : C1_DQ) + vec * 64 + axis * 32 + f;
            const float pos = (float)(axis ? (t & 63) : (t >> 6));
            const float inv = exp2f(-(float)f * (13.287712379549449f / 16.f));
            const float ang = pos * inv; const float cs = cosf(ang), sn = sinf(ang);
            const float xa = bf2f(P[(size_t)r * LD1 + col]), xb = bf2f(P[(size_t)r * LD1 + col + 16]);
            const float sc = which ? 1.f : 0.18033688011112042f;
            P[(size_t)r * LD1 + col] = (bf16)f2bf((xa * cs - xb * sn) * sc); P[(size_t)r * LD1 + col + 16] = (bf16)f2bf((xb * cs + xa * sn) * sc); }
    }
}
__device__ __forceinline__ void ph_da_attn(Frame& F) {
    constexpr int KS_LD = 136, VT_LD = 72, PW_LD = 72;
    LAS bf16* Ks = (LAS bf16*)(F.lds);
    LAS bf16* VT = Ks + 64 * KS_LD;
    LAS bf16* Pw = VT + 128 * VT_LD + (F.wave * 2) * 16 * PW_LD;
    const bf16* P = (const bf16*)(F.ws + WS_P); bf16* Y = (bf16*)(F.ws + WS_Y);
    const float lam_init = 0.35550906759096927f;
    float lam;
    { const float* lv = F.in[I_DLAM]; float s01 = 0.f, s23 = 0.f; for (int i = 0; i < 64; ++i) { s01 += lv[i] * lv[64 + i]; s23 += lv[128 + i] * lv[192 + i]; } lam = expf(s01) - expf(s23) + lam_init; }
    const int fr = F.lane & 15, fq = F.lane >> 4;
    for (int u = F.bid; u < 1024; u += F.G) {
        const int qb = u & 15, h = (u >> 4) & 7, b = u >> 7;
        const int qrow0 = b * 2048 + qb * 128 + F.wave * 16;
        bf16x8 qf[2][2];
#pragma unroll
        for (int c = 0; c < 2; ++c)
#pragma unroll
            for (int ks = 0; ks < 2; ++ks) qf[c][ks] = *(const GAS bf16x8*)(P + (size_t)(qrow0 + fr) * LD1 + C1_DQ + h * 128 + c * 64 + ks * 32 + 8 * fq);
        f32x4 Oa[2][8]; float mrun[2][4], lrun[2][4];
#pragma unroll
        for (int c = 0; c < 2; ++c) {
#pragma unroll
            for (int vt = 0; vt < 8; ++vt) Oa[c][vt] = (f32x4){0.f, 0.f, 0.f, 0.f};
#pragma unroll
            for (int j = 0; j < 4; ++j) { mrun[c][j] = -1e30f; lrun[c][j] = 0.f; } }
        for (int kt = 0; kt < 36; ++kt) {
            __syncthreads();
#pragma unroll
            for (int i = 0; i < 2; ++i) { const int id = F.tid + 512 * i; const int key = id >> 4, ch = id & 15; const int kk = kt * 64 + key;
                const size_t krow = (kk < 256) ? (size_t)(M_LAT + b * 256 + kk) : (size_t)(b * 2048 + kk - 256);
                const v4u kv = *(const GAS v4u*)(P + krow * LD1 + C1_DK + h * 128 + ch * 8);
                *(LAS v4u*)(Ks + key * KS_LD + ch * 8) = kv;
                const v4u vv = *(const GAS v4u*)(P + krow * LD1 + C1_DV + h * 128 + ch * 8);
#pragma unroll
                for (int q = 0; q < 4; ++q) { VT[(ch * 8 + 2 * q) * VT_LD + key] = (bf16)(vv[q] & 0xffffu); VT[(ch * 8 + 2 * q + 1) * VT_LD + key] = (bf16)(vv[q] >> 16); } }
            __syncthreads();
#pragma unroll
            for (int c = 0; c < 2; ++c) {
                f32x4 S[4];
#pragma unroll
                for (int nt = 0; nt < 4; ++nt) { f32x4 a = {0.f, 0.f, 0.f, 0.f};
#pragma unroll
                    for (int ks = 0; ks < 2; ++ks) { const bf16x8 bf = *(const LAS bf16x8*)(Ks + (nt * 16 + fr) * KS_LD + c * 64 + ks * 32 + 8 * fq); a = __builtin_amdgcn_mfma_f32_16x16x32_bf16(qf[c][ks], bf, a, 0, 0, 0); }
                    S[nt] = a; }
#pragma unroll
                for (int j = 0; j < 4; ++j) {
                    float mx = fmaxf(fmaxf(S[0][j], S[1][j]), fmaxf(S[2][j], S[3][j])); mx = grp16_max(mx);
                    const float mn = fmaxf(mrun[c][j], mx); const float alpha = __expf(mrun[c][j] - mn); mrun[c][j] = mn;
                    float rsum = 0.f;
#pragma unroll
                    for (int nt = 0; nt < 4; ++nt) { const float p = __expf(S[nt][j] - mn); rsum += p; Pw[(c * 16 + 4 * fq + j) * PW_LD + nt * 16 + fr] = (bf16)f2bf(p); }
                    rsum = grp16_sum(rsum); lrun[c][j] = lrun[c][j] * alpha + rsum;
#pragma unroll
                    for (int vt = 0; vt < 8; ++vt) Oa[c][vt][j] *= alpha; }
            }
            __syncthreads();
#pragma unroll
            for (int c = 0; c < 2; ++c)
#pragma unroll
                for (int ks = 0; ks < 2; ++ks) { const bf16x8 af = *(const LAS bf16x8*)(Pw + (c * 16 + fr) * PW_LD + ks * 32 + 8 * fq);
#pragma unroll
                    for (int vt = 0; vt < 8; ++vt) { const bf16x8 bf = *(const LAS bf16x8*)(VT + (vt * 16 + fr) * VT_LD + ks * 32 + 8 * fq); Oa[c][vt] = __builtin_amdgcn_mfma_f32_16x16x32_bf16(af, bf, Oa[c][vt], 0, 0, 0); } }
        }
#pragma unroll
        for (int j = 0; j < 4; ++j) { const float i0 = 1.f / lrun[0][j], i1 = lam / lrun[1][j]; float o[8]; float ss = 0.f;
#pragma unroll
            for (int vt = 0; vt < 8; ++vt) { o[vt] = Oa[0][vt][j] * i0 - Oa[1][vt][j] * i1; ss += o[vt] * o[vt]; }
            ss = grp16_sum(ss); const float rs = (1.f - lam_init) / sqrtf(ss * (1.f / 128.f) + EPS);
#pragma unroll
            for (int vt = 0; vt < 8; ++vt) Y[(size_t)(qrow0 + 4 * fq + j) * D + 1024 + h * 128 + vt * 16 + fr] = (bf16)f2bf(o[vt] * rs * F.in[I_DNG][vt * 16 + fr]); }
    }
    __syncthreads();
}
__device__ __forceinline__ void ph_hy_prep_lat(Frame& F) {
    LAS bf16* raw = (LAS bf16*)(F.lds);
    const bf16* P = (const bf16*)(F.ws + WS_P); bf16* XT = (bf16*)(F.ws + WS_XT);
    const float* cw = F.in[I_HCW]; const float* cbias = F.in[I_HCB];
    for (int u = F.bid; u < 12288; u += F.G) {
        const int cb = u & 15, tb = (u >> 4) & 31, b = (u >> 9) & 7, which = u >> 12;
        const int c0 = which * 1024 + cb * 64, t0 = tb * 64;
        __syncthreads();
        for (int id = F.tid; id < 528; id += NTHR) { const int rr = id >> 3, ch = id & 7; const int t = t0 - 1 + rr; v4u val = {0u, 0u, 0u, 0u};
            if (t >= 0 && t < 2048) val = *(const GAS v4u*)(P + (size_t)(b * 2048 + t) * LD0 + c0 + ch * 8);
            *(LAS v4u*)(raw + rr * 72 + ch * 8) = val; }
        __syncthreads();
        const int cc = F.tid & 63, tg = F.tid >> 6, c = c0 + cc;
        const float w0 = cw[c], w1 = cw[3072 + c], w2 = cw[6144 + c], bs = cbias[c];
        float o[8];
#pragma unroll
        for (int i = 0; i < 8; ++i) { const int tt = tg * 8 + i; o[i] = bs + w0 * bf2f(raw[tt * 72 + cc]) + w1 * bf2f(raw[(tt + 1) * 72 + cc]) + w2 * bf2f(raw[(tt + 2) * 72 + cc]); }
        v4u w; w.x = pk2(o[0], o[1]); w.y = pk2(o[2], o[3]); w.z = pk2(o[4], o[5]); w.w = pk2(o[6], o[7]);
        *(GAS v4u*)(XT + ((size_t)c * 8 + b) * 2048 + t0 + tg * 8) = w;
    }
    __syncthreads();
}
__device__ __forceinline__ void ph_hy_post_lat(Frame& F) {
    LAS bf16* tile = (LAS bf16*)(F.lds);
    const bf16* YT = (const bf16*)(F.ws + WS_YT); bf16* Y = (bf16*)(F.ws + WS_Y);
    for (int u = F.bid; u < 4096; u += F.G) { const int cb = u & 15, tb = (u >> 4) & 31, b = u >> 9;
        __syncthreads();
        { const int cc = F.tid >> 3, ch = F.tid & 7;
          *(LAS v4u*)(tile + cc * 72 + ch * 8) = *(const GAS v4u*)(YT + ((size_t)(cb * 64 + cc) * 8 + b) * 2048 + tb * 64 + ch * 8); }
        __syncthreads();
        { const int t = F.tid >> 3, ch = F.tid & 7; unsigned short e[8];
#pragma unroll
          for (int i = 0; i < 8; ++i) e[i] = tile[(ch * 8 + i) * 72 + t];
          v4u w; w.x = e[0] | ((unsigned)e[1] << 16); w.y = e[2] | ((unsigned)e[3] << 16); w.z = e[4] | ((unsigned)e[5] << 16); w.w = e[6] | ((unsigned)e[7] << 16);
          *(GAS v4u*)(Y + (size_t)(b * 2048 + tb * 64 + t) * D + cb * 64 + ch * 8) = w; }
    }
    __syncthreads();
}
__device__ __forceinline__ void ph_hy_ftt(Frame& F) {
    LAS float* tile = (LAS float*)(F.lds);
    const float* FTL = (const float*)(F.ws + WS_FTL); bf16* FTT = (bf16*)(F.ws + WS_FTT);
    for (int u = F.bid; u < 2 * 65 * 16; u += F.G) { const int cb = u & 15; const int rb = (u >> 4) % 65; const int o = (u >> 4) / 65;
        __syncthreads();
        for (int i = F.tid; i < 4096; i += NTHR) { const int rr = i >> 6, cc = i & 63; const int r = rb * 64 + rr; const int idx = 4127 - r;
            tile[rr * 65 + cc] = (idx >= 0 && idx <= 4094) ? FTL[((size_t)o * 4095 + idx) * 1024 + cb * 64 + cc] : 0.f; }
        __syncthreads();
        { const int cc = F.tid >> 3, ch = F.tid & 7; float e[8];
#pragma unroll
          for (int i = 0; i < 8; ++i) e[i] = tile[(ch * 8 + i) * 65 + cc];
          v4u w; w.x = pk2(e[0], e[1]); w.y = pk2(e[2], e[3]); w.z = pk2(e[4], e[5]); w.w = pk2(e[6], e[7]);
          *(GAS v4u*)(FTT + ((size_t)o * 1024 + cb * 64 + cc) * 4160 + rb * 64 + ch * 8) = w; }
    }
    __syncthreads();
}
constexpr int HY_XOFF = 2080, HY_RLEN = 4160, HY_KOFF = 32, HY_UROWB = 4192, HY_UCOPYB = 33600, HY_UOFF = 2 * HY_RLEN * 2;
__device__ __forceinline__ void hy_conv_loop(const LAS bf16* Rp, const LAS unsigned* Ud, int wave, int fr, int fq, f32x4 (&acc)[2][4]) {
    const int dl = fr & 7, s = dl & 1;
    const LAS bf16* ap = Rp + 2048 + 8 * fq - 8 * (32 * wave + fr);
    const LAS unsigned* up = Ud + s * (HY_UCOPYB / 4) + (fr >> 3) * (HY_UROWB / 4) + 4 * fq + ((dl - s) >> 1);
#pragma unroll 1
    for (int K0 = 0; K0 < 65; ++K0) {
        bf16x8 af[2];
#pragma unroll
        for (int mt = 0; mt < 2; ++mt) af[mt] = *(const LAS bf16x8*)(ap + 32 * K0 - 128 * mt);
        bf16x8 bfv[4];
#pragma unroll
        for (int nt = 0; nt < 4; ++nt) { const LAS unsigned* q = up + nt * 2 * (HY_UROWB / 4) + 16 * K0; v4u w; w.x = q[0]; w.y = q[1]; w.z = q[2]; w.w = q[3]; bfv[nt] = __builtin_bit_cast(bf16x8, w); }
#pragma unroll
        for (int mt = 0; mt < 2; ++mt)
#pragma unroll
            for (int nt = 0; nt < 4; ++nt) acc[mt][nt] = __builtin_amdgcn_mfma_f32_16x16x32_bf16(af[mt], bfv[nt], acc[mt][nt], 0, 0, 0);
    }
}
__device__ __forceinline__ void ph_hy_conv_lat(Frame& F) {
    LAS bf16* R = (LAS bf16*)(F.lds);
    LAS unsigned char* Ub = F.lds + HY_UOFF;
    LAS bf16* Gs = (LAS bf16*)(F.lds + HY_UOFF + 2 * HY_UCOPYB);
    const bf16* XT = (const bf16*)(F.ws + WS_XT); bf16* YT = (bf16*)(F.ws + WS_YT);
    const bf16* FTT = (const bf16*)(F.ws + WS_FTT);
    const int fr = F.lane & 15, fq = F.lane >> 4;
    for (int c = F.bid; c < 1024; c += F.G) {
        const bf16* X1 = XT + (size_t)c * 8 * 2048; const bf16* X2 = XT + ((size_t)1024 + c) * 8 * 2048; const bf16* XV_ = XT + ((size_t)2048 + c) * 8 * 2048;
        __syncthreads();
        for (int i = F.tid; i < (2 * HY_UCOPYB) / 16; i += NTHR) *(LAS v4u*)(Ub + i * 16) = (v4u){0u, 0u, 0u, 0u};
        for (int i = F.tid; i < 2 * HY_RLEN / 8; i += NTHR) { const int o = (i >= HY_RLEN / 8) ? 1 : 0; const int q = i - o * (HY_RLEN / 8);
            *(LAS v4u*)(R + o * HY_RLEN + q * 8) = *(const GAS v4u*)(FTT + ((size_t)o * 1024 + c) * 4160 + q * 8); }
        for (int i = F.tid; i < 2048; i += NTHR) { const int b = i >> 8, ch = i & 255; *(LAS v4u*)(Gs + b * 2048 + ch * 8) = *(const GAS v4u*)(X1 + (size_t)b * 2048 + ch * 8); }
        __syncthreads();
        for (int i = F.tid; i < 2048; i += NTHR) { const int b = i >> 8, ch = i & 255, t0 = ch * 8; const v4u val = *(const GAS v4u*)(XV_ + (size_t)b * 2048 + t0);
            *(LAS v4u*)(Ub + b * HY_UROWB + (HY_KOFF + t0) * 2) = val;
            LAS bf16* c1 = (LAS bf16*)(Ub + HY_UCOPYB + b * HY_UROWB) + HY_KOFF + t0 - 1;
#pragma unroll
            for (int q = 0; q < 4; ++q) { c1[2 * q] = (bf16)(val[q] & 0xffffu); c1[2 * q + 1] = (bf16)(val[q] >> 16); } }
        __syncthreads();
#pragma unroll 1
        for (int order = 0; order < 2; ++order) {
            f32x4 acc[2][4];
#pragma unroll
            for (int mt = 0; mt < 2; ++mt)
#pragma unroll
                for (int nt = 0; nt < 4; ++nt) acc[mt][nt] = (f32x4){0.f, 0.f, 0.f, 0.f};
            v4u gpre[4];
            if (order == 0) {
#pragma unroll
                for (int x = 0; x < 4; ++x) { const int i = F.tid + NTHR * x; gpre[x] = *(const GAS v4u*)(X2 + (size_t)(i >> 8) * 2048 + (i & 255) * 8); } }
            hy_conv_loop(R + order * HY_RLEN, (const LAS unsigned*)Ub, F.wave, fr, fq, acc);
            __syncthreads();
            const float sk = F.in[I_HBIAS][order * 1024 + c];
#pragma unroll
            for (int mt = 0; mt < 2; ++mt)
#pragma unroll
                for (int nt = 0; nt < 4; ++nt)
#pragma unroll
                    for (int j = 0; j < 4; ++j) { const int m = 32 * F.wave + 16 * mt + 4 * fq + j; const int b = 2 * nt + (fr >> 3); const int t = 8 * m + (fr & 7);
                        LAS bf16* u0 = (LAS bf16*)(Ub + b * HY_UROWB) + HY_KOFF + t; LAS bf16* u1 = (LAS bf16*)(Ub + HY_UCOPYB + b * HY_UROWB) + HY_KOFF + t;
                        const float uv = bf2f(*u0), g = bf2f(Gs[b * 2048 + t]);
                        const bf16 r = (bf16)f2bf(g * (acc[mt][nt][j] + sk * uv));
                        if (order == 0) { *u0 = r; u1[-1] = r; } else { *u1 = r; } }
            __syncthreads();
            if (order == 0) {
#pragma unroll
                for (int x = 0; x < 4; ++x) { const int i = F.tid + NTHR * x; *(LAS v4u*)(Gs + (i >> 8) * 2048 + (i & 255) * 8) = gpre[x]; } }
        }
        for (int i = F.tid; i < 2048; i += NTHR) { const int b = i >> 8, ch = i & 255;
            *(GAS v4u*)(YT + ((size_t)c * 8 + b) * 2048 + ch * 8) = *(const LAS v4u*)(Ub + HY_UCOPYB + b * HY_UROWB + (HY_KOFF + ch * 8) * 2); }
    }
    __syncthreads();
}
__device__ __forceinline__ void ph_ml_prep(Frame& F) {
    const bf16* P = (const bf16*)(F.ws + WS_P); bf16* MQK = (bf16*)(F.ws + WS_MQK); float* MLS = (float*)(F.ws + WS_MLS); float* KEEP = MLS + (size_t)64 * 36 * 320;
    const int gw = F.bid * NWAVES + F.wave, NGW = F.G * NWAVES;
    if (gw < 64) {
        const int sq = gw, dir = sq & 1, h = (sq >> 1) & 3, b = sq >> 3; const int i = F.lane;
        const float igb = F.in[I_MIGB][dir * 4 + h], fgb = F.in[I_MFGB][dir * 4 + h]; float mrun = 0.f;
        for (int c = 0; c < 36; ++c) { const int row = scan_row(b, dir, 64 * c + i);
            const float ig = bf2f(P[(size_t)row * LD1 + C1_G + dir * 8 + h]) + igb;
            const float lf = logsigmoidf_(bf2f(P[(size_t)row * LD1 + C1_G + dir * 8 + 4 + h]) + fgb);
            const float bi = wave_incl_sum(lf, i); const float blast = __shfl(bi, 63);
            const float wend = blast - bi + ig; const float mnew = fmaxf(blast + mrun, wave_max(wend));
            const float keep = __expf(blast + mrun - mnew); const float wi = __expf(wend - mnew);
            const float ai = bi + mrun; const float colv = ig - bi; const float pm = wave_incl_max(colv, i); const float mt = fmaxf(ai, bi + pm);
            float* o = MLS + ((size_t)sq * 36 + c) * 320 + i;
            o[0] = wi; o[64] = bi - mt; o[128] = colv; o[192] = __expf(ai - mt); o[256] = __expf(-mt); if (i == 0) KEEP[sq * 36 + c] = keep;
            mrun = mnew; }
    }
    const float* cw = F.in[I_MCW]; const float* cbias = F.in[I_MCB];
    const bool scanw = (NGW > 128) && (gw < 64);
    const int cgw = (NGW > 128) ? gw - 64 : gw, CNGW = (NGW > 128) ? NGW - 64 : NGW;
    f32x4 w0[4][2], w1[4][2], w2[4][2], bs[4][2];
    if (!scanw) {
#pragma unroll
        for (int i = 0; i < 4; ++i)
#pragma unroll
            for (int hh = 0; hh < 2; ++hh) { const int c = 8 * (F.lane + 64 * i) + 4 * hh;
                w0[i][hh] = *(const GAS f32x4*)(cw + c); w1[i][hh] = *(const GAS f32x4*)(cw + 2048 + c); w2[i][hh] = *(const GAS f32x4*)(cw + 4096 + c); bs[i][hh] = *(const GAS f32x4*)(cbias + c); } }
    for (int r = scanw ? M_ALL : cgw; r < M_ALL; r += CNGW) {
        const int t = (r < M_LAT) ? (r & 2047) : ((r - M_LAT) & 255); const int L = (r < M_LAT) ? 2048 : 256; const bool hp = t > 0, hn = t < L - 1;
#pragma unroll
        for (int i = 0; i < 4; ++i) { const int c = 8 * (F.lane + 64 * i); const v4u z = {0u, 0u, 0u, 0u};
            const v4u a = hp ? *(const GAS v4u*)(P + (size_t)(r - 1) * LD1 + c) : z; const v4u b2 = *(const GAS v4u*)(P + (size_t)r * LD1 + c); const v4u d = hn ? *(const GAS v4u*)(P + (size_t)(r + 1) * LD1 + c) : z;
            const float ksc = (c < 1024) ? 1.f : 0.0625f; float o[8];
#pragma unroll
            for (int q = 0; q < 4; ++q) { const int hh = q >> 1, e0 = 2 * (q & 1);
                o[2 * q] = siluf(bs[i][hh][e0] + w0[i][hh][e0] * bflo(a[q]) + w1[i][hh][e0] * bflo(b2[q]) + w2[i][hh][e0] * bflo(d[q])) * ksc;
                o[2 * q + 1] = siluf(bs[i][hh][e0 + 1] + w0[i][hh][e0 + 1] * bfhi(a[q]) + w1[i][hh][e0 + 1] * bfhi(b2[q]) + w2[i][hh][e0 + 1] * bfhi(d[q])) * ksc; }
            v4u w; w.x = pk2(o[0], o[1]); w.y = pk2(o[2], o[3]); w.z = pk2(o[4], o[5]); w.w = pk2(o[6], o[7]);
            *(GAS v4u*)(MQK + (size_t)r * 2048 + c) = w; }
    }
}
__device__ __forceinline__ void ph_ml_scan2(Frame& F) {
    constexpr int QLD = 272, VLD = 88, SLD = 72;
    LAS bf16* Qn = (LAS bf16*)(F.lds); LAS bf16* Kn = Qn + 64 * QLD; LAS bf16* Cb = Kn + 64 * QLD; LAS bf16* Vn = Cb + 80 * QLD; LAS bf16* VWn = Vn + 64 * VLD; LAS bf16* SC = VWn + 64 * VLD;
    LAS float* sS = (LAS float*)(SC + 64 * SLD);
    LAS float* sW = sS; LAS float* sRow = sS + 64; LAS float* sCol = sS + 128; LAS float* sAw = sS + 192; LAS float* sEinv = sS + 256;
    const bf16* P = (const bf16*)(F.ws + WS_P); float* OM = (float*)(F.ws + WS_OG);
    const bf16* MQK = (const bf16*)(F.ws + WS_MQK); const float* MLS = (const float*)(F.ws + WS_MLS); const float* KEEP = MLS + (size_t)64 * 36 * 320;
    const int fr = F.lane & 15, fq = F.lane >> 4;
    for (int u0 = F.bid; u0 < 256; u0 += F.G) {
        const int u = (F.G == 256) ? ((((u0 & 7) * 8 + (u0 >> 5)) << 2) | ((u0 >> 3) & 3)) : u0;
        const int vsl = u & 3, dir = (u >> 2) & 1, h = (u >> 3) & 3, b = u >> 5; const int sq = (b * 4 + h) * 2 + dir; const int sgn = dir ? -1 : 1;
        __syncthreads();
        for (int i = F.tid; i < (80 * QLD + 2 * 64 * VLD) / 8; i += NTHR) *(LAS v4u*)(Cb + i * 8) = (v4u){0u, 0u, 0u, 0u};
        __syncthreads();
        if (F.tid < 64) Vn[F.tid * VLD + 64] = (bf16)0x3F80;
        f32x4 st[5][2];
#pragma unroll
        for (int vt = 0; vt < 5; ++vt) { st[vt][0] = (f32x4){0.f, 0.f, 0.f, 0.f}; st[vt][1] = (f32x4){0.f, 0.f, 0.f, 0.f}; }
        v4u rq[4], rk[4], rv; float rs = 0.f, keepn = 0.f;
#define ML_LOAD(cc) do { const int row0_ = scan_row(b, dir, 64 * (cc)); \
            _Pragma("unroll") for (int x = 0; x < 4; ++x) { const int p = F.tid + NTHR * x; const size_t o = (size_t)(row0_ + sgn * (p >> 5)) * 2048 + h * 256 + (p & 31) * 8; \
                rq[x] = *(const GAS v4u*)(MQK + o); rk[x] = *(const GAS v4u*)(MQK + o + 1024); } \
            rv = *(const GAS v4u*)(P + (size_t)(row0_ + sgn * (F.tid >> 3)) * LD1 + C1_MV + h * 256 + vsl * 64 + (F.tid & 7) * 8); \
            if (F.tid < 320) rs = MLS[((size_t)sq * 36 + (cc)) * 320 + F.tid]; keepn = KEEP[sq * 36 + (cc)]; } while (0)
        ML_LOAD(0);
#pragma unroll 1
        for (int c = 0; c < 36; ++c) {
            const bool emit = c >= 4;
#pragma unroll
            for (int x = 0; x < 4; ++x) { const int p = F.tid + NTHR * x; *(LAS v4u*)(Qn + (p >> 5) * QLD + (p & 31) * 8) = rq[x]; *(LAS v4u*)(Kn + (p >> 5) * QLD + (p & 31) * 8) = rk[x]; }
            *(LAS v4u*)(Vn + (F.tid >> 3) * VLD + (F.tid & 7) * 8) = rv;
            if (F.tid < 320) sS[F.tid] = rs;
            const float keep = keepn;
            __syncthreads();
            if (c + 1 < 36) ML_LOAD(c + 1);
            { const int i = F.tid >> 3, cv = F.tid & 7; const float wv = sW[i]; const v4u x = *(const LAS v4u*)(Vn + i * VLD + cv * 8); v4u y;
#pragma unroll
              for (int q = 0; q < 4; ++q) y[q] = pk2(bflo(x[q]) * wv, bfhi(x[q]) * wv);
              *(LAS v4u*)(VWn + i * VLD + cv * 8) = y; if (cv == 0) VWn[i * VLD + 64] = (bf16)f2bf(wv); }
            if (emit) {
                const int it_ = F.wave >> 1;
#pragma unroll
                for (int x = 0; x < 2; ++x) { const int jt = 2 * (F.wave & 1) + x;
                    f32x4 a = {0.f, 0.f, 0.f, 0.f};
                    if (jt <= it_) {
#pragma unroll
                        for (int ks = 0; ks < 8; ++ks) { const bf16x8 af = *(const LAS bf16x8*)(Qn + (16 * it_ + fr) * QLD + 32 * ks + 8 * fq); const bf16x8 bf = *(const LAS bf16x8*)(Kn + (16 * jt + fr) * QLD + 32 * ks + 8 * fq);
                            a = __builtin_amdgcn_mfma_f32_16x16x32_bf16(af, bf, a, 0, 0, 0); } }
                    const int j = 16 * jt + fr; const float cj = sCol[j];
#pragma unroll
                    for (int jj = 0; jj < 4; ++jj) { const int i = 16 * it_ + 4 * fq + jj; const float val = (j <= i) ? a[jj] * __expf(sRow[i] + cj) : 0.f; SC[i * SLD + j] = (bf16)f2bf(val); } }
            }
            __syncthreads();
            if (emit) {
                const int it_ = F.wave & 3, vt0 = 2 * (F.wave >> 2);
                f32x4 acc[3];
#pragma unroll
                for (int x = 0; x < 3; ++x) acc[x] = (f32x4){0.f, 0.f, 0.f, 0.f};
#pragma unroll
                for (int ks = 0; ks < 8; ++ks) { const bf16x8 af = *(const LAS bf16x8*)(Qn + (16 * it_ + fr) * QLD + 32 * ks + 8 * fq);
#pragma unroll
                    for (int x = 0; x < 3; ++x) { const int vt = (x < 2) ? vt0 + x : 4; const bf16x8 bf = *(const LAS bf16x8*)(Cb + (16 * vt + fr) * QLD + 32 * ks + 8 * fq); acc[x] = __builtin_amdgcn_mfma_f32_16x16x32_bf16(af, bf, acc[x], 0, 0, 0); } }
#pragma unroll
                for (int jj = 0; jj < 4; ++jj) { const float awv = sAw[16 * it_ + 4 * fq + jj];
#pragma unroll
                    for (int x = 0; x < 3; ++x) acc[x][jj] *= awv; }
#pragma unroll
                for (int js = 0; js < 2; ++js) { const bf16x8 af = *(const LAS bf16x8*)(SC + (16 * it_ + fr) * SLD + 32 * js + 8 * fq);
#pragma unroll
                    for (int x = 0; x < 3; ++x) { const int vt = (x < 2) ? vt0 + x : 4; const bf16x8 bf = tr_frag(Vn, VLD, 32 * js, 16 * vt, F.lane); acc[x] = __builtin_amdgcn_mfma_f32_16x16x32_bf16(af, bf, acc[x], 0, 0, 0); } }
                const int row0 = scan_row(b, dir, 64 * c);
#pragma unroll
                for (int jj = 0; jj < 4; ++jj) { const int i = 16 * it_ + 4 * fq + jj; const float den = __shfl(acc[2][jj], F.lane & 48); const float dd = fmaxf(fabsf(den), sEinv[i]);
                    const float rdd = __builtin_amdgcn_rcpf(dd);
                    const int row = row0 + sgn * i; bf16* op = (bf16*)OM + ((size_t)dir * M_LAT + row) * 1024 + h * 256 + vsl * 64 + fr;
                    op[16 * vt0] = (bf16)f2bf(acc[0][jj] * rdd); op[16 * vt0 + 16] = (bf16)f2bf(acc[1][jj] * rdd); }
            }
            {
#pragma unroll
              for (int vt = 0; vt < 5; ++vt) { st[vt][0] *= keep; st[vt][1] *= keep; }
#pragma unroll
              for (int is = 0; is < 2; ++is) { bf16x8 kb[2];
#pragma unroll
                  for (int x = 0; x < 2; ++x) kb[x] = tr_frag(Kn, QLD, 32 * is, 16 * (2 * F.wave + x), F.lane);
#pragma unroll
                  for (int vt = 0; vt < 5; ++vt) { const bf16x8 af = tr_frag(VWn, VLD, 32 * is, 16 * vt, F.lane);
                      st[vt][0] = __builtin_amdgcn_mfma_f32_16x16x32_bf16(af, kb[0], st[vt][0], 0, 0, 0); st[vt][1] = __builtin_amdgcn_mfma_f32_16x16x32_bf16(af, kb[1], st[vt][1], 0, 0, 0); } } }
            __syncthreads();
#pragma unroll
            for (int vt = 0; vt < 5; ++vt)
#pragma unroll
                for (int x = 0; x < 2; ++x)
#pragma unroll
                    for (int jj = 0; jj < 4; ++jj) Cb[(16 * vt + 4 * fq + jj) * QLD + 16 * (2 * F.wave + x) + fr] = (bf16)f2bf(st[vt][x][jj]);
        }
#undef ML_LOAD
    }
    __syncthreads();
}
__device__ __forceinline__ void ph_gla_prep(Frame& F) {
    LAS float* sCode = (LAS float*)(F.lds);
    LAS float* sGT = sCode + 1024;
    const bf16* P = (const bf16*)(F.ws + WS_P);
    bf16* GQD = (bf16*)(F.ws + WS_GQ); bf16* GKI = GQD + (size_t)2 * M_ALL * 512; bf16* GKD = GKI + (size_t)2 * M_ALL * 512; float* DEC = (float*)(F.ws + WS_GDEC);
    const int k = F.tid & 127, tg = F.tid >> 7;
    for (int u = F.bid; u < 2304; u += F.G) {
        const int c = u % 36, sq = u / 36; const int dir = sq & 1, h = (sq >> 1) & 3, b = sq >> 3;
        const int n0 = 64 * c; const int row0 = scan_row(b, dir, n0); const int sgn = dir ? -1 : 1;
        __syncthreads();
#pragma unroll
        for (int x = 0; x < 2; ++x) { const int i = F.tid + NTHR * x; sCode[i] = bf2f(P[(size_t)(row0 + sgn * (i >> 4)) * LD0 + C0_CODE + dir * 16 + (i & 15)]); }
        float w2c[16];
#pragma unroll
        for (int r = 0; r < 16; ++r) w2c[r] = F.in[I_GGW2][(size_t)(dir * 16 + r) * 512 + h * 128 + k];
        const float gbk = F.in[I_GGB][dir * 512 + h * 128 + k];
        const bf16* pq = P + (size_t)(row0 + sgn * 16 * tg) * LD0 + C0_GQ + h * 128 + k; const long pstep = (long)sgn * LD0;
        unsigned short qr[16], kr[16]; float bc[16];
#pragma unroll
        for (int x = 0; x < 16; ++x) { qr[x] = pq[x * pstep]; kr[x] = pq[x * pstep + 512]; }
        __syncthreads();
        float run = 0.f;
#pragma unroll
        for (int x = 0; x < 16; ++x) { float lg = gbk; const LAS float* cd = sCode + (16 * tg + x) * 16;
            f32x4 l4 = {0.f, 0.f, 0.f, 0.f};
#pragma unroll
            for (int r = 0; r < 16; r += 4) { const f32x4 cv = *(const LAS f32x4*)(cd + r); l4 += cv * (f32x4){w2c[r], w2c[r + 1], w2c[r + 2], w2c[r + 3]}; }
            lg += (l4[0] + l4[1]) + (l4[2] + l4[3]);
            run += logsigmoidf_(lg) * (1.f / 16.f); bc[x] = run; }
        sGT[tg * 128 + k] = run;
        __syncthreads();
        float off = 0.f, tot = 0.f;
#pragma unroll
        for (int g = 0; g < 4; ++g) { const float t = sGT[g * 128 + k]; tot += t; off += (g < tg) ? t : 0.f; }
        if (tg == 0) DEC[(size_t)u * 128 + k] = __expf(tot);
        const size_t o0 = ((size_t)dir * M_ALL + (row0 + sgn * 16 * tg)) * 512 + h * 128 + k; const long ostep = (long)sgn * 512;
#pragma unroll
        for (int x = 0; x < 16; ++x) { const float bb = bc[x] + off; const float qv = bf2f(qr[x]) * 0.08838834764831845f, kv = bf2f(kr[x]);
            GQD[o0 + x * ostep] = (bf16)f2bf(qv * __expf(bb)); GKI[o0 + x * ostep] = (bf16)f2bf(kv * __expf(-bb)); GKD[o0 + x * ostep] = (bf16)f2bf(kv * __expf(tot - bb)); }
    }
    __syncthreads();
}
__device__ __forceinline__ void ph_gla_scan2(Frame& F) {
    constexpr int KLD = 136, VLD = 72;
    LAS bf16* QD = (LAS bf16*)(F.lds); LAS bf16* KI = QD + 64 * KLD; LAS bf16* KD = KI + 64 * KLD; LAS bf16* Sb = KD + 64 * KLD; LAS bf16* Vn = Sb + 64 * KLD; LAS bf16* ATT = Vn + 64 * VLD;
    const bf16* P = (const bf16*)(F.ws + WS_P); float* OG = (float*)(F.ws + WS_OG);
    const bf16* GQD = (const bf16*)(F.ws + WS_GQ); const bf16* GKI = GQD + (size_t)2 * M_ALL * 512; const bf16* GKD = GKI + (size_t)2 * M_ALL * 512; const float* DEC = (const float*)(F.ws + WS_GDEC);
    const int fr = F.lane & 15, fq = F.lane >> 4;
    for (int u0 = F.bid; u0 < 256; u0 += F.G) {
        const int u = (F.G == 256) ? ((((u0 & 7) * 8 + (u0 >> 5)) << 2) | ((u0 >> 3) & 3)) : u0;
        const int vsl = u & 3, dir = (u >> 2) & 1, h = (u >> 3) & 3, b = u >> 5; const int sq = (b * 4 + h) * 2 + dir; const int sgn = dir ? -1 : 1;
        __syncthreads();
        for (int i = F.tid; i < 64 * KLD / 8; i += NTHR) *(LAS v4u*)(Sb + i * 8) = (v4u){0u, 0u, 0u, 0u};
        f32x4 st[4];
#pragma unroll
        for (int vt = 0; vt < 4; ++vt) st[vt] = (f32x4){0.f, 0.f, 0.f, 0.f};
        v4u rq[2], rk[2], rd[2], rv; float dkn;
#define GLA_LOAD(cc) do { const int row0_ = scan_row(b, dir, 64 * (cc)); \
            _Pragma("unroll") for (int x = 0; x < 2; ++x) { const int p = F.tid + NTHR * x; const size_t o = ((size_t)dir * M_ALL + (row0_ + sgn * (p >> 4))) * 512 + h * 128 + (p & 15) * 8; \
                rq[x] = *(const GAS v4u*)(GQD + o); rk[x] = *(const GAS v4u*)(GKI + o); rd[x] = *(const GAS v4u*)(GKD + o); } \
            rv = *(const GAS v4u*)(P + (size_t)(row0_ + sgn * (F.tid >> 3)) * LD0 + C0_GV + h * 256 + vsl * 64 + (F.tid & 7) * 8); \
            dkn = DEC[((size_t)sq * 36 + (cc)) * 128 + 16 * F.wave + fr]; } while (0)
#define GLA_PUT_QK() do { _Pragma("unroll") for (int x = 0; x < 2; ++x) { const int p = F.tid + NTHR * x; *(LAS v4u*)(QD + (p >> 4) * KLD + (p & 15) * 8) = rq[x]; *(LAS v4u*)(KI + (p >> 4) * KLD + (p & 15) * 8) = rk[x]; } } while (0)
        GLA_LOAD(0);
        GLA_PUT_QK();
#pragma unroll 1
        for (int c = 0; c < 36; ++c) {
            __syncthreads();
#pragma unroll
            for (int x = 0; x < 2; ++x) { const int p = F.tid + NTHR * x; *(LAS v4u*)(KD + (p >> 4) * KLD + (p & 15) * 8) = rd[x]; }
            *(LAS v4u*)(Vn + (F.tid >> 3) * VLD + (F.tid & 7) * 8) = rv;
            const float dk = dkn;
            if (c + 1 < 36) GLA_LOAD(c + 1);
            { const int it_ = F.wave >> 1;
#pragma unroll
              for (int x = 0; x < 2; ++x) { const int jt = 2 * (F.wave & 1) + x; f32x4 a = {0.f, 0.f, 0.f, 0.f};
                  if (jt <= it_) {
#pragma unroll
                      for (int ks = 0; ks < 4; ++ks) { const bf16x8 af = *(const LAS bf16x8*)(QD + (16 * it_ + fr) * KLD + 32 * ks + 8 * fq); const bf16x8 bf = *(const LAS bf16x8*)(KI + (16 * jt + fr) * KLD + 32 * ks + 8 * fq);
                          a = __builtin_amdgcn_mfma_f32_16x16x32_bf16(af, bf, a, 0, 0, 0); } }
                  const int j = 16 * jt + fr;
#pragma unroll
                  for (int jj = 0; jj < 4; ++jj) { const int i = 16 * it_ + 4 * fq + jj; ATT[i * VLD + j] = (bf16)f2bf((j <= i) ? a[jj] : 0.f); } } }
            const int ot = F.wave & 3, vt0 = 2 * (F.wave >> 2);
            f32x4 oa[2] = {(f32x4){0.f, 0.f, 0.f, 0.f}, (f32x4){0.f, 0.f, 0.f, 0.f}};
#pragma unroll
            for (int ks = 0; ks < 4; ++ks) { const bf16x8 af = *(const LAS bf16x8*)(QD + (16 * ot + fr) * KLD + 32 * ks + 8 * fq);
#pragma unroll
                for (int x = 0; x < 2; ++x) { const bf16x8 bf = *(const LAS bf16x8*)(Sb + (16 * (vt0 + x) + fr) * KLD + 32 * ks + 8 * fq); oa[x] = __builtin_amdgcn_mfma_f32_16x16x32_bf16(af, bf, oa[x], 0, 0, 0); } }
            __syncthreads();
#pragma unroll
            for (int js = 0; js < 2; ++js) { const bf16x8 af = *(const LAS bf16x8*)(ATT + (16 * ot + fr) * VLD + 32 * js + 8 * fq);
#pragma unroll
                for (int x = 0; x < 2; ++x) { const bf16x8 bf = tr_frag(Vn, VLD, 32 * js, 16 * (vt0 + x), F.lane); oa[x] = __builtin_amdgcn_mfma_f32_16x16x32_bf16(af, bf, oa[x], 0, 0, 0); } }
            { const int row0 = scan_row(b, dir, 64 * c);
#pragma unroll
              for (int jj = 0; jj < 4; ++jj) { const int i = 16 * ot + 4 * fq + jj; const int row = row0 + sgn * i;
                  bf16* op = (bf16*)OG + ((size_t)dir * M_ALL + row) * 1024 + h * 256 + vsl * 64 + fr; op[16 * vt0] = (bf16)f2bf(oa[0][jj]); op[16 * vt0 + 16] = (bf16)f2bf(oa[1][jj]); } }
            {
#pragma unroll
              for (int vt = 0; vt < 4; ++vt) st[vt] *= dk;
#pragma unroll
              for (int js = 0; js < 2; ++js) { const bf16x8 kb = tr_frag(KD, KLD, 32 * js, 16 * F.wave, F.lane);
#pragma unroll
                  for (int vt = 0; vt < 4; ++vt) { const bf16x8 af = tr_frag(Vn, VLD, 32 * js, 16 * vt, F.lane); st[vt] = __builtin_amdgcn_mfma_f32_16x16x32_bf16(af, kb, st[vt], 0, 0, 0); } }
#pragma unroll
              for (int vt = 0; vt < 4; ++vt)
#pragma unroll
                  for (int jj = 0; jj < 4; ++jj) Sb[(16 * vt + 4 * fq + jj) * KLD + 16 * F.wave + fr] = (bf16)f2bf(st[vt][jj]); }
            if (c + 1 < 36) GLA_PUT_QK();
        }
#undef GLA_LOAD
#undef GLA_PUT_QK
    }
    __syncthreads();
}
__device__ __forceinline__ float vmax3(float a, float b, float c) { float r; asm("v_max3_f32 %0, %1, %2, %3" : "=v"(r) : "v"(a), "v"(b), "v"(c)); return r; }
__device__ __forceinline__ void ph_da_attn2(Frame& F) {
    constexpr int TLD = 144, TILE = 64 * TLD;
    LAS bf16* buf = (LAS bf16*)(F.lds);
    const bf16* P = (const bf16*)(F.ws + WS_P); bf16* Y = (bf16*)(F.ws + WS_Y);
    const float lam_init = 0.35550906759096927f;
    float lam;
    { const float* lv = F.in[I_DLAM]; float s01 = 0.f, s23 = 0.f; for (int i = 0; i < 64; ++i) { s01 += lv[i] * lv[64 + i]; s23 += lv[128 + i] * lv[192 + i]; } lam = expf(s01) - expf(s23) + lam_init; }
    const int fr = F.lane & 15, fq = F.lane >> 4, tq = (F.lane & 15) >> 2, tp = F.lane & 3;
    const int nround = (F.G == 256) ? 4 : (1024 + F.G - 1) / F.G;
    for (int rnd = 0; rnd < nround; ++rnd) {
        int u;
        if (F.G == 256) { const int xcd = F.bid & 7, slot = F.bid >> 3; const int pair = xcd + 8 * (2 * rnd + (slot >> 4)); u = pair * 16 + (slot & 15); }
        else { u = F.bid + rnd * F.G; if (u >= 1024) break; }
        const int qb = u & 15, h = (u >> 4) & 7, b = u >> 7;
        const int qrow = b * 2048 + qb * 128 + F.wave * 16 + fr;
        bf16x8 qf[2][2];
#pragma unroll
        for (int c = 0; c < 2; ++c)
#pragma unroll
            for (int ks = 0; ks < 2; ++ks) qf[c][ks] = *(const GAS bf16x8*)(P + (size_t)qrow * LD1 + C1_DQ + h * 128 + c * 64 + ks * 32 + 8 * fq);
        f32x4 Oa[2][8], Ol[2]; float mst[2] = {0.f, 0.f};
#pragma unroll
        for (int c = 0; c < 2; ++c)
#pragma unroll
            for (int vt = 0; vt < 8; ++vt) Oa[c][vt] = (f32x4){0.f, 0.f, 0.f, 0.f};
        Ol[0] = (f32x4){0.f, 0.f, 0.f, 0.f}; Ol[1] = (f32x4){0.f, 0.f, 0.f, 0.f};
        const bf16x8 ones = (bf16x8){0x3F80, 0x3F80, 0x3F80, 0x3F80, 0x3F80, 0x3F80, 0x3F80, 0x3F80};
        v4u kn[2], vn[2];
        const int skey = F.tid >> 4, sch = F.tid & 15;
#define DA_TB(t) ((const char*)P + (size_t)(((t) < 4) ? (M_LAT + b * 256 + 64 * (t)) : (b * 2048 + 64 * ((t) - 4))) * (LD1 * 2))
        const unsigned vo0 = (unsigned)(skey * LD1 + C1_DK + h * 128 + sch * 8) * 2u, vo1 = vo0 + 32u * LD1 * 2u;
#define DA_LD(t) do { const char* tb_ = DA_TB(t); kn[0] = *(const GAS v4u*)(tb_ + vo0); vn[0] = *(const GAS v4u*)(tb_ + vo0 + (C1_DV - C1_DK) * 2); kn[1] = *(const GAS v4u*)(tb_ + vo1); vn[1] = *(const GAS v4u*)(tb_ + vo1 + (C1_DV - C1_DK) * 2); } while (0)
        DA_LD(0);
        __syncthreads();
#pragma unroll
        for (int i = 0; i < 2; ++i) { *(LAS v4u*)(buf + (skey + 32 * i) * TLD + sch * 8) = kn[i]; *(LAS v4u*)(buf + TILE + (skey + 32 * i) * TLD + sch * 8) = vn[i]; }
        DA_LD(1);
        __syncthreads();
#pragma unroll 1
        for (int kt = 0; kt < 36; ++kt) {
            const LAS bf16* Kc = buf + (kt & 1) * 2 * TILE; const LAS bf16* Vc = Kc + TILE;
            if (kt + 1 < 36) {
                LAS bf16* Kn_ = buf + ((kt + 1) & 1) * 2 * TILE;
#pragma unroll
                for (int i = 0; i < 2; ++i) { *(LAS v4u*)(Kn_ + (skey + 32 * i) * TLD + sch * 8) = kn[i]; *(LAS v4u*)(Kn_ + TILE + (skey + 32 * i) * TLD + sch * 8) = vn[i]; }
                if (kt + 2 < 36) DA_LD(kt + 2); }
            bf16x8 pf[2][2];
            f32x4 S[2][4];
#pragma unroll
            for (int c = 0; c < 2; ++c)
#pragma unroll
                for (int nt = 0; nt < 4; ++nt) { const float nm = -mst[c]; f32x4 a = {nm, nm, nm, nm};
#pragma unroll
                    for (int ks = 0; ks < 2; ++ks) { const bf16x8 kf = *(const LAS bf16x8*)(Kc + (nt * 16 + fr) * TLD + c * 64 + ks * 32 + 8 * fq); a = __builtin_amdgcn_mfma_f32_16x16x32_bf16(kf, qf[c][ks], a, 0, 0, 0); }
                    S[c][nt] = a; }
            float mx[2];
            asm volatile("s_nop 7\n\ts_nop 3\n\t"
                         "v_max3_f32 %0, %2, %3, %4\n\tv_max3_f32 %1, %18, %19, %20\n\t"
                         "v_max3_f32 %0, %0, %5, %6\n\tv_max3_f32 %1, %1, %21, %22\n\t"
                         "v_max3_f32 %0, %0, %7, %8\n\tv_max3_f32 %1, %1, %23, %24\n\t"
                         "v_max3_f32 %0, %0, %9, %10\n\tv_max3_f32 %1, %1, %25, %26\n\t"
                         "v_max3_f32 %0, %0, %11, %12\n\tv_max3_f32 %1, %1, %27, %28\n\t"
                         "v_max3_f32 %0, %0, %13, %14\n\tv_max3_f32 %1, %1, %29, %30\n\t"
                         "v_max3_f32 %0, %0, %15, %16\n\tv_max3_f32 %1, %1, %31, %32\n\t"
                         "v_max_f32 %0, %0, %17\n\tv_max_f32 %1, %1, %33"
                         : "=&v"(mx[0]), "=&v"(mx[1])
                         : "v"(S[0][0][0]), "v"(S[0][0][1]), "v"(S[0][0][2]), "v"(S[0][0][3]), "v"(S[0][1][0]), "v"(S[0][1][1]), "v"(S[0][1][2]), "v"(S[0][1][3]),
                           "v"(S[0][2][0]), "v"(S[0][2][1]), "v"(S[0][2][2]), "v"(S[0][2][3]), "v"(S[0][3][0]), "v"(S[0][3][1]), "v"(S[0][3][2]), "v"(S[0][3][3]),
                           "v"(S[1][0][0]), "v"(S[1][0][1]), "v"(S[1][0][2]), "v"(S[1][0][3]), "v"(S[1][1][0]), "v"(S[1][1][1]), "v"(S[1][1][2]), "v"(S[1][1][3]),
                           "v"(S[1][2][0]), "v"(S[1][2][1]), "v"(S[1][2][2]), "v"(S[1][2][3]), "v"(S[1][3][0]), "v"(S[1][3][1]), "v"(S[1][3][2]), "v"(S[1][3][3]));
            { float a0 = mx[0], b0 = mx[0], a1 = mx[1], b1 = mx[1];
              asm volatile("s_nop 1\n\tv_permlane16_swap_b32 %0, %1\n\tv_permlane16_swap_b32 %2, %3\n\ts_nop 1\n\tv_max_f32 %0, %0, %1\n\tv_max_f32 %2, %2, %3\n\tv_mov_b32 %1, %0\n\tv_mov_b32 %3, %2\n\ts_nop 1\n\t"
                           "v_permlane32_swap_b32 %0, %1\n\tv_permlane32_swap_b32 %2, %3\n\ts_nop 1\n\tv_max_f32 %0, %0, %1\n\tv_max_f32 %2, %2, %3"
                           : "+v"(a0), "+v"(b0), "+v"(a1), "+v"(b1));
              mx[0] = a0; mx[1] = a1; }
            const bool up0 = (kt == 0) || (mx[0] > 8.f), up1 = (kt == 0) || (mx[1] > 8.f);
            if (__any(up0 || up1)) {
#pragma unroll
                for (int c = 0; c < 2; ++c) { const float d = (c ? up1 : up0) ? mx[c] : 0.f; const float al = __builtin_amdgcn_exp2f(-d); mst[c] += d; Ol[c] *= al;
#pragma unroll
                    for (int vt = 0; vt < 8; ++vt) Oa[c][vt] *= al;
#pragma unroll
                    for (int nt = 0; nt < 4; ++nt) S[c][nt] -= d; } }
#pragma unroll
            for (int c = 0; c < 2; ++c) {
#pragma unroll
                for (int nt = 0; nt < 4; ++nt)
#pragma unroll
                    for (int j = 0; j < 4; ++j) S[c][nt][j] = __builtin_amdgcn_exp2f(S[c][nt][j]);
#pragma unroll
                for (int kp = 0; kp < 2; ++kp) { v4u w; w.x = pk2(S[c][2 * kp][0], S[c][2 * kp][1]); w.y = pk2(S[c][2 * kp][2], S[c][2 * kp][3]); w.z = pk2(S[c][2 * kp + 1][0], S[c][2 * kp + 1][1]); w.w = pk2(S[c][2 * kp + 1][2], S[c][2 * kp + 1][3]);
                    pf[c][kp] = __builtin_bit_cast(bf16x8, w); } }
#pragma unroll
            for (int kp = 0; kp < 2; ++kp) { Ol[0] = __builtin_amdgcn_mfma_f32_16x16x32_bf16(ones, pf[0][kp], Ol[0], 0, 0, 0); Ol[1] = __builtin_amdgcn_mfma_f32_16x16x32_bf16(ones, pf[1][kp], Ol[1], 0, 0, 0); }
#pragma unroll
            for (int kp = 0; kp < 2; ++kp)
#pragma unroll
                for (int vt = 0; vt < 8; ++vt) { const LAS bf16* a0 = Vc + (32 * kp + 4 * fq + tq) * TLD + 16 * vt + 4 * tp;
                    const s16x4 lo = __builtin_amdgcn_ds_read_tr16_b64_v4i16((LAS s16x4*)a0); const s16x4 hi = __builtin_amdgcn_ds_read_tr16_b64_v4i16((LAS s16x4*)(a0 + 16 * TLD));
                    const bf16x8 vf = (bf16x8){lo[0], lo[1], lo[2], lo[3], hi[0], hi[1], hi[2], hi[3]};
                    Oa[0][vt] = __builtin_amdgcn_mfma_f32_16x16x32_bf16(vf, pf[0][kp], Oa[0][vt], 0, 0, 0); Oa[1][vt] = __builtin_amdgcn_mfma_f32_16x16x32_bf16(vf, pf[1][kp], Oa[1][vt], 0, 0, 0); }
            __syncthreads();
        }
#undef DA_TB
#undef DA_LD
        { const float i0 = 1.f / Ol[0][0], i1 = lam / Ol[1][0]; float ss = 0.f;
#pragma unroll
          for (int vt = 0; vt < 8; ++vt) { Oa[0][vt] = Oa[0][vt] * i0 - Oa[1][vt] * i1; ss += (Oa[0][vt][0] * Oa[0][vt][0] + Oa[0][vt][1] * Oa[0][vt][1]) + (Oa[0][vt][2] * Oa[0][vt][2] + Oa[0][vt][3] * Oa[0][vt][3]); }
          ss = xrow_sum(ss);
          const float rsn = (1.f - lam_init) / sqrtf(ss * (1.f / 128.f) + EPS);
#pragma unroll
          for (int vt = 0; vt < 8; ++vt) { const f32x4 g = *(const GAS f32x4*)(F.in[I_DNG] + 16 * vt + 4 * fq); const f32x4 o = Oa[0][vt] * rsn * g;
              v2u w; w.x = pk2(o[0], o[1]); w.y = pk2(o[2], o[3]);
              *(GAS v2u*)(Y + (size_t)qrow * D + 1024 + h * 128 + 16 * vt + 4 * fq) = w; } }
    }
    __syncthreads();
}
struct Args { const float* in[35]; float* out; unsigned char* ws; int ph_lo, ph_hi; };
__device__ __forceinline__ bool frame_refresh(Frame& F) { int tz = threadIdx.x; asm volatile("" : "+v"(tz)); F.tid = tz; F.lane = tz & 63; F.wave = __builtin_amdgcn_readfirstlane(tz >> 6);
    const __attribute__((address_space(4))) char* kp = (const __attribute__((address_space(4))) char*)__builtin_amdgcn_kernarg_segment_ptr(); asm volatile("" : "+s"(kp));
    const __attribute__((address_space(4))) Args* ap = (const __attribute__((address_space(4))) Args*)kp;
#pragma unroll
    for (int i = 0; i < 35; ++i) F.in[i] = ap->in[i];
    F.out = ap->out; F.ws = ap->ws; F.ctl = (gu32*)(ap->ws + WS_CTL); return true; }
constexpr int NPHASE = 24;
__global__ void __launch_bounds__(NTHR, 2) skel_fwd(Args args) {
    extern __shared__ __attribute__((aligned(16))) unsigned char lds[];
    Frame F;
    F.lds = (LAS unsigned char*)lds;
    F.MISC = (volatile LAS unsigned*)(F.lds + MISC_OFF);
    F.tid = threadIdx.x; F.lane = F.tid & 63; F.wave = __builtin_amdgcn_readfirstlane(F.tid >> 6);
    F.G = gridDim.x; F.bid = blockIdx.x;
    F.ws = args.ws; F.out = args.out; F.ctl = (gu32*)(args.ws + WS_CTL);
    for (int u = F.tid; u < (LDS_BYTES - LDSCTL_OFF) / 4; u += NTHR) ((LAS unsigned*)(F.lds + LDSCTL_OFF))[u] = 0u;
    __syncthreads();
    const int lo = args.ph_lo, hi = args.ph_hi;
    XcdBarrier bar; bar.bar = (unsigned*)(F.ctl + CW_BAR); bar.x = 0; bar.st = nullptr;
    if (hi - lo > 1) bar = xcd_barrier_post((unsigned*)(F.ctl + CW_BAR), F.MISC + 8);
#define IN(k) (lo <= (k) && (k) < hi && frame_refresh(F))
#define SEAM(k) do { if (lo <= (k) && (k) + 1 < hi) xcd_barrier(bar); } while (0)
#define MOD ((const float*)(F.ws + WS_MOD))
#define Abuf ((bf16*)(F.ws + WS_A))
#define Pbuf ((bf16*)(F.ws + WS_P))
#define Ybuf ((bf16*)(F.ws + WS_Y))
#define Hbuf ((float*)(F.ws + WS_H))
#define XS ((bf16*)(F.ws + WS_XS))
#define HID ((bf16*)(F.ws + WS_HID))
#define YS ((bf16*)(F.ws + WS_YS))
    if (IN(0)) { p0_adaln(F); __syncthreads(); p0_filters(F); __syncthreads(); p0_convert(F); } SEAM(0);
    if (IN(1)) { ph_norm1_l0(F); ph_hy_ftt(F); } SEAM(1);
    if (IN(2)) { pg8::Gemm g{Abuf, (const bf16*)(F.ws + WS_WIN0), M_ALL, 6144, D}; pg8::StaticOrder S; S.init(M_ALL, 6144, F.G, F.bid);
        pg8::EpiStore E{Pbuf, LD0, 24, 1.f};
        pg8::gemm_phase<pg8::EpiStore, pg8::StaticOrder, PG8_ALIGN, PG8_SP2>(F.lds + RING_OFF, g, S, E); ph_codes_skinny(F); cvt_late(F, CVT_L0_END - CVT_LATE0, 192, 10); } SEAM(2);
    if (IN(3)) { ph_gla_prep(F); ph_hy_shortconv(F); ph_hy_prep_lat(F); } SEAM(3);
    if (IN(4)) { ph_gla_scan2(F); ph_hy_conv_lat(F); ph_hy_longconv(F, 0); } SEAM(4);
    if (IN(5)) { ph_hy_longconv(F, 1); ph_hy_post_lat(F); const bf16* OG = (const bf16*)(F.ws + WS_OG);
        ph_mix_combine<0>(F, M_ALL, OG, OG + (size_t)M_ALL * 1024, Pbuf, LD0, C0_GR, F.in[I_GNG], 1024); } SEAM(5);
    if (IN(6)) { pg8::Gemm g{Ybuf, (const bf16*)(F.ws + WS_WOUT), M_ALL, D, D}; pg8::StaticOrder S; S.init(M_ALL, D, F.G, F.bid);
        pg8::EpiRes E{F.in[I_X], F.in[I_CTX], Hbuf, MOD + 2 * 2048};
        pg8::gemm_phase<pg8::EpiRes, pg8::StaticOrder, PG8_ALIGN, PG8_SP2>(F.lds + RING_OFF, g, S, E);  cvt_late(F, CVT_L0_END - CVT_LATE0 + 64 * 10, 64, 14); } SEAM(6);
    if (IN(7)) { ph_norm2_router2(F, 0, M_ALL); } SEAM(7);
    if (IN(8)) { ph_topk(F, 256, ME0); } SEAM(8);
    if (IN(10)) { pg8::Gemm g{XS, (const bf16*)(F.ws + WS_W13), 16 * ME0, 4096, D}; pg8::GroupedOrder S; S.init(ME0 / 256, 16, F.G, F.bid);
        pg8::EpiSwiglu E{(unsigned char*)HID};
        pg8::gemm_phase<pg8::EpiSwiglu, pg8::GroupedOrder, PG8_ALIGN, PG8_SP2, true>(F.lds + RING_OFF, g, S, E); } SEAM(10);
    if (IN(11)) { pg8::Gemm g{HID, (const bf16*)(F.ws + WS_W2), 16 * ME0, 2048, D}; pg8::GroupedOrder S; S.init(ME0 / 256, 8, F.G, F.bid);
        pg8::EpiStore E{YS, D, 8, 1.f / 64.f};
        pg8::gemm_phase<pg8::EpiStore, pg8::GroupedOrder, PG8_ALIGN, PG8_SP2, true>(F.lds + RING_OFF, g, S, E);  cvt_late(F, CVT_L1_END - CVT_LATE1, 128, 5); } SEAM(11);
    if (IN(12)) { ph_combine<0>(F, 0, M_ALL); } SEAM(12);
    if (IN(13)) { pg8::Gemm g{Abuf, (const bf16*)(F.ws + WS_WIN1), M_ALL, LD1, D}; pg8::In1Order S; S.init(F.G, F.bid);
        pg8::EpiStore E{Pbuf, LD1, LD1 / 256, 1.f};
        pg8::gemm_phase<pg8::EpiStore, pg8::In1Order, PG8_ALIGN, PG8_SP2>(F.lds + RING_OFF, g, S, E);  cvt_late(F, CVT_L1_END - CVT_LATE1 + 128 * 5, 200, 10); } SEAM(13);
    if (IN(14)) { ph_ml_prep(F); ph_da_rope(F); } SEAM(14);
    if (IN(15)) { ph_ml_scan2(F); ph_da_attn2(F); } SEAM(15);
    if (IN(16)) { const bf16* OM = (const bf16*)(F.ws + WS_OG);
        ph_mix_combine<1>(F, M_LAT, OM, OM + (size_t)M_LAT * 1024, Pbuf, LD1, C1_MO, F.in[I_MNG], 0); } SEAM(16);
    if (IN(17)) { pg8::Gemm g{Ybuf, (const bf16*)(F.ws + WS_WOUT) + (size_t)D * D, M_LAT, D, D}; pg8::StaticOrder S; S.init(M_LAT, D, F.G, F.bid);
        pg8::EpiRes E{Hbuf, Hbuf, Hbuf, MOD + 9 * 12288 + 2 * 2048};
        pg8::gemm_phase<pg8::EpiRes, pg8::StaticOrder, PG8_ALIGN, PG8_SP2>(F.lds + RING_OFF, g, S, E); } SEAM(17);
    if (IN(18)) { ph_norm2_router2(F, 1, M_LAT); } SEAM(18);
    if (IN(19)) { ph_topk(F, 128, ME1); } SEAM(19);
    if (IN(21)) { pg8::Gemm g{XS, (const bf16*)(F.ws + WS_W13) + (size_t)16 * 4096 * 1024, 16 * ME1, 4096, D}; pg8::GroupedOrder S; S.init(ME1 / 256, 16, F.G, F.bid);
        pg8::EpiSwiglu E{(unsigned char*)HID};
        pg8::gemm_phase<pg8::EpiSwiglu, pg8::GroupedOrder, PG8_ALIGN, PG8_SP2, true>(F.lds + RING_OFF, g, S, E); } SEAM(21);
    if (IN(22)) { pg8::Gemm g{HID, (const bf16*)(F.ws + WS_W2) + (size_t)16 * 2048 * 1024, 16 * ME1, 2048, D}; pg8::GroupedOrder S; S.init(ME1 / 256, 8, F.G, F.bid);
        pg8::EpiStore E{YS, D, 8, 1.f / 64.f};
        pg8::gemm_phase<pg8::EpiStore, pg8::GroupedOrder, PG8_ALIGN, PG8_SP2, true>(F.lds + RING_OFF, g, S, E); } SEAM(22);
    if (IN(23)) { ph_combine<1>(F, 1, M_LAT); }
#undef IN
#undef SEAM
#undef MOD
#undef Abuf
#undef Pbuf
#undef Ybuf
#undef Hbuf
#undef XS
#undef HID
#undef YS
}

extern "C" void kernel_launch(void* const* d_in, const int* in_sizes, int n_in, void* d_out, int out_size, void* d_ws, size_t ws_size, hipStream_t stream) {
    static int grid = 0;
    if (grid == 0) {
        if (n_in != 35 || ws_size < WS_END) { fprintf(stderr, "kernel_launch: unexpected n_in %d / ws_size %zu\n", n_in, ws_size); grid = -1; return; }
        int dev = 0, cus = 0, per_cu = 0;
        if (hipGetDevice(&dev) != hipSuccess || hipDeviceGetAttribute(&cus, hipDeviceAttributeMultiprocessorCount, dev) != hipSuccess) { grid = -1; return; }
        if (hipFuncSetAttribute((const void*)skel_fwd, hipFuncAttributeMaxDynamicSharedMemorySize, LDS_BYTES) != hipSuccess) { fprintf(stderr, "kernel_launch: hipFuncSetAttribute failed\n"); grid = -1; return; }
        if (hipOccupancyMaxActiveBlocksPerMultiprocessor(&per_cu, (const void*)skel_fwd, NTHR, LDS_BYTES) != hipSuccess || per_cu < 1) fprintf(stderr, "kernel_launch: occupancy query says %d\n", per_cu);
        (void)hipGetLastError();
        grid = cus;
    }
    if (grid < 0) return;
    if (hipMemsetAsync((char*)d_ws + WS_CTL, 0, CTL_ZERO_BYTES, stream) != hipSuccess) return;
    Args a{};
    for (int i = 0; i < 35; ++i) a.in[i] = (const float*)d_in[i];
    a.out = (float*)d_out; a.ws = (unsigned char*)d_ws;
#if MK_ONE_LAUNCH
    a.ph_lo = 0; a.ph_hi = NPHASE;
    hipLaunchKernelGGL(skel_fwd, dim3(grid), dim3(NTHR), LDS_BYTES, stream, a);
#else
    for (int k = 0; k < NPHASE; ++k) { a.ph_lo = k; a.ph_hi = k + 1; hipLaunchKernelGGL(skel_fwd, dim3(grid), dim3(NTHR), LDS_BYTES, stream, a); }
#endif
}
```

```cpp
#include <hip/hip_runtime.h>
#include <cstdio>
#include <cstdint>
namespace pg8 {
#define PG8_LAS __attribute__((address_space(3)))
typedef unsigned short bf16_t;
typedef short bf16x8 __attribute__((ext_vector_type(8)));
typedef float f32x4 __attribute__((ext_vector_type(4)));
typedef unsigned u32x4 __attribute__((ext_vector_type(4)));
constexpr int BM = 256, BK = 64, HALF = 128, HTB = HALF * BK * 2  , STAGE_BYTES = 8 * HTB, NXCD = 8, WGM = 8;

__host__ __device__ __forceinline__ int lds_byte(int r, int c) { const int st = (r >> 4) * 2 + (c >> 5), rr = r & 15, cc = c & 31, ob = rr * 64 + cc * 2; return st * 1024 + (ob ^ (((ob >> 9) & 1) << 5)); }
__host__ __device__ __forceinline__ void stage_rc(int b, int& R, int& C) { const int st = b / 1024, sb = b % 1024, swz = sb ^ (((sb >> 9) & 1) << 5); R = (st >> 1) * 16 + swz / 64; C = (st & 1) * 32 + (swz % 64) / 2; }
__host__ __device__ __forceinline__ int perm32(int rho) { const int n = rho >> 4, i = rho & 15; return 8 * (i >> 2) + 4 * n + (i & 3); }

struct Unit { int pm, pn; };
struct Gemm { const bf16_t* A; const bf16_t* Bt; int M, N, K; };

struct StaticOrder {
    int nM, nN, nwg, G, c;
    __host__ __device__ void init(int M, int N, int G_, int c_) { nM = M / BM; nN = N / BM; nwg = nM * nN; G = G_; c = c_; }
    __host__ __device__ bool next(int i, Unit& u) const {
        const long L = (long)i * G + c; if (L >= nwg) return false;
        int wgid = (int)L; { const int q = nwg / NXCD, r = nwg % NXCD, xcd = wgid % NXCD, off = wgid / NXCD; wgid = (xcd < r ? xcd * (q + 1) : r * (q + 1) + (xcd - r) * q) + off; }
        const int nig = WGM * nN, gid = wgid / nig, fm = gid * WGM, gsz = (nM - fm) < WGM ? (nM - fm) : WGM;
        u.pm = fm + ((wgid % nig) % gsz); u.pn = (wgid % nig) / gsz; return true;
    }
    __device__ __forceinline__ void a_ready(const Unit&) const {}
    __device__ __forceinline__ void done(const Unit&) const {}
};

__device__ __forceinline__ unsigned cvt_pk_bf16(float lo, float hi) { unsigned r; asm volatile("v_cvt_pk_bf16_f32 %0, %1, %2" : "=v"(r) : "v"(lo), "v"(hi)); return r; }
typedef float f32x2 __attribute__((ext_vector_type(2)));
__device__ __forceinline__ f32x2 gelu_pk(f32x2 v) {
    const f32x2 av = __builtin_elementwise_abs(v), d = av * 0.2316418882f + 1.0f;
    f32x2 t; t.x = __builtin_amdgcn_rcpf(d.x); t.y = __builtin_amdgcn_rcpf(d.y);
    f32x2 q = t * 0.5307027145f + (-0.7265760135f); q = q * t + 0.7107068705f; q = q * t + (-0.142248368f); q = q * t + 0.127414796f; q = q * t;
    const f32x2 s = (v * v) * (-0.72134752044f);
    f32x2 e; e.x = __builtin_amdgcn_exp2f(s.x); e.y = __builtin_amdgcn_exp2f(s.y);
    const f32x2 m = v * (q * e), r = v - m;
    f32x2 o; o.x = v.x < 0.f ? m.x : r.x; o.y = v.y < 0.f ? m.y : r.y; return o;
}

typedef int v8i32 __attribute__((ext_vector_type(8)));
template <class Epi, class Sched, bool ALIGN_EPI = false, bool SP2 = false, bool FP8 = false>
__device__ __forceinline__ void gemm_phase(PG8_LAS unsigned char* lds, const Gemm g, const Sched& S, const Epi& E) {
    int tid_ = threadIdx.x; asm volatile("" : "+v"(tid_));
    const int tid = tid_, wid = __builtin_amdgcn_readfirstlane(tid >> 6), lane = tid & 63, wr = wid >> 2, wc = wid & 3, fr = lane & 15, fq = lane >> 4;
    const int K = FP8 ? g.K / 2 : g.K, nt = K / BK;
    unsigned voffA[2], voffB[2];
#pragma unroll
    for (int i = 0; i < 2; ++i) { int R, C; stage_rc(tid * 16 + i * 8192, R, C); const int Rb = Epi::PERM ? ((R & ~31) + perm32(R & 31)) : R;
        voffA[i] = (unsigned)(R * K + C) * 2u; voffB[i] = (unsigned)(Rb * K + C) * 2u; }
    const size_t kstep = (size_t)(BK * 2);
    const size_t hstep = (size_t)HALF * K * 2;
    const size_t tstep = 2 * hstep;
    const unsigned ldsw = (unsigned)wid * 1024u;
    const int aoff = lds_byte(wr * 64 + fr, fq * 8), boff = lds_byte(wc * 32 + fr, fq * 8);
#define PG8_SA(b, h) (((b) * 2 + (h)) * HTB)
#define PG8_SB(b, h) ((4 + (b) * 2 + (h)) * HTB)
#define PG8_STAGE(bufoff, gbase, voff) do { _Pragma("unroll") for (int _i = 0; _i < 2; ++_i) \
        __builtin_amdgcn_global_load_lds((const unsigned*)((const char*)(gbase) + (voff)[_i]), (PG8_LAS unsigned*)(lds + (bufoff) + ldsw + _i * 8192), 16, 0, 0); } while (0)
#define PG8_LDA(dst, b, h) do { _Pragma("unroll") for (int m = 0; m < 4; ++m) _Pragma("unroll") for (int k = 0; k < 2; ++k) dst[m][k] = *(const PG8_LAS bf16x8*)(lds + PG8_SA(b, h) + aoff + m * 2048 + k * 1024); } while (0)
#define PG8_LDB(dst, b, h) do { _Pragma("unroll") for (int n = 0; n < 2; ++n) _Pragma("unroll") for (int k = 0; k < 2; ++k) dst[n][k] = *(const PG8_LAS bf16x8*)(lds + PG8_SB(b, h) + boff + n * 2048 + k * 1024); } while (0)
#define PG8_MMA(ai, bj, At, Bt) do { __builtin_amdgcn_s_setprio(1); _Pragma("unroll") for (int m = 0; m < 4; ++m) _Pragma("unroll") for (int n = 0; n < 2; ++n) { \
        if constexpr (FP8) { typedef int i32x4_ __attribute__((ext_vector_type(4))); \
            const v8i32 _bv = __builtin_shufflevector(__builtin_bit_cast(i32x4_, Bt[n][0]), __builtin_bit_cast(i32x4_, Bt[n][1]), 0, 1, 2, 3, 4, 5, 6, 7); \
            const v8i32 _av = __builtin_shufflevector(__builtin_bit_cast(i32x4_, At[m][0]), __builtin_bit_cast(i32x4_, At[m][1]), 0, 1, 2, 3, 4, 5, 6, 7); \
            asm volatile("s_nop 1\n\tv_mfma_scale_f32_16x16x128_f8f6f4 %0, %1, %2, %0, %3, %3 op_sel_hi:[0,0,0]" : "+v"(acc[ai][bj][m][n]) : "v"(_bv), "v"(_av), "v"(0x7f7f7f7f)); } \
        else { _Pragma("unroll") for (int k = 0; k < 2; ++k) acc[ai][bj][m][n] = __builtin_amdgcn_mfma_f32_16x16x32_bf16(Bt[n][k], At[m][k], acc[ai][bj][m][n], 0, 0, 0); } } \
        __builtin_amdgcn_s_setprio(0); } while (0)
#define PG8_WAIT_V(n) asm volatile("s_waitcnt vmcnt(" #n ")" ::: "memory")
#define PG8_WAIT_L(n) asm volatile("s_waitcnt lgkmcnt(" #n ")" ::: "memory")
#define PG8_BAR __builtin_amdgcn_s_barrier()
#define PG8_SCHED __builtin_amdgcn_sched_barrier(0)
    Unit cur, nxt; int ui = 0;
    if (!S.next(0, cur)) return;
    f32x4 acc[2][2][4][2];
#pragma unroll
    for (int a = 0; a < 2; ++a)
#pragma unroll
        for (int b = 0; b < 2; ++b)
#pragma unroll
            for (int m = 0; m < 4; ++m)
#pragma unroll
                for (int n = 0; n < 2; ++n) acc[a][b][m][n] = (f32x4){0.f, 0.f, 0.f, 0.f};
    bf16x8 At[4][2], B0[2][2], B1[2][2];
    const char* cA = (const char*)g.A + (size_t)cur.pm * tstep; const char* cB = (const char*)g.Bt + (size_t)cur.pn * tstep;
    S.a_ready(cur);
    if constexpr (SP2) {
        PG8_STAGE(PG8_SB(0, 0), cB, voffB); PG8_STAGE(PG8_SB(0, 1), cB + hstep, voffB); PG8_STAGE(PG8_SA(0, 0), cA, voffA); PG8_STAGE(PG8_SA(0, 1), cA + hstep, voffA);
        if (wr == 1) PG8_BAR;
        PG8_WAIT_V(2); PG8_BAR;
        PG8_STAGE(PG8_SB(1, 0), cB + kstep, voffB); PG8_STAGE(PG8_SA(1, 0), cA + kstep, voffA); PG8_STAGE(PG8_SB(1, 1), cB + hstep + kstep, voffB);
        PG8_WAIT_V(6); PG8_BAR;
    } else {
        PG8_STAGE(PG8_SB(0, 0), cB, voffB); PG8_STAGE(PG8_SA(0, 0), cA, voffA); PG8_STAGE(PG8_SB(0, 1), cB + hstep, voffB); PG8_STAGE(PG8_SA(0, 1), cA + hstep, voffA);
        if (wr == 1) PG8_BAR;
        PG8_WAIT_V(4); PG8_BAR;
        PG8_STAGE(PG8_SB(1, 0), cB + kstep, voffB); PG8_STAGE(PG8_SA(1, 0), cA + kstep, voffA); PG8_STAGE(PG8_SB(1, 1), cB + hstep + kstep, voffB);
        PG8_WAIT_V(6); PG8_BAR;
    }
    for (;;) {
        const bool has_next = S.next(ui + 1, nxt);
        const char* nA = has_next ? (const char*)g.A + (size_t)nxt.pm * tstep : cA; const char* nB = has_next ? (const char*)g.Bt + (size_t)nxt.pn * tstep : cB;
        for (int t = 0; t < nt; t += 2) {
            const bool last = (t == nt - 2);
            const char* a1 = cA + (size_t)(t + 1) * kstep;
            const char* a2 = last ? nA : cA + (size_t)(t + 2) * kstep; const char* b2 = last ? nB : cB + (size_t)(t + 2) * kstep;
            const char* a3 = a2 + kstep; const char* b3 = b2 + kstep;
            if (last && has_next) S.a_ready(nxt);
            if constexpr (SP2) {
            PG8_LDB(B0, 0, 0); PG8_LDB(B1, 0, 1); PG8_SCHED; PG8_LDA(At, 0, 0); PG8_STAGE(PG8_SA(1, 1), a1 + hstep, voffA);
            PG8_WAIT_V(8); PG8_WAIT_L(0); PG8_BAR; PG8_MMA(0, 0, At, B0); PG8_MMA(0, 1, At, B1); PG8_BAR; PG8_SCHED;
            PG8_LDA(At, 0, 1); PG8_STAGE(PG8_SB(0, 0), b2, voffB); PG8_STAGE(PG8_SB(0, 1), b2 + hstep, voffB); PG8_STAGE(PG8_SA(0, 0), a2, voffA);
            PG8_WAIT_V(8); PG8_WAIT_L(0); PG8_BAR; PG8_MMA(1, 0, At, B0); PG8_MMA(1, 1, At, B1); PG8_BAR; PG8_SCHED;
            PG8_LDB(B0, 1, 0); PG8_LDB(B1, 1, 1); PG8_SCHED; PG8_LDA(At, 1, 0); PG8_STAGE(PG8_SA(0, 1), a2 + hstep, voffA);
            PG8_WAIT_V(8); PG8_WAIT_L(0); PG8_BAR; PG8_MMA(0, 0, At, B0); PG8_MMA(0, 1, At, B1); PG8_BAR; PG8_SCHED;
            PG8_LDA(At, 1, 1); PG8_STAGE(PG8_SB(1, 0), b3, voffB); PG8_STAGE(PG8_SB(1, 1), b3 + hstep, voffB); PG8_STAGE(PG8_SA(1, 0), a3, voffA);
            PG8_WAIT_V(8); PG8_WAIT_L(0); PG8_BAR; PG8_MMA(1, 0, At, B0); PG8_MMA(1, 1, At, B1); PG8_BAR; PG8_SCHED;
            } else {
            PG8_LDB(B0, 0, 0); PG8_SCHED; PG8_LDA(At, 0, 0); PG8_STAGE(PG8_SA(1, 1), a1 + hstep, voffA);
            PG8_WAIT_L(8); PG8_BAR; PG8_WAIT_L(0); PG8_MMA(0, 0, At, B0); PG8_BAR; PG8_SCHED;
            PG8_LDB(B1, 0, 1); PG8_STAGE(PG8_SB(0, 0), b2, voffB);
            PG8_BAR; PG8_WAIT_L(0); PG8_MMA(0, 1, At, B1); PG8_BAR;
            PG8_LDA(At, 0, 1); PG8_STAGE(PG8_SA(0, 0), a2, voffA);
            PG8_BAR; PG8_WAIT_L(0); PG8_MMA(1, 0, At, B0); PG8_BAR; PG8_SCHED;
            PG8_STAGE(PG8_SB(0, 1), b2 + hstep, voffB);
            PG8_WAIT_V(6); PG8_BAR; PG8_MMA(1, 1, At, B1); PG8_BAR;
            PG8_LDB(B0, 1, 0); PG8_SCHED; PG8_LDA(At, 1, 0); PG8_STAGE(PG8_SA(0, 1), a2 + hstep, voffA);
            PG8_WAIT_L(8); PG8_BAR; PG8_WAIT_L(0); PG8_MMA(0, 0, At, B0); PG8_BAR; PG8_SCHED;
            PG8_LDB(B1, 1, 1); PG8_STAGE(PG8_SB(1, 0), b3, voffB);
            PG8_BAR; PG8_WAIT_L(0); PG8_MMA(0, 1, At, B1); PG8_BAR;
            PG8_LDA(At, 1, 1); PG8_STAGE(PG8_SA(1, 0), a3, voffA);
            PG8_BAR; PG8_WAIT_L(0); PG8_MMA(1, 0, At, B0); PG8_BAR; PG8_SCHED;
            PG8_STAGE(PG8_SB(1, 1), b3 + hstep, voffB);
            PG8_WAIT_V(6); PG8_BAR; PG8_MMA(1, 1, At, B1); PG8_BAR;
            }
        }
        if constexpr (FP8) asm volatile("s_nop 15" ::: "memory");
        if constexpr (ALIGN_EPI) { if (wr == 0) PG8_BAR; }
        if constexpr (!Epi::AFTER_DRAIN) { E(acc, cur, wr, wc, fr, fq); S.done(cur); }
        if (!has_next) break;
#pragma unroll
        for (int a = 0; a < 2; ++a)
#pragma unroll
            for (int b = 0; b < 2; ++b)
#pragma unroll
                for (int m = 0; m < 4; ++m)
#pragma unroll
                    for (int n = 0; n < 2; ++n) acc[a][b][m][n] = (f32x4){0.f, 0.f, 0.f, 0.f};
        cur = nxt; cA = nA; cB = nB; ++ui;
        if constexpr (ALIGN_EPI) { if (wr == 1) PG8_BAR; }
    }
    PG8_WAIT_V(0);
    if constexpr (!ALIGN_EPI) { if (wr == 0) PG8_BAR; }
    PG8_BAR;
    if constexpr (Epi::AFTER_DRAIN) { E.fused(acc, cur, wr, wc, fr, fq, lds, wid, lane); S.done(cur); }
#undef PG8_SA
#undef PG8_SB
#undef PG8_STAGE
#undef PG8_LDA
#undef PG8_LDB
#undef PG8_MMA
#undef PG8_WAIT_V
#undef PG8_WAIT_L
#undef PG8_BAR
#undef PG8_SCHED
}
}
namespace pg8 {
struct GroupedOrder {
    int nMe, nNe, per, nwg, G, c;
    __host__ __device__ void init(int nMe_, int nNe_, int G_, int c_) { nMe = nMe_; nNe = nNe_; per = nMe * nNe; nwg = 16 * per; G = G_; c = c_; }
    __host__ __device__ bool next(int i, Unit& u) const {
        const long L = (long)i * G + c; if (L >= nwg) return false;
        int wgid = (int)L; { const int q = nwg / NXCD, r = nwg % NXCD, xcd = wgid % NXCD, off = wgid / NXCD; wgid = (xcd < r ? xcd * (q + 1) : r * (q + 1) + (xcd - r) * q) + off; }
        const int e = wgid / per, l = wgid % per;
        u.pm = e * nMe + (l % nMe); u.pn = e * nNe + (l / nMe); return true;
    }
    __device__ __forceinline__ void a_ready(const Unit&) const {}
    __device__ __forceinline__ void done(const Unit&) const {}
};
struct In1Order {
    StaticOrder S0; int G, c;
    __host__ __device__ void init(int G_, int c_) { S0.init(16384, 29 * 256, G_, c_); G = G_; c = c_; }
    __host__ __device__ bool next(int i, Unit& u) const {
        const long L = (long)i * G + c;
        if (L < 1856) return S0.next(i, u);
        const int q = (int)L - 1856; if (q >= 136) return false;
        const int t = q % 17; u.pm = 64 + q / 17; u.pn = (t < 8) ? 4 + t : ((t < 16) ? 12 + t : 28); return true;
    }
    __device__ __forceinline__ void a_ready(const Unit&) const {}
    __device__ __forceinline__ void done(const Unit&) const {}
};
struct EpiStore {
    static constexpr bool PERM = true, AFTER_DRAIN = false;
    bf16_t* O; int ldc; int nNt; float sc;
    __device__ __forceinline__ void operator()(const f32x4 (&acc)[2][2][4][2], const Unit& u, int wr, int wc, int fr, int fq) const {
        const int row0 = u.pm * BM + wr * 64 + fr; const int col0 = (u.pn % nNt) * BM + wc * 32 + 8 * fq;
#pragma unroll
        for (int ai = 0; ai < 2; ++ai)
#pragma unroll
            for (int m = 0; m < 4; ++m) { bf16_t* rowp = O + (size_t)(row0 + ai * HALF + m * 16) * ldc + col0;
#pragma unroll
                for (int bj = 0; bj < 2; ++bj) { const f32x4 v0 = acc[ai][bj][m][0] * sc, v1 = acc[ai][bj][m][1] * sc;
                    u32x4 w; w.x = cvt_pk_bf16(v0[0], v0[1]); w.y = cvt_pk_bf16(v0[2], v0[3]); w.z = cvt_pk_bf16(v1[0], v1[1]); w.w = cvt_pk_bf16(v1[2], v1[3]);
                    *(u32x4*)(rowp + bj * HALF) = w; } }
    }
};
struct EpiSwiglu {
    static constexpr bool PERM = true, AFTER_DRAIN = false;
    unsigned char* O;
    __device__ __forceinline__ float sg(float a, float b) const { const float x = a * (1.f / 64.f); const float r = x * __builtin_amdgcn_rcpf(1.f + __expf(-x)) * (b * (1.f / 64.f)); return fminf(fmaxf(r, -448.f), 448.f); }
    __device__ __forceinline__ void operator()(const f32x4 (&acc)[2][2][4][2], const Unit& u, int wr, int wc, int fr, int fq) const {
        const int row0 = u.pm * BM + wr * 64 + fr; const int col0 = (u.pn % 16) * HALF + wc * 32 + 8 * fq;
#pragma unroll
        for (int ai = 0; ai < 2; ++ai)
#pragma unroll
            for (int m = 0; m < 4; ++m) { unsigned char* rowp = O + (size_t)(row0 + ai * HALF + m * 16) * 2048 + col0;
                const f32x4 a0 = acc[ai][0][m][0], a1 = acc[ai][0][m][1], b0 = acc[ai][1][m][0], b1 = acc[ai][1][m][1];
                int lo = 0, hi = 0;
                lo = __builtin_amdgcn_cvt_pk_fp8_f32(sg(a0[0], b0[0]), sg(a0[1], b0[1]), lo, false); lo = __builtin_amdgcn_cvt_pk_fp8_f32(sg(a0[2], b0[2]), sg(a0[3], b0[3]), lo, true);
                hi = __builtin_amdgcn_cvt_pk_fp8_f32(sg(a1[0], b1[0]), sg(a1[1], b1[1]), hi, false); hi = __builtin_amdgcn_cvt_pk_fp8_f32(sg(a1[2], b1[2]), sg(a1[3], b1[3]), hi, true);
                typedef unsigned u32x2 __attribute__((ext_vector_type(2)));
                *(u32x2*)rowp = (u32x2){(unsigned)lo, (unsigned)hi}; }
    }
};
struct EpiRes {
    static constexpr bool PERM = false, AFTER_DRAIN = false;
    const float* Xlat; const float* Xctx; float* H; const float* gate;
    __device__ __forceinline__ void operator()(const f32x4 (&acc)[2][2][4][2], const Unit& u, int wr, int wc, int fr, int fq) const {
        const int row0 = u.pm * BM + wr * 64 + fr, col0 = u.pn * BM + wc * 32 + 4 * fq;
        const float* gp = gate + (size_t)((u.pm < 64) ? (u.pm >> 3) : 8) * 12288 + col0;
        f32x4 g[2][2];
#pragma unroll
        for (int bj = 0; bj < 2; ++bj)
#pragma unroll
            for (int n = 0; n < 2; ++n) g[bj][n] = *(const f32x4*)(gp + bj * HALF + n * 16);
        const float* sbase = (u.pm < 64) ? Xlat : Xctx - (size_t)16384 * 2048;
#pragma unroll
        for (int ai = 0; ai < 2; ++ai)
#pragma unroll
            for (int m = 0; m < 4; ++m) { const int row = row0 + ai * HALF + m * 16;
                const float* src = sbase + (size_t)row * 2048 + col0; float* dst = H + (size_t)row * 2048 + col0;
#pragma unroll
                for (int bj = 0; bj < 2; ++bj)
#pragma unroll
                    for (int n = 0; n < 2; ++n) { const int c = bj * HALF + n * 16;
                        const f32x4 x = *(const f32x4*)(src + c);
                        *(f32x4*)(dst + c) = x + g[bj][n] * acc[ai][bj][m][n]; } }
    }
};
}
#ifndef PG8_SP2
#define PG8_SP2 true
#endif
#ifndef PG8_ALIGN
#define PG8_ALIGN true
#endif
constexpr int NWAVES = 8;
constexpr int NTHR = NWAVES * 64;
#ifndef MK_ONE_LAUNCH
#define MK_ONE_LAUNCH 1
#endif
constexpr int D = 2048, NB = 8, SEQ = 2048, CTXL = 256;
constexpr int M_LAT = NB * SEQ, M_CTX = NB * CTXL, M_ALL = M_LAT + M_CTX;
constexpr int LD0 = 6400, LD1 = 7424;
constexpr int EV_IN = 6176, OD_IN = 7184;
constexpr int NE_ = 16, FF = 2048;
constexpr int ME0 = 2304, ME1 = 2048;
constexpr float EPS = 1e-6f;
constexpr int C0_X1 = 0, C0_X2 = 1024, C0_V = 2048, C0_GQ = 3072, C0_GK = 3584, C0_GV = 4096, C0_GR = 5120, C0_CODE = 6144;
constexpr int C1_MQ = 0, C1_MK = 1024, C1_MV = 2048, C1_MO = 3072, C1_DQ = 4096, C1_DK = 5120, C1_DV = 6144, C1_G = 7168;
constexpr size_t MiB = 1u << 20;
constexpr size_t WS_CTL = 0, CTL_ZERO_BYTES = 1 * MiB;
constexpr size_t WS_MOD = 1 * MiB;
constexpr size_t WS_AFF = 2 * MiB;
constexpr size_t WS_SEL = 4 * MiB;
constexpr size_t WS_TOK = 6 * MiB;
constexpr size_t WS_GW  = 7 * MiB;
constexpr size_t WS_FTL = 8 * MiB;
constexpr size_t WS_FTC = 40 * MiB;
constexpr size_t WS_WIN0 = 44 * MiB;
constexpr size_t WS_WIN1 = 69 * MiB;
constexpr size_t WS_WOUT = 98 * MiB;
constexpr size_t WS_W13 = 114 * MiB;
constexpr size_t WS_W2 = 626 * MiB;
constexpr size_t WS_H = 882 * MiB;
constexpr size_t WS_A = 1026 * MiB;
constexpr size_t WS_Y = 1098 * MiB;
constexpr size_t WS_P = 1170 * MiB;
constexpr size_t WS_XS = WS_P, WS_YS = WS_P;
constexpr size_t WS_MIX = 1431 * MiB;
constexpr size_t WS_XV = WS_MIX, WS_Z = WS_MIX + 108 * MiB, WS_OG = WS_MIX + 144 * MiB;
constexpr size_t WS_HID = WS_MIX;
constexpr size_t WS_XT = 1719 * MiB;
constexpr size_t WS_YT = 1815 * MiB;
constexpr size_t WS_FTT = 1847 * MiB;
constexpr size_t WS_GQ = 1864 * MiB;
constexpr size_t WS_GDEC = 1972 * MiB;
constexpr size_t WS_MQK = WS_GQ;
constexpr size_t WS_MLS = WS_GQ + 80 * MiB;
constexpr size_t WS_END = 1974 * MiB;
constexpr int CW_BAR = 4096;
constexpr int RING_OFF = 0, RING_BYTES = 131072;
constexpr int LDSCTL_OFF = 146432, MISC_OFF = LDSCTL_OFF + 320;
constexpr int LDS_BYTES = 147456;
#define GAS __attribute__((address_space(1)))
#define LAS __attribute__((address_space(3)))
typedef unsigned short bf16;
typedef unsigned v4u __attribute__((ext_vector_type(4)));
typedef unsigned v2u __attribute__((ext_vector_type(2)));
typedef float f32x4 __attribute__((ext_vector_type(4)));
typedef short bf16x8 __attribute__((ext_vector_type(8)));
typedef GAS unsigned gu32;
#define RLX_AGENT __ATOMIC_RELAXED, __HIP_MEMORY_SCOPE_AGENT
#define LDS_WAIT() asm volatile("s_waitcnt lgkmcnt(0)" ::: "memory")
#define VM_WAIT() asm volatile("s_waitcnt vmcnt(0)" ::: "memory")
typedef float f32x2v_ __attribute__((ext_vector_type(2)));
typedef __bf16 bf16x2v_ __attribute__((ext_vector_type(2)));
__device__ __forceinline__ unsigned pk2(float lo, float hi) { return __builtin_bit_cast(unsigned, __builtin_convertvector((f32x2v_){lo, hi}, bf16x2v_)); }
__device__ __forceinline__ unsigned f2bf(float f) { return pk2(f, 0.f) & 0xffffu; }
__device__ __forceinline__ unsigned pk4_fp8(float a, float b, float c, float d) { int r = 0; r = __builtin_amdgcn_cvt_pk_fp8_f32(a, b, r, false); r = __builtin_amdgcn_cvt_pk_fp8_f32(c, d, r, true); return (unsigned)r; }
__device__ __forceinline__ float bf2f(unsigned short b) { return __builtin_bit_cast(float, ((unsigned)b) << 16); }
__device__ __forceinline__ float bflo(unsigned w) { return __builtin_bit_cast(float, w << 16); }
__device__ __forceinline__ float bfhi(unsigned w) { return __builtin_bit_cast(float, w & 0xffff0000u); }
__device__ __forceinline__ float siluf(float x) { return x * __builtin_amdgcn_rcpf(1.f + __expf(-x)); }
__device__ __forceinline__ float sigmoidf_(float x) { return __builtin_amdgcn_rcpf(1.f + __expf(-x)); }
__device__ __forceinline__ float logsigmoidf_(float x) { return fminf(x, 0.f) - __logf(1.f + __expf(-fabsf(x))); }
template <int CTRL> __device__ __forceinline__ float dppmov(float v) { return __builtin_bit_cast(float, __builtin_amdgcn_update_dpp(0, __builtin_bit_cast(int, v), CTRL, 0xf, 0xf, true)); }
__device__ __forceinline__ float row16_sum(float v) { v += dppmov<0xB1>(v); v += dppmov<0x4E>(v); v += dppmov<0x124>(v); v += dppmov<0x128>(v); return v; }
__device__ __forceinline__ float row16_max(float v) { v = fmaxf(v, dppmov<0xB1>(v)); v = fmaxf(v, dppmov<0x4E>(v)); v = fmaxf(v, dppmov<0x124>(v)); v = fmaxf(v, dppmov<0x128>(v)); return v; }
__device__ __forceinline__ float xrow_sum(float v) {
    float a = v, b = v; asm volatile("s_nop 1\n\tv_permlane16_swap_b32 %0, %1" : "+v"(a), "+v"(b)); v = a + b; a = v; b = v;
    asm volatile("s_nop 1\n\tv_permlane32_swap_b32 %0, %1" : "+v"(a), "+v"(b)); return a + b; }
__device__ __forceinline__ float xrow_max(float v) {
    float a = v, b = v; asm volatile("s_nop 1\n\tv_permlane16_swap_b32 %0, %1" : "+v"(a), "+v"(b)); v = fmaxf(a, b); a = v; b = v;
    asm volatile("s_nop 1\n\tv_permlane32_swap_b32 %0, %1" : "+v"(a), "+v"(b)); return fmaxf(a, b); }
__device__ __forceinline__ float wave_sum(float v) { return xrow_sum(row16_sum(v)); }
#define XB_TMO      128
#define XB_XCNT(j)  (256  + 64 * (j))
#define XB_XSUB(j)  (1280 + 64 * (j))
#define XB_XGEN(j)  (2304 + 64 * (j))
#define XB_TOP      3328
#define XB_TOPGEN   3392
#define XCD_BAR_WORDS 3456
#define XB_SPIN_CAP (1u << 18)

__device__ __forceinline__ unsigned xb_ld(unsigned* p)              { return __hip_atomic_load(p, __ATOMIC_RELAXED, __HIP_MEMORY_SCOPE_AGENT); }
__device__ __forceinline__ unsigned xb_add(unsigned* p, unsigned v) { return __hip_atomic_fetch_add(p, v, __ATOMIC_RELAXED, __HIP_MEMORY_SCOPE_AGENT); }
__device__ __forceinline__ unsigned xb_xcc_id() { return (unsigned)__builtin_amdgcn_s_getreg((3 << 11) | 20) & 0xFu; }
#define XB_SPIN(cond, bar) do { unsigned _sp = 0; while (cond) { __builtin_amdgcn_s_sleep(1); \
    if ((++_sp & 255u) == 0u) { if (xb_ld(&(bar)[XB_TMO])) break; if (_sp > XB_SPIN_CAP) { atomicAdd(&(bar)[XB_TMO], 1u); break; } } } } while (0)

struct XcdBarrier {
    unsigned* bar; unsigned x;
    volatile LAS unsigned* st;
};

__device__ __forceinline__ XcdBarrier xcd_barrier_post(unsigned* bar, volatile LAS unsigned* st) {
    XcdBarrier b; b.bar = bar; b.x = xb_xcc_id(); b.st = st;
    if (threadIdx.x == 0) (void)xb_add(&bar[XB_XCNT(b.x)], 1u);
    return b;
}
__device__ __forceinline__ void xcd_barrier_complete(unsigned* bar, unsigned x, unsigned& nloc, unsigned& nx) {
    const unsigned G = gridDim.x * gridDim.y * gridDim.z;
    unsigned sum, cnt, mine, sp = 0u;
    for (;;) {
        sum = 0u; cnt = 0u; mine = 0u;
#pragma unroll
        for (unsigned j = 0; j < 16; ++j) { const unsigned c = xb_ld(&bar[XB_XCNT(j)]); sum += c; cnt += (c > 0u) ? 1u : 0u; mine = (j == x) ? c : mine; }
        if (sum == G) break;
        __builtin_amdgcn_s_sleep(1);
        if ((++sp & 255u) == 0u) { if (xb_ld(&bar[XB_TMO])) break; if (sp > XB_SPIN_CAP) { atomicAdd(&bar[XB_TMO], 1u); break; } }
    }
    nloc = mine > 0u ? mine : 1u; nx = cnt > 0u ? cnt : 1u;
}

__device__ __forceinline__ void xcd_barrier(const XcdBarrier& b) {
    asm volatile("s_waitcnt vmcnt(0)" ::: "memory");
    __syncthreads();
    if (threadIdx.x == 0) {
        unsigned* bar = b.bar;
        __builtin_amdgcn_s_waitcnt(0);
        unsigned nloc = b.st[0], nx = b.st[1];
        if (nloc == 0u) { xcd_barrier_complete(bar, b.x, nloc, nx); b.st[0] = nloc; b.st[1] = nx; }
        const unsigned old = xb_add(&bar[XB_XSUB(b.x)], 1u);
        const unsigned gen = old / nloc;
        if (old + 1u == (gen + 1u) * nloc) {
            __builtin_amdgcn_fence(__ATOMIC_RELEASE, "agent");
            asm volatile("s_waitcnt vmcnt(0)" ::: "memory");
            const unsigned og = xb_add(&bar[XB_TOP], 1u);
            const unsigned tg = og / nx;
            if (og + 1u == (tg + 1u) * nx) xb_add(&bar[XB_TOPGEN], 1u);
            else XB_SPIN(xb_ld(&bar[XB_TOPGEN]) == tg, bar);
            __builtin_amdgcn_fence(__ATOMIC_ACQUIRE, "agent");
            xb_add(&bar[XB_XGEN(b.x)], 1u);
            asm volatile("s_waitcnt vmcnt(0)" ::: "memory");
        } else {
            XB_SPIN(xb_ld(&bar[XB_XGEN(b.x)]) == gen, bar);
            __builtin_amdgcn_fence(__ATOMIC_ACQUIRE, "agent");
            asm volatile("s_waitcnt vmcnt(0)" ::: "memory");
        }
    }
    __syncthreads();
}

typedef short s16x4 __attribute__((ext_vector_type(4)));
__device__ __forceinline__ bf16x8 tr_frag(const LAS bf16* T, int ld, int r0, int c0, int lane) {
    const int g = lane >> 4, q = (lane & 15) >> 2, p = lane & 3;
    const LAS bf16* a = T + (r0 + 8 * g + q) * ld + c0 + 4 * p;
    const s16x4 lo = __builtin_amdgcn_ds_read_tr16_b64_v4i16((LAS s16x4*)a);
    const s16x4 hi = __builtin_amdgcn_ds_read_tr16_b64_v4i16((LAS s16x4*)(a + 4 * ld));
    return (bf16x8){lo[0], lo[1], lo[2], lo[3], hi[0], hi[1], hi[2], hi[3]};
}
__device__ __forceinline__ float wave_incl_sum(float v, int lane) {
#pragma unroll
    for (int o = 1; o < 64; o <<= 1) { const float t = __shfl_up(v, o); v = (lane >= o) ? v + t : v; }
    return v;
}
__device__ __forceinline__ float wave_incl_max(float v, int lane) {
#pragma unroll
    for (int o = 1; o < 64; o <<= 1) { const float t = __shfl_up(v, o); v = (lane >= o) ? fmaxf(v, t) : v; }
    return v;
}
__device__ __forceinline__ float wave_max(float v) { return xrow_max(row16_max(v)); }
struct Frame {
    LAS unsigned char* lds;
    volatile LAS unsigned* MISC;
    gu32* ctl;
    int tid, lane, wave;
    int bid, G;
    const float* in[35];
    float* out;
    unsigned char* ws;
};
enum { I_X = 0, I_C, I_CTX, I_CCTX, I_ADAW, I_ADAB, I_N1G, I_N2G, I_OUTW, I_RTW, I_W1, I_W3, I_W2, I_FING, I_EVW, I_HCW, I_HCB, I_HPW1, I_HPB1, I_HFREQ, I_HPW2, I_HPB2, I_HPW3, I_HBIAS,
       I_GGW2, I_GGB, I_GNG, I_ODW, I_MCW, I_MCB, I_MIGB, I_MFGB, I_MNG, I_DLAM, I_DNG };

__device__ __forceinline__ float grp16_max(float v) { return row16_max(v); }
__device__ __forceinline__ float grp16_sum(float v) { return row16_sum(v); }
constexpr int CW_CVT = 64;
typedef unsigned u32x4_ __attribute__((ext_vector_type(4)));
struct CvtItem { const float* src; int ldn, c0, ncols, k0; bf16* dst; int d0, dstep, fp8; };
__device__ __forceinline__ CvtItem cvt_decode(Frame& F, int it) {
    CvtItem c; c.dstep = 128; c.ncols = 256; c.fp8 = 0;
    bf16* Win0 = (bf16*)(F.ws + WS_WIN0); bf16* Win1 = (bf16*)(F.ws + WS_WIN1); bf16* Wout = (bf16*)(F.ws + WS_WOUT); bf16* W13 = (bf16*)(F.ws + WS_W13); bf16* W2t = (bf16*)(F.ws + WS_W2);
    constexpr int N_IN0 = 16 * 25, N_IN1 = 16 * 29, N_OUT = 2 * 16 * 8;
    if (it < N_IN0) { const int kb = it / 25, cb = it % 25; c.src = F.in[I_EVW]; c.ldn = EV_IN; c.k0 = kb * 128; c.dst = Win0; c.c0 = cb * 256; c.d0 = cb * 256; if (cb == 24) c.ncols = 32; return c; }
    it -= N_IN0;
    if (it < N_IN1) { const int kb = it / 29, cb = it % 29; c.src = F.in[I_ODW]; c.ldn = OD_IN; c.k0 = kb * 128; c.dst = Win1;
        if (cb < 16) { c.c0 = cb * 256; c.d0 = cb * 256; } else if (cb < 28) { c.c0 = 4112 + (cb - 16) * 256; c.d0 = 4096 + (cb - 16) * 256; } else { c.c0 = 4096; c.d0 = 7168; c.ncols = 16; }
        return c; }
    it -= N_IN1;
    if (it < N_OUT) { const int l = it >> 7, q = it & 127, kb = q >> 3, cb = q & 7; c.src = F.in[I_OUTW] + (size_t)l * 2048 * 2048; c.ldn = 2048; c.k0 = kb * 128; c.dst = Wout + (size_t)l * 2048 * 2048; c.c0 = cb * 256; c.d0 = cb * 256; return c; }
    it -= N_OUT;
    { const int cb = it & 7; it >>= 3; const int kb = it & 15; it >>= 4; const int which = it % 3; it /= 3; const int e = it & 15, l = it >> 4;
      const size_t so = ((size_t)l * 16 + e) * 2048 * 2048; c.ldn = 2048; c.k0 = kb * 128; c.c0 = cb * 256; c.fp8 = 1;
      if (which == 0) { c.src = F.in[I_W1] + so; c.dst = W13 + ((size_t)l * 16 + e) * 4096 * 1024; c.d0 = cb * 512; c.dstep = 256; }
      else if (which == 1) { c.src = F.in[I_W3] + so; c.dst = W13 + ((size_t)l * 16 + e) * 4096 * 1024; c.d0 = cb * 512 + 128; c.dstep = 256; }
      else { c.src = F.in[I_W2] + so; c.dst = W2t + ((size_t)l * 16 + e) * 2048 * 1024; c.d0 = cb * 256; }
      return c; }
}
__device__ __forceinline__ void cvt_load(const CvtItem& c, int wave, int lane, f32x4 (&v)[16]) {
    const bool ok = 4 * lane < c.ncols;
#pragma unroll
    for (int i = 0; i < 16; ++i) v[i] = ok ? *(const GAS f32x4*)(c.src + (size_t)(c.k0 + 16 * wave + i) * c.ldn + c.c0 + 4 * lane) : (f32x4){0.f, 0.f, 0.f, 0.f};
}
constexpr int CVT_NPRE = 16 * 25 + 16 * 29 + 2 * 16 * 8, CVT_L0_END = CVT_NPRE + 6144, CVT_L1_END = CVT_NPRE + 12288;
constexpr int CVT_LATE0 = 64 * 10 + 192 * 14, CVT_LATE1 = 128 * 5 + 56 * 10;
constexpr int CVT_NEARLY = CVT_NPRE + 12288 - CVT_LATE0 - CVT_LATE1;
__device__ __forceinline__ int cvt_early_item(int j) {
    if (j < CVT_L0_END - CVT_LATE0) return j;
    return j + CVT_LATE0;
}
template <bool DYN> __device__ __forceinline__ void cvt_run(Frame& F, int first, int cnt) {
    constexpr int TLD = 264;
    LAS bf16* T = (LAS bf16*)(F.lds);
    LAS int* nxt = (LAS int*)(F.lds + 128 * TLD * 2);
    const int NIT = DYN ? CVT_NEARLY : cnt;
    __syncthreads();
    int jn = 0;
    if (DYN) { if (F.tid == 0) nxt[0] = (int)__hip_atomic_fetch_add((unsigned*)(F.ctl + CW_CVT), 1u, __ATOMIC_RELAXED, __HIP_MEMORY_SCOPE_AGENT);
        __syncthreads(); jn = nxt[0]; }
    int j = jn;
    f32x4 v[16];
    CvtItem cur = cvt_decode(F, j < NIT ? (DYN ? cvt_early_item(j) : first + j) : 0);
    if (j < NIT) cvt_load(cur, F.wave, F.lane, v);
    while (j < NIT) {
        __syncthreads();
        if (DYN) { if (F.tid == 0) nxt[0] = (int)__hip_atomic_fetch_add((unsigned*)(F.ctl + CW_CVT), 1u, __ATOMIC_RELAXED, __HIP_MEMORY_SCOPE_AGENT); }
        { const float wsc = cur.fp8 ? 64.f : 1.f;
#pragma unroll
        for (int i = 0; i < 16; ++i) { v2u w; w.x = pk2(v[i][0] * wsc, v[i][1] * wsc); w.y = pk2(v[i][2] * wsc, v[i][3] * wsc); *(LAS v2u*)(T + (16 * F.wave + i) * TLD + 4 * F.lane) = w; } }
        __syncthreads();
        const int jnext = DYN ? nxt[0] : j + 1;
        const CvtItem me = cur;
        if (jnext < NIT) { cur = cvt_decode(F, DYN ? cvt_early_item(jnext) : first + jnext); cvt_load(cur, F.wave, F.lane, v); }
        const int fr = F.lane & 15, fq = F.lane >> 4;
#pragma unroll
        for (int x = 0; x < 2; ++x) { const int jc = 32 * F.wave + 16 * x + fr; const int drow = me.d0 + (jc >> 7) * me.dstep + (jc & 127);
#pragma unroll
            for (int r = 0; r < 4; ++r) { const bf16x8 f = tr_frag(T, TLD, 32 * r, 32 * F.wave + 16 * x, F.lane);
                if (me.fp8) { const u32x4_ fw = __builtin_bit_cast(u32x4_, f); v2u o8; o8.x = pk4_fp8(bflo(fw.x), bfhi(fw.x), bflo(fw.y), bfhi(fw.y)); o8.y = pk4_fp8(bflo(fw.z), bfhi(fw.z), bflo(fw.w), bfhi(fw.w));
                    *(GAS v2u*)((unsigned char*)me.dst + (size_t)drow * 2048 + me.k0 + 32 * r + 8 * fq) = o8; }
                else if (jc < me.ncols) *(GAS bf16x8*)(me.dst + (size_t)drow * 2048 + me.k0 + 32 * r + 8 * fq) = f; } }
        j = jnext;
    }
    __syncthreads();
}
__device__ __forceinline__ void p0_convert(Frame& F) {
    { bf16* Win0 = (bf16*)(F.ws + WS_WIN0); bf16* Win1 = (bf16*)(F.ws + WS_WIN1);
      const int gt = F.bid * NTHR + F.tid, NT = F.G * NTHR; const v4u z = {0u, 0u, 0u, 0u};
      for (int i = gt; i < (LD0 - EV_IN) * 256; i += NT) *(GAS v4u*)(Win0 + (size_t)EV_IN * 2048 + (size_t)i * 8) = z;
      for (int i = gt; i < (LD1 - OD_IN) * 256; i += NT) *(GAS v4u*)(Win1 + (size_t)OD_IN * 2048 + (size_t)i * 8) = z; }
    if (F.G == 256) cvt_run<true>(F, 0, 0);
    else { cvt_run<true>(F, 0, 0); if (F.bid == 0) { cvt_run<false>(F, CVT_L0_END - CVT_LATE0, CVT_LATE0); cvt_run<false>(F, CVT_L1_END - CVT_LATE1, CVT_LATE1); } }
}
__device__ __forceinline__ void cvt_late(Frame& F, int first, int w0, int per) {
    if (F.G != 256 || F.bid < w0) return;
    cvt_run<false>(F, first + (F.bid - w0) * per, per);
}
__device__ __forceinline__ void p0_adaln(Frame& F) {
    if (F.bid >= 192) return;
    LAS float* s = (LAS float*)(F.lds);
    LAS float* red = (LAS float*)(F.lds + 9 * 2048 * 4);
    for (int i = F.tid; i < 9 * 2048; i += NTHR) { const float v = (i < 8 * 2048) ? F.in[I_C][i] : F.in[I_CCTX][i - 8 * 2048]; s[i] = siluf(v); }
    __syncthreads();
    float* MOD = (float*)(F.ws + WS_MOD);
    for (int u = F.bid; u < 192; u += F.G) {
        const int l = u / 96, j0 = (u % 96) * 128, jj = F.tid & 127, kq = F.tid >> 7;
        const float* W = F.in[I_ADAW] + (size_t)l * 2048 * 12288 + j0 + jj;
        float acc[9];
#pragma unroll
        for (int r = 0; r < 9; ++r) acc[r] = 0.f;
        for (int k = kq * 512; k < kq * 512 + 512; k += 4) {
            float w[4];
#pragma unroll
            for (int q = 0; q < 4; ++q) w[q] = W[(size_t)(k + q) * 12288];
#pragma unroll
            for (int r = 0; r < 9; ++r) { const f32x4 sv = *(const LAS f32x4*)(s + r * 2048 + k); acc[r] += sv[0] * w[0] + sv[1] * w[1] + sv[2] * w[2] + sv[3] * w[3]; }
        }
#pragma unroll
        for (int r = 0; r < 9; ++r) red[(kq * 9 + r) * 128 + jj] = acc[r];
        __syncthreads();
        for (int i = F.tid; i < 9 * 128; i += NTHR) { const int r = i >> 7, j = i & 127;
            MOD[((size_t)l * 9 + r) * 12288 + j0 + j] = red[(0 * 9 + r) * 128 + j] + red[(1 * 9 + r) * 128 + j] + red[(2 * 9 + r) * 128 + j] + red[(3 * 9 + r) * 128 + j] + F.in[I_ADAB][l * 12288 + j0 + j]; }
        __syncthreads();
    }
}
__device__ __forceinline__ void p0_filters(Frame& F) {
    LAS float* h1 = (LAS float*)(F.lds);
    LAS float* h2 = h1 + 512;
    LAS float* ft = h2 + 512;
    for (int uu = F.bid; uu < 2304; uu += F.G) {
        const int jb = uu & 7, u = uu >> 3;
        const bool lat = u < 256; const int L = lat ? 2048 : 256; const int p0 = (lat ? u : u - 256) * 8;
        float* FT = (float*)(F.ws + (lat ? WS_FTL : WS_FTC));
        __syncthreads();
        if (F.tid < 8 * 33) { const int pp = F.tid / 33, i = F.tid % 33; const float pos = (float)(p0 + pp);
            float v;
            if (i == 0) v = pos / (float)(L - 1);
            else { const int bi = (i - 1) & 15; const float band = 1e-4f + (float)bi * ((15.f - 1e-4f) / 15.f); const float ang = (6.283185307179586f / (float)L) * pos * band; v = (i <= 16) ? cosf(ang) : -sinf(ang); }
            ft[pp * 36 + i] = v; }
        __syncthreads();
        { const int pp = F.tid >> 6, j = F.tid & 63; float a = F.in[I_HPB1][j];
#pragma unroll 11
          for (int i = 0; i < 33; ++i) a += ft[pp * 36 + i] * F.in[I_HPW1][i * 64 + j];
          h1[pp * 64 + j] = sinf(F.in[I_HFREQ][j] * a); }
        __syncthreads();
        { const int pp = F.tid >> 6, j = F.tid & 63; float a = F.in[I_HPB2][j];
#pragma unroll 16
          for (int i = 0; i < 64; ++i) a += h1[pp * 64 + i] * F.in[I_HPW2][i * 64 + j];
          h2[pp * 64 + j] = sinf(F.in[I_HFREQ][64 + j] * a); }
        __syncthreads();
        { const int j = jb * 512 + F.tid;
            float acc[8];
#pragma unroll
            for (int pp = 0; pp < 8; ++pp) acc[pp] = 0.f;
#pragma unroll 16
            for (int i = 0; i < 64; ++i) { const float w = F.in[I_HPW3][(size_t)i * 4096 + j];
#pragma unroll
                for (int pp = 0; pp < 8; ++pp) acc[pp] += h2[pp * 64 + i] * w; }
            const int order = j >> 11, dir = (j >> 10) & 1, ch = j & 1023;
            const float da = -3.0701134573253945f, db = -15.350567286626973f;
            const float delta = fabsf(da + (float)ch * ((db - da) / 1023.f));
#pragma unroll
            for (int pp = 0; pp < 8; ++pp) { const int p = p0 + pp; const float t = (float)p / (float)(L - 1); const float val = acc[pp] * __expf(-t * delta);
                if (dir == 0) FT[((size_t)order * (2 * L - 1) + (L - 1 + p)) * 1024 + ch] = val;
                else if (p >= 1) FT[((size_t)order * (2 * L - 1) + (L - 1 - p)) * 1024 + ch] = val; }
        }
    }
    __syncthreads();
}

__device__ __forceinline__ void load_row(const float* p, int lane, f32x4 (&v)[8]) {
#pragma unroll
    for (int i = 0; i < 8; ++i) v[i] = *(const GAS f32x4*)(p + 4 * (lane + 64 * i));
}
__device__ __forceinline__ float row_rstd(const f32x4 (&v)[8]) {
    float s = 0.f;
#pragma unroll
    for (int i = 0; i < 8; ++i) s += (v[i][0] * v[i][0] + v[i][1] * v[i][1]) + (v[i][2] * v[i][2] + v[i][3] * v[i][3]);
    return 1.f / sqrtf(wave_sum(s) * (1.f / 2048.f) + EPS);
}
__device__ __forceinline__ void modulate_store(f32x4 (&v)[8], float rstd, const float* g, const float* shift, const float* scale, bf16* orow, int lane) {
#pragma unroll
    for (int i = 0; i < 8; ++i) { const int c = 4 * (lane + 64 * i);
        const f32x4 gg = *(const GAS f32x4*)(g + c), sh = *(const GAS f32x4*)(shift + c), sc = *(const GAS f32x4*)(scale + c);
        v[i] = (v[i] * rstd * gg) * (sc + 1.f) + sh;
        v2u w; w.x = pk2(v[i][0], v[i][1]); w.y = pk2(v[i][2], v[i][3]);
        *(GAS v2u*)(orow + c) = w; }
}
__device__ __forceinline__ void modulate_store8(f32x4 (&v)[8], float rstd, const float* g, const float* shift, const float* scale, unsigned char* orow, int lane) {
#pragma unroll
    for (int i = 0; i < 8; ++i) { const int c = 4 * (lane + 64 * i);
        const f32x4 gg = *(const GAS f32x4*)(g + c), sh = *(const GAS f32x4*)(shift + c), sc = *(const GAS f32x4*)(scale + c);
        v[i] = (v[i] * rstd * gg) * (sc + 1.f) + sh;
        *(GAS unsigned*)(orow + c) = pk4_fp8(v[i][0], v[i][1], v[i][2], v[i][3]); }
}
__device__ __forceinline__ const float* xrow_ptr(Frame& F, int r) { return (r < M_LAT) ? F.in[I_X] + (size_t)r * D : F.in[I_CTX] + (size_t)(r - M_LAT) * D; }
__device__ __forceinline__ int row_b(int r) { return (r < M_LAT) ? (r >> 11) : 8; }

__device__ __forceinline__ void mod_params(const float* g, const float* shift, const float* scale, int lane, f32x4 (&gs)[8], f32x4 (&sh)[8]) {
#pragma unroll
    for (int i = 0; i < 8; ++i) { const int c = 4 * (lane + 64 * i); gs[i] = *(const GAS f32x4*)(g + c) * (*(const GAS f32x4*)(scale + c) + 1.f); sh[i] = *(const GAS f32x4*)(shift + c); }
}
__device__ __forceinline__ void ph_norm1_l0(Frame& F) {
    const int gw = F.bid * NWAVES + F.wave, NGW = F.G * NWAVES;
    const float* MOD = (const float*)(F.ws + WS_MOD); bf16* A = (bf16*)(F.ws + WS_A);
    const int per = (M_ALL + NGW - 1) / NGW, r0 = gw * per, r1 = (r0 + per < M_ALL) ? r0 + per : M_ALL;
    f32x4 v[8], gs[8], sh[8]; int curb = -1;
    if (r0 < r1) load_row(xrow_ptr(F, r0), F.lane, v);
    for (int r = r0; r < r1; ++r) { f32x4 nv[8]; if (r + 1 < r1) load_row(xrow_ptr(F, r + 1), F.lane, nv);
        const int bb = row_b(r); if (bb != curb) { const float* m = MOD + (size_t)bb * 12288; mod_params(F.in[I_N1G], m, m + 2048, F.lane, gs, sh); curb = bb; }
        const float rs = row_rstd(v);
        bf16* orow = A + (size_t)r * D;
#pragma unroll
        for (int i = 0; i < 8; ++i) { const f32x4 o = (v[i] * rs) * gs[i] + sh[i]; v2u w; w.x = pk2(o[0], o[1]); w.y = pk2(o[2], o[3]); *(GAS v2u*)(orow + 4 * (F.lane + 64 * i)) = w; }
#pragma unroll
        for (int i = 0; i < 8; ++i) v[i] = nv[i]; }
}
__device__ __forceinline__ void ph_codes_skinny(Frame& F) {
    constexpr int WLD = 2056;
    LAS bf16* W = (LAS bf16*)(F.lds);
    const bf16* A = (const bf16*)(F.ws + WS_A); const bf16* Wc = (const bf16*)(F.ws + WS_WIN0) + (size_t)6144 * 2048; bf16* P = (bf16*)(F.ws + WS_P);
    __syncthreads();
    for (int i = F.tid; i < 32 * 256; i += NTHR) { const int r = i >> 8, ch = i & 255; *(LAS v4u*)(W + r * WLD + ch * 8) = *(const GAS v4u*)(Wc + (size_t)r * 2048 + ch * 8); }
    __syncthreads();
    const int gw = F.bid * NWAVES + F.wave, NGW = F.G * NWAVES; const int fr = F.lane & 15, fq = F.lane >> 4;
    for (int task = gw; task < M_ALL / 16; task += NGW) { const int r0 = task * 16;
        f32x4 acc[2] = {(f32x4){0.f, 0.f, 0.f, 0.f}, (f32x4){0.f, 0.f, 0.f, 0.f}};
        const bf16* ap = A + (size_t)(r0 + fr) * 2048 + 8 * fq;
#pragma unroll 8
        for (int ks = 0; ks < 64; ++ks) { const bf16x8 af = *(const GAS bf16x8*)(ap + 32 * ks);
#pragma unroll
            for (int nt = 0; nt < 2; ++nt) { const bf16x8 bf = *(const LAS bf16x8*)(W + (16 * nt + fr) * WLD + 32 * ks + 8 * fq); acc[nt] = __builtin_amdgcn_mfma_f32_16x16x32_bf16(af, bf, acc[nt], 0, 0, 0); } }
#pragma unroll
        for (int nt = 0; nt < 2; ++nt)
#pragma unroll
            for (int j = 0; j < 4; ++j) P[(size_t)(r0 + 4 * fq + j) * LD0 + C0_CODE + 16 * nt + fr] = (bf16)f2bf(acc[nt][j]);
    }
    __syncthreads();
}
__device__ __forceinline__ void ph_norm2_router(Frame& F, int l, int nrows) {
    LAS float* rwT = (LAS float*)(F.lds);
    __syncthreads();
    for (int i = F.tid; i < 2048 * 16; i += NTHR) { const int j = i >> 4, e = i & 15; rwT[e * 2048 + j] = F.in[I_RTW][(size_t)l * 2048 * 16 + i]; }
    __syncthreads();
    const int gw = F.bid * NWAVES + F.wave, NGW = F.G * NWAVES;
    const float* MOD = (const float*)(F.ws + WS_MOD) + (size_t)l * 9 * 12288; const float* H = (const float*)(F.ws + WS_H);
    bf16* A = (bf16*)(F.ws + WS_A); float* AFF = (float*)(F.ws + WS_AFF); int* SEL = (int*)(F.ws + WS_SEL);
    const int per = (nrows + NGW - 1) / NGW, r0 = gw * per, r1 = (r0 + per < nrows) ? r0 + per : nrows;
    f32x4 v[8], gs[8], sh[8]; int curb = -1;
    if (r0 < r1) load_row(H + (size_t)r0 * D, F.lane, v);
    for (int r = r0; r < r1; ++r) { f32x4 nv[8]; if (r + 1 < r1) load_row(H + (size_t)(r + 1) * D, F.lane, nv);
        const int bb = row_b(r); if (bb != curb) { const float* m = MOD + (size_t)bb * 12288; mod_params(F.in[I_N2G] + l * 2048, m + 3 * 2048, m + 4 * 2048, F.lane, gs, sh); curb = bb; }
        const float rs = row_rstd(v);
        { unsigned char* orow = (unsigned char*)A + (size_t)r * D;
#pragma unroll
          for (int i = 0; i < 8; ++i) { v[i] = (v[i] * rs) * gs[i] + sh[i]; *(GAS unsigned*)(orow + 4 * (F.lane + 64 * i)) = pk4_fp8(v[i][0], v[i][1], v[i][2], v[i][3]); } }
        float pa[16];
#pragma unroll
        for (int e = 0; e < 16; ++e) { const LAS float* wp = rwT + e * 2048 + 4 * F.lane; f32x4 a4 = {0.f, 0.f, 0.f, 0.f};
#pragma unroll
            for (int i = 0; i < 8; ++i) { const f32x4 w = *(const LAS f32x4*)(wp + 256 * i); a4 += v[i] * w; }
            pa[e] = (a4[0] + a4[1]) + (a4[2] + a4[3]); }
        float s1[8], s2[4];
#pragma unroll
        for (int e = 0; e < 8; ++e) { float x = pa[e], y = pa[e + 8]; asm volatile("s_nop 1\n\tv_permlane32_swap_b32 %0, %1" : "+v"(x), "+v"(y)); s1[e] = x + y; }
#pragma unroll
        for (int e = 0; e < 4; ++e) { float x = s1[e], y = s1[e + 4]; asm volatile("s_nop 1\n\tv_permlane16_swap_b32 %0, %1" : "+v"(x), "+v"(y)); s2[e] = row16_sum(x + y); }
        { float mx = fmaxf(fmaxf(s2[0], s2[1]), fmaxf(s2[2], s2[3])); mx = xrow_max(mx);
          float ex[4], se = 0.f;
#pragma unroll
          for (int e = 0; e < 4; ++e) { ex[e] = expf(s2[e] - mx); se += ex[e]; }
          se = xrow_sum(se); const float inv = 1.f / se;
          if ((F.lane & 15) == 0) { const int R = F.lane >> 4; const int eb = 4 * (R & 1) + 8 * (R >> 1);
#pragma unroll
              for (int e = 0; e < 4; ++e) AFF[(size_t)(eb + e) * M_ALL + r] = ex[e] * inv; }
          if (F.lane < 16) SEL[(size_t)r * 16 + F.lane] = -1; }
#pragma unroll
        for (int i = 0; i < 8; ++i) v[i] = nv[i];
    }
    __syncthreads();
}
__device__ __forceinline__ void ph_norm2_router2(Frame& F, int l, int nrows) {
    constexpr int WLD = 2064;
    LAS bf16* Wh = (LAS bf16*)(F.lds); LAS bf16* Wl = Wh + 16 * WLD;
    LAS float* red = (LAS float*)(F.lds + 4 * 16 * WLD);
    LAS float* ssq = red + 8 * 256;
    LAS float* cb = ssq + 128;
    const float* MOD = (const float*)(F.ws + WS_MOD) + (size_t)l * 9 * 12288; const float* H = (const float*)(F.ws + WS_H);
    unsigned char* A8 = (unsigned char*)(F.ws + WS_A); float* AFF = (float*)(F.ws + WS_AFF); int* SEL = (int*)(F.ws + WS_SEL);
    float* GSB = (float*)(F.ws + WS_XT) + (size_t)F.bid * 4 * 4096;
    const int fr = F.lane & 15, fq = F.lane >> 4;
    const int ntile = nrows >> 4; const int t0 = (int)(((long)F.bid * ntile) / F.G), t1 = (int)(((long)(F.bid + 1) * ntile) / F.G);
    const int colw = 256 * F.wave + 8 * fq;
    int curb = -1, nreb = 0; const float* gsb = GSB;
    f32x4 x[8][2];
#define RT_LOAD(dst, tile) do { const float* p_ = H + (size_t)((tile) * 16 + fr) * D + colw; _Pragma("unroll") for (int ks = 0; ks < 8; ++ks) { dst[ks][0] = *(const GAS f32x4*)(p_ + 32 * ks); dst[ks][1] = *(const GAS f32x4*)(p_ + 32 * ks + 4); } } while (0)
    if (t0 < t1) RT_LOAD(x, t0);
    for (int t = t0; t < t1; ++t) {
        const int rbase = t * 16; const int bb = row_b(rbase);
        if (bb != curb) {
            const float* m = MOD + (size_t)bb * 12288; const float* g = F.in[I_N2G] + l * 2048; const float* shp = m + 3 * 2048; const float* scp = m + 4 * 2048;
            float* gw_ = GSB + (size_t)(nreb & 3) * 4096;
            __syncthreads();
            for (int k = F.tid; k < 2048; k += NTHR) { gw_[k] = g[k] * (scp[k] + 1.f); gw_[2048 + k] = shp[k]; }
            const float* rw = F.in[I_RTW] + (size_t)l * 2048 * 16; const int e0 = 4 * (F.tid & 3); f32x4 cacc = {0.f, 0.f, 0.f, 0.f};
#pragma unroll 1
            for (int it = 0; it < 16; it += 4) { f32x4 wv[4]; float gk[4], sk[4], hk[4];
#pragma unroll
                for (int u = 0; u < 4; ++u) { const int i4 = F.tid + NTHR * (it + u); const int k = i4 >> 2; wv[u] = *(const GAS f32x4*)(rw + 4 * (size_t)i4); gk[u] = g[k]; sk[u] = scp[k]; hk[u] = shp[k]; }
#pragma unroll
                for (int u = 0; u < 4; ++u) { const int k = (F.tid + NTHR * (it + u)) >> 2; const float gsk = gk[u] * (sk[u] + 1.f);
#pragma unroll
                    for (int c = 0; c < 4; ++c) { const float val = wv[u][c] * gsk; const unsigned short hi = (unsigned short)f2bf(val); const unsigned short lo = (unsigned short)f2bf(val - bf2f(hi));
                        Wh[(e0 + c) * WLD + k] = (bf16)hi; Wl[(e0 + c) * WLD + k] = (bf16)lo; }
                    cacc += wv[u] * hk[u]; } }
#pragma unroll
            for (int c = 0; c < 4; ++c) { float v_ = cacc[c]; v_ += dppmov<0x124>(v_); v_ += dppmov<0x128>(v_); cacc[c] = xrow_sum(v_); }
            if (F.lane < 4) {
#pragma unroll
                for (int c = 0; c < 4; ++c) red[F.wave * 16 + 4 * F.lane + c] = cacc[c]; }
            __syncthreads();
            if (F.tid < 16) { float c_ = 0.f;
#pragma unroll
                for (int ww = 0; ww < 8; ++ww) c_ += red[ww * 16 + F.tid];
                cb[F.tid] = c_; }
            __syncthreads();
            curb = bb; gsb = gw_; ++nreb; }
        f32x4 nx[8][2];
        if (t + 1 < t1) RT_LOAD(nx, t + 1);
        float ss = 0.f; f32x4 acc = {0.f, 0.f, 0.f, 0.f};
#pragma unroll
        for (int ks = 0; ks < 8; ++ks) { const f32x4 a = x[ks][0], b = x[ks][1];
            ss += (a[0] * a[0] + a[1] * a[1]) + (a[2] * a[2] + a[3] * a[3]) + (b[0] * b[0] + b[1] * b[1]) + (b[2] * b[2] + b[3] * b[3]);
            v4u h, lo_; h.x = pk2(a[0], a[1]); h.y = pk2(a[2], a[3]); h.z = pk2(b[0], b[1]); h.w = pk2(b[2], b[3]);
            lo_.x = pk2(a[0] - bflo(h.x), a[1] - bfhi(h.x)); lo_.y = pk2(a[2] - bflo(h.y), a[3] - bfhi(h.y)); lo_.z = pk2(b[0] - bflo(h.z), b[1] - bfhi(h.z)); lo_.w = pk2(b[2] - bflo(h.w), b[3] - bfhi(h.w));
            const bf16x8 ah = __builtin_bit_cast(bf16x8, h), al = __builtin_bit_cast(bf16x8, lo_);
            const bf16x8 bh = *(const LAS bf16x8*)(Wh + fr * WLD + colw + 32 * ks), bl = *(const LAS bf16x8*)(Wl + fr * WLD + colw + 32 * ks);
            acc = __builtin_amdgcn_mfma_f32_16x16x32_bf16(ah, bh, acc, 0, 0, 0); acc = __builtin_amdgcn_mfma_f32_16x16x32_bf16(al, bh, acc, 0, 0, 0); acc = __builtin_amdgcn_mfma_f32_16x16x32_bf16(ah, bl, acc, 0, 0, 0); }
        ss = xrow_sum(ss);
        if (fq == 0) ssq[F.wave * 16 + fr] = ss;
#pragma unroll
        for (int j = 0; j < 4; ++j) red[(F.wave * 16 + 4 * fq + j) * 16 + fr] = acc[j];
        __syncthreads();
        { float tot = 0.f;
#pragma unroll
          for (int ww = 0; ww < 8; ++ww) tot += ssq[ww * 16 + fr];
          const float rs = 1.f / sqrtf(tot * (1.f / 2048.f) + EPS);
          unsigned char* orow = A8 + (size_t)(rbase + fr) * D + colw;
#pragma unroll
          for (int ks = 0; ks < 8; ++ks) { const f32x4 g0 = *(const GAS f32x4*)(gsb + colw + 32 * ks), g1 = *(const GAS f32x4*)(gsb + colw + 32 * ks + 4), s0 = *(const GAS f32x4*)(gsb + 2048 + colw + 32 * ks), s1 = *(const GAS f32x4*)(gsb + 2048 + colw + 32 * ks + 4);
              const f32x4 o0 = (x[ks][0] * rs) * g0 + s0, o1 = (x[ks][1] * rs) * g1 + s1;
              v2u w8; w8.x = pk4_fp8(o0[0], o0[1], o0[2], o0[3]); w8.y = pk4_fp8(o1[0], o1[1], o1[2], o1[3]);
              *(GAS v2u*)(orow + 32 * ks) = w8; } }
        if (F.lane < 32) {
            const int row = 2 * F.wave + (F.lane >> 4), e = F.lane & 15; float lg = 0.f, tot = 0.f;
#pragma unroll
            for (int ww = 0; ww < 8; ++ww) { lg += red[(ww * 16 + row) * 16 + e]; tot += ssq[ww * 16 + row]; }
            lg = lg * (1.f / sqrtf(tot * (1.f / 2048.f) + EPS)) + cb[e];
            const float mx = row16_max(lg); const float ex = expf(lg - mx); const float se = row16_sum(ex);
            AFF[(size_t)e * M_ALL + rbase + row] = ex / se; SEL[(size_t)(rbase + row) * 16 + e] = -1; }
        __syncthreads();
#pragma unroll
        for (int ks = 0; ks < 8; ++ks) { x[ks][0] = nx[ks][0]; x[ks][1] = nx[ks][1]; }
    }
#undef RT_LOAD
    __syncthreads();
}
__device__ __forceinline__ void ph_topk(Frame& F, int nprob, int Me) {
    typedef unsigned long long u64; typedef u64 u64x2 __attribute__((ext_vector_type(2)));
    LAS u64* keys = (LAS u64*)(F.lds);
    LAS int* lst = (LAS int*)(F.lds + 16384);
    LAS int* lcnt = (LAS int*)(F.lds + 16384 + 4096);
    const float* AFF = (const float*)(F.ws + WS_AFF); int* SEL = (int*)(F.ws + WS_SEL); float* GW = (float*)(F.ws + WS_GW);
    const unsigned char* A8 = (const unsigned char*)(F.ws + WS_A); unsigned char* XS8 = (unsigned char*)(F.ws + WS_XS);
    const int nunits = 512 + (nprob - 128);
    for (int u = F.bid; u < nunits; u += F.G) {
        const bool lat = u < 512; const int q = lat ? (u >> 2) : (u - 512); const int part = lat ? (u & 3) : 0; const int b = q >> 4, e = q & 15;
        const int T = lat ? 2048 : 256, cap = lat ? 256 : 32, r0 = lat ? b * 2048 : M_LAT + b * 256;
        __syncthreads();
        for (int i = F.tid; i < T; i += NTHR) keys[i] = ((u64)__builtin_bit_cast(unsigned, AFF[(size_t)e * M_ALL + r0 + i]) << 32) | (u64)(0xFFFFFFFFu - (unsigned)i);
        if (F.tid == 0) lcnt[0] = 0;
        __syncthreads();
        const int i = part * 512 + F.tid;
        if (i < T) { const u64 ki = keys[i]; int rank = 0;
#pragma unroll 8
            for (int j = 0; j < T; j += 2) { const u64x2 kj = *(const LAS u64x2*)(keys + j); rank += (kj.x > ki) ? 1 : 0; rank += (kj.y > ki) ? 1 : 0; }
            if (rank < cap) { const int slot = e * Me + (lat ? b * 256 + rank : 2048 + b * 32 + rank);
                GW[slot] = __builtin_bit_cast(float, (unsigned)(ki >> 32)); SEL[(size_t)(r0 + i) * 16 + e] = slot;
                const int p = __hip_atomic_fetch_add(lcnt, 1, __ATOMIC_RELAXED, __HIP_MEMORY_SCOPE_WORKGROUP); lst[2 * p] = slot; lst[2 * p + 1] = r0 + i; } }
        __syncthreads();
        const int n = lcnt[0];
        for (int p = F.wave; p < n; p += NWAVES) { const int slot = lst[2 * p], row = lst[2 * p + 1];
            const GAS v4u* src = (const GAS v4u*)(A8 + (size_t)row * D); GAS v4u* dst = (GAS v4u*)(XS8 + (size_t)slot * D);
#pragma unroll
            for (int x = 0; x < 2; ++x) dst[F.lane + 64 * x] = src[F.lane + 64 * x]; }
    }
    __syncthreads();
}
__device__ __forceinline__ void ph_gather(Frame& F, int nslots) {
    const int gw = F.bid * NWAVES + F.wave, NGW = F.G * NWAVES;
    const unsigned char* A = (const unsigned char*)(F.ws + WS_A); unsigned char* XS = (unsigned char*)(F.ws + WS_XS); const int* TOK = (const int*)(F.ws + WS_TOK);
    for (int s = gw; s < nslots; s += NGW) { const int r = TOK[s];
        const GAS v4u* src = (const GAS v4u*)(A + (size_t)r * D); GAS v4u* dst = (GAS v4u*)(XS + (size_t)s * D);
#pragma unroll
        for (int i = 0; i < 2; ++i) dst[F.lane + 64 * i] = src[F.lane + 64 * i]; }
}
template <int MODE> __device__ __forceinline__ void ph_combine(Frame& F, int l, int nrows) {
    const int gw = F.bid * NWAVES + F.wave, NGW = F.G * NWAVES;
    const float* MODl = (const float*)(F.ws + WS_MOD) + (size_t)l * 9 * 12288; const float* MODn = (const float*)(F.ws + WS_MOD) + (size_t)1 * 9 * 12288;
    float* H = (float*)(F.ws + WS_H); const bf16* YS = (const bf16*)(F.ws + WS_YS); const int* SEL = (const int*)(F.ws + WS_SEL); const float* GW = (const float*)(F.ws + WS_GW);
    bf16* A = (bf16*)(F.ws + WS_A);
    f32x4 v[8]; int sel = -1;
    if (gw < nrows) { load_row(H + (size_t)gw * D, F.lane, v); sel = SEL[(size_t)gw * 16 + (F.lane & 15)]; }
    for (int r = gw; r < nrows; r += NGW) { f32x4 nv[8]; int nsel = -1; const int rn = r + NGW;
        if (rn < nrows) { load_row(H + (size_t)rn * D, F.lane, nv); nsel = SEL[(size_t)rn * 16 + (F.lane & 15)]; }
        f32x4 acc[8];
#pragma unroll
        for (int i = 0; i < 8; ++i) acc[i] = (f32x4){0.f, 0.f, 0.f, 0.f};
        const float gsel = (sel >= 0) ? GW[sel] : 0.f;
        unsigned long long mask = __ballot(sel >= 0) & 0xffffull;
        while (mask) { const int e = __builtin_ctzll(mask); mask &= mask - 1;
            const int s = __shfl(sel, e); const float g = __shfl(gsel, e); const bf16* yr = YS + (size_t)s * D;
#pragma unroll
            for (int i = 0; i < 8; ++i) { const v2u w = *(const GAS v2u*)(yr + 4 * (F.lane + 64 * i));
                acc[i][0] += g * bflo(w.x); acc[i][1] += g * bfhi(w.x); acc[i][2] += g * bflo(w.y); acc[i][3] += g * bfhi(w.y); } }
        const float* m5 = MODl + (size_t)row_b(r) * 12288 + 5 * 2048;
#pragma unroll
        for (int i = 0; i < 8; ++i) { const f32x4 g5 = *(const GAS f32x4*)(m5 + 4 * (F.lane + 64 * i)); v[i] = v[i] + g5 * acc[i]; }
        const float rs = row_rstd(v);
        if (MODE == 0) {
#pragma unroll
            for (int i = 0; i < 8; ++i) *(GAS f32x4*)(H + (size_t)r * D + 4 * (F.lane + 64 * i)) = v[i];
            const float* m = MODn + (size_t)row_b(r) * 12288;
            modulate_store(v, rs, F.in[I_N1G] + 2048, m, m + 2048, A + (size_t)r * D, F.lane);
        } else {
#pragma unroll
            for (int i = 0; i < 8; ++i) { const int c = 4 * (F.lane + 64 * i); const f32x4 gg = *(const GAS f32x4*)(F.in[I_FING] + c);
                *(GAS f32x4*)(F.out + (size_t)r * D + c) = v[i] * rs * gg; }
        }
#pragma unroll
        for (int i = 0; i < 8; ++i) v[i] = nv[i];
        sel = nsel;
    }
}
__device__ __forceinline__ void ph_hy_shortconv(Frame& F) {
    const int gw = F.bid * NWAVES + F.wave, NGW = F.G * NWAVES;
    const bf16* P = (const bf16*)(F.ws + WS_P); bf16* XV = (bf16*)(F.ws + WS_XV);
    const float* cw = F.in[I_HCW]; const float* cb = F.in[I_HCB];
    for (int r = M_LAT + gw; r < M_ALL; r += NGW) {
        const int t = (r < M_LAT) ? (r & 2047) : ((r - M_LAT) & 255); const int L = (r < M_LAT) ? 2048 : 256;
        const bool hp = t > 0, hn = t < L - 1;
        for (int i = 0; i < 6; ++i) { const int c = 8 * (F.lane + 64 * i);
            const v4u z = {0u, 0u, 0u, 0u};
            const v4u a = hp ? *(const GAS v4u*)(P + (size_t)(r - 1) * LD0 + c) : z;
            const v4u b = *(const GAS v4u*)(P + (size_t)r * LD0 + c);
            const v4u d = hn ? *(const GAS v4u*)(P + (size_t)(r + 1) * LD0 + c) : z;
            float o[8];
#pragma unroll
            for (int q = 0; q < 4; ++q) { const int cc = c + 2 * q;
                o[2 * q] = cb[cc] + cw[cc] * bflo(a[q]) + cw[3072 + cc] * bflo(b[q]) + cw[6144 + cc] * bflo(d[q]);
                o[2 * q + 1] = cb[cc + 1] + cw[cc + 1] * bfhi(a[q]) + cw[3072 + cc + 1] * bfhi(b[q]) + cw[6144 + cc + 1] * bfhi(d[q]); }
            v4u w; w.x = pk2(o[0], o[1]); w.y = pk2(o[2], o[3]); w.z = pk2(o[4], o[5]); w.w = pk2(o[6], o[7]);
            *(GAS v4u*)(XV + (size_t)r * 3072 + c) = w; }
    }
}
__device__ __forceinline__ void ph_hy_longconv(Frame& F, int order) {
    const bf16* XV = (const bf16*)(F.ws + WS_XV); bf16* Z = (bf16*)(F.ws + WS_Z); bf16* Y = (bf16*)(F.ws + WS_Y);
    const bf16* U = (order == 0) ? XV + C0_V : Z; const int ldu = (order == 0) ? 3072 : 1024;
    const bf16* Gt = XV + ((order == 0) ? C0_X1 : C0_X2);
    bf16* O = (order == 0) ? Z : Y; const int ldo = (order == 0) ? 1024 : 2048;
    const float* skip = F.in[I_HBIAS] + order * 1024;
    for (int u = 2048 + F.bid; u < 2304; u += F.G) {
        const bool lat = u < 2048; const int q = lat ? u : u - 2048;
        int b, cbk, tb, L, r0;
        if (lat) { tb = q & 127; cbk = (q >> 7) & 1; b = q >> 8; L = 2048; r0 = b * 2048; } else { tb = q & 15; cbk = (q >> 4) & 1; b = q >> 5; L = 256; r0 = M_LAT + b * 256; }
        const float* FT = (const float*)(F.ws + (lat ? WS_FTL : WS_FTC)) + (size_t)order * (2 * L - 1) * 1024;
        const int c = cbk * 512 + F.tid, t0 = tb * 16;
        float acc[16];
#pragma unroll
        for (int a = 0; a < 16; ++a) acc[a] = 0.f;
        for (int s0 = 0; s0 < L; s0 += 16) {
            float uu[16], ff[31];
#pragma unroll
            for (int i = 0; i < 16; ++i) uu[i] = bf2f(U[(size_t)(r0 + s0 + i) * ldu + c]);
            const int base = t0 - s0 + L - 1 - 15;
#pragma unroll
            for (int j = 0; j < 31; ++j) ff[j] = FT[(size_t)(base + j) * 1024 + c];
#pragma unroll
            for (int a = 0; a < 16; ++a)
#pragma unroll
                for (int i = 0; i < 16; ++i) acc[a] += ff[a - i + 15] * uu[i];
        }
        const float sk = skip[c];
#pragma unroll
        for (int a = 0; a < 16; ++a) { const size_t r = (size_t)(r0 + t0 + a);
            const float uv = bf2f(U[r * ldu + c]), g = bf2f(Gt[r * 3072 + c]);
            O[r * ldo + c] = (bf16)f2bf(g * (acc[a] + sk * uv)); }
    }
}
__device__ __forceinline__ int scan_row(int b, int dir, int n) {
    if (n < 256) { const int tc = dir ? 255 - n : n; return M_LAT + b * 256 + tc; }
    const int tl = n - 256; const int t = dir ? 2047 - tl : tl; return b * 2048 + t;
}
__device__ __forceinline__ void ph_gla_scan(Frame& F) {
    LAS float* W2s = (LAS float*)(F.lds);
    LAS float* gbs = W2s + 2048;
    LAS float* cds = gbs + 128;
    LAS float* as_ = cds + 256;
    LAS float* ks = as_ + 2048;
    LAS float* qs = ks + 2048;
    LAS float* vs_ = qs + 2048;
    LAS float* red = vs_ + 1024;
    const bf16* P = (const bf16*)(F.ws + WS_P); float* OG = (float*)(F.ws + WS_OG);
    for (int u = F.bid; u < 256; u += F.G) {
        const int vsl = u & 3, dir = (u >> 2) & 1, h = (u >> 3) & 3, b = u >> 5;
        const int v = F.tid & 63, kg = F.tid >> 6;
        __syncthreads();
        for (int i = F.tid; i < 2048; i += NTHR) W2s[i] = F.in[I_GGW2][(size_t)(dir * 16 + (i >> 7)) * 512 + h * 128 + (i & 127)];
        if (F.tid < 128) gbs[F.tid] = F.in[I_GGB][dir * 512 + h * 128 + F.tid];
        float S[16];
#pragma unroll
        for (int j = 0; j < 16; ++j) S[j] = 0.f;
        for (int n0 = 0; n0 < 2304; n0 += 16) {
            __syncthreads();
            if (F.tid < 256) { const int tk = F.tid >> 4, rr = F.tid & 15; const int row = scan_row(b, dir, n0 + tk); cds[F.tid] = bf2f(P[(size_t)row * LD0 + C0_CODE + dir * 16 + rr]); }
            for (int i = F.tid; i < 1024; i += NTHR) { const int tk = i >> 6, vx = i & 63; const int row = scan_row(b, dir, n0 + tk); vs_[i] = bf2f(P[(size_t)row * LD0 + C0_GV + h * 256 + vsl * 64 + vx]); }
            __syncthreads();
            for (int i = F.tid; i < 2048; i += NTHR) { const int tk = i >> 7, kx = i & 127; const int row = scan_row(b, dir, n0 + tk);
                qs[i] = bf2f(P[(size_t)row * LD0 + C0_GQ + h * 128 + kx]) * 0.08838834764831845f;
                ks[i] = bf2f(P[(size_t)row * LD0 + C0_GK + h * 128 + kx]);
                float lg = gbs[kx];
#pragma unroll
                for (int rr = 0; rr < 16; ++rr) lg += cds[tk * 16 + rr] * W2s[rr * 128 + kx];
                as_[i] = __expf(logsigmoidf_(lg) * (1.f / 16.f)); }
            __syncthreads();
            for (int tk = 0; tk < 16; ++tk) {
                const float vv = vs_[tk * 64 + v]; float part = 0.f;
#pragma unroll
                for (int j = 0; j < 16; ++j) { const int k = tk * 128 + kg * 16 + j; S[j] = as_[k] * S[j] + ks[k] * vv; part += qs[k] * S[j]; }
                red[((tk & 1) * 8 + kg) * 64 + v] = part;
                __syncthreads();
                if (kg == 0) { float o = 0.f;
#pragma unroll
                    for (int g = 0; g < 8; ++g) o += red[((tk & 1) * 8 + g) * 64 + v];
                    const int row = scan_row(b, dir, n0 + tk);
                    OG[((size_t)dir * M_ALL + row) * 1024 + h * 256 + vsl * 64 + v] = o; }
            }
        }
    }
    __syncthreads();
}
template <int ACT> __device__ __forceinline__ void ph_mix_combine(Frame& F, int nrows, const bf16* O0, const bf16* O1, const bf16* P, int ldp, int gcol, const float* ng, int ycol) {
    const int gw = F.bid * NWAVES + F.wave, NGW = F.G * NWAVES;
    bf16* Y = (bf16*)(F.ws + WS_Y);
    for (int r = gw; r < nrows; r += NGW) {
#pragma unroll
        for (int h = 0; h < 4; ++h) { const int c = h * 256 + 4 * F.lane;
            const v2u a = *(const GAS v2u*)(O0 + (size_t)r * 1024 + c), b2 = *(const GAS v2u*)(O1 + (size_t)r * 1024 + c);
            const f32x4 o = {bflo(a.x) + bflo(b2.x), bfhi(a.x) + bfhi(b2.x), bflo(a.y) + bflo(b2.y), bfhi(a.y) + bfhi(b2.y)};
            const float ss = wave_sum((o[0] * o[0] + o[1] * o[1]) + (o[2] * o[2] + o[3] * o[3]));
            const float rs = 1.f / sqrtf(ss * (1.f / 256.f) + EPS);
            const f32x4 gg = *(const GAS f32x4*)(ng + 4 * F.lane);
            const v2u gw2 = *(const GAS v2u*)(P + (size_t)r * ldp + gcol + c);
            float gt[4] = {bflo(gw2.x), bfhi(gw2.x), bflo(gw2.y), bfhi(gw2.y)};
            float y[4];
#pragma unroll
            for (int q = 0; q < 4; ++q) y[q] = o[q] * rs * gg[q] * (ACT == 0 ? siluf(gt[q]) : sigmoidf_(gt[q]));
            v2u w; w.x = pk2(y[0], y[1]); w.y = pk2(y[2], y[3]);
            *(GAS v2u*)(Y + (size_t)r * D + ycol + c) = w; }
    }
}
__device__ __forceinline__ void ph_ml_scan(Frame& F) {
    LAS float* qs = (LAS float*)(F.lds);
    LAS float* ks = qs + 2048;
    LAS float* vs_ = ks + 2048;
    LAS float* gts = vs_ + 512;
    LAS float* red = gts + 16;
    LAS float* redd = red + 1024;
    const bf16* P = (const bf16*)(F.ws + WS_P); float* OM = (float*)(F.ws + WS_OG);
    const float* cw = F.in[I_MCW]; const float* cb = F.in[I_MCB];
    for (int u = F.bid; u < 256; u += F.G) {
        const int vsl = u & 3, dir = (u >> 2) & 1, h = (u >> 3) & 3, b = u >> 5;
        const int v = F.tid & 63, kg = F.tid >> 6;
        float C[32], nn[32]; float m = 0.f;
#pragma unroll
        for (int j = 0; j < 32; ++j) { C[j] = 0.f; nn[j] = 0.f; }
        const float igb = F.in[I_MIGB][dir * 4 + h], fgb = F.in[I_MFGB][dir * 4 + h];
        for (int n0 = 0; n0 < 2304; n0 += 8) {
            __syncthreads();
            for (int i = F.tid; i < 4096; i += NTHR) { const int tk = i >> 9, col = i & 511; const int row = scan_row(b, dir, n0 + tk);
                const int pc = (col < 256) ? (h * 256 + col) : (1024 + h * 256 + (col - 256));
                const int t = (row < M_LAT) ? (row & 2047) : ((row - M_LAT) & 255); const int L = (row < M_LAT) ? 2048 : 256;
                float a = cb[pc] + cw[2048 + pc] * bf2f(P[(size_t)row * LD1 + pc]);
                if (t > 0) a += cw[pc] * bf2f(P[(size_t)(row - 1) * LD1 + pc]);
                if (t < L - 1) a += cw[4096 + pc] * bf2f(P[(size_t)(row + 1) * LD1 + pc]);
                a = siluf(a);
                if (col < 256) qs[tk * 256 + col] = a; else ks[tk * 256 + col - 256] = a * 0.0625f; }
            { const int tk = F.tid >> 6, vx = F.tid & 63; const int row = scan_row(b, dir, n0 + tk); vs_[F.tid] = bf2f(P[(size_t)row * LD1 + C1_MV + h * 256 + vsl * 64 + vx]); }
            if (F.tid < 8) { const int row = scan_row(b, dir, n0 + F.tid);
                gts[F.tid * 2 + 0] = bf2f(P[(size_t)row * LD1 + C1_G + dir * 8 + h]) + igb;
                gts[F.tid * 2 + 1] = logsigmoidf_(bf2f(P[(size_t)row * LD1 + C1_G + dir * 8 + 4 + h]) + fgb); }
            __syncthreads();
            for (int tk = 0; tk < 8; ++tk) {
                const float ig = gts[tk * 2], lf = gts[tk * 2 + 1];
                const float mn = fmaxf(lf + m, ig); const float fk = __expf(lf + m - mn), ik = __expf(ig - mn); m = mn;
                const float vv = vs_[tk * 64 + v] * ik; float part = 0.f, dpart = 0.f;
#pragma unroll
                for (int j = 0; j < 32; ++j) { const int k = tk * 256 + kg * 32 + j; const float kv = ks[k], qv = qs[k];
                    C[j] = fk * C[j] + vv * kv; nn[j] = fk * nn[j] + ik * kv; part += C[j] * qv; dpart += nn[j] * qv; }
                red[((tk & 1) * 8 + kg) * 64 + v] = part; if (v == 0) redd[(tk & 1) * 8 + kg] = dpart;
                __syncthreads();
                if (kg == 0 && n0 >= 256) { float num = 0.f, den = 0.f;
#pragma unroll
                    for (int g = 0; g < 8; ++g) { num += red[((tk & 1) * 8 + g) * 64 + v]; den += redd[(tk & 1) * 8 + g]; }
                    const int row = scan_row(b, dir, n0 + tk);
                    OM[((size_t)dir * M_LAT + row) * 1024 + h * 256 + vsl * 64 + v] = num / fmaxf(fabsf(den), __expf(-m)); }
            }
        }
    }
    __syncthreads();
}
__device__ __forceinline__ void ph_da_rope(Frame& F) {
    const int gw = F.bid * NWAVES + F.wave, NGW = F.G * NWAVES;
    bf16* P = (bf16*)(F.ws + WS_P);
    for (int r = gw; r < M_LAT; r += NGW) { const int t = r & 2047;
        for (int i = 0; i < 16; ++i) { const int pi = F.lane + 64 * i; const int which = pi >> 9, vec = (pi >> 5) & 15, axis = (pi >> 4) & 1, f = pi & 15;
            const int col = (which ? C1_DK : C1_DQ) + vec * 64 + axis * 32 + f;
            const float pos = (float)(axis ? (t & 63) : (t >> 6));
            const float inv = exp2f(-(float)f * (13.287712379549449f / 16.f));
            const float ang = pos * inv; const float cs = cosf(ang), sn = sinf(ang);
            const float xa = bf2f(P[(size_t)r * LD1 + col]), xb = bf2f(P[(size_t)r * LD1 + col + 16]);
            const float sc = which ? 1.f : 0.18033688011112042f;
            P[(size_t)r * LD1 + col] = (bf16)f2bf((xa * cs - xb * sn) * sc); P[(size_t)r * LD1 + col + 16] = (bf16)f2bf((xb * cs + xa * sn) * sc); }
    }
}
__device__ __forceinline__ void ph_da_attn(Frame& F) {
    constexpr int KS_LD = 136, VT_LD = 72, PW_LD = 72;
    LAS bf16* Ks = (LAS bf16*)(F.lds);
    LAS bf16* VT = Ks + 64 * KS_LD;
    LAS bf16* Pw = VT + 128 * VT_LD + (F.wave * 2) * 16 * PW_LD;
    const bf16* P = (const bf16*)(F.ws + WS_P); bf16* Y = (bf16*)(F.ws + WS_Y);
    const float lam_init = 0.35550906759096927f;
    float lam;
    { const float* lv = F.in[I_DLAM]; float s01 = 0.f, s23 = 0.f; for (int i = 0; i < 64; ++i) { s01 += lv[i] * lv[64 + i]; s23 += lv[128 + i] * lv[192 + i]; } lam = expf(s01) - expf(s23) + lam_init; }
    const int fr = F.lane & 15, fq = F.lane >> 4;
    for (int u = F.bid; u < 1024; u += F.G) {
        const int qb = u & 15, h = (u >> 4) & 7, b = u >> 7;
        const int qrow0 = b * 2048 + qb * 128 + F.wave * 16;
        bf16x8 qf[2][2];
#pragma unroll
        for (int c = 0; c < 2; ++c)
#pragma unroll
            for (int ks = 0; ks < 2; ++ks) qf[c][ks] = *(const GAS bf16x8*)(P + (size_t)(qrow0 + fr) * LD1 + C1_DQ + h * 128 + c * 64 + ks * 32 + 8 * fq);
        f32x4 Oa[2][8]; float mrun[2][4], lrun[2][4];
#pragma unroll
        for (int c = 0; c < 2; ++c) {
#pragma unroll
            for (int vt = 0; vt < 8; ++vt) Oa[c][vt] = (f32x4){0.f, 0.f, 0.f, 0.f};
#pragma unroll
            for (int j = 0; j < 4; ++j) { mrun[c][j] = -1e30f; lrun[c][j] = 0.f; } }
        for (int kt = 0; kt < 36; ++kt) {
            __syncthreads();
#pragma unroll
            for (int i = 0; i < 2; ++i) { const int id = F.tid + 512 * i; const int key = id >> 4, ch = id & 15; const int kk = kt * 64 + key;
                const size_t krow = (kk < 256) ? (size_t)(M_LAT + b * 256 + kk) : (size_t)(b * 2048 + kk - 256);
                const v4u kv = *(const GAS v4u*)(P + krow * LD1 + C1_DK + h * 128 + ch * 8);
                *(LAS v4u*)(Ks + key * KS_LD + ch * 8) = kv;
                const v4u vv = *(const GAS v4u*)(P + krow * LD1 + C1_DV + h * 128 + ch * 8);
#pragma unroll
                for (int q = 0; q < 4; ++q) { VT[(ch * 8 + 2 * q) * VT_LD + key] = (bf16)(vv[q] & 0xffffu); VT[(ch * 8 + 2 * q + 1) * VT_LD + key] = (bf16)(vv[q] >> 16); } }
            __syncthreads();
#pragma unroll
            for (int c = 0; c < 2; ++c) {
                f32x4 S[4];
#pragma unroll
                for (int nt = 0; nt < 4; ++nt) { f32x4 a = {0.f, 0.f, 0.f, 0.f};
#pragma unroll
                    for (int ks = 0; ks < 2; ++ks) { const bf16x8 bf = *(const LAS bf16x8*)(Ks + (nt * 16 + fr) * KS_LD + c * 64 + ks * 32 + 8 * fq); a = __builtin_amdgcn_mfma_f32_16x16x32_bf16(qf[c][ks], bf, a, 0, 0, 0); }
                    S[nt] = a; }
#pragma unroll
                for (int j = 0; j < 4; ++j) {
                    float mx = fmaxf(fmaxf(S[0][j], S[1][j]), fmaxf(S[2][j], S[3][j])); mx = grp16_max(mx);
                    const float mn = fmaxf(mrun[c][j], mx); const float alpha = __expf(mrun[c][j] - mn); mrun[c][j] = mn;
                    float rsum = 0.f;
#pragma unroll
                    for (int nt = 0; nt < 4; ++nt) { const float p = __expf(S[nt][j] - mn); rsum += p; Pw[(c * 16 + 4 * fq + j) * PW_LD + nt * 16 + fr] = (bf16)f2bf(p); }
                    rsum = grp16_sum(rsum); lrun[c][j] = lrun[c][j] * alpha + rsum;
#pragma unroll
                    for (int vt = 0; vt < 8; ++vt) Oa[c][vt][j] *= alpha; }
            }
            __syncthreads();
#pragma unroll
            for (int c = 0; c < 2; ++c)
#pragma unroll
                for (int ks = 0; ks < 2; ++ks) { const bf16x8 af = *(const LAS bf16x8*)(Pw + (c * 16 + fr) * PW_LD + ks * 32 + 8 * fq);
#pragma unroll
                    for (int vt = 0; vt < 8; ++vt) { const bf16x8 bf = *(const LAS bf16x8*)(VT + (vt * 16 + fr) * VT_LD + ks * 32 + 8 * fq); Oa[c][vt] = __builtin_amdgcn_mfma_f32_16x16x32_bf16(af, bf, Oa[c][vt], 0, 0, 0); } }
        }
#pragma unroll
        for (int j = 0; j < 4; ++j) { const float i0 = 1.f / lrun[0][j], i1 = lam / lrun[1][j]; float o[8]; float ss = 0.f;
#pragma unroll
            for (int vt = 0; vt < 8; ++vt) { o[vt] = Oa[0][vt][j] * i0 - Oa[1][vt][j] * i1; ss += o[vt] * o[vt]; }
            ss = grp16_sum(ss); const float rs = (1.f - lam_init) / sqrtf(ss * (1.f / 128.f) + EPS);
#pragma unroll
            for (int vt = 0; vt < 8; ++vt) Y[(size_t)(qrow0 + 4 * fq + j) * D + 1024 + h * 128 + vt * 16 + fr] = (bf16)f2bf(o[vt] * rs * F.in[I_DNG][vt * 16 + fr]); }
    }
    __syncthreads();
}
__device__ __forceinline__ void ph_hy_prep_lat(Frame& F) {
    LAS bf16* raw = (LAS bf16*)(F.lds);
    const bf16* P = (const bf16*)(F.ws + WS_P); bf16* XT = (bf16*)(F.ws + WS_XT);
    const float* cw = F.in[I_HCW]; const float* cbias = F.in[I_HCB];
    for (int u = F.bid; u < 12288; u += F.G) {
        const int cb = u & 15, tb = (u >> 4) & 31, b = (u >> 9) & 7, which = u >> 12;
        const int c0 = which * 1024 + cb * 64, t0 = tb * 64;
        __syncthreads();
        for (int id = F.tid; id < 528; id += NTHR) { const int rr = id >> 3, ch = id & 7; const int t = t0 - 1 + rr; v4u val = {0u, 0u, 0u, 0u};
            if (t >= 0 && t < 2048) val = *(const GAS v4u*)(P + (size_t)(b * 2048 + t) * LD0 + c0 + ch * 8);
            *(LAS v4u*)(raw + rr * 72 + ch * 8) = val; }
        __syncthreads();
        const int cc = F.tid & 63, tg = F.tid >> 6, c = c0 + cc;
        const float w0 = cw[c], w1 = cw[3072 + c], w2 = cw[6144 + c], bs = cbias[c];
        float o[8];
#pragma unroll
        for (int i = 0; i < 8; ++i) { const int tt = tg * 8 + i; o[i] = bs + w0 * bf2f(raw[tt * 72 + cc]) + w1 * bf2f(raw[(tt + 1) * 72 + cc]) + w2 * bf2f(raw[(tt + 2) * 72 + cc]); }
        v4u w; w.x = pk2(o[0], o[1]); w.y = pk2(o[2], o[3]); w.z = pk2(o[4], o[5]); w.w = pk2(o[6], o[7]);
        *(GAS v4u*)(XT + ((size_t)c * 8 + b) * 2048 + t0 + tg * 8) = w;
    }
    __syncthreads();
}
__device__ __forceinline__ void ph_hy_post_lat(Frame& F) {
    LAS bf16* tile = (LAS bf16*)(F.lds);
    const bf16* YT = (const bf16*)(F.ws + WS_YT); bf16* Y = (bf16*)(F.ws + WS_Y);
    for (int u = F.bid; u < 4096; u += F.G) { const int cb = u & 15, tb = (u >> 4) & 31, b = u >> 9;
        __syncthreads();
        { const int cc = F.tid >> 3, ch = F.tid & 7;
          *(LAS v4u*)(tile + cc * 72 + ch * 8) = *(const GAS v4u*)(YT + ((size_t)(cb * 64 + cc) * 8 + b) * 2048 + tb * 64 + ch * 8); }
        __syncthreads();
        { const int t = F.tid >> 3, ch = F.tid & 7; unsigned short e[8];
#pragma unroll
          for (int i = 0; i < 8; ++i) e[i] = tile[(ch * 8 + i) * 72 + t];
          v4u w; w.x = e[0] | ((unsigned)e[1] << 16); w.y = e[2] | ((unsigned)e[3] << 16); w.z = e[4] | ((unsigned)e[5] << 16); w.w = e[6] | ((unsigned)e[7] << 16);
          *(GAS v4u*)(Y + (size_t)(b * 2048 + tb * 64 + t) * D + cb * 64 + ch * 8) = w; }
    }
    __syncthreads();
}
__device__ __forceinline__ void ph_hy_ftt(Frame& F) {
    LAS float* tile = (LAS float*)(F.lds);
    const float* FTL = (const float*)(F.ws + WS_FTL); bf16* FTT = (bf16*)(F.ws + WS_FTT);
    for (int u = F.bid; u < 2 * 65 * 16; u += F.G) { const int cb = u & 15; const int rb = (u >> 4) % 65; const int o = (u >> 4) / 65;
        __syncthreads();
        for (int i = F.tid; i < 4096; i += NTHR) { const int rr = i >> 6, cc = i & 63; const int r = rb * 64 + rr; const int idx = 4127 - r;
            tile[rr * 65 + cc] = (idx >= 0 && idx <= 4094) ? FTL[((size_t)o * 4095 + idx) * 1024 + cb * 64 + cc] : 0.f; }
        __syncthreads();
        { const int cc = F.tid >> 3, ch = F.tid & 7; float e[8];
#pragma unroll
          for (int i = 0; i < 8; ++i) e[i] = tile[(ch * 8 + i) * 65 + cc];
          v4u w; w.x = pk2(e[0], e[1]); w.y = pk2(e[2], e[3]); w.z = pk2(e[4], e[5]); w.w = pk2(e[6], e[7]);
          *(GAS v4u*)(FTT + ((size_t)o * 1024 + cb * 64 + cc) * 4160 + rb * 64 + ch * 8) = w; }
    }
    __syncthreads();
}
constexpr int HY_XOFF = 2080, HY_RLEN = 4160, HY_KOFF = 32, HY_UROWB = 4192, HY_UCOPYB = 33600, HY_UOFF = 2 * HY_RLEN * 2;
__device__ __forceinline__ void hy_conv_loop(const LAS bf16* Rp, const LAS unsigned* Ud, int wave, int fr, int fq, f32x4 (&acc)[2][4]) {
    const int dl = fr & 7, s = dl & 1;
    const LAS bf16* ap = Rp + 2048 + 8 * fq - 8 * (32 * wave + fr);
    const LAS unsigned* up = Ud + s * (HY_UCOPYB / 4) + (fr >> 3) * (HY_UROWB / 4) + 4 * fq + ((dl - s) >> 1);
#pragma unroll 1
    for (int K0 = 0; K0 < 65; ++K0) {
        bf16x8 af[2];
#pragma unroll
        for (int mt = 0; mt < 2; ++mt) af[mt] = *(const LAS bf16x8*)(ap + 32 * K0 - 128 * mt);
        bf16x8 bfv[4];
#pragma unroll
        for (int nt = 0; nt < 4; ++nt) { const LAS unsigned* q = up + nt * 2 * (HY_UROWB / 4) + 16 * K0; v4u w; w.x = q[0]; w.y = q[1]; w.z = q[2]; w.w = q[3]; bfv[nt] = __builtin_bit_cast(bf16x8, w); }
#pragma unroll
        for (int mt = 0; mt < 2; ++mt)
#pragma unroll
            for (int nt = 0; nt < 4; ++nt) acc[mt][nt] = __builtin_amdgcn_mfma_f32_16x16x32_bf16(af[mt], bfv[nt], acc[mt][nt], 0, 0, 0);
    }
}
__device__ __forceinline__ void ph_hy_conv_lat(Frame& F) {
    LAS bf16* R = (LAS bf16*)(F.lds);
    LAS unsigned char* Ub = F.lds + HY_UOFF;
    LAS bf16* Gs = (LAS bf16*)(F.lds + HY_UOFF + 2 * HY_UCOPYB);
    const bf16* XT = (const bf16*)(F.ws + WS_XT); bf16* YT = (bf16*)(F.ws + WS_YT);
    const bf16* FTT = (const bf16*)(F.ws + WS_FTT);
    const int fr = F.lane & 15, fq = F.lane >> 4;
    for (int c = F.bid; c < 1024; c += F.G) {
        const bf16* X1 = XT + (size_t)c * 8 * 2048; const bf16* X2 = XT + ((size_t)1024 + c) * 8 * 2048; const bf16* XV_ = XT + ((size_t)2048 + c) * 8 * 2048;
        __syncthreads();
        for (int i = F.tid; i < (2 * HY_UCOPYB) / 16; i += NTHR) *(LAS v4u*)(Ub + i * 16) = (v4u){0u, 0u, 0u, 0u};
        for (int i = F.tid; i < 2 * HY_RLEN / 8; i += NTHR) { const int o = (i >= HY_RLEN / 8) ? 1 : 0; const int q = i - o * (HY_RLEN / 8);
            *(LAS v4u*)(R + o * HY_RLEN + q * 8) = *(const GAS v4u*)(FTT + ((size_t)o * 1024 + c) * 4160 + q * 8); }
        for (int i = F.tid; i < 2048; i += NTHR) { const int b = i >> 8, ch = i & 255; *(LAS v4u*)(Gs + b * 2048 + ch * 8) = *(const GAS v4u*)(X1 + (size_t)b * 2048 + ch * 8); }
        __syncthreads();
        for (int i = F.tid; i < 2048; i += NTHR) { const int b = i >> 8, ch = i & 255, t0 = ch * 8; const v4u val = *(const GAS v4u*)(XV_ + (size_t)b * 2048 + t0);
            *(LAS v4u*)(Ub + b * HY_UROWB + (HY_KOFF + t0) * 2) = val;
            LAS bf16* c1 = (LAS bf16*)(Ub + HY_UCOPYB + b * HY_UROWB) + HY_KOFF + t0 - 1;
#pragma unroll
            for (int q = 0; q < 4; ++q) { c1[2 * q] = (bf16)(val[q] & 0xffffu); c1[2 * q + 1] = (bf16)(val[q] >> 16); } }
        __syncthreads();
#pragma unroll 1
        for (int order = 0; order < 2; ++order) {
            f32x4 acc[2][4];
#pragma unroll
            for (int mt = 0; mt < 2; ++mt)
#pragma unroll
                for (int nt = 0; nt < 4; ++nt) acc[mt][nt] = (f32x4){0.f, 0.f, 0.f, 0.f};
            v4u gpre[4];
            if (order == 0) {
#pragma unroll
                for (int x = 0; x < 4; ++x) { const int i = F.tid + NTHR * x; gpre[x] = *(const GAS v4u*)(X2 + (size_t)(i >> 8) * 2048 + (i & 255) * 8); } }
            hy_conv_loop(R + order * HY_RLEN, (const LAS unsigned*)Ub, F.wave, fr, fq, acc);
            __syncthreads();
            const float sk = F.in[I_HBIAS][order * 1024 + c];
#pragma unroll
            for (int mt = 0; mt < 2; ++mt)
#pragma unroll
                for (int nt = 0; nt < 4; ++nt)
#pragma unroll
                    for (int j = 0; j < 4; ++j) { const int m = 32 * F.wave + 16 * mt + 4 * fq + j; const int b = 2 * nt + (fr >> 3); const int t = 8 * m + (fr & 7);
                        LAS bf16* u0 = (LAS bf16*)(Ub + b * HY_UROWB) + HY_KOFF + t; LAS bf16* u1 = (LAS bf16*)(Ub + HY_UCOPYB + b * HY_UROWB) + HY_KOFF + t;
                        const float uv = bf2f(*u0), g = bf2f(Gs[b * 2048 + t]);
                        const bf16 r = (bf16)f2bf(g * (acc[mt][nt][j] + sk * uv));
                        if (order == 0) { *u0 = r; u1[-1] = r; } else { *u1 = r; } }
            __syncthreads();
            if (order == 0) {
#pragma unroll
                for (int x = 0; x < 4; ++x) { const int i = F.tid + NTHR * x; *(LAS v4u*)(Gs + (i >> 8) * 2048 + (i & 255) * 8) = gpre[x]; } }
        }
        for (int i = F.tid; i < 2048; i += NTHR) { const int b = i >> 8, ch = i & 255;
            *(GAS v4u*)(YT + ((size_t)c * 8 + b) * 2048 + ch * 8) = *(const LAS v4u*)(Ub + HY_UCOPYB + b * HY_UROWB + (HY_KOFF + ch * 8) * 2); }
    }
    __syncthreads();
}
__device__ __forceinline__ void ph_ml_prep(Frame& F) {
    const bf16* P = (const bf16*)(F.ws + WS_P); bf16* MQK = (bf16*)(F.ws + WS_MQK); float* MLS = (float*)(F.ws + WS_MLS); float* KEEP = MLS + (size_t)64 * 36 * 320;
    const int gw = F.bid * NWAVES + F.wave, NGW = F.G * NWAVES;
    if (gw < 64) {
        const int sq = gw, dir = sq & 1, h = (sq >> 1) & 3, b = sq >> 3; const int i = F.lane;
        const float igb = F.in[I_MIGB][dir * 4 + h], fgb = F.in[I_MFGB][dir * 4 + h]; float mrun = 0.f;
        for (int c = 0; c < 36; ++c) { const int row = scan_row(b, dir, 64 * c + i);
            const float ig = bf2f(P[(size_t)row * LD1 + C1_G + dir * 8 + h]) + igb;
            const float lf = logsigmoidf_(bf2f(P[(size_t)row * LD1 + C1_G + dir * 8 + 4 + h]) + fgb);
            const float bi = wave_incl_sum(lf, i); const float blast = __shfl(bi, 63);
            const float wend = blast - bi + ig; const float mnew = fmaxf(blast + mrun, wave_max(wend));
            const float keep = __expf(blast + mrun - mnew); const float wi = __expf(wend - mnew);
            const float ai = bi + mrun; const float colv = ig - bi; const float pm = wave_incl_max(colv, i); const float mt = fmaxf(ai, bi + pm);
            float* o = MLS + ((size_t)sq * 36 + c) * 320 + i;
            o[0] = wi; o[64] = bi - mt; o[128] = colv; o[192] = __expf(ai - mt); o[256] = __expf(-mt); if (i == 0) KEEP[sq * 36 + c] = keep;
            mrun = mnew; }
    }
    const float* cw = F.in[I_MCW]; const float* cbias = F.in[I_MCB];
    const bool scanw = (NGW > 128) && (gw < 64);
    const int cgw = (NGW > 128) ? gw - 64 : gw, CNGW = (NGW > 128) ? NGW - 64 : NGW;
    f32x4 w0[4][2], w1[4][2], w2[4][2], bs[4][2];
    if (!scanw) {
#pragma unroll
        for (int i = 0; i < 4; ++i)
#pragma unroll
            for (int hh = 0; hh < 2; ++hh) { const int c = 8 * (F.lane + 64 * i) + 4 * hh;
                w0[i][hh] = *(const GAS f32x4*)(cw + c); w1[i][hh] = *(const GAS f32x4*)(cw + 2048 + c); w2[i][hh] = *(const GAS f32x4*)(cw + 4096 + c); bs[i][hh] = *(const GAS f32x4*)(cbias + c); } }
    for (int r = scanw ? M_ALL : cgw; r < M_ALL; r += CNGW) {
        const int t = (r < M_LAT) ? (r & 2047) : ((r - M_LAT) & 255); const int L = (r < M_LAT) ? 2048 : 256; const bool hp = t > 0, hn = t < L - 1;
#pragma unroll
        for (int i = 0; i < 4; ++i) { const int c = 8 * (F.lane + 64 * i); const v4u z = {0u, 0u, 0u, 0u};
            const v4u a = hp ? *(const GAS v4u*)(P + (size_t)(r - 1) * LD1 + c) : z; const v4u b2 = *(const GAS v4u*)(P + (size_t)r * LD1 + c); const v4u d = hn ? *(const GAS v4u*)(P + (size_t)(r + 1) * LD1 + c) : z;
            const float ksc = (c < 1024) ? 1.f : 0.0625f; float o[8];
#pragma unroll
            for (int q = 0; q < 4; ++q) { const int hh = q >> 1, e0 = 2 * (q & 1);
                o[2 * q] = siluf(bs[i][hh][e0] + w0[i][hh][e0] * bflo(a[q]) + w1[i][hh][e0] * bflo(b2[q]) + w2[i][hh][e0] * bflo(d[q])) * ksc;
                o[2 * q + 1] = siluf(bs[i][hh][e0 + 1] + w0[i][hh][e0 + 1] * bfhi(a[q]) + w1[i][hh][e0 + 1] * bfhi(b2[q]) + w2[i][hh][e0 + 1] * bfhi(d[q])) * ksc; }
            v4u w; w.x = pk2(o[0], o[1]); w.y = pk2(o[2], o[3]); w.z = pk2(o[4], o[5]); w.w = pk2(o[6], o[7]);
            *(GAS v4u*)(MQK + (size_t)r * 2048 + c) = w; }
    }
}
__device__ __forceinline__ void ph_ml_scan2(Frame& F) {
    constexpr int QLD = 272, VLD = 88, SLD = 72;
    LAS bf16* Qn = (LAS bf16*)(F.lds); LAS bf16* Kn = Qn + 64 * QLD; LAS bf16* Cb = Kn + 64 * QLD; LAS bf16* Vn = Cb + 80 * QLD; LAS bf16* VWn = Vn + 64 * VLD; LAS bf16* SC = VWn + 64 * VLD;
    LAS float* sS = (LAS float*)(SC + 64 * SLD);
    LAS float* sW = sS; LAS float* sRow = sS + 64; LAS float* sCol = sS + 128; LAS float* sAw = sS + 192; LAS float* sEinv = sS + 256;
    const bf16* P = (const bf16*)(F.ws + WS_P); float* OM = (float*)(F.ws + WS_OG);
    const bf16* MQK = (const bf16*)(F.ws + WS_MQK); const float* MLS = (const float*)(F.ws + WS_MLS); const float* KEEP = MLS + (size_t)64 * 36 * 320;
    const int fr = F.lane & 15, fq = F.lane >> 4;
    for (int u0 = F.bid; u0 < 256; u0 += F.G) {
        const int u = (F.G == 256) ? ((((u0 & 7) * 8 + (u0 >> 5)) << 2) | ((u0 >> 3) & 3)) : u0;
        const int vsl = u & 3, dir = (u >> 2) & 1, h = (u >> 3) & 3, b = u >> 5; const int sq = (b * 4 + h) * 2 + dir; const int sgn = dir ? -1 : 1;
        __syncthreads();
        for (int i = F.tid; i < (80 * QLD + 2 * 64 * VLD) / 8; i += NTHR) *(LAS v4u*)(Cb + i * 8) = (v4u){0u, 0u, 0u, 0u};
        __syncthreads();
        if (F.tid < 64) Vn[F.tid * VLD + 64] = (bf16)0x3F80;
        f32x4 st[5][2];
#pragma unroll
        for (int vt = 0; vt < 5; ++vt) { st[vt][0] = (f32x4){0.f, 0.f, 0.f, 0.f}; st[vt][1] = (f32x4){0.f, 0.f, 0.f, 0.f}; }
        v4u rq[4], rk[4], rv; float rs = 0.f, keepn = 0.f;
#define ML_LOAD(cc) do { const int row0_ = scan_row(b, dir, 64 * (cc)); \
            _Pragma("unroll") for (int x = 0; x < 4; ++x) { const int p = F.tid + NTHR * x; const size_t o = (size_t)(row0_ + sgn * (p >> 5)) * 2048 + h * 256 + (p & 31) * 8; \
                rq[x] = *(const GAS v4u*)(MQK + o); rk[x] = *(const GAS v4u*)(MQK + o + 1024); } \
            rv = *(const GAS v4u*)(P + (size_t)(row0_ + sgn * (F.tid >> 3)) * LD1 + C1_MV + h * 256 + vsl * 64 + (F.tid & 7) * 8); \
            if (F.tid < 320) rs = MLS[((size_t)sq * 36 + (cc)) * 320 + F.tid]; keepn = KEEP[sq * 36 + (cc)]; } while (0)
        ML_LOAD(0);
#pragma unroll 1
        for (int c = 0; c < 36; ++c) {
            const bool emit = c >= 4;
#pragma unroll
            for (int x = 0; x < 4; ++x) { const int p = F.tid + NTHR * x; *(LAS v4u*)(Qn + (p >> 5) * QLD + (p & 31) * 8) = rq[x]; *(LAS v4u*)(Kn + (p >> 5) * QLD + (p & 31) * 8) = rk[x]; }
            *(LAS v4u*)(Vn + (F.tid >> 3) * VLD + (F.tid & 7) * 8) = rv;
            if (F.tid < 320) sS[F.tid] = rs;
            const float keep = keepn;
            __syncthreads();
            if (c + 1 < 36) ML_LOAD(c + 1);
            { const int i = F.tid >> 3, cv = F.tid & 7; const float wv = sW[i]; const v4u x = *(const LAS v4u*)(Vn + i * VLD + cv * 8); v4u y;
#pragma unroll
              for (int q = 0; q < 4; ++q) y[q] = pk2(bflo(x[q]) * wv, bfhi(x[q]) * wv);
              *(LAS v4u*)(VWn + i * VLD + cv * 8) = y; if (cv == 0) VWn[i * VLD + 64] = (bf16)f2bf(wv); }
            if (emit) {
                const int it_ = F.wave >> 1;
#pragma unroll
                for (int x = 0; x < 2; ++x) { const int jt = 2 * (F.wave & 1) + x;
                    f32x4 a = {0.f, 0.f, 0.f, 0.f};
                    if (jt <= it_) {
#pragma unroll
                        for (int ks = 0; ks < 8; ++ks) { const bf16x8 af = *(const LAS bf16x8*)(Qn + (16 * it_ + fr) * QLD + 32 * ks + 8 * fq); const bf16x8 bf = *(const LAS bf16x8*)(Kn + (16 * jt + fr) * QLD + 32 * ks + 8 * fq);
                            a = __builtin_amdgcn_mfma_f32_16x16x32_bf16(af, bf, a, 0, 0, 0); } }
                    const int j = 16 * jt + fr; const float cj = sCol[j];
#pragma unroll
                    for (int jj = 0; jj < 4; ++jj) { const int i = 16 * it_ + 4 * fq + jj; const float val = (j <= i) ? a[jj] * __expf(sRow[i] + cj) : 0.f; SC[i * SLD + j] = (bf16)f2bf(val); } }
            }
            __syncthreads();
            if (emit) {
                const int it_ = F.wave & 3, vt0 = 2 * (F.wave >> 2);
                f32x4 acc[3];
#pragma unroll
                for (int x = 0; x < 3; ++x) acc[x] = (f32x4){0.f, 0.f, 0.f, 0.f};
#pragma unroll
                for (int ks = 0; ks < 8; ++ks) { const bf16x8 af = *(const LAS bf16x8*)(Qn + (16 * it_ + fr) * QLD + 32 * ks + 8 * fq);
#pragma unroll
                    for (int x = 0; x < 3; ++x) { const int vt = (x < 2) ? vt0 + x : 4; const bf16x8 bf = *(const LAS bf16x8*)(Cb + (16 * vt + fr) * QLD + 32 * ks + 8 * fq); acc[x] = __builtin_amdgcn_mfma_f32_16x16x32_bf16(af, bf, acc[x], 0, 0, 0); } }
#pragma unroll
                for (int jj = 0; jj < 4; ++jj) { const float awv = sAw[16 * it_ + 4 * fq + jj];
#pragma unroll
                    for (int x = 0; x < 3; ++x) acc[x][jj] *= awv; }
#pragma unroll
                for (int js = 0; js < 2; ++js) { const bf16x8 af = *(const LAS bf16x8*)(SC + (16 * it_ + fr) * SLD + 32 * js + 8 * fq);
#pragma unroll
                    for (int x = 0; x < 3; ++x) { const int vt = (x < 2) ? vt0 + x : 4; const bf16x8 bf = tr_frag(Vn, VLD, 32 * js, 16 * vt, F.lane); acc[x] = __builtin_amdgcn_mfma_f32_16x16x32_bf16(af, bf, acc[x], 0, 0, 0); } }
                const int row0 = scan_row(b, dir, 64 * c);
#pragma unroll
                for (int jj = 0; jj < 4; ++jj) { const int i = 16 * it_ + 4 * fq + jj; const float den = __shfl(acc[2][jj], F.lane & 48); const float dd = fmaxf(fabsf(den), sEinv[i]);
                    const float rdd = __builtin_amdgcn_rcpf(dd);
                    const int row = row0 + sgn * i; bf16* op = (bf16*)OM + ((size_t)dir * M_LAT + row) * 1024 + h * 256 + vsl * 64 + fr;
                    op[16 * vt0] = (bf16)f2bf(acc[0][jj] * rdd); op[16 * vt0 + 16] = (bf16)f2bf(acc[1][jj] * rdd); }
            }
            {
#pragma unroll
              for (int vt = 0; vt < 5; ++vt) { st[vt][0] *= keep; st[vt][1] *= keep; }
#pragma unroll
              for (int is = 0; is < 2; ++is) { bf16x8 kb[2];
#pragma unroll
                  for (int x = 0; x < 2; ++x) kb[x] = tr_frag(Kn, QLD, 32 * is, 16 * (2 * F.wave + x), F.lane);
#pragma unroll
                  for (int vt = 0; vt < 5; ++vt) { const bf16x8 af = tr_frag(VWn, VLD, 32 * is, 16 * vt, F.lane);
                      st[vt][0] = __builtin_amdgcn_mfma_f32_16x16x32_bf16(af, kb[0], st[vt][0], 0, 0, 0); st[vt][1] = __builtin_amdgcn_mfma_f32_16x16x32_bf16(af, kb[1], st[vt][1], 0, 0, 0); } } }
            __syncthreads();
#pragma unroll
            for (int vt = 0; vt < 5; ++vt)
#pragma unroll
                for (int x = 0; x < 2; ++x)
#pragma unroll
                    for (int jj = 0; jj < 4; ++jj) Cb[(16 * vt + 4 * fq + jj) * QLD + 16 * (2 * F.wave + x) + fr] = (bf16)f2bf(st[vt][x][jj]);
        }
#undef ML_LOAD
    }
    __syncthreads();
}
__device__ __forceinline__ void ph_gla_prep(Frame& F) {
    LAS float* sCode = (LAS float*)(F.lds);
    LAS float* sGT = sCode + 1024;
    const bf16* P = (const bf16*)(F.ws + WS_P);
    bf16* GQD = (bf16*)(F.ws + WS_GQ); bf16* GKI = GQD + (size_t)2 * M_ALL * 512; bf16* GKD = GKI + (size_t)2 * M_ALL * 512; float* DEC = (float*)(F.ws + WS_GDEC);
    const int k = F.tid & 127, tg = F.tid >> 7;
    for (int u = F.bid; u < 2304; u += F.G) {
        const int c = u % 36, sq = u / 36; const int dir = sq & 1, h = (sq >> 1) & 3, b = sq >> 3;
        const int n0 = 64 * c; const int row0 = scan_row(b, dir, n0); const int sgn = dir ? -1 : 1;
        __syncthreads();
#pragma unroll
        for (int x = 0; x < 2; ++x) { const int i = F.tid + NTHR * x; sCode[i] = bf2f(P[(size_t)(row0 + sgn * (i >> 4)) * LD0 + C0_CODE + dir * 16 + (i & 15)]); }
        float w2c[16];
#pragma unroll
        for (int r = 0; r < 16; ++r) w2c[r] = F.in[I_GGW2][(size_t)(dir * 16 + r) * 512 + h * 128 + k];
        const float gbk = F.in[I_GGB][dir * 512 + h * 128 + k];
        const bf16* pq = P + (size_t)(row0 + sgn * 16 * tg) * LD0 + C0_GQ + h * 128 + k; const long pstep = (long)sgn * LD0;
        unsigned short qr[16], kr[16]; float bc[16];
#pragma unroll
        for (int x = 0; x < 16; ++x) { qr[x] = pq[x * pstep]; kr[x] = pq[x * pstep + 512]; }
        __syncthreads();
        float run = 0.f;
#pragma unroll
        for (int x = 0; x < 16; ++x) { float lg = gbk; const LAS float* cd = sCode + (16 * tg + x) * 16;
            f32x4 l4 = {0.f, 0.f, 0.f, 0.f};
#pragma unroll
            for (int r = 0; r < 16; r += 4) { const f32x4 cv = *(const LAS f32x4*)(cd + r); l4 += cv * (f32x4){w2c[r], w2c[r + 1], w2c[r + 2], w2c[r + 3]}; }
            lg += (l4[0] + l4[1]) + (l4[2] + l4[3]);
            run += logsigmoidf_(lg) * (1.f / 16.f); bc[x] = run; }
        sGT[tg * 128 + k] = run;
        __syncthreads();
        float off = 0.f, tot = 0.f;
#pragma unroll
        for (int g = 0; g < 4; ++g) { const float t = sGT[g * 128 + k]; tot += t; off += (g < tg) ? t : 0.f; }
        if (tg == 0) DEC[(size_t)u * 128 + k] = __expf(tot);
        const size_t o0 = ((size_t)dir * M_ALL + (row0 + sgn * 16 * tg)) * 512 + h * 128 + k; const long ostep = (long)sgn * 512;
#pragma unroll
        for (int x = 0; x < 16; ++x) { const float bb = bc[x] + off; const float qv = bf2f(qr[x]) * 0.08838834764831845f, kv = bf2f(kr[x]);
            GQD[o0 + x * ostep] = (bf16)f2bf(qv * __expf(bb)); GKI[o0 + x * ostep] = (bf16)f2bf(kv * __expf(-bb)); GKD[o0 + x * ostep] = (bf16)f2bf(kv * __expf(tot - bb)); }
    }
    __syncthreads();
}
__device__ __forceinline__ void ph_gla_scan2(Frame& F) {
    constexpr int KLD = 136, VLD = 72;
    LAS bf16* QD = (LAS bf16*)(F.lds); LAS bf16* KI = QD + 64 * KLD; LAS bf16* KD = KI + 64 * KLD; LAS bf16* Sb = KD + 64 * KLD; LAS bf16* Vn = Sb + 64 * KLD; LAS bf16* ATT = Vn + 64 * VLD;
    const bf16* P = (const bf16*)(F.ws + WS_P); float* OG = (float*)(F.ws + WS_OG);
    const bf16* GQD = (const bf16*)(F.ws + WS_GQ); const bf16* GKI = GQD + (size_t)2 * M_ALL * 512; const bf16* GKD = GKI + (size_t)2 * M_ALL * 512; const float* DEC = (const float*)(F.ws + WS_GDEC);
    const int fr = F.lane & 15, fq = F.lane >> 4;
    for (int u0 = F.bid; u0 < 256; u0 += F.G) {
        const int u = (F.G == 256) ? ((((u0 & 7) * 8 + (u0 >> 5)) << 2) | ((u0 >> 3) & 3)) : u0;
        const int vsl = u & 3, dir = (u >> 2) & 1, h = (u >> 3) & 3, b = u >> 5; const int sq = (b * 4 + h) * 2 + dir; const int sgn = dir ? -1 : 1;
        __syncthreads();
        for (int i = F.tid; i < 64 * KLD / 8; i += NTHR) *(LAS v4u*)(Sb + i * 8) = (v4u){0u, 0u, 0u, 0u};
        f32x4 st[4];
#pragma unroll
        for (int vt = 0; vt < 4; ++vt) st[vt] = (f32x4){0.f, 0.f, 0.f, 0.f};
        v4u rq[2], rk[2], rd[2], rv; float dkn;
#define GLA_LOAD(cc) do { const int row0_ = scan_row(b, dir, 64 * (cc)); \
            _Pragma("unroll") for (int x = 0; x < 2; ++x) { const int p = F.tid + NTHR * x; const size_t o = ((size_t)dir * M_ALL + (row0_ + sgn * (p >> 4))) * 512 + h * 128 + (p & 15) * 8; \
                rq[x] = *(const GAS v4u*)(GQD + o); rk[x] = *(const GAS v4u*)(GKI + o); rd[x] = *(const GAS v4u*)(GKD + o); } \
            rv = *(const GAS v4u*)(P + (size_t)(row0_ + sgn * (F.tid >> 3)) * LD0 + C0_GV + h * 256 + vsl * 64 + (F.tid & 7) * 8); \
            dkn = DEC[((size_t)sq * 36 + (cc)) * 128 + 16 * F.wave + fr]; } while (0)
#define GLA_PUT_QK() do { _Pragma("unroll") for (int x = 0; x < 2; ++x) { const int p = F.tid + NTHR * x; *(LAS v4u*)(QD + (p >> 4) * KLD + (p & 15) * 8) = rq[x]; *(LAS v4u*)(KI + (p >> 4) * KLD + (p & 15) * 8) = rk[x]; } } while (0)
        GLA_LOAD(0);
        GLA_PUT_QK();
#pragma unroll 1
        for (int c = 0; c < 36; ++c) {
            __syncthreads();
#pragma unroll
            for (int x = 0; x < 2; ++x) { const int p = F.tid + NTHR * x; *(LAS v4u*)(KD + (p >> 4) * KLD + (p & 15) * 8) = rd[x]; }
            *(LAS v4u*)(Vn + (F.tid >> 3) * VLD + (F.tid & 7) * 8) = rv;
            const float dk = dkn;
            if (c + 1 < 36) GLA_LOAD(c + 1);
            { const int it_ = F.wave >> 1;
#pragma unroll
              for (int x = 0; x < 2; ++x) { const int jt = 2 * (F.wave & 1) + x; f32x4 a = {0.f, 0.f, 0.f, 0.f};
                  if (jt <= it_) {
#pragma unroll
                      for (int ks = 0; ks < 4; ++ks) { const bf16x8 af = *(const LAS bf16x8*)(QD + (16 * it_ + fr) * KLD + 32 * ks + 8 * fq); const bf16x8 bf = *(const LAS bf16x8*)(KI + (16 * jt + fr) * KLD + 32 * ks + 8 * fq);
                          a = __builtin_amdgcn_mfma_f32_16x16x32_bf16(af, bf, a, 0, 0, 0); } }
                  const int j = 16 * jt + fr;
#pragma unroll
                  for (int jj = 0; jj < 4; ++jj) { const int i = 16 * it_ + 4 * fq + jj; ATT[i * VLD + j] = (bf16)f2bf((j <= i) ? a[jj] : 0.f); } } }
            const int ot = F.wave & 3, vt0 = 2 * (F.wave >> 2);
            f32x4 oa[2] = {(f32x4){0.f, 0.f, 0.f, 0.f}, (f32x4){0.f, 0.f, 0.f, 0.f}};
#pragma unroll
            for (int ks = 0; ks < 4; ++ks) { const bf16x8 af = *(const LAS bf16x8*)(QD + (16 * ot + fr) * KLD + 32 * ks + 8 * fq);
#pragma unroll
                for (int x = 0; x < 2; ++x) { const bf16x8 bf = *(const LAS bf16x8*)(Sb + (16 * (vt0 + x) + fr) * KLD + 32 * ks + 8 * fq); oa[x] = __builtin_amdgcn_mfma_f32_16x16x32_bf16(af, bf, oa[x], 0, 0, 0); } }
            __syncthreads();
#pragma unroll
            for (int js = 0; js < 2; ++js) { const bf16x8 af = *(const LAS bf16x8*)(ATT + (16 * ot + fr) * VLD + 32 * js + 8 * fq);
#pragma unroll
                for (int x = 0; x < 2; ++x) { const bf16x8 bf = tr_frag(Vn, VLD, 32 * js, 16 * (vt0 + x), F.lane); oa[x] = __builtin_amdgcn_mfma_f32_16x16x32_bf16(af, bf, oa[x], 0, 0, 0); } }
            { const int row0 = scan_row(b, dir, 64 * c);
#pragma unroll
              for (int jj = 0; jj < 4; ++jj) { const int i = 16 * ot + 4 * fq + jj; const int row = row0 + sgn * i;
                  bf16* op = (bf16*)OG + ((size_t)dir * M_ALL + row) * 1024 + h * 256 + vsl * 64 + fr; op[16 * vt0] = (bf16)f2bf(oa[0][jj]); op[16 * vt0 + 16] = (bf16)f2bf(oa[1][jj]); } }
            {
#pragma unroll
              for (int vt = 0; vt < 4; ++vt) st[vt] *= dk;
#pragma unroll
              for (int js = 0; js < 2; ++js) { const bf16x8 kb = tr_frag(KD, KLD, 32 * js, 16 * F.wave, F.lane);
#pragma unroll
                  for (int vt = 0; vt < 4; ++vt) { const bf16x8 af = tr_frag(Vn, VLD, 32 * js, 16 * vt, F.lane); st[vt] = __builtin_amdgcn_mfma_f32_16x16x32_bf16(af, kb, st[vt], 0, 0, 0); } }
#pragma unroll
              for (int vt = 0; vt < 4; ++vt)
#pragma unroll
                  for (int jj = 0; jj < 4; ++jj) Sb[(16 * vt + 4 * fq + jj) * KLD + 16 * F.wave + fr] = (bf16)f2bf(st[vt][jj]); }
            if (c + 1 < 36) GLA_PUT_QK();
        }
#undef GLA_LOAD
#undef GLA_PUT_QK
    }
    __syncthreads();
}
__device__ __forceinline__ float vmax3(float a, float b, float c) { float r; asm("v_max3_f32 %0, %1, %2, %3" : "=v"(r) : "v"(a), "v"(b), "v"(c)); return r; }
__device__ __forceinline__ void ph_da_attn2(Frame& F) {
    constexpr int TLD = 144, TILE = 64 * TLD;
    LAS bf16* buf = (LAS bf16*)(F.lds);
    const bf16* P = (const bf16*)(F.ws + WS_P); bf16* Y = (bf16*)(F.ws + WS_Y);
    const float lam_init = 0.35550906759096927f;
    float lam;
    { const float* lv = F.in[I_DLAM]; float s01 = 0.f, s23 = 0.f; for (int i = 0; i < 64; ++i) { s01 += lv[i] * lv[64 + i]; s23 += lv[128 + i] * lv[192 + i]; } lam = expf(s01) - expf(s23) + lam_init; }
    const int fr = F.lane & 15, fq = F.lane >> 4, tq = (F.lane & 15) >> 2, tp = F.lane & 3;
    const int nround = (F.G == 256) ? 4 : (1024 + F.G - 1) / F.G;
    for (int rnd = 0; rnd < nround; ++rnd) {
        int u;
        if (F.G == 256) { const int xcd = F.bid & 7, slot = F.bid >> 3; const int pair = xcd + 8 * (2 * rnd + (slot >> 4)); u = pair * 16 + (slot & 15); }
        else { u = F.bid + rnd * F.G; if (u >= 1024) break; }
        const int qb = u & 15, h = (u >> 4) & 7, b = u >> 7;
        const int qrow = b * 2048 + qb * 128 + F.wave * 16 + fr;
        bf16x8 qf[2][2];
#pragma unroll
        for (int c = 0; c < 2; ++c)
#pragma unroll
            for (int ks = 0; ks < 2; ++ks) qf[c][ks] = *(const GAS bf16x8*)(P + (size_t)qrow * LD1 + C1_DQ + h * 128 + c * 64 + ks * 32 + 8 * fq);
        f32x4 Oa[2][8], Ol[2]; float mst[2] = {0.f, 0.f};
#pragma unroll
        for (int c = 0; c < 2; ++c)
#pragma unroll
            for (int vt = 0; vt < 8; ++vt) Oa[c][vt] = (f32x4){0.f, 0.f, 0.f, 0.f};
        Ol[0] = (f32x4){0.f, 0.f, 0.f, 0.f}; Ol[1] = (f32x4){0.f, 0.f, 0.f, 0.f};
        const bf16x8 ones = (bf16x8){0x3F80, 0x3F80, 0x3F80, 0x3F80, 0x3F80, 0x3F80, 0x3F80, 0x3F80};
        v4u kn[2], vn[2];
        const int skey = F.tid >> 4, sch = F.tid & 15;
#define DA_TB(t) ((const char*)P + (size_t)(((t) < 4) ? (M_LAT + b * 256 + 64 * (t)) : (b * 2048 + 64 * ((t) - 4))) * (LD1 * 2))
        const unsigned vo0 = (unsigned)(skey * LD1 + C1_DK + h * 128 + sch * 8) * 2u, vo1 = vo0 + 32u * LD1 * 2u;
#define DA_LD(t) do { const char* tb_ = DA_TB(t); kn[0] = *(const GAS v4u*)(tb_ + vo0); vn[0] = *(const GAS v4u*)(tb_ + vo0 + (C1_DV - C1_DK) * 2); kn[1] = *(const GAS v4u*)(tb_ + vo1); vn[1] = *(const GAS v4u*)(tb_ + vo1 + (C1_DV - C1_DK) * 2); } while (0)
        DA_LD(0);
        __syncthreads();
#pragma unroll
        for (int i = 0; i < 2; ++i) { *(LAS v4u*)(buf + (skey + 32 * i) * TLD + sch * 8) = kn[i]; *(LAS v4u*)(buf + TILE + (skey + 32 * i) * TLD + sch * 8) = vn[i]; }
        DA_LD(1);
        __syncthreads();
#pragma unroll 1
        for (int kt = 0; kt < 36; ++kt) {
            const LAS bf16* Kc = buf + (kt & 1) * 2 * TILE; const LAS bf16* Vc = Kc + TILE;
            if (kt + 1 < 36) {
                LAS bf16* Kn_ = buf + ((kt + 1) & 1) * 2 * TILE;
#pragma unroll
                for (int i = 0; i < 2; ++i) { *(LAS v4u*)(Kn_ + (skey + 32 * i) * TLD + sch * 8) = kn[i]; *(LAS v4u*)(Kn_ + TILE + (skey + 32 * i) * TLD + sch * 8) = vn[i]; }
                if (kt + 2 < 36) DA_LD(kt + 2); }
            bf16x8 pf[2][2];
            f32x4 S[2][4];
#pragma unroll
            for (int c = 0; c < 2; ++c)
#pragma unroll
                for (int nt = 0; nt < 4; ++nt) { const float nm = -mst[c]; f32x4 a = {nm, nm, nm, nm};
#pragma unroll
                    for (int ks = 0; ks < 2; ++ks) { const bf16x8 kf = *(const LAS bf16x8*)(Kc + (nt * 16 + fr) * TLD + c * 64 + ks * 32 + 8 * fq); a = __builtin_amdgcn_mfma_f32_16x16x32_bf16(kf, qf[c][ks], a, 0, 0, 0); }
                    S[c][nt] = a; }
            float mx[2];
            asm volatile("s_nop 7\n\ts_nop 3\n\t"
                         "v_max3_f32 %0, %2, %3, %4\n\tv_max3_f32 %1, %18, %19, %20\n\t"
                         "v_max3_f32 %0, %0, %5, %6\n\tv_max3_f32 %1, %1, %21, %22\n\t"
                         "v_max3_f32 %0, %0, %7, %8\n\tv_max3_f32 %1, %1, %23, %24\n\t"
                         "v_max3_f32 %0, %0, %9, %10\n\tv_max3_f32 %1, %1, %25, %26\n\t"
                         "v_max3_f32 %0, %0, %11, %12\n\tv_max3_f32 %1, %1, %27, %28\n\t"
                         "v_max3_f32 %0, %0, %13, %14\n\tv_max3_f32 %1, %1, %29, %30\n\t"
                         "v_max3_f32 %0, %0, %15, %16\n\tv_max3_f32 %1, %1, %31, %32\n\t"
                         "v_max_f32 %0, %0, %17\n\tv_max_f32 %1, %1, %33"
                         : "=&v"(mx[0]), "=&v"(mx[1])
                         : "v"(S[0][0][0]), "v"(S[0][0][1]), "v"(S[0][0][2]), "v"(S[0][0][3]), "v"(S[0][1][0]), "v"(S[0][1][1]), "v"(S[0][1][2]), "v"(S[0][1][3]),
                           "v"(S[0][2][0]), "v"(S[0][2][1]), "v"(S[0][2][2]), "v"(S[0][2][3]), "v"(S[0][3][0]), "v"(S[0][3][1]), "v"(S[0][3][2]), "v"(S[0][3][3]),
                           "v"(S[1][0][0]), "v"(S[1][0][1]), "v"(S[1][0][2]), "v"(S[1][0][3]), "v"(S[1][1][0]), "v"(S[1][1][1]), "v"(S[1][1][2]), "v"(S[1][1][3]),
                           "v"(S[1][2][0]), "v"(S[1][2][1]), "v"(S[1][2][2]), "v"(S[1][2][3]), "v"(S[1][3][0]), "v"(S[1][3][1]), "v"(S[1][3][2]), "v"(S[1][3][3]));
            { float a0 = mx[0], b0 = mx[0], a1 = mx[1], b1 = mx[1];
              asm volatile("s_nop 1\n\tv_permlane16_swap_b32 %0, %1\n\tv_permlane16_swap_b32 %2, %3\n\ts_nop 1\n\tv_max_f32 %0, %0, %1\n\tv_max_f32 %2, %2, %3\n\tv_mov_b32 %1, %0\n\tv_mov_b32 %3, %2\n\ts_nop 1\n\t"
                           "v_permlane32_swap_b32 %0, %1\n\tv_permlane32_swap_b32 %2, %3\n\ts_nop 1\n\tv_max_f32 %0, %0, %1\n\tv_max_f32 %2, %2, %3"
                           : "+v"(a0), "+v"(b0), "+v"(a1), "+v"(b1));
              mx[0] = a0; mx[1] = a1; }
            const bool up0 = (kt == 0) || (mx[0] > 8.f), up1 = (kt == 0) || (mx[1] > 8.f);
            if (__any(up0 || up1)) {
#pragma unroll
                for (int c = 0; c < 2; ++c) { const float d = (c ? up1 : up0) ? mx[c] : 0.f; const float al = __builtin_amdgcn_exp2f(-d); mst[c] += d; Ol[c] *= al;
#pragma unroll
                    for (int vt = 0; vt < 8; ++vt) Oa[c][vt] *= al;
#pragma unroll
                    for (int nt = 0; nt < 4; ++nt) S[c][nt] -= d; } }
#pragma unroll
            for (int c = 0; c < 2; ++c) {
#pragma unroll
                for (int nt = 0; nt < 4; ++nt)
#pragma unroll
                    for (int j = 0; j < 4; ++j) S[c][nt][j] = __builtin_amdgcn_exp2f(S[c][nt][j]);
#pragma unroll
                for (int kp = 0; kp < 2; ++kp) { v4u w; w.x = pk2(S[c][2 * kp][0], S[c][2 * kp][1]); w.y = pk2(S[c][2 * kp][2], S[c][2 * kp][3]); w.z = pk2(S[c][2 * kp + 1][0], S[c][2 * kp + 1][1]); w.w = pk2(S[c][2 * kp + 1][2], S[c][2 * kp + 1][3]);
                    pf[c][kp] = __builtin_bit_cast(bf16x8, w); } }
#pragma unroll
            for (int kp = 0; kp < 2; ++kp) { Ol[0] = __builtin_amdgcn_mfma_f32_16x16x32_bf16(ones, pf[0][kp], Ol[0], 0, 0, 0); Ol[1] = __builtin_amdgcn_mfma_f32_16x16x32_bf16(ones, pf[1][kp], Ol[1], 0, 0, 0); }
#pragma unroll
            for (int kp = 0; kp < 2; ++kp)
#pragma unroll
                for (int vt = 0; vt < 8; ++vt) { const LAS bf16* a0 = Vc + (32 * kp + 4 * fq + tq) * TLD + 16 * vt + 4 * tp;
                    const s16x4 lo = __builtin_amdgcn_ds_read_tr16_b64_v4i16((LAS s16x4*)a0); const s16x4 hi = __builtin_amdgcn_ds_read_tr16_b64_v4i16((LAS s16x4*)(a0 + 16 * TLD));
                    const bf16x8 vf = (bf16x8){lo[0], lo[1], lo[2], lo[3], hi[0], hi[1], hi[2], hi[3]};
                    Oa[0][vt] = __builtin_amdgcn_mfma_f32_16x16x32_bf16(vf, pf[0][kp], Oa[0][vt], 0, 0, 0); Oa[1][vt] = __builtin_amdgcn_mfma_f32_16x16x32_bf16(vf, pf[1][kp], Oa[1][vt], 0, 0, 0); }
            __syncthreads();
        }
#undef DA_TB
#undef DA_LD
        { const float i0 = 1.f / Ol[0][0], i1 = lam / Ol[1][0]; float ss = 0.f;
#pragma unroll
          for (int vt = 0; vt < 8; ++vt) { Oa[0][vt] = Oa[0][vt] * i0 - Oa[1][vt] * i1; ss += (Oa[0][vt][0] * Oa[0][vt][0] + Oa[0][vt][1] * Oa[0][vt][1]) + (Oa[0][vt][2] * Oa[0][vt][2] + Oa[0][vt][3] * Oa[0][vt][3]); }
          ss = xrow_sum(ss);
          const float rsn = (1.f - lam_init) / sqrtf(ss * (1.f / 128.f) + EPS);
#pragma unroll
          for (int vt = 0; vt < 8; ++vt) { const f32x4 g = *(const GAS f32x4*)(F.in[I_DNG] + 16 * vt + 4 * fq); const f32x4 o = Oa[0][vt] * rsn * g;
              v2u w; w.x = pk2(o[0], o[1]); w.y = pk2(o[2], o[3]);
              *(GAS v2u*)(Y + (size_t)qrow * D + 1024 + h * 128 + 16 * vt + 4 * fq) = w; } }
    }
    __syncthreads();
}
struct Args { const float* in[35]; float* out; unsigned char* ws; int ph_lo, ph_hi; };
__device__ __forceinline__ bool frame_refresh(Frame& F) { int tz = threadIdx.x; asm volatile("" : "+v"(tz)); F.tid = tz; F.lane = tz & 63; F.wave = __builtin_amdgcn_readfirstlane(tz >> 6);
    const __attribute__((address_space(4))) char* kp = (const __attribute__((address_space(4))) char*)__builtin_amdgcn_kernarg_segment_ptr(); asm volatile("" : "+s"(kp));
    const __attribute__((address_space(4))) Args* ap = (const __attribute__((address_space(4))) Args*)kp;
#pragma unroll
    for (int i = 0; i < 35; ++i) F.in[i] = ap->in[i];
    F.out = ap->out; F.ws = ap->ws; F.ctl = (gu32*)(ap->ws + WS_CTL); return true; }
constexpr int NPHASE = 24;
__global__ void __launch_bounds__(NTHR, 2) skel_fwd(Args args) {
    extern __shared__ __attribute__((aligned(16))) unsigned char lds[];
    Frame F;
    F.lds = (LAS unsigned char*)lds;
    F.MISC = (volatile LAS unsigned*)(F.lds + MISC_OFF);
    F.tid = threadIdx.x; F.lane = F.tid & 63; F.wave = __builtin_amdgcn_readfirstlane(F.tid >> 6);
    F.G = gridDim.x; F.bid = blockIdx.x;
    F.ws = args.ws; F.out = args.out; F.ctl = (gu32*)(args.ws + WS_CTL);
    for (int u = F.tid; u < (LDS_BYTES - LDSCTL_OFF) / 4; u += NTHR) ((LAS unsigned*)(F.lds + LDSCTL_OFF))[u] = 0u;
    __syncthreads();
    const int lo = args.ph_lo, hi = args.ph_hi;
    XcdBarrier bar; bar.bar = (unsigned*)(F.ctl + CW_BAR); bar.x = 0; bar.st = nullptr;
    if (hi - lo > 1) bar = xcd_barrier_post((unsigned*)(F.ctl + CW_BAR), F.MISC + 8);
#define IN(k) (lo <= (k) && (k) < hi && frame_refresh(F))
#define SEAM(k) do { if (lo <= (k) && (k) + 1 < hi) xcd_barrier(bar); } while (0)
#define MOD ((const float*)(F.ws + WS_MOD))
#define Abuf ((bf16*)(F.ws + WS_A))
#define Pbuf ((bf16*)(F.ws + WS_P))
#define Ybuf ((bf16*)(F.ws + WS_Y))
#define Hbuf ((float*)(F.ws + WS_H))
#define XS ((bf16*)(F.ws + WS_XS))
#define HID ((bf16*)(F.ws + WS_HID))
#define YS ((bf16*)(F.ws + WS_YS))
    if (IN(0)) { p0_adaln(F); __syncthreads(); p0_filters(F); __syncthreads(); p0_convert(F); } SEAM(0);
    if (IN(1)) { ph_norm1_l0(F); ph_hy_ftt(F); } SEAM(1);
    if (IN(2)) { pg8::Gemm g{Abuf, (const bf16*)(F.ws + WS_WIN0), M_ALL, 6144, D}; pg8::StaticOrder S; S.init(M_ALL, 6144, F.G, F.bid);
        pg8::EpiStore E{Pbuf, LD0, 24, 1.f};
        pg8::gemm_phase<pg8::EpiStore, pg8::StaticOrder, PG8_ALIGN, PG8_SP2>(F.lds + RING_OFF, g, S, E); ph_codes_skinny(F); cvt_late(F, CVT_L0_END - CVT_LATE0, 192, 10); } SEAM(2);
    if (IN(3)) { ph_gla_prep(F); ph_hy_shortconv(F); ph_hy_prep_lat(F); } SEAM(3);
    if (IN(4)) { ph_gla_scan2(F); ph_hy_conv_lat(F); ph_hy_longconv(F, 0); } SEAM(4);
    if (IN(5)) { ph_hy_longconv(F, 1); ph_hy_post_lat(F); const bf16* OG = (const bf16*)(F.ws + WS_OG);
        ph_mix_combine<0>(F, M_ALL, OG, OG + (size_t)M_ALL * 1024, Pbuf, LD0, C0_GR, F.in[I_GNG], 1024); } SEAM(5);
    if (IN(6)) { pg8::Gemm g{Ybuf, (const bf16*)(F.ws + WS_WOUT), M_ALL, D, D}; pg8::StaticOrder S; S.init(M_ALL, D, F.G, F.bid);
        pg8::EpiRes E{F.in[I_X], F.in[I_CTX], Hbuf, MOD + 2 * 2048};
        pg8::gemm_phase<pg8::EpiRes, pg8::StaticOrder, PG8_ALIGN, PG8_SP2>(F.lds + RING_OFF, g, S, E);  cvt_late(F, CVT_L0_END - CVT_LATE0 + 64 * 10, 64, 14); } SEAM(6);
    if (IN(7)) { ph_norm2_router2(F, 0, M_ALL); } SEAM(7);
    if (IN(8)) { ph_topk(F, 256, ME0); } SEAM(8);
    if (IN(10)) { pg8::Gemm g{XS, (const bf16*)(F.ws + WS_W13), 16 * ME0, 4096, D}; pg8::GroupedOrder S; S.init(ME0 / 256, 16, F.G, F.bid);
        pg8::EpiSwiglu E{(unsigned char*)HID};
        pg8::gemm_phase<pg8::EpiSwiglu, pg8::GroupedOrder, PG8_ALIGN, PG8_SP2, true>(F.lds + RING_OFF, g, S, E); } SEAM(10);
    if (IN(11)) { pg8::Gemm g{HID, (const bf16*)(F.ws + WS_W2), 16 * ME0, 2048, D}; pg8::GroupedOrder S; S.init(ME0 / 256, 8, F.G, F.bid);
        pg8::EpiStore E{YS, D, 8, 1.f / 64.f};
        pg8::gemm_phase<pg8::EpiStore, pg8::GroupedOrder, PG8_ALIGN, PG8_SP2, true>(F.lds + RING_OFF, g, S, E);  cvt_late(F, CVT_L1_END - CVT_LATE1, 128, 5); } SEAM(11);
    if (IN(12)) { ph_combine<0>(F, 0, M_ALL); } SEAM(12);
    if (IN(13)) { pg8::Gemm g{Abuf, (const bf16*)(F.ws + WS_WIN1), M_ALL, LD1, D}; pg8::In1Order S; S.init(F.G, F.bid);
        pg8::EpiStore E{Pbuf, LD1, LD1 / 256, 1.f};
        pg8::gemm_phase<pg8::EpiStore, pg8::In1Order, PG8_ALIGN, PG8_SP2>(F.lds + RING_OFF, g, S, E);  cvt_late(F, CVT_L1_END - CVT_LATE1 + 128 * 5, 200, 10); } SEAM(13);
    if (IN(14)) { ph_ml_prep(F); ph_da_rope(F); } SEAM(14);
    if (IN(15)) { ph_ml_scan2(F); ph_da_attn2(F); } SEAM(15);
    if (IN(16)) { const bf16* OM = (const bf16*)(F.ws + WS_OG);
        ph_mix_combine<1>(F, M_LAT, OM, OM + (size_t)M_LAT * 1024, Pbuf, LD1, C1_MO, F.in[I_MNG], 0); } SEAM(16);
    if (IN(17)) { pg8::Gemm g{Ybuf, (const bf16*)(F.ws + WS_WOUT) + (size_t)D * D, M_LAT, D, D}; pg8::StaticOrder S; S.init(M_LAT, D, F.G, F.bid);
        pg8::EpiRes E{Hbuf, Hbuf, Hbuf, MOD + 9 * 12288 + 2 * 2048};
        pg8::gemm_phase<pg8::EpiRes, pg8::StaticOrder, PG8_ALIGN, PG8_SP2>(F.lds + RING_OFF, g, S, E); } SEAM(17);
    if (IN(18)) { ph_norm2_router2(F, 1, M_LAT); } SEAM(18);
    if (IN(19)) { ph_topk(F, 128, ME1); } SEAM(19);
    if (IN(21)) { pg8::Gemm g{XS, (const bf16*)(F.ws + WS_W13) + (size_t)16 * 4096 * 1024, 16 * ME1, 4096, D}; pg8::GroupedOrder S; S.init(ME1 / 256, 16, F.G, F.bid);
        pg8::EpiSwiglu E{(unsigned char*)HID};
        pg8::gemm_phase<pg8::EpiSwiglu, pg8::GroupedOrder, PG8_ALIGN, PG8_SP2, true>(F.lds + RING_OFF, g, S, E); } SEAM(21);
    if (IN(22)) { pg8::Gemm g{HID, (const bf16*)(F.ws + WS_W2) + (size_t)16 * 2048 * 1024, 16 * ME1, 2048, D}; pg8::GroupedOrder S; S.init(ME1 / 256, 8, F.G, F.bid);
        pg8::EpiStore E{YS, D, 8, 1.f / 64.f};
        pg8::gemm_phase<pg8::EpiStore, pg8::GroupedOrder, PG8_ALIGN, PG8_SP2, true>(F.lds + RING_OFF, g, S, E); } SEAM(22);
    if (IN(23)) { ph_combine<1>(F, 1, M_LAT); }
#undef IN
#undef SEAM
#undef MOD
#undef Abuf
#undef Pbuf
#undef Ybuf
#undef Hbuf
#undef XS
#undef HID
#undef YS
}

extern "C" void kernel_launch(void* const* d_in, const int* in_sizes, int n_in, void* d_out, int out_size, void* d_ws, size_t ws_size, hipStream_t stream) {
    static int grid = 0;
    if (grid == 0) {
        if (n_in != 35 || ws_size < WS_END) { fprintf(stderr, "kernel_launch: unexpected n_in %d / ws_size %zu\n", n_in, ws_size); grid = -1; return; }
        int dev = 0, cus = 0, per_cu = 0;
        if (hipGetDevice(&dev) != hipSuccess || hipDeviceGetAttribute(&cus, hipDeviceAttributeMultiprocessorCount, dev) != hipSuccess) { grid = -1; return; }
        if (hipFuncSetAttribute((const void*)skel_fwd, hipFuncAttributeMaxDynamicSharedMemorySize, LDS_BYTES) != hipSuccess) { fprintf(stderr, "kernel_launch: hipFuncSetAttribute failed\n"); grid = -1; return; }
        if (hipOccupancyMaxActiveBlocksPerMultiprocessor(&per_cu, (const void*)skel_fwd, NTHR, LDS_BYTES) != hipSuccess || per_cu < 1) fprintf(stderr, "kernel_launch: occupancy query says %d\n", per_cu);
        (void)hipGetLastError();
        grid = cus;
    }
    if (grid < 0) return;
    if (hipMemsetAsync((char*)d_ws + WS_CTL, 0, CTL_ZERO_BYTES, stream) != hipSuccess) return;
    Args a{};
    for (int i = 0; i < 35; ++i) a.in[i] = (const float*)d_in[i];
    a.out = (float*)d_out; a.ws = (unsigned char*)d_ws;
#if MK_ONE_LAUNCH
    a.ph_lo = 0; a.ph_hi = NPHASE;
    hipLaunchKernelGGL(skel_fwd, dim3(grid), dim3(NTHR), LDS_BYTES, stream, a);
#else
    for (int k = 0; k < NPHASE; ++k) { a.ph_lo = k; a.ph_hi = k + 1; hipLaunchKernelGGL(skel_fwd, dim3(grid), dim3(NTHR), LDS_BYTES, stream, a); }
#endif
}
```

```cpp
#include <hip/hip_runtime.h>
#include <cstdio>
#include <cstdint>
namespace pg8 {
#define PG8_LAS __attribute__((address_space(3)))
typedef unsigned short bf16_t;
typedef short bf16x8 __attribute__((ext_vector_type(8)));
typedef float f32x4 __attribute__((ext_vector_type(4)));
typedef unsigned u32x4 __attribute__((ext_vector_type(4)));
constexpr int BM = 256, BK = 64, HALF = 128, HTB = HALF * BK * 2  , STAGE_BYTES = 8 * HTB, NXCD = 8, WGM = 8;

__host__ __device__ __forceinline__ int lds_byte(int r, int c) { const int st = (r >> 4) * 2 + (c >> 5), rr = r & 15, cc = c & 31, ob = rr * 64 + cc * 2; return st * 1024 + (ob ^ (((ob >> 9) & 1) << 5)); }
__host__ __device__ __forceinline__ void stage_rc(int b, int& R, int& C) { const int st = b / 1024, sb = b % 1024, swz = sb ^ (((sb >> 9) & 1) << 5); R = (st >> 1) * 16 + swz / 64; C = (st & 1) * 32 + (swz % 64) / 2; }
__host__ __device__ __forceinline__ int perm32(int rho) { const int n = rho >> 4, i = rho & 15; return 8 * (i >> 2) + 4 * n + (i & 3); }

struct Unit { int pm, pn; };
struct Gemm { const bf16_t* A; const bf16_t* Bt; int M, N, K; const int* arow = nullptr; };

struct StaticOrder {
    int nM, nN, nwg, G, c;
    __host__ __device__ void init(int M, int N, int G_, int c_) { nM = M / BM; nN = N / BM; nwg = nM * nN; G = G_; c = c_; }
    __host__ __device__ bool next(int i, Unit& u) const {
        const long L = (long)i * G + c; if (L >= nwg) return false;
        int wgid = (int)L; { const int q = nwg / NXCD, r = nwg % NXCD, xcd = wgid % NXCD, off = wgid / NXCD; wgid = (xcd < r ? xcd * (q + 1) : r * (q + 1) + (xcd - r) * q) + off; }
        const int nig = WGM * nN, gid = wgid / nig, fm = gid * WGM, gsz = (nM - fm) < WGM ? (nM - fm) : WGM;
        u.pm = fm + ((wgid % nig) % gsz); u.pn = (wgid % nig) / gsz; return true;
    }
    __device__ __forceinline__ void a_ready(const Unit&) const {}
    __device__ __forceinline__ void done(const Unit&) const {}
};

__device__ __forceinline__ unsigned cvt_pk_bf16(float lo, float hi) { unsigned r; asm volatile("v_cvt_pk_bf16_f32 %0, %1, %2" : "=v"(r) : "v"(lo), "v"(hi)); return r; }
typedef float f32x2 __attribute__((ext_vector_type(2)));
__device__ __forceinline__ f32x2 gelu_pk(f32x2 v) {
    const f32x2 av = __builtin_elementwise_abs(v), d = av * 0.2316418882f + 1.0f;
    f32x2 t; t.x = __builtin_amdgcn_rcpf(d.x); t.y = __builtin_amdgcn_rcpf(d.y);
    f32x2 q = t * 0.5307027145f + (-0.7265760135f); q = q * t + 0.7107068705f; q = q * t + (-0.142248368f); q = q * t + 0.127414796f; q = q * t;
    const f32x2 s = (v * v) * (-0.72134752044f);
    f32x2 e; e.x = __builtin_amdgcn_exp2f(s.x); e.y = __builtin_amdgcn_exp2f(s.y);
    const f32x2 m = v * (q * e), r = v - m;
    f32x2 o; o.x = v.x < 0.f ? m.x : r.x; o.y = v.y < 0.f ? m.y : r.y; return o;
}

typedef int v8i32 __attribute__((ext_vector_type(8)));
template <class Epi, class Sched, bool ALIGN_EPI = false, bool SP2 = false, bool FP8 = false, bool IDXA = false>
__device__ __forceinline__ void gemm_phase(PG8_LAS unsigned char* lds, const Gemm g, const Sched& S, const Epi& E) {
    int tid_ = threadIdx.x; asm volatile("" : "+v"(tid_));
    const int tid = tid_, wid = __builtin_amdgcn_readfirstlane(tid >> 6), lane = tid & 63, wr = wid >> 2, wc = wid & 3, fr = lane & 15, fq = lane >> 4;
    const int K = FP8 ? g.K / 2 : g.K, nt = K / BK;
    unsigned voffA[2], voffB[2]; int Rv[2], Cv[2];
#pragma unroll
    for (int i = 0; i < 2; ++i) { int R, C; stage_rc(tid * 16 + i * 8192, R, C); const int Rb = Epi::PERM ? ((R & ~31) + perm32(R & 31)) : R; Rv[i] = R; Cv[i] = C;
        voffA[i] = (unsigned)(R * K + C) * 2u; voffB[i] = (unsigned)(Rb * K + C) * 2u; }
    static_assert(!IDXA || SP2, "IDXA is written for the SP2 loop");
    unsigned vAc[2][2], vAn[2][2];
#define PG8_IDX(u_, vo) do { _Pragma("unroll") for (int h_ = 0; h_ < 2; ++h_) _Pragma("unroll") for (int i_ = 0; i_ < 2; ++i_) { const int row_ = g.arow[(u_).pm * BM + h_ * HALF + Rv[i_]]; vo[h_][i_] = (unsigned)(row_ * K + Cv[i_]) * 2u; } } while (0)
    const size_t kstep = (size_t)(BK * 2);
    const size_t hstep = (size_t)HALF * K * 2;
    const size_t tstep = 2 * hstep;
    const unsigned ldsw = (unsigned)wid * 1024u;
    const int aoff = lds_byte(wr * 64 + fr, fq * 8), boff = lds_byte(wc * 32 + fr, fq * 8);
#define PG8_SA(b, h) (((b) * 2 + (h)) * HTB)
#define PG8_SB(b, h) ((4 + (b) * 2 + (h)) * HTB)
#define PG8_STAGE(bufoff, gbase, voff) do { _Pragma("unroll") for (int _i = 0; _i < 2; ++_i) \
        __builtin_amdgcn_global_load_lds((const unsigned*)((const char*)(gbase) + (voff)[_i]), (PG8_LAS unsigned*)(lds + (bufoff) + ldsw + _i * 8192), 16, 0, 0); } while (0)
#define PG8_STAGE_A(bufoff, gbase, h, sel) do { if constexpr (IDXA) { _Pragma("unroll") for (int _i = 0; _i < 2; ++_i) { const unsigned vo_ = (sel) ? vAn[h][_i] : vAc[h][_i]; \
        __builtin_amdgcn_global_load_lds((const unsigned*)((const char*)(gbase) + vo_), (PG8_LAS unsigned*)(lds + (bufoff) + ldsw + _i * 8192), 16, 0, 0); } } \
        else PG8_STAGE(bufoff, (gbase) + (h) * hstep, voffA); } while (0)
#define PG8_LDA(dst, b, h) do { _Pragma("unroll") for (int m = 0; m < 4; ++m) _Pragma("unroll") for (int k = 0; k < 2; ++k) dst[m][k] = *(const PG8_LAS bf16x8*)(lds + PG8_SA(b, h) + aoff + m * 2048 + k * 1024); } while (0)
#define PG8_LDB(dst, b, h) do { _Pragma("unroll") for (int n = 0; n < 2; ++n) _Pragma("unroll") for (int k = 0; k < 2; ++k) dst[n][k] = *(const PG8_LAS bf16x8*)(lds + PG8_SB(b, h) + boff + n * 2048 + k * 1024); } while (0)
#define PG8_MMA(ai, bj, At, Bt) do { __builtin_amdgcn_s_setprio(1); _Pragma("unroll") for (int m = 0; m < 4; ++m) _Pragma("unroll") for (int n = 0; n < 2; ++n) { \
        if constexpr (FP8) { typedef int i32x4_ __attribute__((ext_vector_type(4))); \
            const v8i32 _bv = __builtin_shufflevector(__builtin_bit_cast(i32x4_, Bt[n][0]), __builtin_bit_cast(i32x4_, Bt[n][1]), 0, 1, 2, 3, 4, 5, 6, 7); \
            const v8i32 _av = __builtin_shufflevector(__builtin_bit_cast(i32x4_, At[m][0]), __builtin_bit_cast(i32x4_, At[m][1]), 0, 1, 2, 3, 4, 5, 6, 7); \
            asm volatile("s_nop 1\n\tv_mfma_scale_f32_16x16x128_f8f6f4 %0, %1, %2, %0, %3, %3 op_sel_hi:[0,0,0]" : "+v"(acc[ai][bj][m][n]) : "v"(_bv), "v"(_av), "v"(0x7f7f7f7f)); } \
        else { _Pragma("unroll") for (int k = 0; k < 2; ++k) acc[ai][bj][m][n] = __builtin_amdgcn_mfma_f32_16x16x32_bf16(Bt[n][k], At[m][k], acc[ai][bj][m][n], 0, 0, 0); } } \
        __builtin_amdgcn_s_setprio(0); } while (0)
#define PG8_WAIT_V(n) asm volatile("s_waitcnt vmcnt(" #n ")" ::: "memory")
#define PG8_WAIT_L(n) asm volatile("s_waitcnt lgkmcnt(" #n ")" ::: "memory")
#define PG8_BAR __builtin_amdgcn_s_barrier()
#define PG8_SCHED __builtin_amdgcn_sched_barrier(0)
    Unit cur, nxt; int ui = 0;
    if (!S.next(0, cur)) return;
    f32x4 acc[2][2][4][2];
#pragma unroll
    for (int a = 0; a < 2; ++a)
#pragma unroll
        for (int b = 0; b < 2; ++b)
#pragma unroll
            for (int m = 0; m < 4; ++m)
#pragma unroll
                for (int n = 0; n < 2; ++n) acc[a][b][m][n] = (f32x4){0.f, 0.f, 0.f, 0.f};
    bf16x8 At[4][2], B0[2][2], B1[2][2];
    const char* cA = (const char*)g.A + (IDXA ? (size_t)0 : (size_t)cur.pm * tstep); const char* cB = (const char*)g.Bt + (size_t)cur.pn * tstep;
    if constexpr (IDXA) PG8_IDX(cur, vAc);
    S.a_ready(cur);
    if constexpr (SP2) {
        PG8_STAGE(PG8_SB(0, 0), cB, voffB); PG8_STAGE(PG8_SB(0, 1), cB + hstep, voffB); PG8_STAGE_A(PG8_SA(0, 0), cA, 0, false); PG8_STAGE_A(PG8_SA(0, 1), cA, 1, false);
        if (wr == 1) PG8_BAR;
        PG8_WAIT_V(2); PG8_BAR;
        PG8_STAGE(PG8_SB(1, 0), cB + kstep, voffB); PG8_STAGE_A(PG8_SA(1, 0), cA + kstep, 0, false); PG8_STAGE(PG8_SB(1, 1), cB + hstep + kstep, voffB);
        PG8_WAIT_V(6); PG8_BAR;
    } else {
        PG8_STAGE(PG8_SB(0, 0), cB, voffB); PG8_STAGE(PG8_SA(0, 0), cA, voffA); PG8_STAGE(PG8_SB(0, 1), cB + hstep, voffB); PG8_STAGE(PG8_SA(0, 1), cA + hstep, voffA);
        if (wr == 1) PG8_BAR;
        PG8_WAIT_V(4); PG8_BAR;
        PG8_STAGE(PG8_SB(1, 0), cB + kstep, voffB); PG8_STAGE(PG8_SA(1, 0), cA + kstep, voffA); PG8_STAGE(PG8_SB(1, 1), cB + hstep + kstep, voffB);
        PG8_WAIT_V(6); PG8_BAR;
    }
    for (;;) {
        const bool has_next = S.next(ui + 1, nxt);
        if constexpr (IDXA) { if (has_next) PG8_IDX(nxt, vAn); }
        const char* nA = (has_next && !IDXA) ? (const char*)g.A + (size_t)nxt.pm * tstep : cA; const char* nB = has_next ? (const char*)g.Bt + (size_t)nxt.pn * tstep : cB;
        for (int t = 0; t < nt; t += 2) {
            const bool last = (t == nt - 2);
            const char* a1 = cA + (size_t)(t + 1) * kstep;
            const char* a2 = last ? nA : cA + (size_t)(t + 2) * kstep; const char* b2 = last ? nB : cB + (size_t)(t + 2) * kstep;
            const char* a3 = a2 + kstep; const char* b3 = b2 + kstep;
            const bool nsel = last && has_next;
            if (last && has_next) S.a_ready(nxt);
            if constexpr (SP2) {
            PG8_LDB(B0, 0, 0); PG8_LDB(B1, 0, 1); PG8_SCHED; PG8_LDA(At, 0, 0); PG8_STAGE_A(PG8_SA(1, 1), a1, 1, false);
            PG8_WAIT_V(8); PG8_WAIT_L(0); PG8_BAR; PG8_MMA(0, 0, At, B0); PG8_MMA(0, 1, At, B1); PG8_BAR; PG8_SCHED;
            PG8_LDA(At, 0, 1); PG8_STAGE(PG8_SB(0, 0), b2, voffB); PG8_STAGE(PG8_SB(0, 1), b2 + hstep, voffB); PG8_STAGE_A(PG8_SA(0, 0), a2, 0, nsel);
            PG8_WAIT_V(8); PG8_WAIT_L(0); PG8_BAR; PG8_MMA(1, 0, At, B0); PG8_MMA(1, 1, At, B1); PG8_BAR; PG8_SCHED;
            PG8_LDB(B0, 1, 0); PG8_LDB(B1, 1, 1); PG8_SCHED; PG8_LDA(At, 1, 0); PG8_STAGE_A(PG8_SA(0, 1), a2, 1, nsel);
            PG8_WAIT_V(8); PG8_WAIT_L(0); PG8_BAR; PG8_MMA(0, 0, At, B0); PG8_MMA(0, 1, At, B1); PG8_BAR; PG8_SCHED;
            PG8_LDA(At, 1, 1); PG8_STAGE(PG8_SB(1, 0), b3, voffB); PG8_STAGE(PG8_SB(1, 1), b3 + hstep, voffB); PG8_STAGE_A(PG8_SA(1, 0), a3, 0, nsel);
            PG8_WAIT_V(8); PG8_WAIT_L(0); PG8_BAR; PG8_MMA(1, 0, At, B0); PG8_MMA(1, 1, At, B1); PG8_BAR; PG8_SCHED;
            } else {
            PG8_LDB(B0, 0, 0); PG8_SCHED; PG8_LDA(At, 0, 0); PG8_STAGE(PG8_SA(1, 1), a1 + hstep, voffA);
            PG8_WAIT_L(8); PG8_BAR; PG8_WAIT_L(0); PG8_MMA(0, 0, At, B0); PG8_BAR; PG8_SCHED;
            PG8_LDB(B1, 0, 1); PG8_STAGE(PG8_SB(0, 0), b2, voffB);
            PG8_BAR; PG8_WAIT_L(0); PG8_MMA(0, 1, At, B1); PG8_BAR;
            PG8_LDA(At, 0, 1); PG8_STAGE(PG8_SA(0, 0), a2, voffA);
            PG8_BAR; PG8_WAIT_L(0); PG8_MMA(1, 0, At, B0); PG8_BAR; PG8_SCHED;
            PG8_STAGE(PG8_SB(0, 1), b2 + hstep, voffB);
            PG8_WAIT_V(6); PG8_BAR; PG8_MMA(1, 1, At, B1); PG8_BAR;
            PG8_LDB(B0, 1, 0); PG8_SCHED; PG8_LDA(At, 1, 0); PG8_STAGE(PG8_SA(0, 1), a2 + hstep, voffA);
            PG8_WAIT_L(8); PG8_BAR; PG8_WAIT_L(0); PG8_MMA(0, 0, At, B0); PG8_BAR; PG8_SCHED;
            PG8_LDB(B1, 1, 1); PG8_STAGE(PG8_SB(1, 0), b3, voffB);
            PG8_BAR; PG8_WAIT_L(0); PG8_MMA(0, 1, At, B1); PG8_BAR;
            PG8_LDA(At, 1, 1); PG8_STAGE(PG8_SA(1, 0), a3, voffA);
            PG8_BAR; PG8_WAIT_L(0); PG8_MMA(1, 0, At, B0); PG8_BAR; PG8_SCHED;
            PG8_STAGE(PG8_SB(1, 1), b3 + hstep, voffB);
            PG8_WAIT_V(6); PG8_BAR; PG8_MMA(1, 1, At, B1); PG8_BAR;
            }
        }
        if constexpr (FP8) asm volatile("s_nop 15" ::: "memory");
        if constexpr (ALIGN_EPI) { if (wr == 0) PG8_BAR; }
        if constexpr (!Epi::AFTER_DRAIN) { E(acc, cur, wr, wc, fr, fq); S.done(cur); }
        if (!has_next) break;
#pragma unroll
        for (int a = 0; a < 2; ++a)
#pragma unroll
            for (int b = 0; b < 2; ++b)
#pragma unroll
                for (int m = 0; m < 4; ++m)
#pragma unroll
                    for (int n = 0; n < 2; ++n) acc[a][b][m][n] = (f32x4){0.f, 0.f, 0.f, 0.f};
        cur = nxt; cA = nA; cB = nB; ++ui;
        if constexpr (IDXA) { vAc[0][0] = vAn[0][0]; vAc[0][1] = vAn[0][1]; vAc[1][0] = vAn[1][0]; vAc[1][1] = vAn[1][1]; }
        if constexpr (ALIGN_EPI) { if (wr == 1) PG8_BAR; }
    }
    PG8_WAIT_V(0);
    if constexpr (!ALIGN_EPI) { if (wr == 0) PG8_BAR; }
    PG8_BAR;
    if constexpr (Epi::AFTER_DRAIN) { E.fused(acc, cur, wr, wc, fr, fq, lds, wid, lane); S.done(cur); }
#undef PG8_SA
#undef PG8_SB
#undef PG8_STAGE
#undef PG8_STAGE_A
#undef PG8_IDX
#undef PG8_LDA
#undef PG8_LDB
#undef PG8_MMA
#undef PG8_WAIT_V
#undef PG8_WAIT_L
#undef PG8_BAR
#undef PG8_SCHED
}
}
namespace pg8 {
struct GroupedOrder {
    int nMe, nNe, per, nwg, G, c;
    __host__ __device__ void init(int nMe_, int nNe_, int G_, int c_) { nMe = nMe_; nNe = nNe_; per = nMe * nNe; nwg = 16 * per; G = G_; c = c_; }
    __host__ __device__ bool next(int i, Unit& u) const {
        const long L = (long)i * G + c; if (L >= nwg) return false;
        int wgid = (int)L; { const int q = nwg / NXCD, r = nwg % NXCD, xcd = wgid % NXCD, off = wgid / NXCD; wgid = (xcd < r ? xcd * (q + 1) : r * (q + 1) + (xcd - r) * q) + off; }
        const int e = wgid / per, l = wgid % per;
        u.pm = e * nMe + (l % nMe); u.pn = e * nNe + (l / nMe); return true;
    }
    __device__ __forceinline__ void a_ready(const Unit&) const {}
    __device__ __forceinline__ void done(const Unit&) const {}
};
struct In1Order {
    StaticOrder S0; int G, c;
    __host__ __device__ void init(int G_, int c_) { S0.init(16384, 29 * 256, G_, c_); G = G_; c = c_; }
    __host__ __device__ bool next(int i, Unit& u) const {
        const long L = (long)i * G + c;
        if (L < 1856) return S0.next(i, u);
        const int q = (int)L - 1856; if (q >= 136) return false;
        const int t = q % 17; u.pm = 64 + q / 17; u.pn = (t < 8) ? 4 + t : ((t < 16) ? 12 + t : 28); return true;
    }
    __device__ __forceinline__ void a_ready(const Unit&) const {}
    __device__ __forceinline__ void done(const Unit&) const {}
};
struct EpiStore {
    static constexpr bool PERM = true, AFTER_DRAIN = false;
    bf16_t* O; int ldc; int nNt; float sc;
    __device__ __forceinline__ void operator()(const f32x4 (&acc)[2][2][4][2], const Unit& u, int wr, int wc, int fr, int fq) const {
        const int row0 = u.pm * BM + wr * 64 + fr; const int col0 = (u.pn % nNt) * BM + wc * 32 + 8 * fq;
#pragma unroll
        for (int ai = 0; ai < 2; ++ai)
#pragma unroll
            for (int m = 0; m < 4; ++m) { bf16_t* rowp = O + (size_t)(row0 + ai * HALF + m * 16) * ldc + col0;
#pragma unroll
                for (int bj = 0; bj < 2; ++bj) { const f32x4 v0 = acc[ai][bj][m][0] * sc, v1 = acc[ai][bj][m][1] * sc;
                    u32x4 w; w.x = cvt_pk_bf16(v0[0], v0[1]); w.y = cvt_pk_bf16(v0[2], v0[3]); w.z = cvt_pk_bf16(v1[0], v1[1]); w.w = cvt_pk_bf16(v1[2], v1[3]);
                    *(u32x4*)(rowp + bj * HALF) = w; } }
    }
};
struct EpiSwiglu {
    static constexpr bool PERM = true, AFTER_DRAIN = false;
    unsigned char* O;
    __device__ __forceinline__ float sg(float a, float b) const { const float x = a * (1.f / 64.f); const float r = x * __builtin_amdgcn_rcpf(1.f + __expf(-x)) * (b * (1.f / 64.f)); return fminf(fmaxf(r, -448.f), 448.f); }
    __device__ __forceinline__ void operator()(const f32x4 (&acc)[2][2][4][2], const Unit& u, int wr, int wc, int fr, int fq) const {
        const int row0 = u.pm * BM + wr * 64 + fr; const int col0 = (u.pn % 16) * HALF + wc * 32 + 8 * fq;
#pragma unroll
        for (int ai = 0; ai < 2; ++ai)
#pragma unroll
            for (int m = 0; m < 4; ++m) { unsigned char* rowp = O + (size_t)(row0 + ai * HALF + m * 16) * 2048 + col0;
                const f32x4 a0 = acc[ai][0][m][0], a1 = acc[ai][0][m][1], b0 = acc[ai][1][m][0], b1 = acc[ai][1][m][1];
                int lo = 0, hi = 0;
                lo = __builtin_amdgcn_cvt_pk_fp8_f32(sg(a0[0], b0[0]), sg(a0[1], b0[1]), lo, false); lo = __builtin_amdgcn_cvt_pk_fp8_f32(sg(a0[2], b0[2]), sg(a0[3], b0[3]), lo, true);
                hi = __builtin_amdgcn_cvt_pk_fp8_f32(sg(a1[0], b1[0]), sg(a1[1], b1[1]), hi, false); hi = __builtin_amdgcn_cvt_pk_fp8_f32(sg(a1[2], b1[2]), sg(a1[3], b1[3]), hi, true);
                typedef unsigned u32x2 __attribute__((ext_vector_type(2)));
                *(u32x2*)rowp = (u32x2){(unsigned)lo, (unsigned)hi}; }
    }
};
struct EpiRes {
    static constexpr bool PERM = false, AFTER_DRAIN = false;
    const float* Xlat; const float* Xctx; float* H; const float* gate;
    __device__ __forceinline__ void operator()(const f32x4 (&acc)[2][2][4][2], const Unit& u, int wr, int wc, int fr, int fq) const {
        const int row0 = u.pm * BM + wr * 64 + fr, col0 = u.pn * BM + wc * 32 + 4 * fq;
        const float* gp = gate + (size_t)((u.pm < 64) ? (u.pm >> 3) : 8) * 12288 + col0;
        f32x4 g[2][2];
#pragma unroll
        for (int bj = 0; bj < 2; ++bj)
#pragma unroll
            for (int n = 0; n < 2; ++n) g[bj][n] = *(const f32x4*)(gp + bj * HALF + n * 16);
        const float* sbase = (u.pm < 64) ? Xlat : Xctx - (size_t)16384 * 2048;
#pragma unroll
        for (int ai = 0; ai < 2; ++ai)
#pragma unroll
            for (int m = 0; m < 4; ++m) { const int row = row0 + ai * HALF + m * 16;
                const float* src = sbase + (size_t)row * 2048 + col0; float* dst = H + (size_t)row * 2048 + col0;
#pragma unroll
                for (int bj = 0; bj < 2; ++bj)
#pragma unroll
                    for (int n = 0; n < 2; ++n) { const int c = bj * HALF + n * 16;
                        const f32x4 x = *(const f32x4*)(src + c);
                        *(f32x4*)(dst + c) = x + g[bj][n] * acc[ai][bj][m][n]; } }
    }
};
}
#ifndef PG8_SP2
#define PG8_SP2 true
#endif
#ifndef PG8_ALIGN
#define PG8_ALIGN true
#endif
constexpr int NWAVES = 8;
constexpr int NTHR = NWAVES * 64;
#ifndef MK_ONE_LAUNCH
#define MK_ONE_LAUNCH 1
#endif
constexpr int D = 2048, NB = 8, SEQ = 2048, CTXL = 256;
constexpr int M_LAT = NB * SEQ, M_CTX = NB * CTXL, M_ALL = M_LAT + M_CTX;
constexpr int LD0 = 6400, LD1 = 7424;
constexpr int EV_IN = 6176, OD_IN = 7184;
constexpr int NE_ = 16, FF = 2048;
constexpr int ME0 = 2304, ME1 = 2048;
constexpr float EPS = 1e-6f;
constexpr int C0_X1 = 0, C0_X2 = 1024, C0_V = 2048, C0_GQ = 3072, C0_GK = 3584, C0_GV = 4096, C0_GR = 5120, C0_CODE = 6144;
constexpr int C1_MQ = 0, C1_MK = 1024, C1_MV = 2048, C1_MO = 3072, C1_DQ = 4096, C1_DK = 5120, C1_DV = 6144, C1_G = 7168;
constexpr size_t MiB = 1u << 20;
constexpr size_t WS_CTL = 0, CTL_ZERO_BYTES = 1 * MiB;
constexpr size_t WS_MOD = 1 * MiB;
constexpr size_t WS_AFF = 2 * MiB;
constexpr size_t WS_SEL = 4 * MiB;
constexpr size_t WS_TOK = 6 * MiB;
constexpr size_t WS_GW  = 7 * MiB;
constexpr size_t WS_FTL = 8 * MiB;
constexpr size_t WS_FTC = 40 * MiB;
constexpr size_t WS_WIN0 = 44 * MiB;
constexpr size_t WS_WIN1 = 69 * MiB;
constexpr size_t WS_WOUT = 98 * MiB;
constexpr size_t WS_W13 = 114 * MiB;
constexpr size_t WS_W2 = 626 * MiB;
constexpr size_t WS_H = 882 * MiB;
constexpr size_t WS_A = 1026 * MiB;
constexpr size_t WS_Y = 1098 * MiB;
constexpr size_t WS_P = 1170 * MiB;
constexpr size_t WS_XS = WS_P, WS_YS = WS_P;
constexpr size_t WS_MIX = 1431 * MiB;
constexpr size_t WS_XV = WS_MIX, WS_Z = WS_MIX + 108 * MiB, WS_OG = WS_MIX + 144 * MiB;
constexpr size_t WS_HID = WS_MIX;
constexpr size_t WS_XT = 1719 * MiB;
constexpr size_t WS_YT = 1815 * MiB;
constexpr size_t WS_FTT = 1847 * MiB;
constexpr size_t WS_GQ = 1864 * MiB;
constexpr size_t WS_GDEC = 1972 * MiB;
constexpr size_t WS_MQK = WS_GQ;
constexpr size_t WS_MLS = WS_GQ + 80 * MiB;
constexpr size_t WS_END = 1974 * MiB;
constexpr int CW_BAR = 4096;
constexpr int RING_OFF = 0, RING_BYTES = 131072;
constexpr int LDSCTL_OFF = 146432, MISC_OFF = LDSCTL_OFF + 320;
constexpr int LDS_BYTES = 147456;
#define GAS __attribute__((address_space(1)))
#define LAS __attribute__((address_space(3)))
typedef unsigned short bf16;
typedef unsigned v4u __attribute__((ext_vector_type(4)));
typedef unsigned v2u __attribute__((ext_vector_type(2)));
typedef float f32x4 __attribute__((ext_vector_type(4)));
typedef short bf16x8 __attribute__((ext_vector_type(8)));
typedef GAS unsigned gu32;
#define RLX_AGENT __ATOMIC_RELAXED, __HIP_MEMORY_SCOPE_AGENT
#define LDS_WAIT() asm volatile("s_waitcnt lgkmcnt(0)" ::: "memory")
#define VM_WAIT() asm volatile("s_waitcnt vmcnt(0)" ::: "memory")
typedef float f32x2v_ __attribute__((ext_vector_type(2)));
typedef __bf16 bf16x2v_ __attribute__((ext_vector_type(2)));
__device__ __forceinline__ unsigned pk2(float lo, float hi) { return __builtin_bit_cast(unsigned, __builtin_convertvector((f32x2v_){lo, hi}, bf16x2v_)); }
__device__ __forceinline__ unsigned f2bf(float f) { return pk2(f, 0.f) & 0xffffu; }
__device__ __forceinline__ unsigned pk4_fp8(float a, float b, float c, float d) { int r = 0; r = __builtin_amdgcn_cvt_pk_fp8_f32(a, b, r, false); r = __builtin_amdgcn_cvt_pk_fp8_f32(c, d, r, true); return (unsigned)r; }
__device__ __forceinline__ float bf2f(unsigned short b) { return __builtin_bit_cast(float, ((unsigned)b) << 16); }
__device__ __forceinline__ float bflo(unsigned w) { return __builtin_bit_cast(float, w << 16); }
__device__ __forceinline__ float bfhi(unsigned w) { return __builtin_bit_cast(float, w & 0xffff0000u); }
__device__ __forceinline__ float siluf(float x) { return x * __builtin_amdgcn_rcpf(1.f + __expf(-x)); }
__device__ __forceinline__ float sigmoidf_(float x) { return __builtin_amdgcn_rcpf(1.f + __expf(-x)); }
__device__ __forceinline__ float logsigmoidf_(float x) { return fminf(x, 0.f) - __logf(1.f + __expf(-fabsf(x))); }
template <int CTRL> __device__ __forceinline__ float dppmov(float v) { return __builtin_bit_cast(float, __builtin_amdgcn_update_dpp(0, __builtin_bit_cast(int, v), CTRL, 0xf, 0xf, true)); }
__device__ __forceinline__ float row16_sum(float v) { v += dppmov<0xB1>(v); v += dppmov<0x4E>(v); v += dppmov<0x124>(v); v += dppmov<0x128>(v); return v; }
__device__ __forceinline__ float row16_max(float v) { v = fmaxf(v, dppmov<0xB1>(v)); v = fmaxf(v, dppmov<0x4E>(v)); v = fmaxf(v, dppmov<0x124>(v)); v = fmaxf(v, dppmov<0x128>(v)); return v; }
__device__ __forceinline__ float xrow_sum(float v) {
    float a = v, b = v; asm volatile("s_nop 1\n\tv_permlane16_swap_b32 %0, %1" : "+v"(a), "+v"(b)); v = a + b; a = v; b = v;
    asm volatile("s_nop 1\n\tv_permlane32_swap_b32 %0, %1" : "+v"(a), "+v"(b)); return a + b; }
__device__ __forceinline__ float xrow_max(float v) {
    float a = v, b = v; asm volatile("s_nop 1\n\tv_permlane16_swap_b32 %0, %1" : "+v"(a), "+v"(b)); v = fmaxf(a, b); a = v; b = v;
    asm volatile("s_nop 1\n\tv_permlane32_swap_b32 %0, %1" : "+v"(a), "+v"(b)); return fmaxf(a, b); }
__device__ __forceinline__ float wave_sum(float v) { return xrow_sum(row16_sum(v)); }
#define XB_TMO      128
#define XB_XCNT(j)  (256  + 64 * (j))
#define XB_XSUB(j)  (1280 + 64 * (j))
#define XB_XGEN(j)  (2304 + 64 * (j))
#define XB_TOP      3328
#define XB_TOPGEN   3392
#define XCD_BAR_WORDS 3456
#define XB_SPIN_CAP (1u << 18)

__device__ __forceinline__ unsigned xb_ld(unsigned* p)              { return __hip_atomic_load(p, __ATOMIC_RELAXED, __HIP_MEMORY_SCOPE_AGENT); }
__device__ __forceinline__ unsigned xb_add(unsigned* p, unsigned v) { return __hip_atomic_fetch_add(p, v, __ATOMIC_RELAXED, __HIP_MEMORY_SCOPE_AGENT); }
__device__ __forceinline__ unsigned xb_xcc_id() { return (unsigned)__builtin_amdgcn_s_getreg((3 << 11) | 20) & 0xFu; }
#define XB_SPIN(cond, bar) do { unsigned _sp = 0; while (cond) { __builtin_amdgcn_s_sleep(1); \
    if ((++_sp & 255u) == 0u) { if (xb_ld(&(bar)[XB_TMO])) break; if (_sp > XB_SPIN_CAP) { atomicAdd(&(bar)[XB_TMO], 1u); break; } } } } while (0)

struct XcdBarrier {
    unsigned* bar; unsigned x;
    volatile LAS unsigned* st;
};

__device__ __forceinline__ XcdBarrier xcd_barrier_post(unsigned* bar, volatile LAS unsigned* st) {
    XcdBarrier b; b.bar = bar; b.x = xb_xcc_id(); b.st = st;
    if (threadIdx.x == 0) (void)xb_add(&bar[XB_XCNT(b.x)], 1u);
    return b;
}
__device__ __forceinline__ void xcd_barrier_complete(unsigned* bar, unsigned x, unsigned& nloc, unsigned& nx) {
    const unsigned G = gridDim.x * gridDim.y * gridDim.z;
    unsigned sum, cnt, mine, sp = 0u;
    for (;;) {
        sum = 0u; cnt = 0u; mine = 0u;
#pragma unroll
        for (unsigned j = 0; j < 16; ++j) { const unsigned c = xb_ld(&bar[XB_XCNT(j)]); sum += c; cnt += (c > 0u) ? 1u : 0u; mine = (j == x) ? c : mine; }
        if (sum == G) break;
        __builtin_amdgcn_s_sleep(1);
        if ((++sp & 255u) == 0u) { if (xb_ld(&bar[XB_TMO])) break; if (sp > XB_SPIN_CAP) { atomicAdd(&bar[XB_TMO], 1u); break; } }
    }
    nloc = mine > 0u ? mine : 1u; nx = cnt > 0u ? cnt : 1u;
}

__device__ __forceinline__ void xcd_barrier(const XcdBarrier& b) {
    asm volatile("s_waitcnt vmcnt(0)" ::: "memory");
    __syncthreads();
    if (threadIdx.x == 0) {
        unsigned* bar = b.bar;
        __builtin_amdgcn_s_waitcnt(0);
        unsigned nloc = b.st[0], nx = b.st[1];
        if (nloc == 0u) { xcd_barrier_complete(bar, b.x, nloc, nx); b.st[0] = nloc; b.st[1] = nx; }
        const unsigned old = xb_add(&bar[XB_XSUB(b.x)], 1u);
        const unsigned gen = old / nloc;
        if (old + 1u == (gen + 1u) * nloc) {
            __builtin_amdgcn_fence(__ATOMIC_RELEASE, "agent");
            asm volatile("s_waitcnt vmcnt(0)" ::: "memory");
            const unsigned og = xb_add(&bar[XB_TOP], 1u);
            const unsigned tg = og / nx;
            if (og + 1u == (tg + 1u) * nx) xb_add(&bar[XB_TOPGEN], 1u);
            else XB_SPIN(xb_ld(&bar[XB_TOPGEN]) == tg, bar);
            __builtin_amdgcn_fence(__ATOMIC_ACQUIRE, "agent");
            xb_add(&bar[XB_XGEN(b.x)], 1u);
            asm volatile("s_waitcnt vmcnt(0)" ::: "memory");
        } else {
            XB_SPIN(xb_ld(&bar[XB_XGEN(b.x)]) == gen, bar);
            __builtin_amdgcn_fence(__ATOMIC_ACQUIRE, "agent");
            asm volatile("s_waitcnt vmcnt(0)" ::: "memory");
        }
    }
    __syncthreads();
}

typedef short s16x4 __attribute__((ext_vector_type(4)));
__device__ __forceinline__ bf16x8 tr_frag(const LAS bf16* T, int ld, int r0, int c0, int lane) {
    const int g = lane >> 4, q = (lane & 15) >> 2, p = lane & 3;
    const LAS bf16* a = T + (r0 + 8 * g + q) * ld + c0 + 4 * p;
    const s16x4 lo = __builtin_amdgcn_ds_read_tr16_b64_v4i16((LAS s16x4*)a);
    const s16x4 hi = __builtin_amdgcn_ds_read_tr16_b64_v4i16((LAS s16x4*)(a + 4 * ld));
    return (bf16x8){lo[0], lo[1], lo[2], lo[3], hi[0], hi[1], hi[2], hi[3]};
}
__device__ __forceinline__ float wave_incl_sum(float v, int lane) {
#pragma unroll
    for (int o = 1; o < 64; o <<= 1) { const float t = __shfl_up(v, o); v = (lane >= o) ? v + t : v; }
    return v;
}
__device__ __forceinline__ float wave_incl_max(float v, int lane) {
#pragma unroll
    for (int o = 1; o < 64; o <<= 1) { const float t = __shfl_up(v, o); v = (lane >= o) ? fmaxf(v, t) : v; }
    return v;
}
__device__ __forceinline__ float wave_max(float v) { return xrow_max(row16_max(v)); }
struct Frame {
    LAS unsigned char* lds;
    volatile LAS unsigned* MISC;
    gu32* ctl;
    int tid, lane, wave;
    int bid, G;
    const float* in[35];
    float* out;
    unsigned char* ws;
};
enum { I_X = 0, I_C, I_CTX, I_CCTX, I_ADAW, I_ADAB, I_N1G, I_N2G, I_OUTW, I_RTW, I_W1, I_W3, I_W2, I_FING, I_EVW, I_HCW, I_HCB, I_HPW1, I_HPB1, I_HFREQ, I_HPW2, I_HPB2, I_HPW3, I_HBIAS,
       I_GGW2, I_GGB, I_GNG, I_ODW, I_MCW, I_MCB, I_MIGB, I_MFGB, I_MNG, I_DLAM, I_DNG };

__device__ __forceinline__ float grp16_max(float v) { return row16_max(v); }
__device__ __forceinline__ float grp16_sum(float v) { return row16_sum(v); }
constexpr int CW_CVT = 64;
typedef unsigned u32x4_ __attribute__((ext_vector_type(4)));
struct CvtItem { const float* src; int ldn, c0, ncols, k0; bf16* dst; int d0, dstep, fp8; };
__device__ __forceinline__ CvtItem cvt_decode(Frame& F, int it) {
    CvtItem c; c.dstep = 128; c.ncols = 256; c.fp8 = 0;
    bf16* Win0 = (bf16*)(F.ws + WS_WIN0); bf16* Win1 = (bf16*)(F.ws + WS_WIN1); bf16* Wout = (bf16*)(F.ws + WS_WOUT); bf16* W13 = (bf16*)(F.ws + WS_W13); bf16* W2t = (bf16*)(F.ws + WS_W2);
    constexpr int N_IN0 = 16 * 25, N_IN1 = 16 * 29, N_OUT = 2 * 16 * 8;
    if (it < N_IN0) { const int kb = it / 25, cb = it % 25; c.src = F.in[I_EVW]; c.ldn = EV_IN; c.k0 = kb * 128; c.dst = Win0; c.c0 = cb * 256; c.d0 = cb * 256; if (cb == 24) c.ncols = 32; return c; }
    it -= N_IN0;
    if (it < N_IN1) { const int kb = it / 29, cb = it % 29; c.src = F.in[I_ODW]; c.ldn = OD_IN; c.k0 = kb * 128; c.dst = Win1;
        if (cb < 16) { c.c0 = cb * 256; c.d0 = cb * 256; } else if (cb < 28) { c.c0 = 4112 + (cb - 16) * 256; c.d0 = 4096 + (cb - 16) * 256; } else { c.c0 = 4096; c.d0 = 7168; c.ncols = 16; }
        return c; }
    it -= N_IN1;
    if (it < N_OUT) { const int l = it >> 7, q = it & 127, kb = q >> 3, cb = q & 7; c.src = F.in[I_OUTW] + (size_t)l * 2048 * 2048; c.ldn = 2048; c.k0 = kb * 128; c.dst = Wout + (size_t)l * 2048 * 2048; c.c0 = cb * 256; c.d0 = cb * 256; return c; }
    it -= N_OUT;
    { const int cb = it & 7; it >>= 3; const int kb = it & 15; it >>= 4; const int which = it % 3; it /= 3; const int e = it & 15, l = it >> 4;
      const size_t so = ((size_t)l * 16 + e) * 2048 * 2048; c.ldn = 2048; c.k0 = kb * 128; c.c0 = cb * 256; c.fp8 = 1;
      if (which == 0) { c.src = F.in[I_W1] + so; c.dst = W13 + ((size_t)l * 16 + e) * 4096 * 1024; c.d0 = cb * 512; c.dstep = 256; }
      else if (which == 1) { c.src = F.in[I_W3] + so; c.dst = W13 + ((size_t)l * 16 + e) * 4096 * 1024; c.d0 = cb * 512 + 128; c.dstep = 256; }
      else { c.src = F.in[I_W2] + so; c.dst = W2t + ((size_t)l * 16 + e) * 2048 * 1024; c.d0 = cb * 256; }
      return c; }
}
__device__ __forceinline__ void cvt_load(const CvtItem& c, int wave, int lane, f32x4 (&v)[16]) {
    const bool ok = 4 * lane < c.ncols;
#pragma unroll
    for (int i = 0; i < 16; ++i) v[i] = ok ? *(const GAS f32x4*)(c.src + (size_t)(c.k0 + 16 * wave + i) * c.ldn + c.c0 + 4 * lane) : (f32x4){0.f, 0.f, 0.f, 0.f};
}
constexpr int CVT_NPRE = 16 * 25 + 16 * 29 + 2 * 16 * 8, CVT_L0_END = CVT_NPRE + 6144, CVT_L1_END = CVT_NPRE + 12288;
constexpr int CVT_LATE0 = 64 * 10 + 192 * 14, CVT_LATE1 = 128 * 5 + 56 * 10;
constexpr int CVT_NEARLY = CVT_NPRE + 12288 - CVT_LATE0 - CVT_LATE1;
__device__ __forceinline__ int cvt_early_item(int j) {
    if (j < CVT_L0_END - CVT_LATE0) return j;
    return j + CVT_LATE0;
}
template <bool DYN> __device__ __forceinline__ void cvt_run(Frame& F, int first, int cnt) {
    constexpr int TLD = 264;
    LAS bf16* T = (LAS bf16*)(F.lds);
    LAS int* nxt = (LAS int*)(F.lds + 128 * TLD * 2);
    const int NIT = DYN ? CVT_NEARLY : cnt;
    __syncthreads();
    int jn = 0;
    if (DYN) { if (F.tid == 0) nxt[0] = (int)__hip_atomic_fetch_add((unsigned*)(F.ctl + CW_CVT), 1u, __ATOMIC_RELAXED, __HIP_MEMORY_SCOPE_AGENT);
        __syncthreads(); jn = nxt[0]; }
    int j = jn;
    f32x4 v[16];
    CvtItem cur = cvt_decode(F, j < NIT ? (DYN ? cvt_early_item(j) : first + j) : 0);
    if (j < NIT) cvt_load(cur, F.wave, F.lane, v);
    while (j < NIT) {
        __syncthreads();
        if (DYN) { if (F.tid == 0) nxt[0] = (int)__hip_atomic_fetch_add((unsigned*)(F.ctl + CW_CVT), 1u, __ATOMIC_RELAXED, __HIP_MEMORY_SCOPE_AGENT); }
        { const float wsc = cur.fp8 ? 64.f : 1.f;
#pragma unroll
        for (int i = 0; i < 16; ++i) { v2u w; w.x = pk2(v[i][0] * wsc, v[i][1] * wsc); w.y = pk2(v[i][2] * wsc, v[i][3] * wsc); *(LAS v2u*)(T + (16 * F.wave + i) * TLD + 4 * F.lane) = w; } }
        __syncthreads();
        const int jnext = DYN ? nxt[0] : j + 1;
        const CvtItem me = cur;
        if (jnext < NIT) { cur = cvt_decode(F, DYN ? cvt_early_item(jnext) : first + jnext); cvt_load(cur, F.wave, F.lane, v); }
        const int fr = F.lane & 15, fq = F.lane >> 4;
#pragma unroll
        for (int x = 0; x < 2; ++x) { const int jc = 32 * F.wave + 16 * x + fr; const int drow = me.d0 + (jc >> 7) * me.dstep + (jc & 127);
#pragma unroll
            for (int r = 0; r < 4; ++r) { const bf16x8 f = tr_frag(T, TLD, 32 * r, 32 * F.wave + 16 * x, F.lane);
                if (me.fp8) { const u32x4_ fw = __builtin_bit_cast(u32x4_, f); v2u o8; o8.x = pk4_fp8(bflo(fw.x), bfhi(fw.x), bflo(fw.y), bfhi(fw.y)); o8.y = pk4_fp8(bflo(fw.z), bfhi(fw.z), bflo(fw.w), bfhi(fw.w));
                    *(GAS v2u*)((unsigned char*)me.dst + (size_t)drow * 2048 + me.k0 + 32 * r + 8 * fq) = o8; }
                else if (jc < me.ncols) *(GAS bf16x8*)(me.dst + (size_t)drow * 2048 + me.k0 + 32 * r + 8 * fq) = f; } }
        j = jnext;
    }
    __syncthreads();
}
__device__ __forceinline__ void p0_convert(Frame& F) {
    { bf16* Win0 = (bf16*)(F.ws + WS_WIN0); bf16* Win1 = (bf16*)(F.ws + WS_WIN1);
      const int gt = F.bid * NTHR + F.tid, NT = F.G * NTHR; const v4u z = {0u, 0u, 0u, 0u};
      for (int i = gt; i < (LD0 - EV_IN) * 256; i += NT) *(GAS v4u*)(Win0 + (size_t)EV_IN * 2048 + (size_t)i * 8) = z;
      for (int i = gt; i < (LD1 - OD_IN) * 256; i += NT) *(GAS v4u*)(Win1 + (size_t)OD_IN * 2048 + (size_t)i * 8) = z; }
    if (F.G == 256) cvt_run<true>(F, 0, 0);
    else { cvt_run<true>(F, 0, 0); if (F.bid == 0) { cvt_run<false>(F, CVT_L0_END - CVT_LATE0, CVT_LATE0); cvt_run<false>(F, CVT_L1_END - CVT_LATE1, CVT_LATE1); } }
}
__device__ __forceinline__ void cvt_late(Frame& F, int first, int w0, int per) {
    if (F.G != 256 || F.bid < w0) return;
    cvt_run<false>(F, first + (F.bid - w0) * per, per);
}
__device__ __forceinline__ void p0_adaln(Frame& F) {
    if (F.bid >= 192) return;
    LAS float* s = (LAS float*)(F.lds);
    LAS float* red = (LAS float*)(F.lds + 9 * 2048 * 4);
    for (int i = F.tid; i < 9 * 2048; i += NTHR) { const float v = (i < 8 * 2048) ? F.in[I_C][i] : F.in[I_CCTX][i - 8 * 2048]; s[i] = siluf(v); }
    __syncthreads();
    float* MOD = (float*)(F.ws + WS_MOD);
    for (int u = F.bid; u < 192; u += F.G) {
        const int l = u / 96, j0 = (u % 96) * 128, jj = F.tid & 127, kq = F.tid >> 7;
        const float* W = F.in[I_ADAW] + (size_t)l * 2048 * 12288 + j0 + jj;
        float acc[9];
#pragma unroll
        for (int r = 0; r < 9; ++r) acc[r] = 0.f;
        for (int k = kq * 512; k < kq * 512 + 512; k += 4) {
            float w[4];
#pragma unroll
            for (int q = 0; q < 4; ++q) w[q] = W[(size_t)(k + q) * 12288];
#pragma unroll
            for (int r = 0; r < 9; ++r) { const f32x4 sv = *(const LAS f32x4*)(s + r * 2048 + k); acc[r] += sv[0] * w[0] + sv[1] * w[1] + sv[2] * w[2] + sv[3] * w[3]; }
        }
#pragma unroll
        for (int r = 0; r < 9; ++r) red[(kq * 9 + r) * 128 + jj] = acc[r];
        __syncthreads();
        for (int i = F.tid; i < 9 * 128; i += NTHR) { const int r = i >> 7, j = i & 127;
            MOD[((size_t)l * 9 + r) * 12288 + j0 + j] = red[(0 * 9 + r) * 128 + j] + red[(1 * 9 + r) * 128 + j] + red[(2 * 9 + r) * 128 + j] + red[(3 * 9 + r) * 128 + j] + F.in[I_ADAB][l * 12288 + j0 + j]; }
        __syncthreads();
    }
}
__device__ __forceinline__ void p0_filters(Frame& F) {
    LAS float* h1 = (LAS float*)(F.lds);
    LAS float* h2 = h1 + 512;
    LAS float* ft = h2 + 512;
    for (int uu = F.bid; uu < 2304; uu += F.G) {
        const int jb = uu & 7, u = uu >> 3;
        const bool lat = u < 256; const int L = lat ? 2048 : 256; const int p0 = (lat ? u : u - 256) * 8;
        float* FT = (float*)(F.ws + (lat ? WS_FTL : WS_FTC));
        __syncthreads();
        if (F.tid < 8 * 33) { const int pp = F.tid / 33, i = F.tid % 33; const float pos = (float)(p0 + pp);
            float v;
            if (i == 0) v = pos / (float)(L - 1);
            else { const int bi = (i - 1) & 15; const float band = 1e-4f + (float)bi * ((15.f - 1e-4f) / 15.f); const float ang = (6.283185307179586f / (float)L) * pos * band; v = (i <= 16) ? cosf(ang) : -sinf(ang); }
            ft[pp * 36 + i] = v; }
        __syncthreads();
        { const int pp = F.tid >> 6, j = F.tid & 63; float a = F.in[I_HPB1][j];
#pragma unroll 11
          for (int i = 0; i < 33; ++i) a += ft[pp * 36 + i] * F.in[I_HPW1][i * 64 + j];
          h1[pp * 64 + j] = sinf(F.in[I_HFREQ][j] * a); }
        __syncthreads();
        { const int pp = F.tid >> 6, j = F.tid & 63; float a = F.in[I_HPB2][j];
#pragma unroll 16
          for (int i = 0; i < 64; ++i) a += h1[pp * 64 + i] * F.in[I_HPW2][i * 64 + j];
          h2[pp * 64 + j] = sinf(F.in[I_HFREQ][64 + j] * a); }
        __syncthreads();
        { const int j = jb * 512 + F.tid;
            float acc[8];
#pragma unroll
            for (int pp = 0; pp < 8; ++pp) acc[pp] = 0.f;
#pragma unroll 16
            for (int i = 0; i < 64; ++i) { const float w = F.in[I_HPW3][(size_t)i * 4096 + j];
#pragma unroll
                for (int pp = 0; pp < 8; ++pp) acc[pp] += h2[pp * 64 + i] * w; }
            const int order = j >> 11, dir = (j >> 10) & 1, ch = j & 1023;
            const float da = -3.0701134573253945f, db = -15.350567286626973f;
            const float delta = fabsf(da + (float)ch * ((db - da) / 1023.f));
#pragma unroll
            for (int pp = 0; pp < 8; ++pp) { const int p = p0 + pp; const float t = (float)p / (float)(L - 1); const float val = acc[pp] * __expf(-t * delta);
                if (dir == 0) FT[((size_t)order * (2 * L - 1) + (L - 1 + p)) * 1024 + ch] = val;
                else if (p >= 1) FT[((size_t)order * (2 * L - 1) + (L - 1 - p)) * 1024 + ch] = val; }
        }
    }
    __syncthreads();
}

__device__ __forceinline__ void load_row(const float* p, int lane, f32x4 (&v)[8]) {
#pragma unroll
    for (int i = 0; i < 8; ++i) v[i] = *(const GAS f32x4*)(p + 4 * (lane + 64 * i));
}
__device__ __forceinline__ float row_rstd(const f32x4 (&v)[8]) {
    float s = 0.f;
#pragma unroll
    for (int i = 0; i < 8; ++i) s += (v[i][0] * v[i][0] + v[i][1] * v[i][1]) + (v[i][2] * v[i][2] + v[i][3] * v[i][3]);
    return 1.f / sqrtf(wave_sum(s) * (1.f / 2048.f) + EPS);
}
__device__ __forceinline__ void modulate_store(f32x4 (&v)[8], float rstd, const float* g, const float* shift, const float* scale, bf16* orow, int lane) {
#pragma unroll
    for (int i = 0; i < 8; ++i) { const int c = 4 * (lane + 64 * i);
        const f32x4 gg = *(const GAS f32x4*)(g + c), sh = *(const GAS f32x4*)(shift + c), sc = *(const GAS f32x4*)(scale + c);
        v[i] = (v[i] * rstd * gg) * (sc + 1.f) + sh;
        v2u w; w.x = pk2(v[i][0], v[i][1]); w.y = pk2(v[i][2], v[i][3]);
        *(GAS v2u*)(orow + c) = w; }
}
__device__ __forceinline__ void modulate_store8(f32x4 (&v)[8], float rstd, const float* g, const float* shift, const float* scale, unsigned char* orow, int lane) {
#pragma unroll
    for (int i = 0; i < 8; ++i) { const int c = 4 * (lane + 64 * i);
        const f32x4 gg = *(const GAS f32x4*)(g + c), sh = *(const GAS f32x4*)(shift + c), sc = *(const GAS f32x4*)(scale + c);
        v[i] = (v[i] * rstd * gg) * (sc + 1.f) + sh;
        *(GAS unsigned*)(orow + c) = pk4_fp8(v[i][0], v[i][1], v[i][2], v[i][3]); }
}
__device__ __forceinline__ const float* xrow_ptr(Frame& F, int r) { return (r < M_LAT) ? F.in[I_X] + (size_t)r * D : F.in[I_CTX] + (size_t)(r - M_LAT) * D; }
__device__ __forceinline__ int row_b(int r) { return (r < M_LAT) ? (r >> 11) : 8; }

__device__ __forceinline__ void mod_params(const float* g, const float* shift, const float* scale, int lane, f32x4 (&gs)[8], f32x4 (&sh)[8]) {
#pragma unroll
    for (int i = 0; i < 8; ++i) { const int c = 4 * (lane + 64 * i); gs[i] = *(const GAS f32x4*)(g + c) * (*(const GAS f32x4*)(scale + c) + 1.f); sh[i] = *(const GAS f32x4*)(shift + c); }
}
__device__ __forceinline__ void ph_norm1_l0(Frame& F) {
    const int gw = F.bid * NWAVES + F.wave, NGW = F.G * NWAVES;
    const float* MOD = (const float*)(F.ws + WS_MOD); bf16* A = (bf16*)(F.ws + WS_A);
    const int per = (M_ALL + NGW - 1) / NGW, r0 = gw * per, r1 = (r0 + per < M_ALL) ? r0 + per : M_ALL;
    f32x4 v[8], gs[8], sh[8]; int curb = -1;
    if (r0 < r1) load_row(xrow_ptr(F, r0), F.lane, v);
    for (int r = r0; r < r1; ++r) { f32x4 nv[8]; if (r + 1 < r1) load_row(xrow_ptr(F, r + 1), F.lane, nv);
        const int bb = row_b(r); if (bb != curb) { const float* m = MOD + (size_t)bb * 12288; mod_params(F.in[I_N1G], m, m + 2048, F.lane, gs, sh); curb = bb; }
        const float rs = row_rstd(v);
        bf16* orow = A + (size_t)r * D;
#pragma unroll
        for (int i = 0; i < 8; ++i) { const f32x4 o = (v[i] * rs) * gs[i] + sh[i]; v2u w; w.x = pk2(o[0], o[1]); w.y = pk2(o[2], o[3]); *(GAS v2u*)(orow + 4 * (F.lane + 64 * i)) = w; }
#pragma unroll
        for (int i = 0; i < 8; ++i) v[i] = nv[i]; }
}
__device__ __forceinline__ void ph_codes_skinny(Frame& F) {
    constexpr int WLD = 2056;
    LAS bf16* W = (LAS bf16*)(F.lds);
    const bf16* A = (const bf16*)(F.ws + WS_A); const bf16* Wc = (const bf16*)(F.ws + WS_WIN0) + (size_t)6144 * 2048; bf16* P = (bf16*)(F.ws + WS_P);
    __syncthreads();
    for (int i = F.tid; i < 32 * 256; i += NTHR) { const int r = i >> 8, ch = i & 255; *(LAS v4u*)(W + r * WLD + ch * 8) = *(const GAS v4u*)(Wc + (size_t)r * 2048 + ch * 8); }
    __syncthreads();
    const int gw = F.bid * NWAVES + F.wave, NGW = F.G * NWAVES; const int fr = F.lane & 15, fq = F.lane >> 4;
    for (int task = gw; task < M_ALL / 16; task += NGW) { const int r0 = task * 16;
        f32x4 acc[2] = {(f32x4){0.f, 0.f, 0.f, 0.f}, (f32x4){0.f, 0.f, 0.f, 0.f}};
        const bf16* ap = A + (size_t)(r0 + fr) * 2048 + 8 * fq;
#pragma unroll 8
        for (int ks = 0; ks < 64; ++ks) { const bf16x8 af = *(const GAS bf16x8*)(ap + 32 * ks);
#pragma unroll
            for (int nt = 0; nt < 2; ++nt) { const bf16x8 bf = *(const LAS bf16x8*)(W + (16 * nt + fr) * WLD + 32 * ks + 8 * fq); acc[nt] = __builtin_amdgcn_mfma_f32_16x16x32_bf16(af, bf, acc[nt], 0, 0, 0); } }
#pragma unroll
        for (int nt = 0; nt < 2; ++nt)
#pragma unroll
            for (int j = 0; j < 4; ++j) P[(size_t)(r0 + 4 * fq + j) * LD0 + C0_CODE + 16 * nt + fr] = (bf16)f2bf(acc[nt][j]);
    }
    __syncthreads();
}
__device__ __forceinline__ void ph_norm2_router(Frame& F, int l, int nrows) {
    LAS float* rwT = (LAS float*)(F.lds);
    __syncthreads();
    for (int i = F.tid; i < 2048 * 16; i += NTHR) { const int j = i >> 4, e = i & 15; rwT[e * 2048 + j] = F.in[I_RTW][(size_t)l * 2048 * 16 + i]; }
    __syncthreads();
    const int gw = F.bid * NWAVES + F.wave, NGW = F.G * NWAVES;
    const float* MOD = (const float*)(F.ws + WS_MOD) + (size_t)l * 9 * 12288; const float* H = (const float*)(F.ws + WS_H);
    bf16* A = (bf16*)(F.ws + WS_A); float* AFF = (float*)(F.ws + WS_AFF); int* SEL = (int*)(F.ws + WS_SEL);
    const int per = (nrows + NGW - 1) / NGW, r0 = gw * per, r1 = (r0 + per < nrows) ? r0 + per : nrows;
    f32x4 v[8], gs[8], sh[8]; int curb = -1;
    if (r0 < r1) load_row(H + (size_t)r0 * D, F.lane, v);
    for (int r = r0; r < r1; ++r) { f32x4 nv[8]; if (r + 1 < r1) load_row(H + (size_t)(r + 1) * D, F.lane, nv);
        const int bb = row_b(r); if (bb != curb) { const float* m = MOD + (size_t)bb * 12288; mod_params(F.in[I_N2G] + l * 2048, m + 3 * 2048, m + 4 * 2048, F.lane, gs, sh); curb = bb; }
        const float rs = row_rstd(v);
        { unsigned char* orow = (unsigned char*)A + (size_t)r * D;
#pragma unroll
          for (int i = 0; i < 8; ++i) { v[i] = (v[i] * rs) * gs[i] + sh[i]; *(GAS unsigned*)(orow + 4 * (F.lane + 64 * i)) = pk4_fp8(v[i][0], v[i][1], v[i][2], v[i][3]); } }
        float pa[16];
#pragma unroll
        for (int e = 0; e < 16; ++e) { const LAS float* wp = rwT + e * 2048 + 4 * F.lane; f32x4 a4 = {0.f, 0.f, 0.f, 0.f};
#pragma unroll
            for (int i = 0; i < 8; ++i) { const f32x4 w = *(const LAS f32x4*)(wp + 256 * i); a4 += v[i] * w; }
            pa[e] = (a4[0] + a4[1]) + (a4[2] + a4[3]); }
        float s1[8], s2[4];
#pragma unroll
        for (int e = 0; e < 8; ++e) { float x = pa[e], y = pa[e + 8]; asm volatile("s_nop 1\n\tv_permlane32_swap_b32 %0, %1" : "+v"(x), "+v"(y)); s1[e] = x + y; }
#pragma unroll
        for (int e = 0; e < 4; ++e) { float x = s1[e], y = s1[e + 4]; asm volatile("s_nop 1\n\tv_permlane16_swap_b32 %0, %1" : "+v"(x), "+v"(y)); s2[e] = row16_sum(x + y); }
        { float mx = fmaxf(fmaxf(s2[0], s2[1]), fmaxf(s2[2], s2[3])); mx = xrow_max(mx);
          float ex[4], se = 0.f;
#pragma unroll
          for (int e = 0; e < 4; ++e) { ex[e] = expf(s2[e] - mx); se += ex[e]; }
          se = xrow_sum(se); const float inv = 1.f / se;
          if ((F.lane & 15) == 0) { const int R = F.lane >> 4; const int eb = 4 * (R & 1) + 8 * (R >> 1);
#pragma unroll
              for (int e = 0; e < 4; ++e) AFF[(size_t)(eb + e) * M_ALL + r] = ex[e] * inv; }
          if (F.lane < 16) SEL[(size_t)r * 16 + F.lane] = -1; }
#pragma unroll
        for (int i = 0; i < 8; ++i) v[i] = nv[i];
    }
    __syncthreads();
}
__device__ __forceinline__ void ph_norm2_router2(Frame& F, int l, int nrows) {
    constexpr int WLD = 2064;
    LAS bf16* Wh = (LAS bf16*)(F.lds); LAS bf16* Wl = Wh + 16 * WLD;
    LAS float* red = (LAS float*)(F.lds + 4 * 16 * WLD);
    LAS float* ssq = red + 8 * 256;
    LAS float* cb = ssq + 128;
    const float* MOD = (const float*)(F.ws + WS_MOD) + (size_t)l * 9 * 12288; const float* H = (const float*)(F.ws + WS_H);
    unsigned char* A8 = (unsigned char*)(F.ws + WS_A); float* AFF = (float*)(F.ws + WS_AFF); int* SEL = (int*)(F.ws + WS_SEL);
    float* GSB = (float*)(F.ws + WS_XT) + (size_t)F.bid * 4 * 4096;
    const int fr = F.lane & 15, fq = F.lane >> 4;
    const int ntile = nrows >> 4; const int t0 = (int)(((long)F.bid * ntile) / F.G), t1 = (int)(((long)(F.bid + 1) * ntile) / F.G);
    const int colw = 256 * F.wave + 8 * fq;
    int curb = -1, nreb = 0; const float* gsb = GSB;
    f32x4 x[8][2];
#define RT_LOAD(dst, tile) do { const float* p_ = H + (size_t)((tile) * 16 + fr) * D + colw; _Pragma("unroll") for (int ks = 0; ks < 8; ++ks) { dst[ks][0] = *(const GAS f32x4*)(p_ + 32 * ks); dst[ks][1] = *(const GAS f32x4*)(p_ + 32 * ks + 4); } } while (0)
    if (t0 < t1) RT_LOAD(x, t0);
    for (int t = t0; t < t1; ++t) {
        const int rbase = t * 16; const int bb = row_b(rbase);
        if (bb != curb) {
            const float* m = MOD + (size_t)bb * 12288; const float* g = F.in[I_N2G] + l * 2048; const float* shp = m + 3 * 2048; const float* scp = m + 4 * 2048;
            float* gw_ = GSB + (size_t)(nreb & 3) * 4096;
            __syncthreads();
            for (int k = F.tid; k < 2048; k += NTHR) { gw_[k] = g[k] * (scp[k] + 1.f); gw_[2048 + k] = shp[k]; }
            const float* rw = F.in[I_RTW] + (size_t)l * 2048 * 16; const int e0 = 4 * (F.tid & 3); f32x4 cacc = {0.f, 0.f, 0.f, 0.f};
#pragma unroll 1
            for (int it = 0; it < 16; it += 4) { f32x4 wv[4]; float gk[4], sk[4], hk[4];
#pragma unroll
                for (int u = 0; u < 4; ++u) { const int i4 = F.tid + NTHR * (it + u); const int k = i4 >> 2; wv[u] = *(const GAS f32x4*)(rw + 4 * (size_t)i4); gk[u] = g[k]; sk[u] = scp[k]; hk[u] = shp[k]; }
#pragma unroll
                for (int u = 0; u < 4; ++u) { const int k = (F.tid + NTHR * (it + u)) >> 2; const float gsk = gk[u] * (sk[u] + 1.f);
#pragma unroll
                    for (int c = 0; c < 4; ++c) { const float val = wv[u][c] * gsk; const unsigned short hi = (unsigned short)f2bf(val); const unsigned short lo = (unsigned short)f2bf(val - bf2f(hi));
                        Wh[(e0 + c) * WLD + k] = (bf16)hi; Wl[(e0 + c) * WLD + k] = (bf16)lo; }
                    cacc += wv[u] * hk[u]; } }
#pragma unroll
            for (int c = 0; c < 4; ++c) { float v_ = cacc[c]; v_ += dppmov<0x124>(v_); v_ += dppmov<0x128>(v_); cacc[c] = xrow_sum(v_); }
            if (F.lane < 4) {
#pragma unroll
                for (int c = 0; c < 4; ++c) red[F.wave * 16 + 4 * F.lane + c] = cacc[c]; }
            __syncthreads();
            if (F.tid < 16) { float c_ = 0.f;
#pragma unroll
                for (int ww = 0; ww < 8; ++ww) c_ += red[ww * 16 + F.tid];
                cb[F.tid] = c_; }
            __syncthreads();
            curb = bb; gsb = gw_; ++nreb; }
        f32x4 nx[8][2];
        if (t + 1 < t1) RT_LOAD(nx, t + 1);
        float ss = 0.f; f32x4 acc = {0.f, 0.f, 0.f, 0.f};
#pragma unroll
        for (int ks = 0; ks < 8; ++ks) { const f32x4 a = x[ks][0], b = x[ks][1];
            ss += (a[0] * a[0] + a[1] * a[1]) + (a[2] * a[2] + a[3] * a[3]) + (b[0] * b[0] + b[1] * b[1]) + (b[2] * b[2] + b[3] * b[3]);
            v4u h, lo_; h.x = pk2(a[0], a[1]); h.y = pk2(a[2], a[3]); h.z = pk2(b[0], b[1]); h.w = pk2(b[2], b[3]);
            lo_.x = pk2(a[0] - bflo(h.x), a[1] - bfhi(h.x)); lo_.y = pk2(a[2] - bflo(h.y), a[3] - bfhi(h.y)); lo_.z = pk2(b[0] - bflo(h.z), b[1] - bfhi(h.z)); lo_.w = pk2(b[2] - bflo(h.w), b[3] - bfhi(h.w));
            const bf16x8 ah = __builtin_bit_cast(bf16x8, h), al = __builtin_bit_cast(bf16x8, lo_);
            const bf16x8 bh = *(const LAS bf16x8*)(Wh + fr * WLD + colw + 32 * ks), bl = *(const LAS bf16x8*)(Wl + fr * WLD + colw + 32 * ks);
            acc = __builtin_amdgcn_mfma_f32_16x16x32_bf16(ah, bh, acc, 0, 0, 0); acc = __builtin_amdgcn_mfma_f32_16x16x32_bf16(al, bh, acc, 0, 0, 0); acc = __builtin_amdgcn_mfma_f32_16x16x32_bf16(ah, bl, acc, 0, 0, 0); }
        ss = xrow_sum(ss);
        if (fq == 0) ssq[F.wave * 16 + fr] = ss;
#pragma unroll
        for (int j = 0; j < 4; ++j) red[(F.wave * 16 + 4 * fq + j) * 16 + fr] = acc[j];
        __syncthreads();
        { float tot = 0.f;
#pragma unroll
          for (int ww = 0; ww < 8; ++ww) tot += ssq[ww * 16 + fr];
          const float rs = 1.f / sqrtf(tot * (1.f / 2048.f) + EPS);
          unsigned char* orow = A8 + (size_t)(rbase + fr) * D + colw;
#pragma unroll
          for (int ks = 0; ks < 8; ++ks) { const f32x4 g0 = *(const GAS f32x4*)(gsb + colw + 32 * ks), g1 = *(const GAS f32x4*)(gsb + colw + 32 * ks + 4), s0 = *(const GAS f32x4*)(gsb + 2048 + colw + 32 * ks), s1 = *(const GAS f32x4*)(gsb + 2048 + colw + 32 * ks + 4);
              const f32x4 o0 = (x[ks][0] * rs) * g0 + s0, o1 = (x[ks][1] * rs) * g1 + s1;
              v2u w8; w8.x = pk4_fp8(o0[0], o0[1], o0[2], o0[3]); w8.y = pk4_fp8(o1[0], o1[1], o1[2], o1[3]);
              *(GAS v2u*)(orow + 32 * ks) = w8; } }
        if (F.lane < 32) {
            const int row = 2 * F.wave + (F.lane >> 4), e = F.lane & 15; float lg = 0.f, tot = 0.f;
#pragma unroll
            for (int ww = 0; ww < 8; ++ww) { lg += red[(ww * 16 + row) * 16 + e]; tot += ssq[ww * 16 + row]; }
            lg = lg * (1.f / sqrtf(tot * (1.f / 2048.f) + EPS)) + cb[e];
            const float mx = row16_max(lg); const float ex = expf(lg - mx); const float se = row16_sum(ex);
            AFF[(size_t)e * M_ALL + rbase + row] = ex / se; SEL[(size_t)(rbase + row) * 16 + e] = -1; }
        __syncthreads();
#pragma unroll
        for (int ks = 0; ks < 8; ++ks) { x[ks][0] = nx[ks][0]; x[ks][1] = nx[ks][1]; }
    }
#undef RT_LOAD
    __syncthreads();
}
__device__ __forceinline__ void ph_topk(Frame& F, int nprob, int Me) {
    typedef unsigned long long u64; typedef u64 u64x2 __attribute__((ext_vector_type(2)));
    LAS u64* keys = (LAS u64*)(F.lds);
    const float* AFF = (const float*)(F.ws + WS_AFF); int* SEL = (int*)(F.ws + WS_SEL); float* GW = (float*)(F.ws + WS_GW);
    int* TOK = (int*)(F.ws + WS_TOK);
    const int nunits = 512 + (nprob - 128);
    for (int u = F.bid; u < nunits; u += F.G) {
        const bool lat = u < 512; const int q = lat ? (u >> 2) : (u - 512); const int part = lat ? (u & 3) : 0; const int b = q >> 4, e = q & 15;
        const int T = lat ? 2048 : 256, cap = lat ? 256 : 32, r0 = lat ? b * 2048 : M_LAT + b * 256;
        __syncthreads();
        for (int i = F.tid; i < T; i += NTHR) keys[i] = ((u64)__builtin_bit_cast(unsigned, AFF[(size_t)e * M_ALL + r0 + i]) << 32) | (u64)(0xFFFFFFFFu - (unsigned)i);
        __syncthreads();
        const int i = part * 512 + F.tid;
        if (i < T) { const u64 ki = keys[i]; int rank = 0;
#pragma unroll 8
            for (int j = 0; j < T; j += 2) { const u64x2 kj = *(const LAS u64x2*)(keys + j); rank += (kj.x > ki) ? 1 : 0; rank += (kj.y > ki) ? 1 : 0; }
            if (rank < cap) { const int slot = e * Me + (lat ? b * 256 + rank : 2048 + b * 32 + rank);
                GW[slot] = __builtin_bit_cast(float, (unsigned)(ki >> 32)); SEL[(size_t)(r0 + i) * 16 + e] = slot; TOK[slot] = r0 + i; } }
    }
    __syncthreads();
}
__device__ __forceinline__ void ph_gather(Frame& F, int nslots) {
    const int gw = F.bid * NWAVES + F.wave, NGW = F.G * NWAVES;
    const unsigned char* A = (const unsigned char*)(F.ws + WS_A); unsigned char* XS = (unsigned char*)(F.ws + WS_XS); const int* TOK = (const int*)(F.ws + WS_TOK);
    for (int s = gw; s < nslots; s += NGW) { const int r = TOK[s];
        const GAS v4u* src = (const GAS v4u*)(A + (size_t)r * D); GAS v4u* dst = (GAS v4u*)(XS + (size_t)s * D);
#pragma unroll
        for (int i = 0; i < 2; ++i) dst[F.lane + 64 * i] = src[F.lane + 64 * i]; }
}
template <int MODE> __device__ __forceinline__ void ph_combine(Frame& F, int l, int nrows) {
    const int gw = F.bid * NWAVES + F.wave, NGW = F.G * NWAVES;
    const float* MODl = (const float*)(F.ws + WS_MOD) + (size_t)l * 9 * 12288; const float* MODn = (const float*)(F.ws + WS_MOD) + (size_t)1 * 9 * 12288;
    float* H = (float*)(F.ws + WS_H); const bf16* YS = (const bf16*)(F.ws + WS_YS); const int* SEL = (const int*)(F.ws + WS_SEL); const float* GW = (const float*)(F.ws + WS_GW);
    bf16* A = (bf16*)(F.ws + WS_A);
    f32x4 v[8]; int sel = -1;
    if (gw < nrows) { load_row(H + (size_t)gw * D, F.lane, v); sel = SEL[(size_t)gw * 16 + (F.lane & 15)]; }
    for (int r = gw; r < nrows; r += NGW) { f32x4 nv[8]; int nsel = -1; const int rn = r + NGW;
        if (rn < nrows) { load_row(H + (size_t)rn * D, F.lane, nv); nsel = SEL[(size_t)rn * 16 + (F.lane & 15)]; }
        f32x4 acc[8];
#pragma unroll
        for (int i = 0; i < 8; ++i) acc[i] = (f32x4){0.f, 0.f, 0.f, 0.f};
        const float gsel = (sel >= 0) ? GW[sel] : 0.f;
        unsigned long long mask = __ballot(sel >= 0) & 0xffffull;
        while (mask) { const int e = __builtin_ctzll(mask); mask &= mask - 1;
            const int s = __shfl(sel, e); const float g = __shfl(gsel, e); const bf16* yr = YS + (size_t)s * D;
#pragma unroll
            for (int i = 0; i < 8; ++i) { const v2u w = *(const GAS v2u*)(yr + 4 * (F.lane + 64 * i));
                acc[i][0] += g * bflo(w.x); acc[i][1] += g * bfhi(w.x); acc[i][2] += g * bflo(w.y); acc[i][3] += g * bfhi(w.y); } }
        const float* m5 = MODl + (size_t)row_b(r) * 12288 + 5 * 2048;
#pragma unroll
        for (int i = 0; i < 8; ++i) { const f32x4 g5 = *(const GAS f32x4*)(m5 + 4 * (F.lane + 64 * i)); v[i] = v[i] + g5 * acc[i]; }
        const float rs = row_rstd(v);
        if (MODE == 0) {
#pragma unroll
            for (int i = 0; i < 8; ++i) *(GAS f32x4*)(H + (size_t)r * D + 4 * (F.lane + 64 * i)) = v[i];
            const float* m = MODn + (size_t)row_b(r) * 12288;
            modulate_store(v, rs, F.in[I_N1G] + 2048, m, m + 2048, A + (size_t)r * D, F.lane);
        } else {
#pragma unroll
            for (int i = 0; i < 8; ++i) { const int c = 4 * (F.lane + 64 * i); const f32x4 gg = *(const GAS f32x4*)(F.in[I_FING] + c);
                *(GAS f32x4*)(F.out + (size_t)r * D + c) = v[i] * rs * gg; }
        }
#pragma unroll
        for (int i = 0; i < 8; ++i) v[i] = nv[i];
        sel = nsel;
    }
}
__device__ __forceinline__ void ph_hy_shortconv(Frame& F) {
    const int gw = F.bid * NWAVES + F.wave, NGW = F.G * NWAVES;
    const bf16* P = (const bf16*)(F.ws + WS_P); bf16* XV = (bf16*)(F.ws + WS_XV);
    const float* cw = F.in[I_HCW]; const float* cb = F.in[I_HCB];
    for (int r = M_LAT + gw; r < M_ALL; r += NGW) {
        const int t = (r < M_LAT) ? (r & 2047) : ((r - M_LAT) & 255); const int L = (r < M_LAT) ? 2048 : 256;
        const bool hp = t > 0, hn = t < L - 1;
        for (int i = 0; i < 6; ++i) { const int c = 8 * (F.lane + 64 * i);
            const v4u z = {0u, 0u, 0u, 0u};
            const v4u a = hp ? *(const GAS v4u*)(P + (size_t)(r - 1) * LD0 + c) : z;
            const v4u b = *(const GAS v4u*)(P + (size_t)r * LD0 + c);
            const v4u d = hn ? *(const GAS v4u*)(P + (size_t)(r + 1) * LD0 + c) : z;
            float o[8];
#pragma unroll
            for (int q = 0; q < 4; ++q) { const int cc = c + 2 * q;
                o[2 * q] = cb[cc] + cw[cc] * bflo(a[q]) + cw[3072 + cc] * bflo(b[q]) + cw[6144 + cc] * bflo(d[q]);
                o[2 * q + 1] = cb[cc + 1] + cw[cc + 1] * bfhi(a[q]) + cw[3072 + cc + 1] * bfhi(b[q]) + cw[6144 + cc + 1] * bfhi(d[q]); }
            v4u w; w.x = pk2(o[0], o[1]); w.y = pk2(o[2], o[3]); w.z = pk2(o[4], o[5]); w.w = pk2(o[6], o[7]);
            *(GAS v4u*)(XV + (size_t)r * 3072 + c) = w; }
    }
}
__device__ __forceinline__ void ph_hy_longconv(Frame& F, int order) {
    const bf16* XV = (const bf16*)(F.ws + WS_XV); bf16* Z = (bf16*)(F.ws + WS_Z); bf16* Y = (bf16*)(F.ws + WS_Y);
    const bf16* U = (order == 0) ? XV + C0_V : Z; const int ldu = (order == 0) ? 3072 : 1024;
    const bf16* Gt = XV + ((order == 0) ? C0_X1 : C0_X2);
    bf16* O = (order == 0) ? Z : Y; const int ldo = (order == 0) ? 1024 : 2048;
    const float* skip = F.in[I_HBIAS] + order * 1024;
    for (int u = 2048 + F.bid; u < 2304; u += F.G) {
        const bool lat = u < 2048; const int q = lat ? u : u - 2048;
        int b, cbk, tb, L, r0;
        if (lat) { tb = q & 127; cbk = (q >> 7) & 1; b = q >> 8; L = 2048; r0 = b * 2048; } else { tb = q & 15; cbk = (q >> 4) & 1; b = q >> 5; L = 256; r0 = M_LAT + b * 256; }
        const float* FT = (const float*)(F.ws + (lat ? WS_FTL : WS_FTC)) + (size_t)order * (2 * L - 1) * 1024;
        const int c = cbk * 512 + F.tid, t0 = tb * 16;
        float acc[16];
#pragma unroll
        for (int a = 0; a < 16; ++a) acc[a] = 0.f;
        for (int s0 = 0; s0 < L; s0 += 16) {
            float uu[16], ff[31];
#pragma unroll
            for (int i = 0; i < 16; ++i) uu[i] = bf2f(U[(size_t)(r0 + s0 + i) * ldu + c]);
            const int base = t0 - s0 + L - 1 - 15;
#pragma unroll
            for (int j = 0; j < 31; ++j) ff[j] = FT[(size_t)(base + j) * 1024 + c];
#pragma unroll
            for (int a = 0; a < 16; ++a)
#pragma unroll
                for (int i = 0; i < 16; ++i) acc[a] += ff[a - i + 15] * uu[i];
        }
        const float sk = skip[c];
#pragma unroll
        for (int a = 0; a < 16; ++a) { const size_t r = (size_t)(r0 + t0 + a);
            const float uv = bf2f(U[r * ldu + c]), g = bf2f(Gt[r * 3072 + c]);
            O[r * ldo + c] = (bf16)f2bf(g * (acc[a] + sk * uv)); }
    }
}
__device__ __forceinline__ int scan_row(int b, int dir, int n) {
    if (n < 256) { const int tc = dir ? 255 - n : n; return M_LAT + b * 256 + tc; }
    const int tl = n - 256; const int t = dir ? 2047 - tl : tl; return b * 2048 + t;
}
__device__ __forceinline__ void ph_gla_scan(Frame& F) {
    LAS float* W2s = (LAS float*)(F.lds);
    LAS float* gbs = W2s + 2048;
    LAS float* cds = gbs + 128;
    LAS float* as_ = cds + 256;
    LAS float* ks = as_ + 2048;
    LAS float* qs = ks + 2048;
    LAS float* vs_ = qs + 2048;
    LAS float* red = vs_ + 1024;
    const bf16* P = (const bf16*)(F.ws + WS_P); float* OG = (float*)(F.ws + WS_OG);
    for (int u = F.bid; u < 256; u += F.G) {
        const int vsl = u & 3, dir = (u >> 2) & 1, h = (u >> 3) & 3, b = u >> 5;
        const int v = F.tid & 63, kg = F.tid >> 6;
        __syncthreads();
        for (int i = F.tid; i < 2048; i += NTHR) W2s[i] = F.in[I_GGW2][(size_t)(dir * 16 + (i >> 7)) * 512 + h * 128 + (i & 127)];
        if (F.tid < 128) gbs[F.tid] = F.in[I_GGB][dir * 512 + h * 128 + F.tid];
        float S[16];
#pragma unroll
        for (int j = 0; j < 16; ++j) S[j] = 0.f;
        for (int n0 = 0; n0 < 2304; n0 += 16) {
            __syncthreads();
            if (F.tid < 256) { const int tk = F.tid >> 4, rr = F.tid & 15; const int row = scan_row(b, dir, n0 + tk); cds[F.tid] = bf2f(P[(size_t)row * LD0 + C0_CODE + dir * 16 + rr]); }
            for (int i = F.tid; i < 1024; i += NTHR) { const int tk = i >> 6, vx = i & 63; const int row = scan_row(b, dir, n0 + tk); vs_[i] = bf2f(P[(size_t)row * LD0 + C0_GV + h * 256 + vsl * 64 + vx]); }
            __syncthreads();
            for (int i = F.tid; i < 2048; i += NTHR) { const int tk = i >> 7, kx = i & 127; const int row = scan_row(b, dir, n0 + tk);
                qs[i] = bf2f(P[(size_t)row * LD0 + C0_GQ + h * 128 + kx]) * 0.08838834764831845f;
                ks[i] = bf2f(P[(size_t)row * LD0 + C0_GK + h * 128 + kx]);
                float lg = gbs[kx];
#pragma unroll
                for (int rr = 0; rr < 16; ++rr) lg += cds[tk * 16 + rr] * W2s[rr * 128 + kx];
                as_[i] = __expf(logsigmoidf_(lg) * (1.f / 16.f)); }
            __syncthreads();
            for (int tk = 0; tk < 16; ++tk) {
                const float vv = vs_[tk * 64 + v]; float part = 0.f;
#pragma unroll
                for (int j = 0; j < 16; ++j) { const int k = tk * 128 + kg * 16 + j; S[j] = as_[k] * S[j] + ks[k] * vv; part += qs[k] * S[j]; }
                red[((tk & 1) * 8 + kg) * 64 + v] = part;
                __syncthreads();
                if (kg == 0) { float o = 0.f;
#pragma unroll
                    for (int g = 0; g < 8; ++g) o += red[((tk & 1) * 8 + g) * 64 + v];
                    const int row = scan_row(b, dir, n0 + tk);
                    OG[((size_t)dir * M_ALL + row) * 1024 + h * 256 + vsl * 64 + v] = o; }
            }
        }
    }
    __syncthreads();
}
template <int ACT> __device__ __forceinline__ void ph_mix_combine(Frame& F, int nrows, const bf16* O0, const bf16* O1, const bf16* P, int ldp, int gcol, const float* ng, int ycol) {
    const int gw = F.bid * NWAVES + F.wave, NGW = F.G * NWAVES;
    bf16* Y = (bf16*)(F.ws + WS_Y);
    for (int r = gw; r < nrows; r += NGW) {
#pragma unroll
        for (int h = 0; h < 4; ++h) { const int c = h * 256 + 4 * F.lane;
            const v2u a = *(const GAS v2u*)(O0 + (size_t)r * 1024 + c), b2 = *(const GAS v2u*)(O1 + (size_t)r * 1024 + c);
            const f32x4 o = {bflo(a.x) + bflo(b2.x), bfhi(a.x) + bfhi(b2.x), bflo(a.y) + bflo(b2.y), bfhi(a.y) + bfhi(b2.y)};
            const float ss = wave_sum((o[0] * o[0] + o[1] * o[1]) + (o[2] * o[2] + o[3] * o[3]));
            const float rs = 1.f / sqrtf(ss * (1.f / 256.f) + EPS);
            const f32x4 gg = *(const GAS f32x4*)(ng + 4 * F.lane);
            const v2u gw2 = *(const GAS v2u*)(P + (size_t)r * ldp + gcol + c);
            float gt[4] = {bflo(gw2.x), bfhi(gw2.x), bflo(gw2.y), bfhi(gw2.y)};
            float y[4];
#pragma unroll
            for (int q = 0; q < 4; ++q) y[q] = o[q] * rs * gg[q] * (ACT == 0 ? siluf(gt[q]) : sigmoidf_(gt[q]));
            v2u w; w.x = pk2(y[0], y[1]); w.y = pk2(y[2], y[3]);
            *(GAS v2u*)(Y + (size_t)r * D + ycol + c) = w; }
    }
}
__device__ __forceinline__ void ph_ml_scan(Frame& F) {
    LAS float* qs = (LAS float*)(F.lds);
    LAS float* ks = qs + 2048;
    LAS float* vs_ = ks + 2048;
    LAS float* gts = vs_ + 512;
    LAS float* red = gts + 16;
    LAS float* redd = red + 1024;
    const bf16* P = (const bf16*)(F.ws + WS_P); float* OM = (float*)(F.ws + WS_OG);
    const float* cw = F.in[I_MCW]; const float* cb = F.in[I_MCB];
    for (int u = F.bid; u < 256; u += F.G) {
        const int vsl = u & 3, dir = (u >> 2) & 1, h = (u >> 3) & 3, b = u >> 5;
        const int v = F.tid & 63, kg = F.tid >> 6;
        float C[32], nn[32]; float m = 0.f;
#pragma unroll
        for (int j = 0; j < 32; ++j) { C[j] = 0.f; nn[j] = 0.f; }
        const float igb = F.in[I_MIGB][dir * 4 + h], fgb = F.in[I_MFGB][dir * 4 + h];
        for (int n0 = 0; n0 < 2304; n0 += 8) {
            __syncthreads();
            for (int i = F.tid; i < 4096; i += NTHR) { const int tk = i >> 9, col = i & 511; const int row = scan_row(b, dir, n0 + tk);
                const int pc = (col < 256) ? (h * 256 + col) : (1024 + h * 256 + (col - 256));
                const int t = (row < M_LAT) ? (row & 2047) : ((row - M_LAT) & 255); const int L = (row < M_LAT) ? 2048 : 256;
                float a = cb[pc] + cw[2048 + pc] * bf2f(P[(size_t)row * LD1 + pc]);
                if (t > 0) a += cw[pc] * bf2f(P[(size_t)(row - 1) * LD1 + pc]);
                if (t < L - 1) a += cw[4096 + pc] * bf2f(P[(size_t)(row + 1) * LD1 + pc]);
                a = siluf(a);
                if (col < 256) qs[tk * 256 + col] = a; else ks[tk * 256 + col - 256] = a * 0.0625f; }
            { const int tk = F.tid >> 6, vx = F.tid & 63; const int row = scan_row(b, dir, n0 + tk); vs_[F.tid] = bf2f(P[(size_t)row * LD1 + C1_MV + h * 256 + vsl * 64 + vx]); }
            if (F.tid < 8) { const int row = scan_row(b, dir, n0 + F.tid);
                gts[F.tid * 2 + 0] = bf2f(P[(size_t)row * LD1 + C1_G + dir * 8 + h]) + igb;
                gts[F.tid * 2 + 1] = logsigmoidf_(bf2f(P[(size_t)row * LD1 + C1_G + dir * 8 + 4 + h]) + fgb); }
            __syncthreads();
            for (int tk = 0; tk < 8; ++tk) {
                const float ig = gts[tk * 2], lf = gts[tk * 2 + 1];
                const float mn = fmaxf(lf + m, ig); const float fk = __expf(lf + m - mn), ik = __expf(ig - mn); m = mn;
                const float vv = vs_[tk * 64 + v] * ik; float part = 0.f, dpart = 0.f;
#pragma unroll
                for (int j = 0; j < 32; ++j) { const int k = tk * 256 + kg * 32 + j; const float kv = ks[k], qv = qs[k];
                    C[j] = fk * C[j] + vv * kv; nn[j] = fk * nn[j] + ik * kv; part += C[j] * qv; dpart += nn[j] * qv; }
                red[((tk & 1) * 8 + kg) * 64 + v] = part; if (v == 0) redd[(tk & 1) * 8 + kg] = dpart;
                __syncthreads();
                if (kg == 0 && n0 >= 256) { float num = 0.f, den = 0.f;
#pragma unroll
                    for (int g = 0; g < 8; ++g) { num += red[((tk & 1) * 8 + g) * 64 + v]; den += redd[(tk & 1) * 8 + g]; }
                    const int row = scan_row(b, dir, n0 + tk);
                    OM[((size_t)dir * M_LAT + row) * 1024 + h * 256 + vsl * 64 + v] = num / fmaxf(fabsf(den), __expf(-m)); }
            }
        }
    }
    __syncthreads();
}
__device__ __forceinline__ void ph_da_rope(Frame& F) {
    const int gw = F.bid * NWAVES + F.wave, NGW = F.G * NWAVES;
    bf16* P = (bf16*)(F.ws + WS_P);
    for (int r = gw; r < M_LAT; r += NGW) { const int t = r & 2047;
        for (int i = 0; i < 16; ++i) { const int pi = F.lane + 64 * i; const int which = pi >> 9, vec = (pi >> 5) & 15, axis = (pi >> 4) & 1, f = pi & 15;
            const int col = (which ? C1_DK : C1_DQ) + vec * 64 + axis * 32 + f;
            const float pos = (float)(axis ? (t & 63) : (t >> 6));
            const float inv = exp2f(-(float)f * (13.287712379549449f / 16.f));
            const float ang = pos * inv; const float cs = cosf(ang), sn = sinf(ang);
            const float xa = bf2f(P[(size_t)r * LD1 + col]), xb = bf2f(P[(size_t)r * LD1 + col + 16]);
            const float sc = which ? 1.f : 0.18033688011112042f;
            P[(size_t)r * LD1 + col] = (bf16)f2bf((xa * cs - xb * sn) * sc); P[(size_t)r * LD1 + col + 16] = (bf16)f2bf((xb * cs + xa * sn) * sc); }
    }
}
__device__ __forceinline__ void ph_da_attn(Frame& F) {
    constexpr int KS_LD = 136, VT_LD = 72, PW_LD = 72;
    LAS bf16* Ks = (LAS bf16*)(F.lds);
    LAS bf16* VT = Ks + 64 * KS_LD;
    LAS bf16* Pw = VT + 128 * VT_LD + (F.wave * 2) * 16 * PW_LD;
    const bf16* P = (const bf16*)(F.ws + WS_P); bf16* Y = (bf16*)(F.ws + WS_Y);
    const float lam_init = 0.35550906759096927f;
    float lam;
    { const float* lv = F.in[I_DLAM]; float s01 = 0.f, s23 = 0.f; for (int i = 0; i < 64; ++i) { s01 += lv[i] * lv[64 + i]; s23 += lv[128 + i] * lv[192 + i]; } lam = expf(s01) - expf(s23) + lam_init; }
    const int fr = F.lane & 15, fq = F.lane >> 4;
    for (int u = F.bid; u < 1024; u += F.G) {
        const int qb = u & 15, h = (u >> 4) & 7, b = u >> 7;
        const int qrow0 = b * 2048 + qb * 128 + F.wave * 16;
        bf16x8 qf[2][2];
#pragma unroll
        for (int c = 0; c < 2; ++c)
#pragma unroll
            for (int ks = 0; ks < 2; ++ks) qf[c][ks] = *(const GAS bf16x8*)(P + (size_t)(qrow0 + fr) * LD1 + C1_DQ + h * 128 + c * 64 + ks * 32 + 8 * fq);
        f32x4 Oa[2][8]; float mrun[2][4], lrun[2][4];
#pragma unroll
        for (int c = 0; c < 2; ++c) {
#pragma unroll
            for (int vt = 0; vt < 8; ++vt) Oa[c][vt] = (f32x4){0.f, 0.f, 0.f, 0.f};
#pragma unroll
            for (int j = 0; j < 4; ++j) { mrun[c][j] = -1e30f; lrun[c][j] = 0.f; } }
        for (int kt = 0; kt < 36; ++kt) {
            __syncthreads();
#pragma unroll
            for (int i = 0; i < 2; ++i) { const int id = F.tid + 512 * i; const int key = id >> 4, ch = id & 15; const int kk = kt * 64 + key;
                const size_t krow = (kk < 256) ? (size_t)(M_LAT + b * 256 + kk) : (size_t)(b * 2048 + kk - 256);
                const v4u kv = *(const GAS v4u*)(P + krow * LD1 + C1_DK + h * 128 + ch * 8);
                *(LAS v4u*)(Ks + key * KS_LD + ch * 8) = kv;
                const v4u vv = *(const GAS v4u*)(P + krow * LD1 + C1_DV + h * 128 + ch * 8);
#pragma unroll
                for (int q = 0; q < 4; ++q) { VT[(ch * 8 + 2 * q) * VT_LD + key] = (bf16)(vv[q] & 0xffffu); VT[(ch * 8 + 2 * q + 1) * VT_LD + key] = (bf16)(vv[q] >> 16); } }
            __syncthreads();
#pragma unroll
            for (int c = 0; c < 2; ++c) {
                f32x4 S[4];
#pragma unroll
                for (int nt = 0; nt < 4; ++nt) { f32x4 a = {0.f, 0.f, 0.f, 0.f};
#pragma unroll
                    for (int ks = 0; ks < 2; ++ks) { const bf16x8 bf = *(const LAS bf16x8*)(Ks + (nt * 16 + fr) * KS_LD + c * 64 + ks * 32 + 8 * fq); a = __builtin_amdgcn_mfma_f32_16x16x32_bf16(qf[c][ks], bf, a, 0, 0, 0); }
                    S[nt] = a; }
#pragma unroll
                for (int j = 0; j < 4; ++j) {
                    float mx = fmaxf(fmaxf(S[0][j], S[1][j]), fmaxf(S[2][j], S[3][j])); mx = grp16_max(mx);
                    const float mn = fmaxf(mrun[c][j], mx); const float alpha = __expf(mrun[c][j] - mn); mrun[c][j] = mn;
                    float rsum = 0.f;
#pragma unroll
                    for (int nt = 0; nt < 4; ++nt) { const float p = __expf(S[nt][j] - mn); rsum += p; Pw[(c * 16 + 4 * fq + j) * PW_LD + nt * 16 + fr] = (bf16)f2bf(p); }
                    rsum = grp16_sum(rsum); lrun[c][j] = lrun[c][j] * alpha + rsum;
#pragma unroll
                    for (int vt = 0; vt < 8; ++vt) Oa[c][vt][j] *= alpha; }
            }
            __syncthreads();
#pragma unroll
            for (int c = 0; c < 2; ++c)
#pragma unroll
                for (int ks = 0; ks < 2; ++ks) { const bf16x8 af = *(const LAS bf16x8*)(Pw + (c * 16 + fr) * PW_LD + ks * 32 + 8 * fq);
#pragma unroll
                    for (int vt = 0; vt < 8; ++vt) { const bf16x8 bf = *(const LAS bf16x8*)(VT + (vt * 16 + fr) * VT_LD + ks * 32 + 8 * fq); Oa[c][vt] = __builtin_amdgcn_mfma_f32_16x16x32_bf16(af, bf, Oa[c][vt], 0, 0, 0); } }
        }
#pragma unroll
        for (int j = 0; j < 4; ++j) { const float i0 = 1.f / lrun[0][j], i1 = lam / lrun[1][j]; float o[8]; float ss = 0.f;
#pragma unroll
            for (int vt = 0; vt < 8; ++vt) { o[vt] = Oa[0][vt][j] * i0 - Oa[1][vt][j] * i1; ss += o[vt] * o[vt]; }
            ss = grp16_sum(ss); const float rs = (1.f - lam_init) / sqrtf(ss * (1.f / 128.f) + EPS);
#pragma unroll
            for (int vt = 0; vt < 8; ++vt) Y[(size_t)(qrow0 + 4 * fq + j) * D + 1024 + h * 128 + vt * 16 + fr] = (bf16)f2bf(o[vt] * rs * F.in[I_DNG][vt * 16 + fr]); }
    }
    __syncthreads();
}
__device__ __forceinline__ void ph_hy_prep_lat(Frame& F) {
    LAS bf16* raw = (LAS bf16*)(F.lds);
    const bf16* P = (const bf16*)(F.ws + WS_P); bf16* XT = (bf16*)(F.ws + WS_XT);
    const float* cw = F.in[I_HCW]; const float* cbias = F.in[I_HCB];
    for (int u = F.bid; u < 12288; u += F.G) {
        const int cb = u & 15, tb = (u >> 4) & 31, b = (u >> 9) & 7, which = u >> 12;
        const int c0 = which * 1024 + cb * 64, t0 = tb * 64;
        __syncthreads();
        for (int id = F.tid; id < 528; id += NTHR) { const int rr = id >> 3, ch = id & 7; const int t = t0 - 1 + rr; v4u val = {0u, 0u, 0u, 0u};
            if (t >= 0 && t < 2048) val = *(const GAS v4u*)(P + (size_t)(b * 2048 + t) * LD0 + c0 + ch * 8);
            *(LAS v4u*)(raw + rr * 72 + ch * 8) = val; }
        __syncthreads();
        const int cc = F.tid & 63, tg = F.tid >> 6, c = c0 + cc;
        const float w0 = cw[c], w1 = cw[3072 + c], w2 = cw[6144 + c], bs = cbias[c];
        float o[8];
#pragma unroll
        for (int i = 0; i < 8; ++i) { const int tt = tg * 8 + i; o[i] = bs + w0 * bf2f(raw[tt * 72 + cc]) + w1 * bf2f(raw[(tt + 1) * 72 + cc]) + w2 * bf2f(raw[(tt + 2) * 72 + cc]); }
        v4u w; w.x = pk2(o[0], o[1]); w.y = pk2(o[2], o[3]); w.z = pk2(o[4], o[5]); w.w = pk2(o[6], o[7]);
        *(GAS v4u*)(XT + ((size_t)c * 8 + b) * 2048 + t0 + tg * 8) = w;
    }
    __syncthreads();
}
__device__ __forceinline__ void ph_hy_post_lat(Frame& F) {
    LAS bf16* tile = (LAS bf16*)(F.lds);
    const bf16* YT = (const bf16*)(F.ws + WS_YT); bf16* Y = (bf16*)(F.ws + WS_Y);
    for (int u = F.bid; u < 4096; u += F.G) { const int cb = u & 15, tb = (u >> 4) & 31, b = u >> 9;
        __syncthreads();
        { const int cc = F.tid >> 3, ch = F.tid & 7;
          *(LAS v4u*)(tile + cc * 72 + ch * 8) = *(const GAS v4u*)(YT + ((size_t)(cb * 64 + cc) * 8 + b) * 2048 + tb * 64 + ch * 8); }
        __syncthreads();
        { const int t = F.tid >> 3, ch = F.tid & 7; unsigned short e[8];
#pragma unroll
          for (int i = 0; i < 8; ++i) e[i] = tile[(ch * 8 + i) * 72 + t];
          v4u w; w.x = e[0] | ((unsigned)e[1] << 16); w.y = e[2] | ((unsigned)e[3] << 16); w.z = e[4] | ((unsigned)e[5] << 16); w.w = e[6] | ((unsigned)e[7] << 16);
          *(GAS v4u*)(Y + (size_t)(b * 2048 + tb * 64 + t) * D + cb * 64 + ch * 8) = w; }
    }
    __syncthreads();
}
__device__ __forceinline__ void ph_hy_ftt(Frame& F) {
    LAS float* tile = (LAS float*)(F.lds);
    const float* FTL = (const float*)(F.ws + WS_FTL); bf16* FTT = (bf16*)(F.ws + WS_FTT);
    for (int u = F.bid; u < 2 * 65 * 16; u += F.G) { const int cb = u & 15; const int rb = (u >> 4) % 65; const int o = (u >> 4) / 65;
        __syncthreads();
        for (int i = F.tid; i < 4096; i += NTHR) { const int rr = i >> 6, cc = i & 63; const int r = rb * 64 + rr; const int idx = 4127 - r;
            tile[rr * 65 + cc] = (idx >= 0 && idx <= 4094) ? FTL[((size_t)o * 4095 + idx) * 1024 + cb * 64 + cc] : 0.f; }
        __syncthreads();
        { const int cc = F.tid >> 3, ch = F.tid & 7; float e[8];
#pragma unroll
          for (int i = 0; i < 8; ++i) e[i] = tile[(ch * 8 + i) * 65 + cc];
          v4u w; w.x = pk2(e[0], e[1]); w.y = pk2(e[2], e[3]); w.z = pk2(e[4], e[5]); w.w = pk2(e[6], e[7]);
          *(GAS v4u*)(FTT + ((size_t)o * 1024 + cb * 64 + cc) * 4160 + rb * 64 + ch * 8) = w; }
    }
    __syncthreads();
}
constexpr int HY_XOFF = 2080, HY_RLEN = 4160, HY_KOFF = 32, HY_UROWB = 4192, HY_UCOPYB = 33600, HY_UOFF = 2 * HY_RLEN * 2;
__device__ __forceinline__ void hy_conv_loop(const LAS bf16* Rp, const LAS unsigned* Ud, int wave, int fr, int fq, f32x4 (&acc)[2][4]) {
    const int dl = fr & 7, s = dl & 1;
    const LAS bf16* ap = Rp + 2048 + 8 * fq - 8 * (32 * wave + fr);
    const LAS unsigned* up = Ud + s * (HY_UCOPYB / 4) + (fr >> 3) * (HY_UROWB / 4) + 4 * fq + ((dl - s) >> 1);
#pragma unroll 1
    for (int K0 = 0; K0 < 65; ++K0) {
        bf16x8 af[2];
#pragma unroll
        for (int mt = 0; mt < 2; ++mt) af[mt] = *(const LAS bf16x8*)(ap + 32 * K0 - 128 * mt);
        bf16x8 bfv[4];
#pragma unroll
        for (int nt = 0; nt < 4; ++nt) { const LAS unsigned* q = up + nt * 2 * (HY_UROWB / 4) + 16 * K0; v4u w; w.x = q[0]; w.y = q[1]; w.z = q[2]; w.w = q[3]; bfv[nt] = __builtin_bit_cast(bf16x8, w); }
#pragma unroll
        for (int mt = 0; mt < 2; ++mt)
#pragma unroll
            for (int nt = 0; nt < 4; ++nt) acc[mt][nt] = __builtin_amdgcn_mfma_f32_16x16x32_bf16(af[mt], bfv[nt], acc[mt][nt], 0, 0, 0);
    }
}
__device__ __forceinline__ void ph_hy_conv_lat(Frame& F) {
    LAS bf16* R = (LAS bf16*)(F.lds);
    LAS unsigned char* Ub = F.lds + HY_UOFF;
    LAS bf16* Gs = (LAS bf16*)(F.lds + HY_UOFF + 2 * HY_UCOPYB);
    const bf16* XT = (const bf16*)(F.ws + WS_XT); bf16* YT = (bf16*)(F.ws + WS_YT);
    const bf16* FTT = (const bf16*)(F.ws + WS_FTT);
    const int fr = F.lane & 15, fq = F.lane >> 4;
    for (int c = F.bid; c < 1024; c += F.G) {
        const bf16* X1 = XT + (size_t)c * 8 * 2048; const bf16* X2 = XT + ((size_t)1024 + c) * 8 * 2048; const bf16* XV_ = XT + ((size_t)2048 + c) * 8 * 2048;
        __syncthreads();
        for (int i = F.tid; i < (2 * HY_UCOPYB) / 16; i += NTHR) *(LAS v4u*)(Ub + i * 16) = (v4u){0u, 0u, 0u, 0u};
        for (int i = F.tid; i < 2 * HY_RLEN / 8; i += NTHR) { const int o = (i >= HY_RLEN / 8) ? 1 : 0; const int q = i - o * (HY_RLEN / 8);
            *(LAS v4u*)(R + o * HY_RLEN + q * 8) = *(const GAS v4u*)(FTT + ((size_t)o * 1024 + c) * 4160 + q * 8); }
        for (int i = F.tid; i < 2048; i += NTHR) { const int b = i >> 8, ch = i & 255; *(LAS v4u*)(Gs + b * 2048 + ch * 8) = *(const GAS v4u*)(X1 + (size_t)b * 2048 + ch * 8); }
        __syncthreads();
        for (int i = F.tid; i < 2048; i += NTHR) { const int b = i >> 8, ch = i & 255, t0 = ch * 8; const v4u val = *(const GAS v4u*)(XV_ + (size_t)b * 2048 + t0);
            *(LAS v4u*)(Ub + b * HY_UROWB + (HY_KOFF + t0) * 2) = val;
            LAS bf16* c1 = (LAS bf16*)(Ub + HY_UCOPYB + b * HY_UROWB) + HY_KOFF + t0 - 1;
#pragma unroll
            for (int q = 0; q < 4; ++q) { c1[2 * q] = (bf16)(val[q] & 0xffffu); c1[2 * q + 1] = (bf16)(val[q] >> 16); } }
        __syncthreads();
#pragma unroll 1
        for (int order = 0; order < 2; ++order) {
            f32x4 acc[2][4];
#pragma unroll
            for (int mt = 0; mt < 2; ++mt)
#pragma unroll
                for (int nt = 0; nt < 4; ++nt) acc[mt][nt] = (f32x4){0.f, 0.f, 0.f, 0.f};
            v4u gpre[4];
            if (order == 0) {
#pragma unroll
                for (int x = 0; x < 4; ++x) { const int i = F.tid + NTHR * x; gpre[x] = *(const GAS v4u*)(X2 + (size_t)(i >> 8) * 2048 + (i & 255) * 8); } }
            hy_conv_loop(R + order * HY_RLEN, (const LAS unsigned*)Ub, F.wave, fr, fq, acc);
            __syncthreads();
            const float sk = F.in[I_HBIAS][order * 1024 + c];
#pragma unroll
            for (int mt = 0; mt < 2; ++mt)
#pragma unroll
                for (int nt = 0; nt < 4; ++nt)
#pragma unroll
                    for (int j = 0; j < 4; ++j) { const int m = 32 * F.wave + 16 * mt + 4 * fq + j; const int b = 2 * nt + (fr >> 3); const int t = 8 * m + (fr & 7);
                        LAS bf16* u0 = (LAS bf16*)(Ub + b * HY_UROWB) + HY_KOFF + t; LAS bf16* u1 = (LAS bf16*)(Ub + HY_UCOPYB + b * HY_UROWB) + HY_KOFF + t;
                        const float uv = bf2f(*u0), g = bf2f(Gs[b * 2048 + t]);
                        const bf16 r = (bf16)f2bf(g * (acc[mt][nt][j] + sk * uv));
                        if (order == 0) { *u0 = r; u1[-1] = r; } else { *u1 = r; } }
            __syncthreads();
            if (order == 0) {
#pragma unroll
                for (int x = 0; x < 4; ++x) { const int i = F.tid + NTHR * x; *(LAS v4u*)(Gs + (i >> 8) * 2048 + (i & 255) * 8) = gpre[x]; } }
        }
        for (int i = F.tid; i < 2048; i += NTHR) { const int b = i >> 8, ch = i & 255;
            *(GAS v4u*)(YT + ((size_t)c * 8 + b) * 2048 + ch * 8) = *(const LAS v4u*)(Ub + HY_UCOPYB + b * HY_UROWB + (HY_KOFF + ch * 8) * 2); }
    }
    __syncthreads();
}
__device__ __forceinline__ void ph_ml_prep(Frame& F) {
    const bf16* P = (const bf16*)(F.ws + WS_P); bf16* MQK = (bf16*)(F.ws + WS_MQK); float* MLS = (float*)(F.ws + WS_MLS); float* KEEP = MLS + (size_t)64 * 36 * 320;
    const int gw = F.bid * NWAVES + F.wave, NGW = F.G * NWAVES;
    if (gw < 64) {
        const int sq = gw, dir = sq & 1, h = (sq >> 1) & 3, b = sq >> 3; const int i = F.lane;
        const float igb = F.in[I_MIGB][dir * 4 + h], fgb = F.in[I_MFGB][dir * 4 + h]; float mrun = 0.f;
        for (int c = 0; c < 36; ++c) { const int row = scan_row(b, dir, 64 * c + i);
            const float ig = bf2f(P[(size_t)row * LD1 + C1_G + dir * 8 + h]) + igb;
            const float lf = logsigmoidf_(bf2f(P[(size_t)row * LD1 + C1_G + dir * 8 + 4 + h]) + fgb);
            const float bi = wave_incl_sum(lf, i); const float blast = __shfl(bi, 63);
            const float wend = blast - bi + ig; const float mnew = fmaxf(blast + mrun, wave_max(wend));
            const float keep = __expf(blast + mrun - mnew); const float wi = __expf(wend - mnew);
            const float ai = bi + mrun; const float colv = ig - bi; const float pm = wave_incl_max(colv, i); const float mt = fmaxf(ai, bi + pm);
            float* o = MLS + ((size_t)sq * 36 + c) * 320 + i;
            o[0] = wi; o[64] = bi - mt; o[128] = colv; o[192] = __expf(ai - mt); o[256] = __expf(-mt); if (i == 0) KEEP[sq * 36 + c] = keep;
            mrun = mnew; }
    }
    const float* cw = F.in[I_MCW]; const float* cbias = F.in[I_MCB];
    const bool scanw = (NGW > 128) && (gw < 64);
    const int cgw = (NGW > 128) ? gw - 64 : gw, CNGW = (NGW > 128) ? NGW - 64 : NGW;
    f32x4 w0[4][2], w1[4][2], w2[4][2], bs[4][2];
    if (!scanw) {
#pragma unroll
        for (int i = 0; i < 4; ++i)
#pragma unroll
            for (int hh = 0; hh < 2; ++hh) { const int c = 8 * (F.lane + 64 * i) + 4 * hh;
                w0[i][hh] = *(const GAS f32x4*)(cw + c); w1[i][hh] = *(const GAS f32x4*)(cw + 2048 + c); w2[i][hh] = *(const GAS f32x4*)(cw + 4096 + c); bs[i][hh] = *(const GAS f32x4*)(cbias + c); } }
    for (int r = scanw ? M_ALL : cgw; r < M_ALL; r += CNGW) {
        const int t = (r < M_LAT) ? (r & 2047) : ((r - M_LAT) & 255); const int L = (r < M_LAT) ? 2048 : 256; const bool hp = t > 0, hn = t < L - 1;
#pragma unroll
        for (int i = 0; i < 4; ++i) { const int c = 8 * (F.lane + 64 * i); const v4u z = {0u, 0u, 0u, 0u};
            const v4u a = hp ? *(const GAS v4u*)(P + (size_t)(r - 1) * LD1 + c) : z; const v4u b2 = *(const GAS v4u*)(P + (size_t)r * LD1 + c); const v4u d = hn ? *(const GAS v4u*)(P + (size_t)(r + 1) * LD1 + c) : z;
            const float ksc = (c < 1024) ? 1.f : 0.0625f; float o[8];
#pragma unroll
            for (int q = 0; q < 4; ++q) { const int hh = q >> 1, e0 = 2 * (q & 1);
                o[2 * q] = siluf(bs[i][hh][e0] + w0[i][hh][e0] * bflo(a[q]) + w1[i][hh][e0] * bflo(b2[q]) + w2[i][hh][e0] * bflo(d[q])) * ksc;
                o[2 * q + 1] = siluf(bs[i][hh][e0 + 1] + w0[i][hh][e0 + 1] * bfhi(a[q]) + w1[i][hh][e0 + 1] * bfhi(b2[q]) + w2[i][hh][e0 + 1] * bfhi(d[q])) * ksc; }
            v4u w; w.x = pk2(o[0], o[1]); w.y = pk2(o[2], o[3]); w.z = pk2(o[4], o[5]); w.w = pk2(o[6], o[7]);
            *(GAS v4u*)(MQK + (size_t)r * 2048 + c) = w; }
    }
}
__device__ __forceinline__ void ph_ml_scan2(Frame& F) {
    constexpr int QLD = 272, VLD = 88, SLD = 72;
    LAS bf16* Qn = (LAS bf16*)(F.lds); LAS bf16* Kn = Qn + 64 * QLD; LAS bf16* Cb = Kn + 64 * QLD; LAS bf16* Vn = Cb + 80 * QLD; LAS bf16* VWn = Vn + 64 * VLD; LAS bf16* SC = VWn + 64 * VLD;
    LAS float* sS = (LAS float*)(SC + 64 * SLD);
    LAS float* sW = sS; LAS float* sRow = sS + 64; LAS float* sCol = sS + 128; LAS float* sAw = sS + 192; LAS float* sEinv = sS + 256;
    const bf16* P = (const bf16*)(F.ws + WS_P); float* OM = (float*)(F.ws + WS_OG);
    const bf16* MQK = (const bf16*)(F.ws + WS_MQK); const float* MLS = (const float*)(F.ws + WS_MLS); const float* KEEP = MLS + (size_t)64 * 36 * 320;
    const int fr = F.lane & 15, fq = F.lane >> 4;
    for (int u0 = F.bid; u0 < 256; u0 += F.G) {
        const int u = (F.G == 256) ? ((((u0 & 7) * 8 + (u0 >> 5)) << 2) | ((u0 >> 3) & 3)) : u0;
        const int vsl = u & 3, dir = (u >> 2) & 1, h = (u >> 3) & 3, b = u >> 5; const int sq = (b * 4 + h) * 2 + dir; const int sgn = dir ? -1 : 1;
        __syncthreads();
        for (int i = F.tid; i < (80 * QLD + 2 * 64 * VLD) / 8; i += NTHR) *(LAS v4u*)(Cb + i * 8) = (v4u){0u, 0u, 0u, 0u};
        __syncthreads();
        if (F.tid < 64) Vn[F.tid * VLD + 64] = (bf16)0x3F80;
        f32x4 st[5][2];
#pragma unroll
        for (int vt = 0; vt < 5; ++vt) { st[vt][0] = (f32x4){0.f, 0.f, 0.f, 0.f}; st[vt][1] = (f32x4){0.f, 0.f, 0.f, 0.f}; }
        v4u rq[4], rk[4], rv; float rs = 0.f, keepn = 0.f;
#define ML_LOAD(cc) do { const int row0_ = scan_row(b, dir, 64 * (cc)); \
            _Pragma("unroll") for (int x = 0; x < 4; ++x) { const int p = F.tid + NTHR * x; const size_t o = (size_t)(row0_ + sgn * (p >> 5)) * 2048 + h * 256 + (p & 31) * 8; \
                rq[x] = *(const GAS v4u*)(MQK + o); rk[x] = *(const GAS v4u*)(MQK + o + 1024); } \
            rv = *(const GAS v4u*)(P + (size_t)(row0_ + sgn * (F.tid >> 3)) * LD1 + C1_MV + h * 256 + vsl * 64 + (F.tid & 7) * 8); \
            if (F.tid < 320) rs = MLS[((size_t)sq * 36 + (cc)) * 320 + F.tid]; keepn = KEEP[sq * 36 + (cc)]; } while (0)
        ML_LOAD(0);
#pragma unroll 1
        for (int c = 0; c < 36; ++c) {
            const bool emit = c >= 4;
#pragma unroll
            for (int x = 0; x < 4; ++x) { const int p = F.tid + NTHR * x; *(LAS v4u*)(Qn + (p >> 5) * QLD + (p & 31) * 8) = rq[x]; *(LAS v4u*)(Kn + (p >> 5) * QLD + (p & 31) * 8) = rk[x]; }
            *(LAS v4u*)(Vn + (F.tid >> 3) * VLD + (F.tid & 7) * 8) = rv;
            if (F.tid < 320) sS[F.tid] = rs;
            const float keep = keepn;
            __syncthreads();
            if (c + 1 < 36) ML_LOAD(c + 1);
            { const int i = F.tid >> 3, cv = F.tid & 7; const float wv = sW[i]; const v4u x = *(const LAS v4u*)(Vn + i * VLD + cv * 8); v4u y;
#pragma unroll
              for (int q = 0; q < 4; ++q) y[q] = pk2(bflo(x[q]) * wv, bfhi(x[q]) * wv);
              *(LAS v4u*)(VWn + i * VLD + cv * 8) = y; if (cv == 0) VWn[i * VLD + 64] = (bf16)f2bf(wv); }
            if (emit) {
                const int it_ = F.wave >> 1;
#pragma unroll
                for (int x = 0; x < 2; ++x) { const int jt = 2 * (F.wave & 1) + x;
                    f32x4 a = {0.f, 0.f, 0.f, 0.f};
                    if (jt <= it_) {
#pragma unroll
                        for (int ks = 0; ks < 8; ++ks) { const bf16x8 af = *(const LAS bf16x8*)(Qn + (16 * it_ + fr) * QLD + 32 * ks + 8 * fq); const bf16x8 bf = *(const LAS bf16x8*)(Kn + (16 * jt + fr) * QLD + 32 * ks + 8 * fq);
                            a = __builtin_amdgcn_mfma_f32_16x16x32_bf16(af, bf, a, 0, 0, 0); } }
                    const int j = 16 * jt + fr; const float cj = sCol[j];
#pragma unroll
                    for (int jj = 0; jj < 4; ++jj) { const int i = 16 * it_ + 4 * fq + jj; const float val = (j <= i) ? a[jj] * __expf(sRow[i] + cj) : 0.f; SC[i * SLD + j] = (bf16)f2bf(val); } }
            }
            __syncthreads();
            if (emit) {
                const int it_ = F.wave & 3, vt0 = 2 * (F.wave >> 2);
                f32x4 acc[3];
#pragma unroll
                for (int x = 0; x < 3; ++x) acc[x] = (f32x4){0.f, 0.f, 0.f, 0.f};
#pragma unroll
                for (int ks = 0; ks < 8; ++ks) { const bf16x8 af = *(const LAS bf16x8*)(Qn + (16 * it_ + fr) * QLD + 32 * ks + 8 * fq);
#pragma unroll
                    for (int x = 0; x < 3; ++x) { const int vt = (x < 2) ? vt0 + x : 4; const bf16x8 bf = *(const LAS bf16x8*)(Cb + (16 * vt + fr) * QLD + 32 * ks + 8 * fq); acc[x] = __builtin_amdgcn_mfma_f32_16x16x32_bf16(af, bf, acc[x], 0, 0, 0); } }
#pragma unroll
                for (int jj = 0; jj < 4; ++jj) { const float awv = sAw[16 * it_ + 4 * fq + jj];
#pragma unroll
                    for (int x = 0; x < 3; ++x) acc[x][jj] *= awv; }
#pragma unroll
                for (int js = 0; js < 2; ++js) { const bf16x8 af = *(const LAS bf16x8*)(SC + (16 * it_ + fr) * SLD + 32 * js + 8 * fq);
#pragma unroll
                    for (int x = 0; x < 3; ++x) { const int vt = (x < 2) ? vt0 + x : 4; const bf16x8 bf = tr_frag(Vn, VLD, 32 * js, 16 * vt, F.lane); acc[x] = __builtin_amdgcn_mfma_f32_16x16x32_bf16(af, bf, acc[x], 0, 0, 0); } }
                const int row0 = scan_row(b, dir, 64 * c);
#pragma unroll
                for (int jj = 0; jj < 4; ++jj) { const int i = 16 * it_ + 4 * fq + jj; const float den = __shfl(acc[2][jj], F.lane & 48); const float dd = fmaxf(fabsf(den), sEinv[i]);
                    const float rdd = __builtin_amdgcn_rcpf(dd);
                    const int row = row0 + sgn * i; bf16* op = (bf16*)OM + ((size_t)dir * M_LAT + row) * 1024 + h * 256 + vsl * 64 + fr;
                    op[16 * vt0] = (bf16)f2bf(acc[0][jj] * rdd); op[16 * vt0 + 16] = (bf16)f2bf(acc[1][jj] * rdd); }
            }
            {
#pragma unroll
              for (int vt = 0; vt < 5; ++vt) { st[vt][0] *= keep; st[vt][1] *= keep; }
#pragma unroll
              for (int is = 0; is < 2; ++is) { bf16x8 kb[2];
#pragma unroll
                  for (int x = 0; x < 2; ++x) kb[x] = tr_frag(Kn, QLD, 32 * is, 16 * (2 * F.wave + x), F.lane);
#pragma unroll
                  for (int vt = 0; vt < 5; ++vt) { const bf16x8 af = tr_frag(VWn, VLD, 32 * is, 16 * vt, F.lane);
                      st[vt][0] = __builtin_amdgcn_mfma_f32_16x16x32_bf16(af, kb[0], st[vt][0], 0, 0, 0); st[vt][1] = __builtin_amdgcn_mfma_f32_16x16x32_bf16(af, kb[1], st[vt][1], 0, 0, 0); } } }
            __syncthreads();
#pragma unroll
            for (int vt = 0; vt < 5; ++vt)
#pragma unroll
                for (int x = 0; x < 2; ++x)
#pragma unroll
                    for (int jj = 0; jj < 4; ++jj) Cb[(16 * vt + 4 * fq + jj) * QLD + 16 * (2 * F.wave + x) + fr] = (bf16)f2bf(st[vt][x][jj]);
        }
#undef ML_LOAD
    }
    __syncthreads();
}
__device__ __forceinline__ void ph_gla_prep(Frame& F) {
    LAS float* sCode = (LAS float*)(F.lds);
    LAS float* sGT = sCode + 1024;
    const bf16* P = (const bf16*)(F.ws + WS_P);
    bf16* GQD = (bf16*)(F.ws + WS_GQ); bf16* GKI = GQD + (size_t)2 * M_ALL * 512; bf16* GKD = GKI + (size_t)2 * M_ALL * 512; float* DEC = (float*)(F.ws + WS_GDEC);
    const int k = F.tid & 127, tg = F.tid >> 7;
    for (int u = F.bid; u < 2304; u += F.G) {
        const int c = u % 36, sq = u / 36; const int dir = sq & 1, h = (sq >> 1) & 3, b = sq >> 3;
        const int n0 = 64 * c; const int row0 = scan_row(b, dir, n0); const int sgn = dir ? -1 : 1;
        __syncthreads();
#pragma unroll
        for (int x = 0; x < 2; ++x) { const int i = F.tid + NTHR * x; sCode[i] = bf2f(P[(size_t)(row0 + sgn * (i >> 4)) * LD0 + C0_CODE + dir * 16 + (i & 15)]); }
        float w2c[16];
#pragma unroll
        for (int r = 0; r < 16; ++r) w2c[r] = F.in[I_GGW2][(size_t)(dir * 16 + r) * 512 + h * 128 + k];
        const float gbk = F.in[I_GGB][dir * 512 + h * 128 + k];
        const bf16* pq = P + (size_t)(row0 + sgn * 16 * tg) * LD0 + C0_GQ + h * 128 + k; const long pstep = (long)sgn * LD0;
        unsigned short qr[16], kr[16]; float bc[16];
#pragma unroll
        for (int x = 0; x < 16; ++x) { qr[x] = pq[x * pstep]; kr[x] = pq[x * pstep + 512]; }
        __syncthreads();
        float run = 0.f;
#pragma unroll
        for (int x = 0; x < 16; ++x) { float lg = gbk; const LAS float* cd = sCode + (16 * tg + x) * 16;
            f32x4 l4 = {0.f, 0.f, 0.f, 0.f};
#pragma unroll
            for (int r = 0; r < 16; r += 4) { const f32x4 cv = *(const LAS f32x4*)(cd + r); l4 += cv * (f32x4){w2c[r], w2c[r + 1], w2c[r + 2], w2c[r + 3]}; }
            lg += (l4[0] + l4[1]) + (l4[2] + l4[3]);
            run += logsigmoidf_(lg) * (1.f / 16.f); bc[x] = run; }
        sGT[tg * 128 + k] = run;
        __syncthreads();
        float off = 0.f, tot = 0.f;
#pragma unroll
        for (int g = 0; g < 4; ++g) { const float t = sGT[g * 128 + k]; tot += t; off += (g < tg) ? t : 0.f; }
        if (tg == 0) DEC[(size_t)u * 128 + k] = __expf(tot);
        const size_t o0 = ((size_t)dir * M_ALL + (row0 + sgn * 16 * tg)) * 512 + h * 128 + k; const long ostep = (long)sgn * 512;
#pragma unroll
        for (int x = 0; x < 16; ++x) { const float bb = bc[x] + off; const float qv = bf2f(qr[x]) * 0.08838834764831845f, kv = bf2f(kr[x]);
            GQD[o0 + x * ostep] = (bf16)f2bf(qv * __expf(bb)); GKI[o0 + x * ostep] = (bf16)f2bf(kv * __expf(-bb)); GKD[o0 + x * ostep] = (bf16)f2bf(kv * __expf(tot - bb)); }
    }
    __syncthreads();
}
__device__ __forceinline__ void ph_gla_scan2(Frame& F) {
    constexpr int KLD = 136, VLD = 72;
    LAS bf16* QD = (LAS bf16*)(F.lds); LAS bf16* KI = QD + 64 * KLD; LAS bf16* KD = KI + 64 * KLD; LAS bf16* Sb = KD + 64 * KLD; LAS bf16* Vn = Sb + 64 * KLD; LAS bf16* ATT = Vn + 64 * VLD;
    const bf16* P = (const bf16*)(F.ws + WS_P); float* OG = (float*)(F.ws + WS_OG);
    const bf16* GQD = (const bf16*)(F.ws + WS_GQ); const bf16* GKI = GQD + (size_t)2 * M_ALL * 512; const bf16* GKD = GKI + (size_t)2 * M_ALL * 512; const float* DEC = (const float*)(F.ws + WS_GDEC);
    const int fr = F.lane & 15, fq = F.lane >> 4;
    for (int u0 = F.bid; u0 < 256; u0 += F.G) {
        const int u = (F.G == 256) ? ((((u0 & 7) * 8 + (u0 >> 5)) << 2) | ((u0 >> 3) & 3)) : u0;
        const int vsl = u & 3, dir = (u >> 2) & 1, h = (u >> 3) & 3, b = u >> 5; const int sq = (b * 4 + h) * 2 + dir; const int sgn = dir ? -1 : 1;
        __syncthreads();
        for (int i = F.tid; i < 64 * KLD / 8; i += NTHR) *(LAS v4u*)(Sb + i * 8) = (v4u){0u, 0u, 0u, 0u};
        f32x4 st[4];
#pragma unroll
        for (int vt = 0; vt < 4; ++vt) st[vt] = (f32x4){0.f, 0.f, 0.f, 0.f};
        v4u rq[2], rk[2], rd[2], rv; float dkn;
#define GLA_LOAD(cc) do { const int row0_ = scan_row(b, dir, 64 * (cc)); \
            _Pragma("unroll") for (int x = 0; x < 2; ++x) { const int p = F.tid + NTHR * x; const size_t o = ((size_t)dir * M_ALL + (row0_ + sgn * (p >> 4))) * 512 + h * 128 + (p & 15) * 8; \
                rq[x] = *(const GAS v4u*)(GQD + o); rk[x] = *(const GAS v4u*)(GKI + o); rd[x] = *(const GAS v4u*)(GKD + o); } \
            rv = *(const GAS v4u*)(P + (size_t)(row0_ + sgn * (F.tid >> 3)) * LD0 + C0_GV + h * 256 + vsl * 64 + (F.tid & 7) * 8); \
            dkn = DEC[((size_t)sq * 36 + (cc)) * 128 + 16 * F.wave + fr]; } while (0)
#define GLA_PUT_QK() do { _Pragma("unroll") for (int x = 0; x < 2; ++x) { const int p = F.tid + NTHR * x; *(LAS v4u*)(QD + (p >> 4) * KLD + (p & 15) * 8) = rq[x]; *(LAS v4u*)(KI + (p >> 4) * KLD + (p & 15) * 8) = rk[x]; } } while (0)
        GLA_LOAD(0);
        GLA_PUT_QK();
#pragma unroll 1
        for (int c = 0; c < 36; ++c) {
            __syncthreads();
#pragma unroll
            for (int x = 0; x < 2; ++x) { const int p = F.tid + NTHR * x; *(LAS v4u*)(KD + (p >> 4) * KLD + (p & 15) * 8) = rd[x]; }
            *(LAS v4u*)(Vn + (F.tid >> 3) * VLD + (F.tid & 7) * 8) = rv;
            const float dk = dkn;
            if (c + 1 < 36) GLA_LOAD(c + 1);
            { const int it_ = F.wave >> 1;
#pragma unroll
              for (int x = 0; x < 2; ++x) { const int jt = 2 * (F.wave & 1) + x; f32x4 a = {0.f, 0.f, 0.f, 0.f};
                  if (jt <= it_) {
#pragma unroll
                      for (int ks = 0; ks < 4; ++ks) { const bf16x8 af = *(const LAS bf16x8*)(QD + (16 * it_ + fr) * KLD + 32 * ks + 8 * fq); const bf16x8 bf = *(const LAS bf16x8*)(KI + (16 * jt + fr) * KLD + 32 * ks + 8 * fq);
                          a = __builtin_amdgcn_mfma_f32_16x16x32_bf16(af, bf, a, 0, 0, 0); } }
                  const int j = 16 * jt + fr;
#pragma unroll
                  for (int jj = 0; jj < 4; ++jj) { const int i = 16 * it_ + 4 * fq + jj; ATT[i * VLD + j] = (bf16)f2bf((j <= i) ? a[jj] : 0.f); } } }
            const int ot = F.wave & 3, vt0 = 2 * (F.wave >> 2);
            f32x4 oa[2] = {(f32x4){0.f, 0.f, 0.f, 0.f}, (f32x4){0.f, 0.f, 0.f, 0.f}};
#pragma unroll
            for (int ks = 0; ks < 4; ++ks) { const bf16x8 af = *(const LAS bf16x8*)(QD + (16 * ot + fr) * KLD + 32 * ks + 8 * fq);
#pragma unroll
                for (int x = 0; x < 2; ++x) { const bf16x8 bf = *(const LAS bf16x8*)(Sb + (16 * (vt0 + x) + fr) * KLD + 32 * ks + 8 * fq); oa[x] = __builtin_amdgcn_mfma_f32_16x16x32_bf16(af, bf, oa[x], 0, 0, 0); } }
            __syncthreads();
#pragma unroll
            for (int js = 0; js < 2; ++js) { const bf16x8 af = *(const LAS bf16x8*)(ATT + (16 * ot + fr) * VLD + 32 * js + 8 * fq);
#pragma unroll
                for (int x = 0; x < 2; ++x) { const bf16x8 bf = tr_frag(Vn, VLD, 32 * js, 16 * (vt0 + x), F.lane); oa[x] = __builtin_amdgcn_mfma_f32_16x16x32_bf16(af, bf, oa[x], 0, 0, 0); } }
            { const int row0 = scan_row(b, dir, 64 * c);
#pragma unroll
              for (int jj = 0; jj < 4; ++jj) { const int i = 16 * ot + 4 * fq + jj; const int row = row0 + sgn * i;
                  bf16* op = (bf16*)OG + ((size_t)dir * M_ALL + row) * 1024 + h * 256 + vsl * 64 + fr; op[16 * vt0] = (bf16)f2bf(oa[0][jj]); op[16 * vt0 + 16] = (bf16)f2bf(oa[1][jj]); } }
            {
#pragma unroll
              for (int vt = 0; vt < 4; ++vt) st[vt] *= dk;
#pragma unroll
              for (int js = 0; js < 2; ++js) { const bf16x8 kb = tr_frag(KD, KLD, 32 * js, 16 * F.wave, F.lane);
#pragma unroll
                  for (int vt = 0; vt < 4; ++vt) { const bf16x8 af = tr_frag(Vn, VLD, 32 * js, 16 * vt, F.lane); st[vt] = __builtin_amdgcn_mfma_f32_16x16x32_bf16(af, kb, st[vt], 0, 0, 0); } }
#pragma unroll
              for (int vt = 0; vt < 4; ++vt)
#pragma unroll
                  for (int jj = 0; jj < 4; ++jj) Sb[(16 * vt + 4 * fq + jj) * KLD + 16 * F.wave + fr] = (bf16)f2bf(st[vt][jj]); }
            if (c + 1 < 36) GLA_PUT_QK();
        }
#undef GLA_LOAD
#undef GLA_PUT_QK
    }
    __syncthreads();
}
__device__ __forceinline__ float vmax3(float a, float b, float c) { float r; asm("v_max3_f32 %0, %1, %2, %3" : "=v"(r) : "v"(a), "v"(b), "v"(c)); return r; }
__device__ __forceinline__ void ph_da_attn2(Frame& F) {
    constexpr int TLD = 144, TILE = 64 * TLD;
    LAS bf16* buf = (LAS bf16*)(F.lds);
    const bf16* P = (const bf16*)(F.ws + WS_P); bf16* Y = (bf16*)(F.ws + WS_Y);
    const float lam_init = 0.35550906759096927f;
    float lam;
    { const float* lv = F.in[I_DLAM]; float s01 = 0.f, s23 = 0.f; for (int i = 0; i < 64; ++i) { s01 += lv[i] * lv[64 + i]; s23 += lv[128 + i] * lv[192 + i]; } lam = expf(s01) - expf(s23) + lam_init; }
    const int fr = F.lane & 15, fq = F.lane >> 4, tq = (F.lane & 15) >> 2, tp = F.lane & 3;
    const int nround = (F.G == 256) ? 4 : (1024 + F.G - 1) / F.G;
    for (int rnd = 0; rnd < nround; ++rnd) {
        int u;
        if (F.G == 256) { const int xcd = F.bid & 7, slot = F.bid >> 3; const int pair = xcd + 8 * (2 * rnd + (slot >> 4)); u = pair * 16 + (slot & 15); }
        else { u = F.bid + rnd * F.G; if (u >= 1024) break; }
        const int qb = u & 15, h = (u >> 4) & 7, b = u >> 7;
        const int qrow = b * 2048 + qb * 128 + F.wave * 16 + fr;
        bf16x8 qf[2][2];
#pragma unroll
        for (int c = 0; c < 2; ++c)
#pragma unroll
            for (int ks = 0; ks < 2; ++ks) qf[c][ks] = *(const GAS bf16x8*)(P + (size_t)qrow * LD1 + C1_DQ + h * 128 + c * 64 + ks * 32 + 8 * fq);
        f32x4 Oa[2][8], Ol[2]; float mst[2] = {0.f, 0.f};
#pragma unroll
        for (int c = 0; c < 2; ++c)
#pragma unroll
            for (int vt = 0; vt < 8; ++vt) Oa[c][vt] = (f32x4){0.f, 0.f, 0.f, 0.f};
        Ol[0] = (f32x4){0.f, 0.f, 0.f, 0.f}; Ol[1] = (f32x4){0.f, 0.f, 0.f, 0.f};
        const bf16x8 ones = (bf16x8){0x3F80, 0x3F80, 0x3F80, 0x3F80, 0x3F80, 0x3F80, 0x3F80, 0x3F80};
        v4u kn[2], vn[2];
        const int skey = F.tid >> 4, sch = F.tid & 15;
#define DA_TB(t) ((const char*)P + (size_t)(((t) < 4) ? (M_LAT + b * 256 + 64 * (t)) : (b * 2048 + 64 * ((t) - 4))) * (LD1 * 2))
        const unsigned vo0 = (unsigned)(skey * LD1 + C1_DK + h * 128 + sch * 8) * 2u, vo1 = vo0 + 32u * LD1 * 2u;
#define DA_LD(t) do { const char* tb_ = DA_TB(t); kn[0] = *(const GAS v4u*)(tb_ + vo0); vn[0] = *(const GAS v4u*)(tb_ + vo0 + (C1_DV - C1_DK) * 2); kn[1] = *(const GAS v4u*)(tb_ + vo1); vn[1] = *(const GAS v4u*)(tb_ + vo1 + (C1_DV - C1_DK) * 2); } while (0)
        DA_LD(0);
        __syncthreads();
#pragma unroll
        for (int i = 0; i < 2; ++i) { *(LAS v4u*)(buf + (skey + 32 * i) * TLD + sch * 8) = kn[i]; *(LAS v4u*)(buf + TILE + (skey + 32 * i) * TLD + sch * 8) = vn[i]; }
        DA_LD(1);
        __syncthreads();
#pragma unroll 1
        for (int kt = 0; kt < 36; ++kt) {
            const LAS bf16* Kc = buf + (kt & 1) * 2 * TILE; const LAS bf16* Vc = Kc + TILE;
            if (kt + 1 < 36) {
                LAS bf16* Kn_ = buf + ((kt + 1) & 1) * 2 * TILE;
#pragma unroll
                for (int i = 0; i < 2; ++i) { *(LAS v4u*)(Kn_ + (skey + 32 * i) * TLD + sch * 8) = kn[i]; *(LAS v4u*)(Kn_ + TILE + (skey + 32 * i) * TLD + sch * 8) = vn[i]; }
                if (kt + 2 < 36) DA_LD(kt + 2); }
            bf16x8 pf[2][2];
            f32x4 S[2][4];
#pragma unroll
            for (int c = 0; c < 2; ++c)
#pragma unroll
                for (int nt = 0; nt < 4; ++nt) { const float nm = -mst[c]; f32x4 a = {nm, nm, nm, nm};
#pragma unroll
                    for (int ks = 0; ks < 2; ++ks) { const bf16x8 kf = *(const LAS bf16x8*)(Kc + (nt * 16 + fr) * TLD + c * 64 + ks * 32 + 8 * fq); a = __builtin_amdgcn_mfma_f32_16x16x32_bf16(kf, qf[c][ks], a, 0, 0, 0); }
                    S[c][nt] = a; }
            float mx[2];
            asm volatile("s_nop 7\n\ts_nop 3\n\t"
                         "v_max3_f32 %0, %2, %3, %4\n\tv_max3_f32 %1, %18, %19, %20\n\t"
                         "v_max3_f32 %0, %0, %5, %6\n\tv_max3_f32 %1, %1, %21, %22\n\t"
                         "v_max3_f32 %0, %0, %7, %8\n\tv_max3_f32 %1, %1, %23, %24\n\t"
                         "v_max3_f32 %0, %0, %9, %10\n\tv_max3_f32 %1, %1, %25, %26\n\t"
                         "v_max3_f32 %0, %0, %11, %12\n\tv_max3_f32 %1, %1, %27, %28\n\t"
                         "v_max3_f32 %0, %0, %13, %14\n\tv_max3_f32 %1, %1, %29, %30\n\t"
                         "v_max3_f32 %0, %0, %15, %16\n\tv_max3_f32 %1, %1, %31, %32\n\t"
                         "v_max_f32 %0, %0, %17\n\tv_max_f32 %1, %1, %33"
                         : "=&v"(mx[0]), "=&v"(mx[1])
                         : "v"(S[0][0][0]), "v"(S[0][0][1]), "v"(S[0][0][2]), "v"(S[0][0][3]), "v"(S[0][1][0]), "v"(S[0][1][1]), "v"(S[0][1][2]), "v"(S[0][1][3]),
                           "v"(S[0][2][0]), "v"(S[0][2][1]), "v"(S[0][2][2]), "v"(S[0][2][3]), "v"(S[0][3][0]), "v"(S[0][3][1]), "v"(S[0][3][2]), "v"(S[0][3][3]),
                           "v"(S[1][0][0]), "v"(S[1][0][1]), "v"(S[1][0][2]), "v"(S[1][0][3]), "v"(S[1][1][0]), "v"(S[1][1][1]), "v"(S[1][1][2]), "v"(S[1][1][3]),
                           "v"(S[1][2][0]), "v"(S[1][2][1]), "v"(S[1][2][2]), "v"(S[1][2][3]), "v"(S[1][3][0]), "v"(S[1][3][1]), "v"(S[1][3][2]), "v"(S[1][3][3]));
            { float a0 = mx[0], b0 = mx[0], a1 = mx[1], b1 = mx[1];
              asm volatile("s_nop 1\n\tv_permlane16_swap_b32 %0, %1\n\tv_permlane16_swap_b32 %2, %3\n\ts_nop 1\n\tv_max_f32 %0, %0, %1\n\tv_max_f32 %2, %2, %3\n\tv_mov_b32 %1, %0\n\tv_mov_b32 %3, %2\n\ts_nop 1\n\t"
                           "v_permlane32_swap_b32 %0, %1\n\tv_permlane32_swap_b32 %2, %3\n\ts_nop 1\n\tv_max_f32 %0, %0, %1\n\tv_max_f32 %2, %2, %3"
                           : "+v"(a0), "+v"(b0), "+v"(a1), "+v"(b1));
              mx[0] = a0; mx[1] = a1; }
            const bool up0 = (kt == 0) || (mx[0] > 8.f), up1 = (kt == 0) || (mx[1] > 8.f);
            if (__any(up0 || up1)) {
#pragma unroll
                for (int c = 0; c < 2; ++c) { const float d = (c ? up1 : up0) ? mx[c] : 0.f; const float al = __builtin_amdgcn_exp2f(-d); mst[c] += d; Ol[c] *= al;
#pragma unroll
                    for (int vt = 0; vt < 8; ++vt) Oa[c][vt] *= al;
#pragma unroll
                    for (int nt = 0; nt < 4; ++nt) S[c][nt] -= d; } }
#pragma unroll
            for (int c = 0; c < 2; ++c) {
#pragma unroll
                for (int nt = 0; nt < 4; ++nt)
#pragma unroll
                    for (int j = 0; j < 4; ++j) S[c][nt][j] = __builtin_amdgcn_exp2f(S[c][nt][j]);
#pragma unroll
                for (int kp = 0; kp < 2; ++kp) { v4u w; w.x = pk2(S[c][2 * kp][0], S[c][2 * kp][1]); w.y = pk2(S[c][2 * kp][2], S[c][2 * kp][3]); w.z = pk2(S[c][2 * kp + 1][0], S[c][2 * kp + 1][1]); w.w = pk2(S[c][2 * kp + 1][2], S[c][2 * kp + 1][3]);
                    pf[c][kp] = __builtin_bit_cast(bf16x8, w); } }
#pragma unroll
            for (int kp = 0; kp < 2; ++kp) { Ol[0] = __builtin_amdgcn_mfma_f32_16x16x32_bf16(ones, pf[0][kp], Ol[0], 0, 0, 0); Ol[1] = __builtin_amdgcn_mfma_f32_16x16x32_bf16(ones, pf[1][kp], Ol[1], 0, 0, 0); }
#pragma unroll
            for (int kp = 0; kp < 2; ++kp)
#pragma unroll
                for (int vt = 0; vt < 8; ++vt) { const LAS bf16* a0 = Vc + (32 * kp + 4 * fq + tq) * TLD + 16 * vt + 4 * tp;
                    const s16x4 lo = __builtin_amdgcn_ds_read_tr16_b64_v4i16((LAS s16x4*)a0); const s16x4 hi = __builtin_amdgcn_ds_read_tr16_b64_v4i16((LAS s16x4*)(a0 + 16 * TLD));
                    const bf16x8 vf = (bf16x8){lo[0], lo[1], lo[2], lo[3], hi[0], hi[1], hi[2], hi[3]};
                    Oa[0][vt] = __builtin_amdgcn_mfma_f32_16x16x32_bf16(vf, pf[0][kp], Oa[0][vt], 0, 0, 0); Oa[1][vt] = __builtin_amdgcn_mfma_f32_16x16x32_bf16(vf, pf[1][kp], Oa[1][vt], 0, 0, 0); }
            __syncthreads();
        }
#undef DA_TB
#undef DA_LD
        { const float i0 = 1.f / Ol[0][0], i1 = lam / Ol[1][0]; float ss = 0.f;
#pragma unroll
          for (int vt = 0; vt < 8; ++vt) { Oa[0][vt] = Oa[0][vt] * i0 - Oa[1][vt] * i1; ss += (Oa[0][vt][0] * Oa[0][vt][0] + Oa[0][vt][1] * Oa[0][vt][1]) + (Oa[0][vt][2] * Oa[0][vt][2] + Oa[0][vt][3] * Oa[0][vt][3]); }
          ss = xrow_sum(ss);
          const float rsn = (1.f - lam_init) / sqrtf(ss * (1.f / 128.f) + EPS);
#pragma unroll
          for (int vt = 0; vt < 8; ++vt) { const f32x4 g = *(const GAS f32x4*)(F.in[I_DNG] + 16 * vt + 4 * fq); const f32x4 o = Oa[0][vt] * rsn * g;
              v2u w; w.x = pk2(o[0], o[1]); w.y = pk2(o[2], o[3]);
              *(GAS v2u*)(Y + (size_t)qrow * D + 1024 + h * 128 + 16 * vt + 4 * fq) = w; } }
    }
    __syncthreads();
}
struct Args { const float* in[35]; float* out; unsigned char* ws; int ph_lo, ph_hi; };
__device__ __forceinline__ bool frame_refresh(Frame& F) { int tz = threadIdx.x; asm volatile("" : "+v"(tz)); F.tid = tz; F.lane = tz & 63; F.wave = __builtin_amdgcn_readfirstlane(tz >> 6);
    const __attribute__((address_space(4))) char* kp = (const __attribute__((address_space(4))) char*)__builtin_amdgcn_kernarg_segment_ptr(); asm volatile("" : "+s"(kp));
    const __attribute__((address_space(4))) Args* ap = (const __attribute__((address_space(4))) Args*)kp;
#pragma unroll
    for (int i = 0; i < 35; ++i) F.in[i] = ap->in[i];
    F.out = ap->out; F.ws = ap->ws; F.ctl = (gu32*)(ap->ws + WS_CTL); return true; }
constexpr int NPHASE = 24;
__global__ void __launch_bounds__(NTHR, 2) skel_fwd(Args args) {
    extern __shared__ __attribute__((aligned(16))) unsigned char lds[];
    Frame F;
    F.lds = (LAS unsigned char*)lds;
    F.MISC = (volatile LAS unsigned*)(F.lds + MISC_OFF);
    F.tid = threadIdx.x; F.lane = F.tid & 63; F.wave = __builtin_amdgcn_readfirstlane(F.tid >> 6);
    F.G = gridDim.x; F.bid = blockIdx.x;
    F.ws = args.ws; F.out = args.out; F.ctl = (gu32*)(args.ws + WS_CTL);
    for (int u = F.tid; u < (LDS_BYTES - LDSCTL_OFF) / 4; u += NTHR) ((LAS unsigned*)(F.lds + LDSCTL_OFF))[u] = 0u;
    __syncthreads();
    const int lo = args.ph_lo, hi = args.ph_hi;
    XcdBarrier bar; bar.bar = (unsigned*)(F.ctl + CW_BAR); bar.x = 0; bar.st = nullptr;
    if (hi - lo > 1) bar = xcd_barrier_post((unsigned*)(F.ctl + CW_BAR), F.MISC + 8);
#define IN(k) (lo <= (k) && (k) < hi && frame_refresh(F))
#define SEAM(k) do { if (lo <= (k) && (k) + 1 < hi) xcd_barrier(bar); } while (0)
#define MOD ((const float*)(F.ws + WS_MOD))
#define Abuf ((bf16*)(F.ws + WS_A))
#define Pbuf ((bf16*)(F.ws + WS_P))
#define Ybuf ((bf16*)(F.ws + WS_Y))
#define Hbuf ((float*)(F.ws + WS_H))
#define XS ((bf16*)(F.ws + WS_XS))
#define HID ((bf16*)(F.ws + WS_HID))
#define YS ((bf16*)(F.ws + WS_YS))
    if (IN(0)) { p0_adaln(F); __syncthreads(); p0_filters(F); __syncthreads(); p0_convert(F); } SEAM(0);
    if (IN(1)) { ph_norm1_l0(F); ph_hy_ftt(F); } SEAM(1);
    if (IN(2)) { pg8::Gemm g{Abuf, (const bf16*)(F.ws + WS_WIN0), M_ALL, 6144, D}; pg8::StaticOrder S; S.init(M_ALL, 6144, F.G, F.bid);
        pg8::EpiStore E{Pbuf, LD0, 24, 1.f};
        pg8::gemm_phase<pg8::EpiStore, pg8::StaticOrder, PG8_ALIGN, PG8_SP2>(F.lds + RING_OFF, g, S, E); ph_codes_skinny(F); cvt_late(F, CVT_L0_END - CVT_LATE0, 192, 10); } SEAM(2);
    if (IN(3)) { ph_gla_prep(F); ph_hy_shortconv(F); ph_hy_prep_lat(F); } SEAM(3);
    if (IN(4)) { ph_gla_scan2(F); ph_hy_conv_lat(F); ph_hy_longconv(F, 0); } SEAM(4);
    if (IN(5)) { ph_hy_longconv(F, 1); ph_hy_post_lat(F); const bf16* OG = (const bf16*)(F.ws + WS_OG);
        ph_mix_combine<0>(F, M_ALL, OG, OG + (size_t)M_ALL * 1024, Pbuf, LD0, C0_GR, F.in[I_GNG], 1024); } SEAM(5);
    if (IN(6)) { pg8::Gemm g{Ybuf, (const bf16*)(F.ws + WS_WOUT), M_ALL, D, D}; pg8::StaticOrder S; S.init(M_ALL, D, F.G, F.bid);
        pg8::EpiRes E{F.in[I_X], F.in[I_CTX], Hbuf, MOD + 2 * 2048};
        pg8::gemm_phase<pg8::EpiRes, pg8::StaticOrder, PG8_ALIGN, PG8_SP2>(F.lds + RING_OFF, g, S, E);  cvt_late(F, CVT_L0_END - CVT_LATE0 + 64 * 10, 64, 14); } SEAM(6);
    if (IN(7)) { ph_norm2_router2(F, 0, M_ALL); } SEAM(7);
    if (IN(8)) { ph_topk(F, 256, ME0); } SEAM(8);
    if (IN(10)) { pg8::Gemm g{(const bf16*)(F.ws + WS_A), (const bf16*)(F.ws + WS_W13), 16 * ME0, 4096, D, (const int*)(F.ws + WS_TOK)}; pg8::GroupedOrder S; S.init(ME0 / 256, 16, F.G, F.bid);
        pg8::EpiSwiglu E{(unsigned char*)HID};
        pg8::gemm_phase<pg8::EpiSwiglu, pg8::GroupedOrder, PG8_ALIGN, PG8_SP2, true, true>(F.lds + RING_OFF, g, S, E); } SEAM(10);
    if (IN(11)) { pg8::Gemm g{HID, (const bf16*)(F.ws + WS_W2), 16 * ME0, 2048, D}; pg8::GroupedOrder S; S.init(ME0 / 256, 8, F.G, F.bid);
        pg8::EpiStore E{YS, D, 8, 1.f / 64.f};
        pg8::gemm_phase<pg8::EpiStore, pg8::GroupedOrder, PG8_ALIGN, PG8_SP2, true>(F.lds + RING_OFF, g, S, E);  cvt_late(F, CVT_L1_END - CVT_LATE1, 128, 5); } SEAM(11);
    if (IN(12)) { ph_combine<0>(F, 0, M_ALL); } SEAM(12);
    if (IN(13)) { pg8::Gemm g{Abuf, (const bf16*)(F.ws + WS_WIN1), M_ALL, LD1, D}; pg8::In1Order S; S.init(F.G, F.bid);
        pg8::EpiStore E{Pbuf, LD1, LD1 / 256, 1.f};
        pg8::gemm_phase<pg8::EpiStore, pg8::In1Order, PG8_ALIGN, PG8_SP2>(F.lds + RING_OFF, g, S, E);  cvt_late(F, CVT_L1_END - CVT_LATE1 + 128 * 5, 200, 10); } SEAM(13);
    if (IN(14)) { ph_ml_prep(F); ph_da_rope(F); } SEAM(14);
    if (IN(15)) { ph_ml_scan2(F); ph_da_attn2(F); } SEAM(15);
    if (IN(16)) { const bf16* OM = (const bf16*)(F.ws + WS_OG);
        ph_mix_combine<1>(F, M_LAT, OM, OM + (size_t)M_LAT * 1024, Pbuf, LD1, C1_MO, F.in[I_MNG], 0); } SEAM(16);
    if (IN(17)) { pg8::Gemm g{Ybuf, (const bf16*)(F.ws + WS_WOUT) + (size_t)D * D, M_LAT, D, D}; pg8::StaticOrder S; S.init(M_LAT, D, F.G, F.bid);
        pg8::EpiRes E{Hbuf, Hbuf, Hbuf, MOD + 9 * 12288 + 2 * 2048};
        pg8::gemm_phase<pg8::EpiRes, pg8::StaticOrder, PG8_ALIGN, PG8_SP2>(F.lds + RING_OFF, g, S, E); } SEAM(17);
    if (IN(18)) { ph_norm2_router2(F, 1, M_LAT); } SEAM(18);
    if (IN(19)) { ph_topk(F, 128, ME1); } SEAM(19);
    if (IN(21)) { pg8::Gemm g{(const bf16*)(F.ws + WS_A), (const bf16*)(F.ws + WS_W13) + (size_t)16 * 4096 * 1024, 16 * ME1, 4096, D, (const int*)(F.ws + WS_TOK)}; pg8::GroupedOrder S; S.init(ME1 / 256, 16, F.G, F.bid);
        pg8::EpiSwiglu E{(unsigned char*)HID};
        pg8::gemm_phase<pg8::EpiSwiglu, pg8::GroupedOrder, PG8_ALIGN, PG8_SP2, true, true>(F.lds + RING_OFF, g, S, E); } SEAM(21);
    if (IN(22)) { pg8::Gemm g{HID, (const bf16*)(F.ws + WS_W2) + (size_t)16 * 2048 * 1024, 16 * ME1, 2048, D}; pg8::GroupedOrder S; S.init(ME1 / 256, 8, F.G, F.bid);
        pg8::EpiStore E{YS, D, 8, 1.f / 64.f};
        pg8::gemm_phase<pg8::EpiStore, pg8::GroupedOrder, PG8_ALIGN, PG8_SP2, true>(F.lds + RING_OFF, g, S, E); } SEAM(22);
    if (IN(23)) { ph_combine<1>(F, 1, M_LAT); }
#undef IN
#undef SEAM
#undef MOD
#undef Abuf
#undef Pbuf
#undef Ybuf
#undef Hbuf
#undef XS
#undef HID
#undef YS
}

extern "C" void kernel_launch(void* const* d_in, const int* in_sizes, int n_in, void* d_out, int out_size, void* d_ws, size_t ws_size, hipStream_t stream) {
    static int grid = 0;
    if (grid == 0) {
        if (n_in != 35 || ws_size < WS_END) { fprintf(stderr, "kernel_launch: unexpected n_in %d / ws_size %zu\n", n_in, ws_size); grid = -1; return; }
        int dev = 0, cus = 0, per_cu = 0;
        if (hipGetDevice(&dev) != hipSuccess || hipDeviceGetAttribute(&cus, hipDeviceAttributeMultiprocessorCount, dev) != hipSuccess) { grid = -1; return; }
        if (hipFuncSetAttribute((const void*)skel_fwd, hipFuncAttributeMaxDynamicSharedMemorySize, LDS_BYTES) != hipSuccess) { fprintf(stderr, "kernel_launch: hipFuncSetAttribute failed\n"); grid = -1; return; }
        if (hipOccupancyMaxActiveBlocksPerMultiprocessor(&per_cu, (const void*)skel_fwd, NTHR, LDS_BYTES) != hipSuccess || per_cu < 1) fprintf(stderr, "kernel_launch: occupancy query says %d\n", per_cu);
        (void)hipGetLastError();
        grid = cus;
    }
    if (grid < 0) return;
    if (hipMemsetAsync((char*)d_ws + WS_CTL, 0, CTL_ZERO_BYTES, stream) != hipSuccess) return;
    Args a{};
    for (int i = 0; i < 35; ++i) a.in[i] = (const float*)d_in[i];
    a.out = (float*)d_out; a.ws = (unsigned char*)d_ws;
#if MK_ONE_LAUNCH
    a.ph_lo = 0; a.ph_hi = NPHASE;
    hipLaunchKernelGGL(skel_fwd, dim3(grid), dim3(NTHR), LDS_BYTES, stream, a);
#else
    for (int k = 0; k < NPHASE; ++k) { a.ph_lo = k; a.ph_hi = k + 1; hipLaunchKernelGGL(skel_fwd, dim3(grid), dim3(NTHR), LDS_BYTES, stream, a); }
#endif
}
```

```cpp
#include <hip/hip_runtime.h>
#include <cstdio>
#include <cstdint>
namespace pg8 {
#define PG8_LAS __attribute__((address_space(3)))
typedef unsigned short bf16_t;
typedef short bf16x8 __attribute__((ext_vector_type(8)));
typedef float f32x4 __attribute__((ext_vector_type(4)));
typedef unsigned u32x4 __attribute__((ext_vector_type(4)));
constexpr int BM = 256, BK = 64, HALF = 128, HTB = HALF * BK * 2  , STAGE_BYTES = 8 * HTB, NXCD = 8, WGM = 8;

__host__ __device__ __forceinline__ int lds_byte(int r, int c) { const int st = (r >> 4) * 2 + (c >> 5), rr = r & 15, cc = c & 31, ob = rr * 64 + cc * 2; return st * 1024 + (ob ^ (((ob >> 9) & 1) << 5)); }
__host__ __device__ __forceinline__ void stage_rc(int b, int& R, int& C) { const int st = b / 1024, sb = b % 1024, swz = sb ^ (((sb >> 9) & 1) << 5); R = (st >> 1) * 16 + swz / 64; C = (st & 1) * 32 + (swz % 64) / 2; }
__host__ __device__ __forceinline__ int perm32(int rho) { const int n = rho >> 4, i = rho & 15; return 8 * (i >> 2) + 4 * n + (i & 3); }

struct Unit { int pm, pn; };
struct Gemm { const bf16_t* A; const bf16_t* Bt; int M, N, K; const int* arow = nullptr; };

struct StaticOrder {
    int nM, nN, nwg, G, c;
    __host__ __device__ void init(int M, int N, int G_, int c_) { nM = M / BM; nN = N / BM; nwg = nM * nN; G = G_; c = c_; }
    __host__ __device__ bool next(int i, Unit& u) const {
        const long L = (long)i * G + c; if (L >= nwg) return false;
        int wgid = (int)L; { const int q = nwg / NXCD, r = nwg % NXCD, xcd = wgid % NXCD, off = wgid / NXCD; wgid = (xcd < r ? xcd * (q + 1) : r * (q + 1) + (xcd - r) * q) + off; }
        const int nig = WGM * nN, gid = wgid / nig, fm = gid * WGM, gsz = (nM - fm) < WGM ? (nM - fm) : WGM;
        u.pm = fm + ((wgid % nig) % gsz); u.pn = (wgid % nig) / gsz; return true;
    }
    __device__ __forceinline__ void a_ready(const Unit&) const {}
    __device__ __forceinline__ void done(const Unit&) const {}
};

__device__ __forceinline__ unsigned cvt_pk_bf16(float lo, float hi) { unsigned r; asm volatile("v_cvt_pk_bf16_f32 %0, %1, %2" : "=v"(r) : "v"(lo), "v"(hi)); return r; }
typedef float f32x2 __attribute__((ext_vector_type(2)));
__device__ __forceinline__ f32x2 gelu_pk(f32x2 v) {
    const f32x2 av = __builtin_elementwise_abs(v), d = av * 0.2316418882f + 1.0f;
    f32x2 t; t.x = __builtin_amdgcn_rcpf(d.x); t.y = __builtin_amdgcn_rcpf(d.y);
    f32x2 q = t * 0.5307027145f + (-0.7265760135f); q = q * t + 0.7107068705f; q = q * t + (-0.142248368f); q = q * t + 0.127414796f; q = q * t;
    const f32x2 s = (v * v) * (-0.72134752044f);
    f32x2 e; e.x = __builtin_amdgcn_exp2f(s.x); e.y = __builtin_amdgcn_exp2f(s.y);
    const f32x2 m = v * (q * e), r = v - m;
    f32x2 o; o.x = v.x < 0.f ? m.x : r.x; o.y = v.y < 0.f ? m.y : r.y; return o;
}

typedef int v8i32 __attribute__((ext_vector_type(8)));
template <class Epi, class Sched, bool ALIGN_EPI = false, bool SP2 = false, bool FP8 = false, bool IDXA = false>
__device__ __forceinline__ void gemm_phase(PG8_LAS unsigned char* lds, const Gemm g, const Sched& S, const Epi& E) {
    int tid_ = threadIdx.x; asm volatile("" : "+v"(tid_));
    const int tid = tid_, wid = __builtin_amdgcn_readfirstlane(tid >> 6), lane = tid & 63, wr = wid >> 2, wc = wid & 3, fr = lane & 15, fq = lane >> 4;
    const int K = FP8 ? g.K / 2 : g.K, nt = K / BK;
    unsigned voffA[2], voffB[2]; int Rv[2], Cv[2];
#pragma unroll
    for (int i = 0; i < 2; ++i) { int R, C; stage_rc(tid * 16 + i * 8192, R, C); const int Rb = Epi::PERM ? ((R & ~31) + perm32(R & 31)) : R; Rv[i] = R; Cv[i] = C;
        voffA[i] = (unsigned)(R * K + C) * 2u; voffB[i] = (unsigned)(Rb * K + C) * 2u; }
    static_assert(!IDXA || SP2, "IDXA is written for the SP2 loop");
    unsigned vAc[2][2], vAn[2][2];
#define PG8_IDX(u_, vo) do { _Pragma("unroll") for (int h_ = 0; h_ < 2; ++h_) _Pragma("unroll") for (int i_ = 0; i_ < 2; ++i_) { const int row_ = g.arow[(u_).pm * BM + h_ * HALF + Rv[i_]]; vo[h_][i_] = (unsigned)(row_ * K + Cv[i_]) * 2u; } } while (0)
    const size_t kstep = (size_t)(BK * 2);
    const size_t hstep = (size_t)HALF * K * 2;
    const size_t tstep = 2 * hstep;
    const unsigned ldsw = (unsigned)wid * 1024u;
    const int aoff = lds_byte(wr * 64 + fr, fq * 8), boff = lds_byte(wc * 32 + fr, fq * 8);
#define PG8_SA(b, h) (((b) * 2 + (h)) * HTB)
#define PG8_SB(b, h) ((4 + (b) * 2 + (h)) * HTB)
#define PG8_STAGE(bufoff, gbase, voff) do { _Pragma("unroll") for (int _i = 0; _i < 2; ++_i) \
        __builtin_amdgcn_global_load_lds((const unsigned*)((const char*)(gbase) + (voff)[_i]), (PG8_LAS unsigned*)(lds + (bufoff) + ldsw + _i * 8192), 16, 0, 0); } while (0)
#define PG8_STAGE_A(bufoff, gbase, h, sel) do { if constexpr (IDXA) { _Pragma("unroll") for (int _i = 0; _i < 2; ++_i) { const unsigned vo_ = (sel) ? vAn[h][_i] : vAc[h][_i]; \
        __builtin_amdgcn_global_load_lds((const unsigned*)((const char*)(gbase) + vo_), (PG8_LAS unsigned*)(lds + (bufoff) + ldsw + _i * 8192), 16, 0, 0); } } \
        else PG8_STAGE(bufoff, (gbase) + (h) * hstep, voffA); } while (0)
#define PG8_LDA(dst, b, h) do { _Pragma("unroll") for (int m = 0; m < 4; ++m) _Pragma("unroll") for (int k = 0; k < 2; ++k) dst[m][k] = *(const PG8_LAS bf16x8*)(lds + PG8_SA(b, h) + aoff + m * 2048 + k * 1024); } while (0)
#define PG8_LDB(dst, b, h) do { _Pragma("unroll") for (int n = 0; n < 2; ++n) _Pragma("unroll") for (int k = 0; k < 2; ++k) dst[n][k] = *(const PG8_LAS bf16x8*)(lds + PG8_SB(b, h) + boff + n * 2048 + k * 1024); } while (0)
#define PG8_MMA(ai, bj, At, Bt) do { __builtin_amdgcn_s_setprio(1); _Pragma("unroll") for (int m = 0; m < 4; ++m) _Pragma("unroll") for (int n = 0; n < 2; ++n) { \
        if constexpr (FP8) { typedef int i32x4_ __attribute__((ext_vector_type(4))); \
            const v8i32 _bv = __builtin_shufflevector(__builtin_bit_cast(i32x4_, Bt[n][0]), __builtin_bit_cast(i32x4_, Bt[n][1]), 0, 1, 2, 3, 4, 5, 6, 7); \
            const v8i32 _av = __builtin_shufflevector(__builtin_bit_cast(i32x4_, At[m][0]), __builtin_bit_cast(i32x4_, At[m][1]), 0, 1, 2, 3, 4, 5, 6, 7); \
            asm volatile("s_nop 1\n\tv_mfma_scale_f32_16x16x128_f8f6f4 %0, %1, %2, %0, %3, %3 op_sel_hi:[0,0,0]" : "+v"(acc[ai][bj][m][n]) : "v"(_bv), "v"(_av), "v"(0x7f7f7f7f)); } \
        else { _Pragma("unroll") for (int k = 0; k < 2; ++k) acc[ai][bj][m][n] = __builtin_amdgcn_mfma_f32_16x16x32_bf16(Bt[n][k], At[m][k], acc[ai][bj][m][n], 0, 0, 0); } } \
        __builtin_amdgcn_s_setprio(0); } while (0)
#define PG8_WAIT_V(n) asm volatile("s_waitcnt vmcnt(" #n ")" ::: "memory")
#define PG8_WAIT_L(n) asm volatile("s_waitcnt lgkmcnt(" #n ")" ::: "memory")
#define PG8_BAR __builtin_amdgcn_s_barrier()
#define PG8_SCHED __builtin_amdgcn_sched_barrier(0)
    Unit cur, nxt; int ui = 0;
    if (!S.next(0, cur)) return;
    f32x4 acc[2][2][4][2];
#pragma unroll
    for (int a = 0; a < 2; ++a)
#pragma unroll
        for (int b = 0; b < 2; ++b)
#pragma unroll
            for (int m = 0; m < 4; ++m)
#pragma unroll
                for (int n = 0; n < 2; ++n) acc[a][b][m][n] = (f32x4){0.f, 0.f, 0.f, 0.f};
    bf16x8 At[4][2], B0[2][2], B1[2][2];
    const char* cA = (const char*)g.A + (IDXA ? (size_t)0 : (size_t)cur.pm * tstep); const char* cB = (const char*)g.Bt + (size_t)cur.pn * tstep;
    if constexpr (IDXA) PG8_IDX(cur, vAc);
    S.a_ready(cur);
    if constexpr (SP2) {
        PG8_STAGE(PG8_SB(0, 0), cB, voffB); PG8_STAGE(PG8_SB(0, 1), cB + hstep, voffB); PG8_STAGE_A(PG8_SA(0, 0), cA, 0, false); PG8_STAGE_A(PG8_SA(0, 1), cA, 1, false);
        if (wr == 1) PG8_BAR;
        PG8_WAIT_V(2); PG8_BAR;
        PG8_STAGE(PG8_SB(1, 0), cB + kstep, voffB); PG8_STAGE_A(PG8_SA(1, 0), cA + kstep, 0, false); PG8_STAGE(PG8_SB(1, 1), cB + hstep + kstep, voffB);
        PG8_WAIT_V(6); PG8_BAR;
    } else {
        PG8_STAGE(PG8_SB(0, 0), cB, voffB); PG8_STAGE(PG8_SA(0, 0), cA, voffA); PG8_STAGE(PG8_SB(0, 1), cB + hstep, voffB); PG8_STAGE(PG8_SA(0, 1), cA + hstep, voffA);
        if (wr == 1) PG8_BAR;
        PG8_WAIT_V(4); PG8_BAR;
        PG8_STAGE(PG8_SB(1, 0), cB + kstep, voffB); PG8_STAGE(PG8_SA(1, 0), cA + kstep, voffA); PG8_STAGE(PG8_SB(1, 1), cB + hstep + kstep, voffB);
        PG8_WAIT_V(6); PG8_BAR;
    }
    for (;;) {
        const bool has_next = S.next(ui + 1, nxt);
        if constexpr (IDXA) { if (has_next) PG8_IDX(nxt, vAn); }
        const char* nA = (has_next && !IDXA) ? (const char*)g.A + (size_t)nxt.pm * tstep : cA; const char* nB = has_next ? (const char*)g.Bt + (size_t)nxt.pn * tstep : cB;
        for (int t = 0; t < nt; t += 2) {
            const bool last = (t == nt - 2);
            const char* a1 = cA + (size_t)(t + 1) * kstep;
            const char* a2 = last ? nA : cA + (size_t)(t + 2) * kstep; const char* b2 = last ? nB : cB + (size_t)(t + 2) * kstep;
            const char* a3 = a2 + kstep; const char* b3 = b2 + kstep;
            const bool nsel = last && has_next;
            if (last && has_next) S.a_ready(nxt);
            if constexpr (SP2) {
            PG8_LDB(B0, 0, 0); PG8_LDB(B1, 0, 1); PG8_SCHED; PG8_LDA(At, 0, 0); PG8_STAGE_A(PG8_SA(1, 1), a1, 1, false);
            PG8_WAIT_V(8); PG8_WAIT_L(0); PG8_BAR; PG8_MMA(0, 0, At, B0); PG8_MMA(0, 1, At, B1); PG8_BAR; PG8_SCHED;
            PG8_LDA(At, 0, 1); PG8_STAGE(PG8_SB(0, 0), b2, voffB); PG8_STAGE(PG8_SB(0, 1), b2 + hstep, voffB); PG8_STAGE_A(PG8_SA(0, 0), a2, 0, nsel);
            PG8_WAIT_V(8); PG8_WAIT_L(0); PG8_BAR; PG8_MMA(1, 0, At, B0); PG8_MMA(1, 1, At, B1); PG8_BAR; PG8_SCHED;
            PG8_LDB(B0, 1, 0); PG8_LDB(B1, 1, 1); PG8_SCHED; PG8_LDA(At, 1, 0); PG8_STAGE_A(PG8_SA(0, 1), a2, 1, nsel);
            PG8_WAIT_V(8); PG8_WAIT_L(0); PG8_BAR; PG8_MMA(0, 0, At, B0); PG8_MMA(0, 1, At, B1); PG8_BAR; PG8_SCHED;
            PG8_LDA(At, 1, 1); PG8_STAGE(PG8_SB(1, 0), b3, voffB); PG8_STAGE(PG8_SB(1, 1), b3 + hstep, voffB); PG8_STAGE_A(PG8_SA(1, 0), a3, 0, nsel);
            PG8_WAIT_V(8); PG8_WAIT_L(0); PG8_BAR; PG8_MMA(1, 0, At, B0); PG8_MMA(1, 1, At, B1); PG8_BAR; PG8_SCHED;
            } else {
            PG8_LDB(B0, 0, 0); PG8_SCHED; PG8_LDA(At, 0, 0); PG8_STAGE(PG8_SA(1, 1), a1 + hstep, voffA);
            PG8_WAIT_L(8); PG8_BAR; PG8_WAIT_L(0); PG8_MMA(0, 0, At, B0); PG8_BAR; PG8_SCHED;
            PG8_LDB(B1, 0, 1); PG8_STAGE(PG8_SB(0, 0), b2, voffB);
            PG8_BAR; PG8_WAIT_L(0); PG8_MMA(0, 1, At, B1); PG8_BAR;
            PG8_LDA(At, 0, 1); PG8_STAGE(PG8_SA(0, 0), a2, voffA);
            PG8_BAR; PG8_WAIT_L(0); PG8_MMA(1, 0, At, B0); PG8_BAR; PG8_SCHED;
            PG8_STAGE(PG8_SB(0, 1), b2 + hstep, voffB);
            PG8_WAIT_V(6); PG8_BAR; PG8_MMA(1, 1, At, B1); PG8_BAR;
            PG8_LDB(B0, 1, 0); PG8_SCHED; PG8_LDA(At, 1, 0); PG8_STAGE(PG8_SA(0, 1), a2 + hstep, voffA);
            PG8_WAIT_L(8); PG8_BAR; PG8_WAIT_L(0); PG8_MMA(0, 0, At, B0); PG8_BAR; PG8_SCHED;
            PG8_LDB(B1, 1, 1); PG8_STAGE(PG8_SB(1, 0), b3, voffB);
            PG8_BAR; PG8_WAIT_L(0); PG8_MMA(0, 1, At, B1); PG8_BAR;
            PG8_LDA(At, 1, 1); PG8_STAGE(PG8_SA(1, 0), a3, voffA);
            PG8_BAR; PG8_WAIT_L(0); PG8_MMA(1, 0, At, B0); PG8_BAR; PG8_SCHED;
            PG8_STAGE(PG8_SB(1, 1), b3 + hstep, voffB);
            PG8_WAIT_V(6); PG8_BAR; PG8_MMA(1, 1, At, B1); PG8_BAR;
            }
        }
        if constexpr (FP8) asm volatile("s_nop 15" ::: "memory");
        if constexpr (ALIGN_EPI) { if (wr == 0) PG8_BAR; }
        if constexpr (!Epi::AFTER_DRAIN) { E(acc, cur, wr, wc, fr, fq); S.done(cur); }
        if (!has_next) break;
#pragma unroll
        for (int a = 0; a < 2; ++a)
#pragma unroll
            for (int b = 0; b < 2; ++b)
#pragma unroll
                for (int m = 0; m < 4; ++m)
#pragma unroll
                    for (int n = 0; n < 2; ++n) acc[a][b][m][n] = (f32x4){0.f, 0.f, 0.f, 0.f};
        cur = nxt; cA = nA; cB = nB; ++ui;
        if constexpr (IDXA) { vAc[0][0] = vAn[0][0]; vAc[0][1] = vAn[0][1]; vAc[1][0] = vAn[1][0]; vAc[1][1] = vAn[1][1]; }
        if constexpr (ALIGN_EPI) { if (wr == 1) PG8_BAR; }
    }
    PG8_WAIT_V(0);
    if constexpr (!ALIGN_EPI) { if (wr == 0) PG8_BAR; }
    PG8_BAR;
    if constexpr (Epi::AFTER_DRAIN) { E.fused(acc, cur, wr, wc, fr, fq, lds, wid, lane); S.done(cur); }
#undef PG8_SA
#undef PG8_SB
#undef PG8_STAGE
#undef PG8_STAGE_A
#undef PG8_IDX
#undef PG8_LDA
#undef PG8_LDB
#undef PG8_MMA
#undef PG8_WAIT_V
#undef PG8_WAIT_L
#undef PG8_BAR
#undef PG8_SCHED
}
}
namespace pg8 {
struct GroupedOrder {
    int nMe, nNe, per, nwg, G, c;
    __host__ __device__ void init(int nMe_, int nNe_, int G_, int c_) { nMe = nMe_; nNe = nNe_; per = nMe * nNe; nwg = 16 * per; G = G_; c = c_; }
    __host__ __device__ bool next(int i, Unit& u) const {
        const long L = (long)i * G + c; if (L >= nwg) return false;
        int wgid = (int)L; { const int q = nwg / NXCD, r = nwg % NXCD, xcd = wgid % NXCD, off = wgid / NXCD; wgid = (xcd < r ? xcd * (q + 1) : r * (q + 1) + (xcd - r) * q) + off; }
        const int e = wgid / per, l = wgid % per;
        u.pm = e * nMe + (l % nMe); u.pn = e * nNe + (l / nMe); return true;
    }
    __device__ __forceinline__ void a_ready(const Unit&) const {}
    __device__ __forceinline__ void done(const Unit&) const {}
};
struct In1Order {
    StaticOrder S0; int G, c;
    __host__ __device__ void init(int G_, int c_) { S0.init(16384, 29 * 256, G_, c_); G = G_; c = c_; }
    __host__ __device__ bool next(int i, Unit& u) const {
        const long L = (long)i * G + c;
        if (L < 1856) return S0.next(i, u);
        const int q = (int)L - 1856; if (q >= 136) return false;
        const int t = q % 17; u.pm = 64 + q / 17; u.pn = (t < 8) ? 4 + t : ((t < 16) ? 12 + t : 28); return true;
    }
    __device__ __forceinline__ void a_ready(const Unit&) const {}
    __device__ __forceinline__ void done(const Unit&) const {}
};
struct EpiStore {
    static constexpr bool PERM = true, AFTER_DRAIN = false;
    bf16_t* O; int ldc; int nNt; float sc;
    __device__ __forceinline__ void operator()(const f32x4 (&acc)[2][2][4][2], const Unit& u, int wr, int wc, int fr, int fq) const {
        const int row0 = u.pm * BM + wr * 64 + fr; const int col0 = (u.pn % nNt) * BM + wc * 32 + 8 * fq;
#pragma unroll
        for (int ai = 0; ai < 2; ++ai)
#pragma unroll
            for (int m = 0; m < 4; ++m) { bf16_t* rowp = O + (size_t)(row0 + ai * HALF + m * 16) * ldc + col0;
#pragma unroll
                for (int bj = 0; bj < 2; ++bj) { const f32x4 v0 = acc[ai][bj][m][0] * sc, v1 = acc[ai][bj][m][1] * sc;
                    u32x4 w; w.x = cvt_pk_bf16(v0[0], v0[1]); w.y = cvt_pk_bf16(v0[2], v0[3]); w.z = cvt_pk_bf16(v1[0], v1[1]); w.w = cvt_pk_bf16(v1[2], v1[3]);
                    *(u32x4*)(rowp + bj * HALF) = w; } }
    }
};
struct EpiSwiglu {
    static constexpr bool PERM = true, AFTER_DRAIN = false;
    unsigned char* O;
    __device__ __forceinline__ float sg(float a, float b) const { const float x = a * (1.f / 64.f); const float r = x * __builtin_amdgcn_rcpf(1.f + __expf(-x)) * (b * (1.f / 64.f)); return fminf(fmaxf(r, -448.f), 448.f); }
    __device__ __forceinline__ void operator()(const f32x4 (&acc)[2][2][4][2], const Unit& u, int wr, int wc, int fr, int fq) const {
        const int row0 = u.pm * BM + wr * 64 + fr; const int col0 = (u.pn % 16) * HALF + wc * 32 + 8 * fq;
#pragma unroll
        for (int ai = 0; ai < 2; ++ai)
#pragma unroll
            for (int m = 0; m < 4; ++m) { unsigned char* rowp = O + (size_t)(row0 + ai * HALF + m * 16) * 2048 + col0;
                const f32x4 a0 = acc[ai][0][m][0], a1 = acc[ai][0][m][1], b0 = acc[ai][1][m][0], b1 = acc[ai][1][m][1];
                int lo = 0, hi = 0;
                lo = __builtin_amdgcn_cvt_pk_fp8_f32(sg(a0[0], b0[0]), sg(a0[1], b0[1]), lo, false); lo = __builtin_amdgcn_cvt_pk_fp8_f32(sg(a0[2], b0[2]), sg(a0[3], b0[3]), lo, true);
                hi = __builtin_amdgcn_cvt_pk_fp8_f32(sg(a1[0], b1[0]), sg(a1[1], b1[1]), hi, false); hi = __builtin_amdgcn_cvt_pk_fp8_f32(sg(a1[2], b1[2]), sg(a1[3], b1[3]), hi, true);
                typedef unsigned u32x2 __attribute__((ext_vector_type(2)));
                *(u32x2*)rowp = (u32x2){(unsigned)lo, (unsigned)hi}; }
    }
};
struct EpiRes {
    static constexpr bool PERM = false, AFTER_DRAIN = false;
    const float* Xlat; const float* Xctx; float* H; const float* gate;
    __device__ __forceinline__ void operator()(const f32x4 (&acc)[2][2][4][2], const Unit& u, int wr, int wc, int fr, int fq) const {
        const int row0 = u.pm * BM + wr * 64 + fr, col0 = u.pn * BM + wc * 32 + 4 * fq;
        const float* gp = gate + (size_t)((u.pm < 64) ? (u.pm >> 3) : 8) * 12288 + col0;
        f32x4 g[2][2];
#pragma unroll
        for (int bj = 0; bj < 2; ++bj)
#pragma unroll
            for (int n = 0; n < 2; ++n) g[bj][n] = *(const f32x4*)(gp + bj * HALF + n * 16);
        const float* sbase = (u.pm < 64) ? Xlat : Xctx - (size_t)16384 * 2048;
#pragma unroll
        for (int ai = 0; ai < 2; ++ai)
#pragma unroll
            for (int m = 0; m < 4; ++m) { const int row = row0 + ai * HALF + m * 16;
                const float* src = sbase + (size_t)row * 2048 + col0; float* dst = H + (size_t)row * 2048 + col0;
#pragma unroll
                for (int bj = 0; bj < 2; ++bj)
#pragma unroll
                    for (int n = 0; n < 2; ++n) { const int c = bj * HALF + n * 16;
                        const f32x4 x = *(const f32x4*)(src + c);
                        *(f32x4*)(dst + c) = x + g[bj][n] * acc[ai][bj][m][n]; } }
    }
};
}
#ifndef PG8_SP2
#define PG8_SP2 true
#endif
#ifndef PG8_ALIGN
#define PG8_ALIGN true
#endif
constexpr int NWAVES = 8;
constexpr int NTHR = NWAVES * 64;
#ifndef MK_ONE_LAUNCH
#define MK_ONE_LAUNCH 1
#endif
constexpr int D = 2048, NB = 8, SEQ = 2048, CTXL = 256;
constexpr int M_LAT = NB * SEQ, M_CTX = NB * CTXL, M_ALL = M_LAT + M_CTX;
constexpr int LD0 = 6400, LD1 = 7424;
constexpr int EV_IN = 6176, OD_IN = 7184;
constexpr int NE_ = 16, FF = 2048;
constexpr int ME0 = 2304, ME1 = 2048;
constexpr float EPS = 1e-6f;
constexpr int C0_X1 = 0, C0_X2 = 1024, C0_V = 2048, C0_GQ = 3072, C0_GK = 3584, C0_GV = 4096, C0_GR = 5120, C0_CODE = 6144;
constexpr int C1_MQ = 0, C1_MK = 1024, C1_MV = 2048, C1_MO = 3072, C1_DQ = 4096, C1_DK = 5120, C1_DV = 6144, C1_G = 7168;
constexpr size_t MiB = 1u << 20;
constexpr size_t WS_CTL = 0, CTL_ZERO_BYTES = 1 * MiB;
constexpr size_t WS_MOD = 1 * MiB;
constexpr size_t WS_AFF = 2 * MiB;
constexpr size_t WS_SEL = 4 * MiB;
constexpr size_t WS_TOK = 6 * MiB;
constexpr size_t WS_GW  = 7 * MiB;
constexpr size_t WS_FTL = 8 * MiB;
constexpr size_t WS_FTC = 40 * MiB;
constexpr size_t WS_WIN0 = 44 * MiB;
constexpr size_t WS_WIN1 = 69 * MiB;
constexpr size_t WS_WOUT = 98 * MiB;
constexpr size_t WS_W13 = 114 * MiB;
constexpr size_t WS_W2 = 626 * MiB;
constexpr size_t WS_H = 882 * MiB;
constexpr size_t WS_A = 1026 * MiB;
constexpr size_t WS_Y = 1098 * MiB;
constexpr size_t WS_P = 1170 * MiB;
constexpr size_t WS_XS = WS_P, WS_YS = WS_P;
constexpr size_t WS_MIX = 1431 * MiB;
constexpr size_t WS_XV = WS_MIX, WS_Z = WS_MIX + 108 * MiB, WS_OG = WS_MIX + 144 * MiB;
constexpr size_t WS_HID = WS_MIX;
constexpr size_t WS_XT = 1719 * MiB;
constexpr size_t WS_YT = 1815 * MiB;
constexpr size_t WS_FTT = 1847 * MiB;
constexpr size_t WS_GQ = 1864 * MiB;
constexpr size_t WS_GDEC = 1972 * MiB;
constexpr size_t WS_MQK = WS_GQ;
constexpr size_t WS_MLS = WS_GQ + 80 * MiB;
constexpr size_t WS_END = 1974 * MiB;
constexpr int CW_BAR = 4096;
constexpr int RING_OFF = 0, RING_BYTES = 131072;
constexpr int LDSCTL_OFF = 146432, MISC_OFF = LDSCTL_OFF + 320;
constexpr int LDS_BYTES = 147456;
#define GAS __attribute__((address_space(1)))
#define LAS __attribute__((address_space(3)))
typedef unsigned short bf16;
typedef unsigned v4u __attribute__((ext_vector_type(4)));
typedef unsigned v2u __attribute__((ext_vector_type(2)));
typedef float f32x4 __attribute__((ext_vector_type(4)));
typedef short bf16x8 __attribute__((ext_vector_type(8)));
typedef GAS unsigned gu32;
#define RLX_AGENT __ATOMIC_RELAXED, __HIP_MEMORY_SCOPE_AGENT
#define LDS_WAIT() asm volatile("s_waitcnt lgkmcnt(0)" ::: "memory")
#define VM_WAIT() asm volatile("s_waitcnt vmcnt(0)" ::: "memory")
typedef float f32x2v_ __attribute__((ext_vector_type(2)));
typedef __bf16 bf16x2v_ __attribute__((ext_vector_type(2)));
__device__ __forceinline__ unsigned pk2(float lo, float hi) { return __builtin_bit_cast(unsigned, __builtin_convertvector((f32x2v_){lo, hi}, bf16x2v_)); }
__device__ __forceinline__ unsigned f2bf(float f) { return pk2(f, 0.f) & 0xffffu; }
__device__ __forceinline__ unsigned pk4_fp8(float a, float b, float c, float d) { int r = 0; r = __builtin_amdgcn_cvt_pk_fp8_f32(a, b, r, false); r = __builtin_amdgcn_cvt_pk_fp8_f32(c, d, r, true); return (unsigned)r; }
__device__ __forceinline__ float bf2f(unsigned short b) { return __builtin_bit_cast(float, ((unsigned)b) << 16); }
__device__ __forceinline__ float bflo(unsigned w) { return __builtin_bit_cast(float, w << 16); }
__device__ __forceinline__ float bfhi(unsigned w) { return __builtin_bit_cast(float, w & 0xffff0000u); }
__device__ __forceinline__ float siluf(float x) { return x * __builtin_amdgcn_rcpf(1.f + __expf(-x)); }
__device__ __forceinline__ float sigmoidf_(float x) { return __builtin_amdgcn_rcpf(1.f + __expf(-x)); }
__device__ __forceinline__ float logsigmoidf_(float x) { return fminf(x, 0.f) - __logf(1.f + __expf(-fabsf(x))); }
template <int CTRL> __device__ __forceinline__ float dppmov(float v) { return __builtin_bit_cast(float, __builtin_amdgcn_update_dpp(0, __builtin_bit_cast(int, v), CTRL, 0xf, 0xf, true)); }
__device__ __forceinline__ float row16_sum(float v) { v += dppmov<0xB1>(v); v += dppmov<0x4E>(v); v += dppmov<0x124>(v); v += dppmov<0x128>(v); return v; }
__device__ __forceinline__ float row16_max(float v) { v = fmaxf(v, dppmov<0xB1>(v)); v = fmaxf(v, dppmov<0x4E>(v)); v = fmaxf(v, dppmov<0x124>(v)); v = fmaxf(v, dppmov<0x128>(v)); return v; }
__device__ __forceinline__ float xrow_sum(float v) {
    float a = v, b = v; asm volatile("s_nop 1\n\tv_permlane16_swap_b32 %0, %1" : "+v"(a), "+v"(b)); v = a + b; a = v; b = v;
    asm volatile("s_nop 1\n\tv_permlane32_swap_b32 %0, %1" : "+v"(a), "+v"(b)); return a + b; }
__device__ __forceinline__ float xrow_max(float v) {
    float a = v, b = v; asm volatile("s_nop 1\n\tv_permlane16_swap_b32 %0, %1" : "+v"(a), "+v"(b)); v = fmaxf(a, b); a = v; b = v;
    asm volatile("s_nop 1\n\tv_permlane32_swap_b32 %0, %1" : "+v"(a), "+v"(b)); return fmaxf(a, b); }
__device__ __forceinline__ float wave_sum(float v) { return xrow_sum(row16_sum(v)); }
#define XB_TMO      128
#define XB_XCNT(j)  (256  + 64 * (j))
#define XB_XSUB(j)  (1280 + 64 * (j))
#define XB_XGEN(j)  (2304 + 64 * (j))
#define XB_TOP      3328
#define XB_TOPGEN   3392
#define XCD_BAR_WORDS 3456
#define XB_SPIN_CAP (1u << 18)

__device__ __forceinline__ unsigned xb_ld(unsigned* p)              { return __hip_atomic_load(p, __ATOMIC_RELAXED, __HIP_MEMORY_SCOPE_AGENT); }
__device__ __forceinline__ unsigned xb_add(unsigned* p, unsigned v) { return __hip_atomic_fetch_add(p, v, __ATOMIC_RELAXED, __HIP_MEMORY_SCOPE_AGENT); }
__device__ __forceinline__ unsigned xb_xcc_id() { return (unsigned)__builtin_amdgcn_s_getreg((3 << 11) | 20) & 0xFu; }
#define XB_SPIN(cond, bar) do { unsigned _sp = 0; while (cond) { __builtin_amdgcn_s_sleep(1); \
    if ((++_sp & 255u) == 0u) { if (xb_ld(&(bar)[XB_TMO])) break; if (_sp > XB_SPIN_CAP) { atomicAdd(&(bar)[XB_TMO], 1u); break; } } } } while (0)

struct XcdBarrier {
    unsigned* bar; unsigned x;
    volatile LAS unsigned* st;
};

__device__ __forceinline__ XcdBarrier xcd_barrier_post(unsigned* bar, volatile LAS unsigned* st) {
    XcdBarrier b; b.bar = bar; b.x = xb_xcc_id(); b.st = st;
    if (threadIdx.x == 0) (void)xb_add(&bar[XB_XCNT(b.x)], 1u);
    return b;
}
__device__ __forceinline__ void xcd_barrier_complete(unsigned* bar, unsigned x, unsigned& nloc, unsigned& nx) {
    const unsigned G = gridDim.x * gridDim.y * gridDim.z;
    unsigned sum, cnt, mine, sp = 0u;
    for (;;) {
        sum = 0u; cnt = 0u; mine = 0u;
#pragma unroll
        for (unsigned j = 0; j < 16; ++j) { const unsigned c = xb_ld(&bar[XB_XCNT(j)]); sum += c; cnt += (c > 0u) ? 1u : 0u; mine = (j == x) ? c : mine; }
        if (sum == G) break;
        __builtin_amdgcn_s_sleep(1);
        if ((++sp & 255u) == 0u) { if (xb_ld(&bar[XB_TMO])) break; if (sp > XB_SPIN_CAP) { atomicAdd(&bar[XB_TMO], 1u); break; } }
    }
    nloc = mine > 0u ? mine : 1u; nx = cnt > 0u ? cnt : 1u;
}

__device__ __forceinline__ void xcd_barrier(const XcdBarrier& b) {
    asm volatile("s_waitcnt vmcnt(0)" ::: "memory");
    __syncthreads();
    if (threadIdx.x == 0) {
        unsigned* bar = b.bar;
        __builtin_amdgcn_s_waitcnt(0);
        unsigned nloc = b.st[0], nx = b.st[1];
        if (nloc == 0u) { xcd_barrier_complete(bar, b.x, nloc, nx); b.st[0] = nloc; b.st[1] = nx; }
        const unsigned old = xb_add(&bar[XB_XSUB(b.x)], 1u);
        const unsigned gen = old / nloc;
        if (old + 1u == (gen + 1u) * nloc) {
            __builtin_amdgcn_fence(__ATOMIC_RELEASE, "agent");
            asm volatile("s_waitcnt vmcnt(0)" ::: "memory");
            const unsigned og = xb_add(&bar[XB_TOP], 1u);
            const unsigned tg = og / nx;
            if (og + 1u == (tg + 1u) * nx) xb_add(&bar[XB_TOPGEN], 1u);
            else XB_SPIN(xb_ld(&bar[XB_TOPGEN]) == tg, bar);
            __builtin_amdgcn_fence(__ATOMIC_ACQUIRE, "agent");
            xb_add(&bar[XB_XGEN(b.x)], 1u);
            asm volatile("s_waitcnt vmcnt(0)" ::: "memory");
        } else {
            XB_SPIN(xb_ld(&bar[XB_XGEN(b.x)]) == gen, bar);
            __builtin_amdgcn_fence(__ATOMIC_ACQUIRE, "agent");
            asm volatile("s_waitcnt vmcnt(0)" ::: "memory");
        }
    }
    __syncthreads();
}

typedef short s16x4 __attribute__((ext_vector_type(4)));
__device__ __forceinline__ bf16x8 tr_frag(const LAS bf16* T, int ld, int r0, int c0, int lane) {
    const int g = lane >> 4, q = (lane & 15) >> 2, p = lane & 3;
    const LAS bf16* a = T + (r0 + 8 * g + q) * ld + c0 + 4 * p;
    const s16x4 lo = __builtin_amdgcn_ds_read_tr16_b64_v4i16((LAS s16x4*)a);
    const s16x4 hi = __builtin_amdgcn_ds_read_tr16_b64_v4i16((LAS s16x4*)(a + 4 * ld));
    return (bf16x8){lo[0], lo[1], lo[2], lo[3], hi[0], hi[1], hi[2], hi[3]};
}
__device__ __forceinline__ float wave_incl_sum(float v, int lane) {
#pragma unroll
    for (int o = 1; o < 64; o <<= 1) { const float t = __shfl_up(v, o); v = (lane >= o) ? v + t : v; }
    return v;
}
__device__ __forceinline__ float wave_incl_max(float v, int lane) {
#pragma unroll
    for (int o = 1; o < 64; o <<= 1) { const float t = __shfl_up(v, o); v = (lane >= o) ? fmaxf(v, t) : v; }
    return v;
}
__device__ __forceinline__ float wave_max(float v) { return xrow_max(row16_max(v)); }
struct Frame {
    LAS unsigned char* lds;
    volatile LAS unsigned* MISC;
    gu32* ctl;
    int tid, lane, wave;
    int bid, G;
    const float* in[35];
    float* out;
    unsigned char* ws;
};
enum { I_X = 0, I_C, I_CTX, I_CCTX, I_ADAW, I_ADAB, I_N1G, I_N2G, I_OUTW, I_RTW, I_W1, I_W3, I_W2, I_FING, I_EVW, I_HCW, I_HCB, I_HPW1, I_HPB1, I_HFREQ, I_HPW2, I_HPB2, I_HPW3, I_HBIAS,
       I_GGW2, I_GGB, I_GNG, I_ODW, I_MCW, I_MCB, I_MIGB, I_MFGB, I_MNG, I_DLAM, I_DNG };

__device__ __forceinline__ float grp16_max(float v) { return row16_max(v); }
__device__ __forceinline__ float grp16_sum(float v) { return row16_sum(v); }
constexpr int CW_CVT = 64;
typedef unsigned u32x4_ __attribute__((ext_vector_type(4)));
struct CvtItem { const float* src; int ldn, c0, ncols, k0; bf16* dst; int d0, dstep, fp8; };
__device__ __forceinline__ CvtItem cvt_decode(Frame& F, int it) {
    CvtItem c; c.dstep = 128; c.ncols = 256; c.fp8 = 0;
    bf16* Win0 = (bf16*)(F.ws + WS_WIN0); bf16* Win1 = (bf16*)(F.ws + WS_WIN1); bf16* Wout = (bf16*)(F.ws + WS_WOUT); bf16* W13 = (bf16*)(F.ws + WS_W13); bf16* W2t = (bf16*)(F.ws + WS_W2);
    constexpr int N_IN0 = 16 * 25, N_IN1 = 16 * 29, N_OUT = 2 * 16 * 8;
    if (it < N_IN0) { const int kb = it / 25, cb = it % 25; c.src = F.in[I_EVW]; c.ldn = EV_IN; c.k0 = kb * 128; c.dst = Win0; c.c0 = cb * 256; c.d0 = cb * 256; if (cb == 24) c.ncols = 32; return c; }
    it -= N_IN0;
    if (it < N_IN1) { const int kb = it / 29, cb = it % 29; c.src = F.in[I_ODW]; c.ldn = OD_IN; c.k0 = kb * 128; c.dst = Win1;
        if (cb < 16) { c.c0 = cb * 256; c.d0 = cb * 256; } else if (cb < 28) { c.c0 = 4112 + (cb - 16) * 256; c.d0 = 4096 + (cb - 16) * 256; } else { c.c0 = 4096; c.d0 = 7168; c.ncols = 16; }
        return c; }
    it -= N_IN1;
    if (it < N_OUT) { const int l = it >> 7, q = it & 127, kb = q >> 3, cb = q & 7; c.src = F.in[I_OUTW] + (size_t)l * 2048 * 2048; c.ldn = 2048; c.k0 = kb * 128; c.dst = Wout + (size_t)l * 2048 * 2048; c.c0 = cb * 256; c.d0 = cb * 256; return c; }
    it -= N_OUT;
    { const int cb = it & 7; it >>= 3; const int kb = it & 15; it >>= 4; const int which = it % 3; it /= 3; const int e = it & 15, l = it >> 4;
      const size_t so = ((size_t)l * 16 + e) * 2048 * 2048; c.ldn = 2048; c.k0 = kb * 128; c.c0 = cb * 256; c.fp8 = 1;
      if (which == 0) { c.src = F.in[I_W1] + so; c.dst = W13 + ((size_t)l * 16 + e) * 4096 * 1024; c.d0 = cb * 512; c.dstep = 256; }
      else if (which == 1) { c.src = F.in[I_W3] + so; c.dst = W13 + ((size_t)l * 16 + e) * 4096 * 1024; c.d0 = cb * 512 + 128; c.dstep = 256; }
      else { c.src = F.in[I_W2] + so; c.dst = W2t + ((size_t)l * 16 + e) * 2048 * 1024; c.d0 = cb * 256; }
      return c; }
}
__device__ __forceinline__ void cvt_load(const CvtItem& c, int wave, int lane, f32x4 (&v)[16]) {
    const bool ok = 4 * lane < c.ncols;
#pragma unroll
    for (int i = 0; i < 16; ++i) v[i] = ok ? *(const GAS f32x4*)(c.src + (size_t)(c.k0 + 16 * wave + i) * c.ldn + c.c0 + 4 * lane) : (f32x4){0.f, 0.f, 0.f, 0.f};
}
constexpr int CVT_NPRE = 16 * 25 + 16 * 29 + 2 * 16 * 8, CVT_L0_END = CVT_NPRE + 6144, CVT_L1_END = CVT_NPRE + 12288;
constexpr int CVT_LATE0 = 64 * 10 + 192 * 14, CVT_LATE1 = 128 * 5 + 56 * 10;
constexpr int CVT_NEARLY = CVT_NPRE + 12288 - CVT_LATE0 - CVT_LATE1;
__device__ __forceinline__ int cvt_early_item(int j) {
    if (j < CVT_L0_END - CVT_LATE0) return j;
    return j + CVT_LATE0;
}
template <bool DYN> __device__ __forceinline__ void cvt_run(Frame& F, int first, int cnt) {
    constexpr int TLD = 264;
    LAS bf16* T = (LAS bf16*)(F.lds);
    LAS int* nxt = (LAS int*)(F.lds + 128 * TLD * 2);
    const int NIT = DYN ? CVT_NEARLY : cnt;
    __syncthreads();
    int jn = 0;
    if (DYN) { if (F.tid == 0) nxt[0] = (int)__hip_atomic_fetch_add((unsigned*)(F.ctl + CW_CVT), 1u, __ATOMIC_RELAXED, __HIP_MEMORY_SCOPE_AGENT);
        __syncthreads(); jn = nxt[0]; }
    int j = jn;
    f32x4 v[16];
    CvtItem cur = cvt_decode(F, j < NIT ? (DYN ? cvt_early_item(j) : first + j) : 0);
    if (j < NIT) cvt_load(cur, F.wave, F.lane, v);
    while (j < NIT) {
        __syncthreads();
        if (DYN) { if (F.tid == 0) nxt[0] = (int)__hip_atomic_fetch_add((unsigned*)(F.ctl + CW_CVT), 1u, __ATOMIC_RELAXED, __HIP_MEMORY_SCOPE_AGENT); }
        { const float wsc = cur.fp8 ? 64.f : 1.f;
#pragma unroll
        for (int i = 0; i < 16; ++i) { v2u w; w.x = pk2(v[i][0] * wsc, v[i][1] * wsc); w.y = pk2(v[i][2] * wsc, v[i][3] * wsc); *(LAS v2u*)(T + (16 * F.wave + i) * TLD + 4 * F.lane) = w; } }
        __syncthreads();
        const int jnext = DYN ? nxt[0] : j + 1;
        const CvtItem me = cur;
        if (jnext < NIT) { cur = cvt_decode(F, DYN ? cvt_early_item(jnext) : first + jnext); cvt_load(cur, F.wave, F.lane, v); }
        const int fr = F.lane & 15, fq = F.lane >> 4;
#pragma unroll
        for (int x = 0; x < 2; ++x) { const int jc = 32 * F.wave + 16 * x + fr; const int drow = me.d0 + (jc >> 7) * me.dstep + (jc & 127);
#pragma unroll
            for (int r = 0; r < 4; ++r) { const bf16x8 f = tr_frag(T, TLD, 32 * r, 32 * F.wave + 16 * x, F.lane);
                if (me.fp8) { const u32x4_ fw = __builtin_bit_cast(u32x4_, f); v2u o8; o8.x = pk4_fp8(bflo(fw.x), bfhi(fw.x), bflo(fw.y), bfhi(fw.y)); o8.y = pk4_fp8(bflo(fw.z), bfhi(fw.z), bflo(fw.w), bfhi(fw.w));
                    *(GAS v2u*)((unsigned char*)me.dst + (size_t)drow * 2048 + me.k0 + 32 * r + 8 * fq) = o8; }
                else if (jc < me.ncols) *(GAS bf16x8*)(me.dst + (size_t)drow * 2048 + me.k0 + 32 * r + 8 * fq) = f; } }
        j = jnext;
    }
    __syncthreads();
}
__device__ __forceinline__ void p0_convert(Frame& F) {
    { bf16* Win0 = (bf16*)(F.ws + WS_WIN0); bf16* Win1 = (bf16*)(F.ws + WS_WIN1);
      const int gt = F.bid * NTHR + F.tid, NT = F.G * NTHR; const v4u z = {0u, 0u, 0u, 0u};
      for (int i = gt; i < (LD0 - EV_IN) * 256; i += NT) *(GAS v4u*)(Win0 + (size_t)EV_IN * 2048 + (size_t)i * 8) = z;
      for (int i = gt; i < (LD1 - OD_IN) * 256; i += NT) *(GAS v4u*)(Win1 + (size_t)OD_IN * 2048 + (size_t)i * 8) = z; }
    if (F.G == 256) cvt_run<true>(F, 0, 0);
    else { cvt_run<true>(F, 0, 0); if (F.bid == 0) { cvt_run<false>(F, CVT_L0_END - CVT_LATE0, CVT_LATE0); cvt_run<false>(F, CVT_L1_END - CVT_LATE1, CVT_LATE1); } }
}
__device__ __forceinline__ void cvt_late(Frame& F, int first, int w0, int per) {
    if (F.G != 256 || F.bid < w0) return;
    cvt_run<false>(F, first + (F.bid - w0) * per, per);
}
__device__ __forceinline__ void p0_adaln(Frame& F) {
    if (F.bid >= 192) return;
    LAS float* s = (LAS float*)(F.lds);
    LAS float* red = (LAS float*)(F.lds + 9 * 2048 * 4);
    for (int i = F.tid; i < 9 * 2048; i += NTHR) { const float v = (i < 8 * 2048) ? F.in[I_C][i] : F.in[I_CCTX][i - 8 * 2048]; s[i] = siluf(v); }
    __syncthreads();
    float* MOD = (float*)(F.ws + WS_MOD);
    for (int u = F.bid; u < 192; u += F.G) {
        const int l = u / 96, j0 = (u % 96) * 128, jj = F.tid & 127, kq = F.tid >> 7;
        const float* W = F.in[I_ADAW] + (size_t)l * 2048 * 12288 + j0 + jj;
        float acc[9];
#pragma unroll
        for (int r = 0; r < 9; ++r) acc[r] = 0.f;
        for (int k = kq * 512; k < kq * 512 + 512; k += 4) {
            float w[4];
#pragma unroll
            for (int q = 0; q < 4; ++q) w[q] = W[(size_t)(k + q) * 12288];
#pragma unroll
            for (int r = 0; r < 9; ++r) { const f32x4 sv = *(const LAS f32x4*)(s + r * 2048 + k); acc[r] += sv[0] * w[0] + sv[1] * w[1] + sv[2] * w[2] + sv[3] * w[3]; }
        }
#pragma unroll
        for (int r = 0; r < 9; ++r) red[(kq * 9 + r) * 128 + jj] = acc[r];
        __syncthreads();
        for (int i = F.tid; i < 9 * 128; i += NTHR) { const int r = i >> 7, j = i & 127;
            MOD[((size_t)l * 9 + r) * 12288 + j0 + j] = red[(0 * 9 + r) * 128 + j] + red[(1 * 9 + r) * 128 + j] + red[(2 * 9 + r) * 128 + j] + red[(3 * 9 + r) * 128 + j] + F.in[I_ADAB][l * 12288 + j0 + j]; }
        __syncthreads();
    }
}
__device__ __forceinline__ void p0_filters(Frame& F) {
    LAS float* h1 = (LAS float*)(F.lds);
    LAS float* h2 = h1 + 512;
    LAS float* ft = h2 + 512;
    for (int uu = F.bid; uu < 2304; uu += F.G) {
        const int jb = uu & 7, u = uu >> 3;
        const bool lat = u < 256; const int L = lat ? 2048 : 256; const int p0 = (lat ? u : u - 256) * 8;
        float* FT = (float*)(F.ws + (lat ? WS_FTL : WS_FTC));
        __syncthreads();
        if (F.tid < 8 * 33) { const int pp = F.tid / 33, i = F.tid % 33; const float pos = (float)(p0 + pp);
            float v;
            if (i == 0) v = pos / (float)(L - 1);
            else { const int bi = (i - 1) & 15; const float band = 1e-4f + (float)bi * ((15.f - 1e-4f) / 15.f); const float ang = (6.283185307179586f / (float)L) * pos * band; v = (i <= 16) ? cosf(ang) : -sinf(ang); }
            ft[pp * 36 + i] = v; }
        __syncthreads();
        { const int pp = F.tid >> 6, j = F.tid & 63; float a = F.in[I_HPB1][j];
#pragma unroll 11
          for (int i = 0; i < 33; ++i) a += ft[pp * 36 + i] * F.in[I_HPW1][i * 64 + j];
          h1[pp * 64 + j] = sinf(F.in[I_HFREQ][j] * a); }
        __syncthreads();
        { const int pp = F.tid >> 6, j = F.tid & 63; float a = F.in[I_HPB2][j];
#pragma unroll 16
          for (int i = 0; i < 64; ++i) a += h1[pp * 64 + i] * F.in[I_HPW2][i * 64 + j];
          h2[pp * 64 + j] = sinf(F.in[I_HFREQ][64 + j] * a); }
        __syncthreads();
        { const int j = jb * 512 + F.tid;
            float acc[8];
#pragma unroll
            for (int pp = 0; pp < 8; ++pp) acc[pp] = 0.f;
#pragma unroll 16
            for (int i = 0; i < 64; ++i) { const float w = F.in[I_HPW3][(size_t)i * 4096 + j];
#pragma unroll
                for (int pp = 0; pp < 8; ++pp) acc[pp] += h2[pp * 64 + i] * w; }
            const int order = j >> 11, dir = (j >> 10) & 1, ch = j & 1023;
            const float da = -3.0701134573253945f, db = -15.350567286626973f;
            const float delta = fabsf(da + (float)ch * ((db - da) / 1023.f));
#pragma unroll
            for (int pp = 0; pp < 8; ++pp) { const int p = p0 + pp; const float t = (float)p / (float)(L - 1); const float val = acc[pp] * __expf(-t * delta);
                if (dir == 0) FT[((size_t)order * (2 * L - 1) + (L - 1 + p)) * 1024 + ch] = val;
                else if (p >= 1) FT[((size_t)order * (2 * L - 1) + (L - 1 - p)) * 1024 + ch] = val; }
        }
    }
    __syncthreads();
}

__device__ __forceinline__ void load_row(const float* p, int lane, f32x4 (&v)[8]) {
#pragma unroll
    for (int i = 0; i < 8; ++i) v[i] = *(const GAS f32x4*)(p + 4 * (lane + 64 * i));
}
__device__ __forceinline__ float row_rstd(const f32x4 (&v)[8]) {
    float s = 0.f;
#pragma unroll
    for (int i = 0; i < 8; ++i) s += (v[i][0] * v[i][0] + v[i][1] * v[i][1]) + (v[i][2] * v[i][2] + v[i][3] * v[i][3]);
    return 1.f / sqrtf(wave_sum(s) * (1.f / 2048.f) + EPS);
}
__device__ __forceinline__ void modulate_store(f32x4 (&v)[8], float rstd, const float* g, const float* shift, const float* scale, bf16* orow, int lane) {
#pragma unroll
    for (int i = 0; i < 8; ++i) { const int c = 4 * (lane + 64 * i);
        const f32x4 gg = *(const GAS f32x4*)(g + c), sh = *(const GAS f32x4*)(shift + c), sc = *(const GAS f32x4*)(scale + c);
        v[i] = (v[i] * rstd * gg) * (sc + 1.f) + sh;
        v2u w; w.x = pk2(v[i][0], v[i][1]); w.y = pk2(v[i][2], v[i][3]);
        *(GAS v2u*)(orow + c) = w; }
}
__device__ __forceinline__ void modulate_store8(f32x4 (&v)[8], float rstd, const float* g, const float* shift, const float* scale, unsigned char* orow, int lane) {
#pragma unroll
    for (int i = 0; i < 8; ++i) { const int c = 4 * (lane + 64 * i);
        const f32x4 gg = *(const GAS f32x4*)(g + c), sh = *(const GAS f32x4*)(shift + c), sc = *(const GAS f32x4*)(scale + c);
        v[i] = (v[i] * rstd * gg) * (sc + 1.f) + sh;
        *(GAS unsigned*)(orow + c) = pk4_fp8(v[i][0], v[i][1], v[i][2], v[i][3]); }
}
__device__ __forceinline__ const float* xrow_ptr(Frame& F, int r) { return (r < M_LAT) ? F.in[I_X] + (size_t)r * D : F.in[I_CTX] + (size_t)(r - M_LAT) * D; }
__device__ __forceinline__ int row_b(int r) { return (r < M_LAT) ? (r >> 11) : 8; }

__device__ __forceinline__ void mod_params(const float* g, const float* shift, const float* scale, int lane, f32x4 (&gs)[8], f32x4 (&sh)[8]) {
#pragma unroll
    for (int i = 0; i < 8; ++i) { const int c = 4 * (lane + 64 * i); gs[i] = *(const GAS f32x4*)(g + c) * (*(const GAS f32x4*)(scale + c) + 1.f); sh[i] = *(const GAS f32x4*)(shift + c); }
}
__device__ __forceinline__ void ph_norm1_l0(Frame& F) {
    const int gw = F.bid * NWAVES + F.wave, NGW = F.G * NWAVES;
    const float* MOD = (const float*)(F.ws + WS_MOD); bf16* A = (bf16*)(F.ws + WS_A);
    const int per = (M_ALL + NGW - 1) / NGW, r0 = gw * per, r1 = (r0 + per < M_ALL) ? r0 + per : M_ALL;
    f32x4 v[8], gs[8], sh[8]; int curb = -1;
    if (r0 < r1) load_row(xrow_ptr(F, r0), F.lane, v);
    for (int r = r0; r < r1; ++r) { f32x4 nv[8]; if (r + 1 < r1) load_row(xrow_ptr(F, r + 1), F.lane, nv);
        const int bb = row_b(r); if (bb != curb) { const float* m = MOD + (size_t)bb * 12288; mod_params(F.in[I_N1G], m, m + 2048, F.lane, gs, sh); curb = bb; }
        const float rs = row_rstd(v);
        bf16* orow = A + (size_t)r * D;
#pragma unroll
        for (int i = 0; i < 8; ++i) { const f32x4 o = (v[i] * rs) * gs[i] + sh[i]; v2u w; w.x = pk2(o[0], o[1]); w.y = pk2(o[2], o[3]); *(GAS v2u*)(orow + 4 * (F.lane + 64 * i)) = w; }
#pragma unroll
        for (int i = 0; i < 8; ++i) v[i] = nv[i]; }
}
__device__ __forceinline__ void ph_codes_skinny(Frame& F) {
    constexpr int WLD = 2056;
    LAS bf16* W = (LAS bf16*)(F.lds);
    const bf16* A = (const bf16*)(F.ws + WS_A); const bf16* Wc = (const bf16*)(F.ws + WS_WIN0) + (size_t)6144 * 2048; bf16* P = (bf16*)(F.ws + WS_P);
    __syncthreads();
    for (int i = F.tid; i < 32 * 256; i += NTHR) { const int r = i >> 8, ch = i & 255; *(LAS v4u*)(W + r * WLD + ch * 8) = *(const GAS v4u*)(Wc + (size_t)r * 2048 + ch * 8); }
    __syncthreads();
    const int gw = F.bid * NWAVES + F.wave, NGW = F.G * NWAVES; const int fr = F.lane & 15, fq = F.lane >> 4;
    for (int task = gw; task < M_ALL / 16; task += NGW) { const int r0 = task * 16;
        f32x4 acc[2] = {(f32x4){0.f, 0.f, 0.f, 0.f}, (f32x4){0.f, 0.f, 0.f, 0.f}};
        const bf16* ap = A + (size_t)(r0 + fr) * 2048 + 8 * fq;
#pragma unroll 8
        for (int ks = 0; ks < 64; ++ks) { const bf16x8 af = *(const GAS bf16x8*)(ap + 32 * ks);
#pragma unroll
            for (int nt = 0; nt < 2; ++nt) { const bf16x8 bf = *(const LAS bf16x8*)(W + (16 * nt + fr) * WLD + 32 * ks + 8 * fq); acc[nt] = __builtin_amdgcn_mfma_f32_16x16x32_bf16(af, bf, acc[nt], 0, 0, 0); } }
#pragma unroll
        for (int nt = 0; nt < 2; ++nt)
#pragma unroll
            for (int j = 0; j < 4; ++j) P[(size_t)(r0 + 4 * fq + j) * LD0 + C0_CODE + 16 * nt + fr] = (bf16)f2bf(acc[nt][j]);
    }
    __syncthreads();
}
__device__ __forceinline__ void ph_norm2_router(Frame& F, int l, int nrows) {
    LAS float* rwT = (LAS float*)(F.lds);
    __syncthreads();
    for (int i = F.tid; i < 2048 * 16; i += NTHR) { const int j = i >> 4, e = i & 15; rwT[e * 2048 + j] = F.in[I_RTW][(size_t)l * 2048 * 16 + i]; }
    __syncthreads();
    const int gw = F.bid * NWAVES + F.wave, NGW = F.G * NWAVES;
    const float* MOD = (const float*)(F.ws + WS_MOD) + (size_t)l * 9 * 12288; const float* H = (const float*)(F.ws + WS_H);
    bf16* A = (bf16*)(F.ws + WS_A); float* AFF = (float*)(F.ws + WS_AFF); int* SEL = (int*)(F.ws + WS_SEL);
    const int per = (nrows + NGW - 1) / NGW, r0 = gw * per, r1 = (r0 + per < nrows) ? r0 + per : nrows;
    f32x4 v[8], gs[8], sh[8]; int curb = -1;
    if (r0 < r1) load_row(H + (size_t)r0 * D, F.lane, v);
    for (int r = r0; r < r1; ++r) { f32x4 nv[8]; if (r + 1 < r1) load_row(H + (size_t)(r + 1) * D, F.lane, nv);
        const int bb = row_b(r); if (bb != curb) { const float* m = MOD + (size_t)bb * 12288; mod_params(F.in[I_N2G] + l * 2048, m + 3 * 2048, m + 4 * 2048, F.lane, gs, sh); curb = bb; }
        const float rs = row_rstd(v);
        { unsigned char* orow = (unsigned char*)A + (size_t)r * D;
#pragma unroll
          for (int i = 0; i < 8; ++i) { v[i] = (v[i] * rs) * gs[i] + sh[i]; *(GAS unsigned*)(orow + 4 * (F.lane + 64 * i)) = pk4_fp8(v[i][0], v[i][1], v[i][2], v[i][3]); } }
        float pa[16];
#pragma unroll
        for (int e = 0; e < 16; ++e) { const LAS float* wp = rwT + e * 2048 + 4 * F.lane; f32x4 a4 = {0.f, 0.f, 0.f, 0.f};
#pragma unroll
            for (int i = 0; i < 8; ++i) { const f32x4 w = *(const LAS f32x4*)(wp + 256 * i); a4 += v[i] * w; }
            pa[e] = (a4[0] + a4[1]) + (a4[2] + a4[3]); }
        float s1[8], s2[4];
#pragma unroll
        for (int e = 0; e < 8; ++e) { float x = pa[e], y = pa[e + 8]; asm volatile("s_nop 1\n\tv_permlane32_swap_b32 %0, %1" : "+v"(x), "+v"(y)); s1[e] = x + y; }
#pragma unroll
        for (int e = 0; e < 4; ++e) { float x = s1[e], y = s1[e + 4]; asm volatile("s_nop 1\n\tv_permlane16_swap_b32 %0, %1" : "+v"(x), "+v"(y)); s2[e] = row16_sum(x + y); }
        { float mx = fmaxf(fmaxf(s2[0], s2[1]), fmaxf(s2[2], s2[3])); mx = xrow_max(mx);
          float ex[4], se = 0.f;
#pragma unroll
          for (int e = 0; e < 4; ++e) { ex[e] = expf(s2[e] - mx); se += ex[e]; }
          se = xrow_sum(se); const float inv = 1.f / se;
          if ((F.lane & 15) == 0) { const int R = F.lane >> 4; const int eb = 4 * (R & 1) + 8 * (R >> 1);
#pragma unroll
              for (int e = 0; e < 4; ++e) AFF[(size_t)(eb + e) * M_ALL + r] = ex[e] * inv; }
          if (F.lane < 16) SEL[(size_t)r * 16 + F.lane] = -1; }
#pragma unroll
        for (int i = 0; i < 8; ++i) v[i] = nv[i];
    }
    __syncthreads();
}
__device__ __forceinline__ void ph_norm2_router2(Frame& F, int l, int nrows) {
    constexpr int WLD = 2064;
    LAS bf16* Wh = (LAS bf16*)(F.lds); LAS bf16* Wl = Wh + 16 * WLD;
    LAS float* red = (LAS float*)(F.lds + 4 * 16 * WLD);
    LAS float* ssq = red + 8 * 256;
    LAS float* cb = ssq + 128;
    const float* MOD = (const float*)(F.ws + WS_MOD) + (size_t)l * 9 * 12288; const float* H = (const float*)(F.ws + WS_H);
    unsigned char* A8 = (unsigned char*)(F.ws + WS_A); float* AFF = (float*)(F.ws + WS_AFF); int* SEL = (int*)(F.ws + WS_SEL);
    float* GSB = (float*)(F.ws + WS_XT) + (size_t)F.bid * 4 * 4096;
    const int fr = F.lane & 15, fq = F.lane >> 4;
    const int ntile = nrows >> 4; const int t0 = (int)(((long)F.bid * ntile) / F.G), t1 = (int)(((long)(F.bid + 1) * ntile) / F.G);
    const int colw = 256 * F.wave + 8 * fq;
    int curb = -1, nreb = 0; const float* gsb = GSB;
    f32x4 x[8][2];
#define RT_LOAD(dst, tile) do { const float* p_ = H + (size_t)((tile) * 16 + fr) * D + colw; _Pragma("unroll") for (int ks = 0; ks < 8; ++ks) { dst[ks][0] = *(const GAS f32x4*)(p_ + 32 * ks); dst[ks][1] = *(const GAS f32x4*)(p_ + 32 * ks + 4); } } while (0)
    if (t0 < t1) RT_LOAD(x, t0);
    for (int t = t0; t < t1; ++t) {
        const int rbase = t * 16; const int bb = row_b(rbase);
        if (bb != curb) {
            const float* m = MOD + (size_t)bb * 12288; const float* g = F.in[I_N2G] + l * 2048; const float* shp = m + 3 * 2048; const float* scp = m + 4 * 2048;
            float* gw_ = GSB + (size_t)(nreb & 3) * 4096;
            __syncthreads();
            for (int k = F.tid; k < 2048; k += NTHR) { gw_[k] = g[k] * (scp[k] + 1.f); gw_[2048 + k] = shp[k]; }
            const float* rw = F.in[I_RTW] + (size_t)l * 2048 * 16; const int e0 = 4 * (F.tid & 3); f32x4 cacc = {0.f, 0.f, 0.f, 0.f};
#pragma unroll 1
            for (int it = 0; it < 16; it += 4) { f32x4 wv[4]; float gk[4], sk[4], hk[4];
#pragma unroll
                for (int u = 0; u < 4; ++u) { const int i4 = F.tid + NTHR * (it + u); const int k = i4 >> 2; wv[u] = *(const GAS f32x4*)(rw + 4 * (size_t)i4); gk[u] = g[k]; sk[u] = scp[k]; hk[u] = shp[k]; }
#pragma unroll
                for (int u = 0; u < 4; ++u) { const int k = (F.tid + NTHR * (it + u)) >> 2; const float gsk = gk[u] * (sk[u] + 1.f);
#pragma unroll
                    for (int c = 0; c < 4; ++c) { const float val = wv[u][c] * gsk; const unsigned short hi = (unsigned short)f2bf(val); const unsigned short lo = (unsigned short)f2bf(val - bf2f(hi));
                        Wh[(e0 + c) * WLD + k] = (bf16)hi; Wl[(e0 + c) * WLD + k] = (bf16)lo; }
                    cacc += wv[u] * hk[u]; } }
#pragma unroll
            for (int c = 0; c < 4; ++c) { float v_ = cacc[c]; v_ += dppmov<0x124>(v_); v_ += dppmov<0x128>(v_); cacc[c] = xrow_sum(v_); }
            if (F.lane < 4) {
#pragma unroll
                for (int c = 0; c < 4; ++c) red[F.wave * 16 + 4 * F.lane + c] = cacc[c]; }
            __syncthreads();
            if (F.tid < 16) { float c_ = 0.f;
#pragma unroll
                for (int ww = 0; ww < 8; ++ww) c_ += red[ww * 16 + F.tid];
                cb[F.tid] = c_; }
            __syncthreads();
            curb = bb; gsb = gw_; ++nreb; }
        f32x4 nx[8][2];
        if (t + 1 < t1) RT_LOAD(nx, t + 1);
        float ss = 0.f; f32x4 acc = {0.f, 0.f, 0.f, 0.f};
#pragma unroll
        for (int ks = 0; ks < 8; ++ks) { const f32x4 a = x[ks][0], b = x[ks][1];
            ss += (a[0] * a[0] + a[1] * a[1]) + (a[2] * a[2] + a[3] * a[3]) + (b[0] * b[0] + b[1] * b[1]) + (b[2] * b[2] + b[3] * b[3]);
            v4u h, lo_; h.x = pk2(a[0], a[1]); h.y = pk2(a[2], a[3]); h.z = pk2(b[0], b[1]); h.w = pk2(b[2], b[3]);
            lo_.x = pk2(a[0] - bflo(h.x), a[1] - bfhi(h.x)); lo_.y = pk2(a[2] - bflo(h.y), a[3] - bfhi(h.y)); lo_.z = pk2(b[0] - bflo(h.z), b[1] - bfhi(h.z)); lo_.w = pk2(b[2] - bflo(h.w), b[3] - bfhi(h.w));
            const bf16x8 ah = __builtin_bit_cast(bf16x8, h), al = __builtin_bit_cast(bf16x8, lo_);
            const bf16x8 bh = *(const LAS bf16x8*)(Wh + fr * WLD + colw + 32 * ks), bl = *(const LAS bf16x8*)(Wl + fr * WLD + colw + 32 * ks);
            acc = __builtin_amdgcn_mfma_f32_16x16x32_bf16(ah, bh, acc, 0, 0, 0); acc = __builtin_amdgcn_mfma_f32_16x16x32_bf16(al, bh, acc, 0, 0, 0); acc = __builtin_amdgcn_mfma_f32_16x16x32_bf16(ah, bl, acc, 0, 0, 0); }
        ss = xrow_sum(ss);
        if (fq == 0) ssq[F.wave * 16 + fr] = ss;
#pragma unroll
        for (int j = 0; j < 4; ++j) red[(F.wave * 16 + 4 * fq + j) * 16 + fr] = acc[j];
        __syncthreads();
        { float tot = 0.f;
#pragma unroll
          for (int ww = 0; ww < 8; ++ww) tot += ssq[ww * 16 + fr];
          const float rs = 1.f / sqrtf(tot * (1.f / 2048.f) + EPS);
          unsigned char* orow = A8 + (size_t)(rbase + fr) * D + colw;
#pragma unroll
          for (int ks = 0; ks < 8; ++ks) { const f32x4 g0 = *(const GAS f32x4*)(gsb + colw + 32 * ks), g1 = *(const GAS f32x4*)(gsb + colw + 32 * ks + 4), s0 = *(const GAS f32x4*)(gsb + 2048 + colw + 32 * ks), s1 = *(const GAS f32x4*)(gsb + 2048 + colw + 32 * ks + 4);
              const f32x4 o0 = (x[ks][0] * rs) * g0 + s0, o1 = (x[ks][1] * rs) * g1 + s1;
              v2u w8; w8.x = pk4_fp8(o0[0], o0[1], o0[2], o0[3]); w8.y = pk4_fp8(o1[0], o1[1], o1[2], o1[3]);
              *(GAS v2u*)(orow + 32 * ks) = w8; } }
        if (F.lane < 32) {
            const int row = 2 * F.wave + (F.lane >> 4), e = F.lane & 15; float lg = 0.f, tot = 0.f;
#pragma unroll
            for (int ww = 0; ww < 8; ++ww) { lg += red[(ww * 16 + row) * 16 + e]; tot += ssq[ww * 16 + row]; }
            lg = lg * (1.f / sqrtf(tot * (1.f / 2048.f) + EPS)) + cb[e];
            const float mx = row16_max(lg); const float ex = expf(lg - mx); const float se = row16_sum(ex);
            AFF[(size_t)e * M_ALL + rbase + row] = ex / se; SEL[(size_t)(rbase + row) * 16 + e] = -1; }
        __syncthreads();
#pragma unroll
        for (int ks = 0; ks < 8; ++ks) { x[ks][0] = nx[ks][0]; x[ks][1] = nx[ks][1]; }
    }
#undef RT_LOAD
    __syncthreads();
}
__device__ __forceinline__ void ph_topk(Frame& F, int nprob, int Me) {
    typedef unsigned long long u64; typedef u64 u64x2 __attribute__((ext_vector_type(2)));
    LAS u64* keys = (LAS u64*)(F.lds);
    const float* AFF = (const float*)(F.ws + WS_AFF); int* SEL = (int*)(F.ws + WS_SEL); float* GW = (float*)(F.ws + WS_GW);
    int* TOK = (int*)(F.ws + WS_TOK);
    const int nunits = 512 + (nprob - 128);
    for (int u = F.bid; u < nunits; u += F.G) {
        const bool lat = u < 512; const int q = lat ? (u >> 2) : (u - 512); const int part = lat ? (u & 3) : 0; const int b = q >> 4, e = q & 15;
        const int T = lat ? 2048 : 256, cap = lat ? 256 : 32, r0 = lat ? b * 2048 : M_LAT + b * 256;
        __syncthreads();
        for (int i = F.tid; i < T; i += NTHR) keys[i] = ((u64)__builtin_bit_cast(unsigned, AFF[(size_t)e * M_ALL + r0 + i]) << 32) | (u64)(0xFFFFFFFFu - (unsigned)i);
        __syncthreads();
        const int i = part * 512 + F.tid;
        if (i < T) { const u64 ki = keys[i]; int rank = 0;
#pragma unroll 8
            for (int j = 0; j < T; j += 2) { const u64x2 kj = *(const LAS u64x2*)(keys + j); rank += (kj.x > ki) ? 1 : 0; rank += (kj.y > ki) ? 1 : 0; }
            if (rank < cap) { const int slot = e * Me + (lat ? b * 256 + rank : 2048 + b * 32 + rank);
                GW[slot] = __builtin_bit_cast(float, (unsigned)(ki >> 32)); SEL[(size_t)(r0 + i) * 16 + e] = slot; TOK[slot] = r0 + i; } }
    }
    __syncthreads();
}
__device__ __forceinline__ void ph_topk2(Frame& F, int nprob, int Me) {
    LAS unsigned* hist = (LAS unsigned*)(F.lds);
    LAS unsigned* ctl = hist + 256;
    LAS unsigned* wcnt = ctl + 8;
    LAS unsigned* tlist = wcnt + 32;
    const float* AFF = (const float*)(F.ws + WS_AFF); int* SEL = (int*)(F.ws + WS_SEL); float* GW = (float*)(F.ws + WS_GW); int* TOK = (int*)(F.ws + WS_TOK);
    for (int u = F.bid; u < nprob; u += F.G) {
        const bool lat = u < 128; const int q = lat ? u : u - 128; const int b = q >> 4, e = q & 15;
        const int T = lat ? 2048 : 256, cap = lat ? 256 : 32, r0 = lat ? b * 2048 : M_LAT + b * 256;
        unsigned v[4]; bool ok[4];
#pragma unroll
        for (int x = 0; x < 4; ++x) { const int i = F.tid + NTHR * x; ok[x] = i < T; v[x] = ok[x] ? __builtin_bit_cast(unsigned, AFF[(size_t)e * M_ALL + r0 + i]) : 0u; }
        unsigned prefix = 0u, want = (unsigned)cap;
#pragma unroll 1
        for (int p = 0; p < 4; ++p) { const int shift = 24 - 8 * p;
            __syncthreads();
            if (F.tid < 256) hist[F.tid] = 0u;
            __syncthreads();
#pragma unroll
            for (int x = 0; x < 4; ++x) if (ok[x] && (p == 0 || (v[x] >> (shift + 8)) == prefix)) __hip_atomic_fetch_add(hist + ((v[x] >> shift) & 255u), 1u, __ATOMIC_RELAXED, __HIP_MEMORY_SCOPE_WORKGROUP);
            __syncthreads();
            if (F.wave == 0) {
                const int top = 255 - 4 * F.lane; unsigned c[4];
#pragma unroll
                for (int j = 0; j < 4; ++j) c[j] = hist[top - j];
                const unsigned sgrp = (c[0] + c[1]) + (c[2] + c[3]); unsigned inc = sgrp;
#pragma unroll
                for (int d = 1; d < 64; d <<= 1) { const unsigned t_ = __shfl_up(inc, d); if (F.lane >= d) inc += t_; }
                const unsigned exc = inc - sgrp;
                if (exc < want && want <= inc) { unsigned acc = exc; int dsel = top; unsigned above = exc, cnt = c[0]; bool found = false;
#pragma unroll
                    for (int j = 0; j < 4; ++j) { if (!found) { if (acc + c[j] >= want) { dsel = top - j; above = acc; cnt = c[j]; found = true; } else acc += c[j]; } }
                    ctl[0] = (unsigned)dsel; ctl[1] = want - above; ctl[2] = cnt; } }
            __syncthreads();
            prefix = (prefix << 8) | ctl[0]; want = ctl[1]; }
        const unsigned vstar = prefix, neq = ctl[2];
        bool sel[4];
#pragma unroll
        for (int x = 0; x < 4; ++x) sel[x] = ok[x] && (v[x] >= vstar);
        if (neq != want) {
            __syncthreads();
            if (F.tid == 0) ctl[3] = 0u;
            __syncthreads();
#pragma unroll
            for (int x = 0; x < 4; ++x) if (ok[x] && v[x] == vstar) { const unsigned p_ = __hip_atomic_fetch_add(ctl + 3, 1u, __ATOMIC_RELAXED, __HIP_MEMORY_SCOPE_WORKGROUP); tlist[p_] = (unsigned)(F.tid + NTHR * x); }
            __syncthreads();
#pragma unroll
            for (int x = 0; x < 4; ++x) if (ok[x] && v[x] == vstar) { const unsigned me = (unsigned)(F.tid + NTHR * x); unsigned lower = 0u; for (unsigned j = 0; j < neq; ++j) lower += (tlist[j] < me) ? 1u : 0u; sel[x] = lower < want; } }
        unsigned lpre[4];
#pragma unroll
        for (int x = 0; x < 4; ++x) { const unsigned long long bal = __ballot(sel[x]); lpre[x] = (unsigned)__popcll(bal & ((1ull << F.lane) - 1ull)); if (F.lane == 0) wcnt[x * 8 + F.wave] = (unsigned)__popcll(bal); }
        __syncthreads();
        if (F.tid < 32) { unsigned o_ = 0u; for (int k = 0; k < F.tid; ++k) o_ += wcnt[k]; tlist[F.tid] = o_; }
        __syncthreads();
#pragma unroll
        for (int x = 0; x < 4; ++x) if (sel[x]) { const int pos = (int)(tlist[x * 8 + F.wave] + lpre[x]); const int i = F.tid + NTHR * x;
            const int slot = e * Me + (lat ? b * 256 + pos : 2048 + b * 32 + pos);
            GW[slot] = __builtin_bit_cast(float, v[x]); SEL[(size_t)(r0 + i) * 16 + e] = slot; TOK[slot] = r0 + i; }
    }
    __syncthreads();
}
__device__ __forceinline__ void ph_gather(Frame& F, int nslots) {
    const int gw = F.bid * NWAVES + F.wave, NGW = F.G * NWAVES;
    const unsigned char* A = (const unsigned char*)(F.ws + WS_A); unsigned char* XS = (unsigned char*)(F.ws + WS_XS); const int* TOK = (const int*)(F.ws + WS_TOK);
    for (int s = gw; s < nslots; s += NGW) { const int r = TOK[s];
        const GAS v4u* src = (const GAS v4u*)(A + (size_t)r * D); GAS v4u* dst = (GAS v4u*)(XS + (size_t)s * D);
#pragma unroll
        for (int i = 0; i < 2; ++i) dst[F.lane + 64 * i] = src[F.lane + 64 * i]; }
}
template <int MODE> __device__ __forceinline__ void ph_combine(Frame& F, int l, int nrows) {
    const int gw = F.bid * NWAVES + F.wave, NGW = F.G * NWAVES;
    const float* MODl = (const float*)(F.ws + WS_MOD) + (size_t)l * 9 * 12288; const float* MODn = (const float*)(F.ws + WS_MOD) + (size_t)1 * 9 * 12288;
    float* H = (float*)(F.ws + WS_H); const bf16* YS = (const bf16*)(F.ws + WS_YS); const int* SEL = (const int*)(F.ws + WS_SEL); const float* GW = (const float*)(F.ws + WS_GW);
    bf16* A = (bf16*)(F.ws + WS_A);
    f32x4 v[8]; int sel = -1;
    if (gw < nrows) { load_row(H + (size_t)gw * D, F.lane, v); sel = SEL[(size_t)gw * 16 + (F.lane & 15)]; }
    for (int r = gw; r < nrows; r += NGW) { f32x4 nv[8]; int nsel = -1; const int rn = r + NGW;
        if (rn < nrows) { load_row(H + (size_t)rn * D, F.lane, nv); nsel = SEL[(size_t)rn * 16 + (F.lane & 15)]; }
        f32x4 acc[8];
#pragma unroll
        for (int i = 0; i < 8; ++i) acc[i] = (f32x4){0.f, 0.f, 0.f, 0.f};
        const float gsel = (sel >= 0) ? GW[sel] : 0.f;
        unsigned long long mask = __ballot(sel >= 0) & 0xffffull;
        while (mask) { const int e = __builtin_ctzll(mask); mask &= mask - 1;
            const int s = __shfl(sel, e); const float g = __shfl(gsel, e); const bf16* yr = YS + (size_t)s * D;
#pragma unroll
            for (int i = 0; i < 8; ++i) { const v2u w = *(const GAS v2u*)(yr + 4 * (F.lane + 64 * i));
                acc[i][0] += g * bflo(w.x); acc[i][1] += g * bfhi(w.x); acc[i][2] += g * bflo(w.y); acc[i][3] += g * bfhi(w.y); } }
        const float* m5 = MODl + (size_t)row_b(r) * 12288 + 5 * 2048;
#pragma unroll
        for (int i = 0; i < 8; ++i) { const f32x4 g5 = *(const GAS f32x4*)(m5 + 4 * (F.lane + 64 * i)); v[i] = v[i] + g5 * acc[i]; }
        const float rs = row_rstd(v);
        if (MODE == 0) {
#pragma unroll
            for (int i = 0; i < 8; ++i) *(GAS f32x4*)(H + (size_t)r * D + 4 * (F.lane + 64 * i)) = v[i];
            const float* m = MODn + (size_t)row_b(r) * 12288;
            modulate_store(v, rs, F.in[I_N1G] + 2048, m, m + 2048, A + (size_t)r * D, F.lane);
        } else {
#pragma unroll
            for (int i = 0; i < 8; ++i) { const int c = 4 * (F.lane + 64 * i); const f32x4 gg = *(const GAS f32x4*)(F.in[I_FING] + c);
                *(GAS f32x4*)(F.out + (size_t)r * D + c) = v[i] * rs * gg; }
        }
#pragma unroll
        for (int i = 0; i < 8; ++i) v[i] = nv[i];
        sel = nsel;
    }
}
__device__ __forceinline__ void ph_hy_shortconv(Frame& F) {
    const int gw = F.bid * NWAVES + F.wave, NGW = F.G * NWAVES;
    const bf16* P = (const bf16*)(F.ws + WS_P); bf16* XV = (bf16*)(F.ws + WS_XV);
    const float* cw = F.in[I_HCW]; const float* cb = F.in[I_HCB];
    for (int r = M_LAT + gw; r < M_ALL; r += NGW) {
        const int t = (r < M_LAT) ? (r & 2047) : ((r - M_LAT) & 255); const int L = (r < M_LAT) ? 2048 : 256;
        const bool hp = t > 0, hn = t < L - 1;
        for (int i = 0; i < 6; ++i) { const int c = 8 * (F.lane + 64 * i);
            const v4u z = {0u, 0u, 0u, 0u};
            const v4u a = hp ? *(const GAS v4u*)(P + (size_t)(r - 1) * LD0 + c) : z;
            const v4u b = *(const GAS v4u*)(P + (size_t)r * LD0 + c);
            const v4u d = hn ? *(const GAS v4u*)(P + (size_t)(r + 1) * LD0 + c) : z;
            float o[8];
#pragma unroll
            for (int q = 0; q < 4; ++q) { const int cc = c + 2 * q;
                o[2 * q] = cb[cc] + cw[cc] * bflo(a[q]) + cw[3072 + cc] * bflo(b[q]) + cw[6144 + cc] * bflo(d[q]);
                o[2 * q + 1] = cb[cc + 1] + cw[cc + 1] * bfhi(a[q]) + cw[3072 + cc + 1] * bfhi(b[q]) + cw[6144 + cc + 1] * bfhi(d[q]); }
            v4u w; w.x = pk2(o[0], o[1]); w.y = pk2(o[2], o[3]); w.z = pk2(o[4], o[5]); w.w = pk2(o[6], o[7]);
            *(GAS v4u*)(XV + (size_t)r * 3072 + c) = w; }
    }
}
__device__ __forceinline__ void ph_hy_longconv(Frame& F, int order) {
    const bf16* XV = (const bf16*)(F.ws + WS_XV); bf16* Z = (bf16*)(F.ws + WS_Z); bf16* Y = (bf16*)(F.ws + WS_Y);
    const bf16* U = (order == 0) ? XV + C0_V : Z; const int ldu = (order == 0) ? 3072 : 1024;
    const bf16* Gt = XV + ((order == 0) ? C0_X1 : C0_X2);
    bf16* O = (order == 0) ? Z : Y; const int ldo = (order == 0) ? 1024 : 2048;
    const float* skip = F.in[I_HBIAS] + order * 1024;
    for (int u = 2048 + F.bid; u < 2304; u += F.G) {
        const bool lat = u < 2048; const int q = lat ? u : u - 2048;
        int b, cbk, tb, L, r0;
        if (lat) { tb = q & 127; cbk = (q >> 7) & 1; b = q >> 8; L = 2048; r0 = b * 2048; } else { tb = q & 15; cbk = (q >> 4) & 1; b = q >> 5; L = 256; r0 = M_LAT + b * 256; }
        const float* FT = (const float*)(F.ws + (lat ? WS_FTL : WS_FTC)) + (size_t)order * (2 * L - 1) * 1024;
        const int c = cbk * 512 + F.tid, t0 = tb * 16;
        float acc[16];
#pragma unroll
        for (int a = 0; a < 16; ++a) acc[a] = 0.f;
        for (int s0 = 0; s0 < L; s0 += 16) {
            float uu[16], ff[31];
#pragma unroll
            for (int i = 0; i < 16; ++i) uu[i] = bf2f(U[(size_t)(r0 + s0 + i) * ldu + c]);
            const int base = t0 - s0 + L - 1 - 15;
#pragma unroll
            for (int j = 0; j < 31; ++j) ff[j] = FT[(size_t)(base + j) * 1024 + c];
#pragma unroll
            for (int a = 0; a < 16; ++a)
#pragma unroll
                for (int i = 0; i < 16; ++i) acc[a] += ff[a - i + 15] * uu[i];
        }
        const float sk = skip[c];
#pragma unroll
        for (int a = 0; a < 16; ++a) { const size_t r = (size_t)(r0 + t0 + a);
            const float uv = bf2f(U[r * ldu + c]), g = bf2f(Gt[r * 3072 + c]);
            O[r * ldo + c] = (bf16)f2bf(g * (acc[a] + sk * uv)); }
    }
}
__device__ __forceinline__ int scan_row(int b, int dir, int n) {
    if (n < 256) { const int tc = dir ? 255 - n : n; return M_LAT + b * 256 + tc; }
    const int tl = n - 256; const int t = dir ? 2047 - tl : tl; return b * 2048 + t;
}
__device__ __forceinline__ void ph_gla_scan(Frame& F) {
    LAS float* W2s = (LAS float*)(F.lds);
    LAS float* gbs = W2s + 2048;
    LAS float* cds = gbs + 128;
    LAS float* as_ = cds + 256;
    LAS float* ks = as_ + 2048;
    LAS float* qs = ks + 2048;
    LAS float* vs_ = qs + 2048;
    LAS float* red = vs_ + 1024;
    const bf16* P = (const bf16*)(F.ws + WS_P); float* OG = (float*)(F.ws + WS_OG);
    for (int u = F.bid; u < 256; u += F.G) {
        const int vsl = u & 3, dir = (u >> 2) & 1, h = (u >> 3) & 3, b = u >> 5;
        const int v = F.tid & 63, kg = F.tid >> 6;
        __syncthreads();
        for (int i = F.tid; i < 2048; i += NTHR) W2s[i] = F.in[I_GGW2][(size_t)(dir * 16 + (i >> 7)) * 512 + h * 128 + (i & 127)];
        if (F.tid < 128) gbs[F.tid] = F.in[I_GGB][dir * 512 + h * 128 + F.tid];
        float S[16];
#pragma unroll
        for (int j = 0; j < 16; ++j) S[j] = 0.f;
        for (int n0 = 0; n0 < 2304; n0 += 16) {
            __syncthreads();
            if (F.tid < 256) { const int tk = F.tid >> 4, rr = F.tid & 15; const int row = scan_row(b, dir, n0 + tk); cds[F.tid] = bf2f(P[(size_t)row * LD0 + C0_CODE + dir * 16 + rr]); }
            for (int i = F.tid; i < 1024; i += NTHR) { const int tk = i >> 6, vx = i & 63; const int row = scan_row(b, dir, n0 + tk); vs_[i] = bf2f(P[(size_t)row * LD0 + C0_GV + h * 256 + vsl * 64 + vx]); }
            __syncthreads();
            for (int i = F.tid; i < 2048; i += NTHR) { const int tk = i >> 7, kx = i & 127; const int row = scan_row(b, dir, n0 + tk);
                qs[i] = bf2f(P[(size_t)row * LD0 + C0_GQ + h * 128 + kx]) * 0.08838834764831845f;
                ks[i] = bf2f(P[(size_t)row * LD0 + C0_GK + h * 128 + kx]);
                float lg = gbs[kx];
#pragma unroll
                for (int rr = 0; rr < 16; ++rr) lg += cds[tk * 16 + rr] * W2s[rr * 128 + kx];
                as_[i] = __expf(logsigmoidf_(lg) * (1.f / 16.f)); }
            __syncthreads();
            for (int tk = 0; tk < 16; ++tk) {
                const float vv = vs_[tk * 64 + v]; float part = 0.f;
#pragma unroll
                for (int j = 0; j < 16; ++j) { const int k = tk * 128 + kg * 16 + j; S[j] = as_[k] * S[j] + ks[k] * vv; part += qs[k] * S[j]; }
                red[((tk & 1) * 8 + kg) * 64 + v] = part;
                __syncthreads();
                if (kg == 0) { float o = 0.f;
#pragma unroll
                    for (int g = 0; g < 8; ++g) o += red[((tk & 1) * 8 + g) * 64 + v];
                    const int row = scan_row(b, dir, n0 + tk);
                    OG[((size_t)dir * M_ALL + row) * 1024 + h * 256 + vsl * 64 + v] = o; }
            }
        }
    }
    __syncthreads();
}
template <int ACT> __device__ __forceinline__ void ph_mix_combine(Frame& F, int nrows, const bf16* O0, const bf16* O1, const bf16* P, int ldp, int gcol, const float* ng, int ycol) {
    const int gw = F.bid * NWAVES + F.wave, NGW = F.G * NWAVES;
    bf16* Y = (bf16*)(F.ws + WS_Y);
    for (int r = gw; r < nrows; r += NGW) {
#pragma unroll
        for (int h = 0; h < 4; ++h) { const int c = h * 256 + 4 * F.lane;
            const v2u a = *(const GAS v2u*)(O0 + (size_t)r * 1024 + c), b2 = *(const GAS v2u*)(O1 + (size_t)r * 1024 + c);
            const f32x4 o = {bflo(a.x) + bflo(b2.x), bfhi(a.x) + bfhi(b2.x), bflo(a.y) + bflo(b2.y), bfhi(a.y) + bfhi(b2.y)};
            const float ss = wave_sum((o[0] * o[0] + o[1] * o[1]) + (o[2] * o[2] + o[3] * o[3]));
            const float rs = 1.f / sqrtf(ss * (1.f / 256.f) + EPS);
            const f32x4 gg = *(const GAS f32x4*)(ng + 4 * F.lane);
            const v2u gw2 = *(const GAS v2u*)(P + (size_t)r * ldp + gcol + c);
            float gt[4] = {bflo(gw2.x), bfhi(gw2.x), bflo(gw2.y), bfhi(gw2.y)};
            float y[4];
#pragma unroll
            for (int q = 0; q < 4; ++q) y[q] = o[q] * rs * gg[q] * (ACT == 0 ? siluf(gt[q]) : sigmoidf_(gt[q]));
            v2u w; w.x = pk2(y[0], y[1]); w.y = pk2(y[2], y[3]);
            *(GAS v2u*)(Y + (size_t)r * D + ycol + c) = w; }
    }
}
__device__ __forceinline__ void ph_ml_scan(Frame& F) {
    LAS float* qs = (LAS float*)(F.lds);
    LAS float* ks = qs + 2048;
    LAS float* vs_ = ks + 2048;
    LAS float* gts = vs_ + 512;
    LAS float* red = gts + 16;
    LAS float* redd = red + 1024;
    const bf16* P = (const bf16*)(F.ws + WS_P); float* OM = (float*)(F.ws + WS_OG);
    const float* cw = F.in[I_MCW]; const float* cb = F.in[I_MCB];
    for (int u = F.bid; u < 256; u += F.G) {
        const int vsl = u & 3, dir = (u >> 2) & 1, h = (u >> 3) & 3, b = u >> 5;
        const int v = F.tid & 63, kg = F.tid >> 6;
        float C[32], nn[32]; float m = 0.f;
#pragma unroll
        for (int j = 0; j < 32; ++j) { C[j] = 0.f; nn[j] = 0.f; }
        const float igb = F.in[I_MIGB][dir * 4 + h], fgb = F.in[I_MFGB][dir * 4 + h];
        for (int n0 = 0; n0 < 2304; n0 += 8) {
            __syncthreads();
            for (int i = F.tid; i < 4096; i += NTHR) { const int tk = i >> 9, col = i & 511; const int row = scan_row(b, dir, n0 + tk);
                const int pc = (col < 256) ? (h * 256 + col) : (1024 + h * 256 + (col - 256));
                const int t = (row < M_LAT) ? (row & 2047) : ((row - M_LAT) & 255); const int L = (row < M_LAT) ? 2048 : 256;
                float a = cb[pc] + cw[2048 + pc] * bf2f(P[(size_t)row * LD1 + pc]);
                if (t > 0) a += cw[pc] * bf2f(P[(size_t)(row - 1) * LD1 + pc]);
                if (t < L - 1) a += cw[4096 + pc] * bf2f(P[(size_t)(row + 1) * LD1 + pc]);
                a = siluf(a);
                if (col < 256) qs[tk * 256 + col] = a; else ks[tk * 256 + col - 256] = a * 0.0625f; }
            { const int tk = F.tid >> 6, vx = F.tid & 63; const int row = scan_row(b, dir, n0 + tk); vs_[F.tid] = bf2f(P[(size_t)row * LD1 + C1_MV + h * 256 + vsl * 64 + vx]); }
            if (F.tid < 8) { const int row = scan_row(b, dir, n0 + F.tid);
                gts[F.tid * 2 + 0] = bf2f(P[(size_t)row * LD1 + C1_G + dir * 8 + h]) + igb;
                gts[F.tid * 2 + 1] = logsigmoidf_(bf2f(P[(size_t)row * LD1 + C1_G + dir * 8 + 4 + h]) + fgb); }
            __syncthreads();
            for (int tk = 0; tk < 8; ++tk) {
                const float ig = gts[tk * 2], lf = gts[tk * 2 + 1];
                const float mn = fmaxf(lf + m, ig); const float fk = __expf(lf + m - mn), ik = __expf(ig - mn); m = mn;
                const float vv = vs_[tk * 64 + v] * ik; float part = 0.f, dpart = 0.f;
#pragma unroll
                for (int j = 0; j < 32; ++j) { const int k = tk * 256 + kg * 32 + j; const float kv = ks[k], qv = qs[k];
                    C[j] = fk * C[j] + vv * kv; nn[j] = fk * nn[j] + ik * kv; part += C[j] * qv; dpart += nn[j] * qv; }
                red[((tk & 1) * 8 + kg) * 64 + v] = part; if (v == 0) redd[(tk & 1) * 8 + kg] = dpart;
                __syncthreads();
                if (kg == 0 && n0 >= 256) { float num = 0.f, den = 0.f;
#pragma unroll
                    for (int g = 0; g < 8; ++g) { num += red[((tk & 1) * 8 + g) * 64 + v]; den += redd[(tk & 1) * 8 + g]; }
                    const int row = scan_row(b, dir, n0 + tk);
                    OM[((size_t)dir * M_LAT + row) * 1024 + h * 256 + vsl * 64 + v] = num / fmaxf(fabsf(den), __expf(-m)); }
            }
        }
    }
    __syncthreads();
}
__device__ __forceinline__ void ph_da_rope(Frame& F) {
    const int gw = F.bid * NWAVES + F.wave, NGW = F.G * NWAVES;
    bf16* P = (bf16*)(F.ws + WS_P);
    for (int r = gw; r < M_LAT; r += NGW) { const int t = r & 2047;
        for (int i = 0; i < 16; ++i) { const int pi = F.lane + 64 * i; const int which = pi >> 9, vec = (pi >> 5) & 15, axis = (pi >> 4) & 1, f = pi & 15;
            const int col = (which ? C1_DK : C1_DQ) + vec * 64 + axis * 32 + f;
            const float pos = (float)(axis ? (t & 63) : (t >> 6));
            const float inv = exp2f(-(float)f * (13.287712379549449f / 16.f));
            const float ang = pos * inv; const float cs = cosf(ang), sn = sinf(ang);
            const float xa = bf2f(P[(size_t)r * LD1 + col]), xb = bf2f(P[(size_t)r * LD1 + col + 16]);
            const float sc = which ? 1.f : 0.18033688011112042f;
            P[(size_t)r * LD1 + col] = (bf16)f2bf((xa * cs - xb * sn) * sc); P[(size_t)r * LD1 + col + 16] = (bf16)f2bf((xb * cs + xa * sn) * sc); }
    }
}
__device__ __forceinline__ void ph_da_attn(Frame& F) {
    constexpr int KS_LD = 136, VT_LD = 72, PW_LD = 72;
    LAS bf16* Ks = (LAS bf16*)(F.lds);
    LAS bf16* VT = Ks + 64 * KS_LD;
    LAS bf16* Pw = VT + 128 * VT_LD + (F.wave * 2) * 16 * PW_LD;
    const bf16* P = (const bf16*)(F.ws + WS_P); bf16* Y = (bf16*)(F.ws + WS_Y);
    const float lam_init = 0.35550906759096927f;
    float lam;
    { const float* lv = F.in[I_DLAM]; float s01 = 0.f, s23 = 0.f; for (int i = 0; i < 64; ++i) { s01 += lv[i] * lv[64 + i]; s23 += lv[128 + i] * lv[192 + i]; } lam = expf(s01) - expf(s23) + lam_init; }
    const int fr = F.lane & 15, fq = F.lane >> 4;
    for (int u = F.bid; u < 1024; u += F.G) {
        const int qb = u & 15, h = (u >> 4) & 7, b = u >> 7;
        const int qrow0 = b * 2048 + qb * 128 + F.wave * 16;
        bf16x8 qf[2][2];
#pragma unroll
        for (int c = 0; c < 2; ++c)
#pragma unroll
            for (int ks = 0; ks < 2; ++ks) qf[c][ks] = *(const GAS bf16x8*)(P + (size_t)(qrow0 + fr) * LD1 + C1_DQ + h * 128 + c * 64 + ks * 32 + 8 * fq);
        f32x4 Oa[2][8]; float mrun[2][4], lrun[2][4];
#pragma unroll
        for (int c = 0; c < 2; ++c) {
#pragma unroll
            for (int vt = 0; vt < 8; ++vt) Oa[c][vt] = (f32x4){0.f, 0.f, 0.f, 0.f};
#pragma unroll
            for (int j = 0; j < 4; ++j) { mrun[c][j] = -1e30f; lrun[c][j] = 0.f; } }
        for (int kt = 0; kt < 36; ++kt) {
            __syncthreads();
#pragma unroll
            for (int i = 0; i < 2; ++i) { const int id = F.tid + 512 * i; const int key = id >> 4, ch = id & 15; const int kk = kt * 64 + key;
                const size_t krow = (kk < 256) ? (size_t)(M_LAT + b * 256 + kk) : (size_t)(b * 2048 + kk - 256);
                const v4u kv = *(const GAS v4u*)(P + krow * LD1 + C1_DK + h * 128 + ch * 8);
                *(LAS v4u*)(Ks + key * KS_LD + ch * 8) = kv;
                const v4u vv = *(const GAS v4u*)(P + krow * LD1 + C1_DV + h * 128 + ch * 8);
#pragma unroll
                for (int q = 0; q < 4; ++q) { VT[(ch * 8 + 2 * q) * VT_LD + key] = (bf16)(vv[q] & 0xffffu); VT[(ch * 8 + 2 * q + 1) * VT_LD + key] = (bf16)(vv[q] >> 16); } }
            __syncthreads();
#pragma unroll
            for (int c = 0; c < 2; ++c) {
                f32x4 S[4];
#pragma unroll
                for (int nt = 0; nt < 4; ++nt) { f32x4 a = {0.f, 0.f, 0.f, 0.f};
#pragma unroll
                    for (int ks = 0; ks < 2; ++ks) { const bf16x8 bf = *(const LAS bf16x8*)(Ks + (nt * 16 + fr) * KS_LD + c * 64 + ks * 32 + 8 * fq); a = __builtin_amdgcn_mfma_f32_16x16x32_bf16(qf[c][ks], bf, a, 0, 0, 0); }
                    S[nt] = a; }
#pragma unroll
                for (int j = 0; j < 4; ++j) {
                    float mx = fmaxf(fmaxf(S[0][j], S[1][j]), fmaxf(S[2][j], S[3][j])); mx = grp16_max(mx);
                    const float mn = fmaxf(mrun[c][j], mx); const float alpha = __expf(mrun[c][j] - mn); mrun[c][j] = mn;
                    float rsum = 0.f;
#pragma unroll
                    for (int nt = 0; nt < 4; ++nt) { const float p = __expf(S[nt][j] - mn); rsum += p; Pw[(c * 16 + 4 * fq + j) * PW_LD + nt * 16 + fr] = (bf16)f2bf(p); }
                    rsum = grp16_sum(rsum); lrun[c][j] = lrun[c][j] * alpha + rsum;
#pragma unroll
                    for (int vt = 0; vt < 8; ++vt) Oa[c][vt][j] *= alpha; }
            }
            __syncthreads();
#pragma unroll
            for (int c = 0; c < 2; ++c)
#pragma unroll
                for (int ks = 0; ks < 2; ++ks) { const bf16x8 af = *(const LAS bf16x8*)(Pw + (c * 16 + fr) * PW_LD + ks * 32 + 8 * fq);
#pragma unroll
                    for (int vt = 0; vt < 8; ++vt) { const bf16x8 bf = *(const LAS bf16x8*)(VT + (vt * 16 + fr) * VT_LD + ks * 32 + 8 * fq); Oa[c][vt] = __builtin_amdgcn_mfma_f32_16x16x32_bf16(af, bf, Oa[c][vt], 0, 0, 0); } }
        }
#pragma unroll
        for (int j = 0; j < 4; ++j) { const float i0 = 1.f / lrun[0][j], i1 = lam / lrun[1][j]; float o[8]; float ss = 0.f;
#pragma unroll
            for (int vt = 0; vt < 8; ++vt) { o[vt] = Oa[0][vt][j] * i0 - Oa[1][vt][j] * i1; ss += o[vt] * o[vt]; }
            ss = grp16_sum(ss); const float rs = (1.f - lam_init) / sqrtf(ss * (1.f / 128.f) + EPS);
#pragma unroll
            for (int vt = 0; vt < 8; ++vt) Y[(size_t)(qrow0 + 4 * fq + j) * D + 1024 + h * 128 + vt * 16 + fr] = (bf16)f2bf(o[vt] * rs * F.in[I_DNG][vt * 16 + fr]); }
    }
    __syncthreads();
}
__device__ __forceinline__ void ph_hy_prep_lat(Frame& F) {
    LAS bf16* raw = (LAS bf16*)(F.lds);
    const bf16* P = (const bf16*)(F.ws + WS_P); bf16* XT = (bf16*)(F.ws + WS_XT);
    const float* cw = F.in[I_HCW]; const float* cbias = F.in[I_HCB];
    for (int u = F.bid; u < 12288; u += F.G) {
        const int cb = u & 15, tb = (u >> 4) & 31, b = (u >> 9) & 7, which = u >> 12;
        const int c0 = which * 1024 + cb * 64, t0 = tb * 64;
        __syncthreads();
        for (int id = F.tid; id < 528; id += NTHR) { const int rr = id >> 3, ch = id & 7; const int t = t0 - 1 + rr; v4u val = {0u, 0u, 0u, 0u};
            if (t >= 0 && t < 2048) val = *(const GAS v4u*)(P + (size_t)(b * 2048 + t) * LD0 + c0 + ch * 8);
            *(LAS v4u*)(raw + rr * 72 + ch * 8) = val; }
        __syncthreads();
        const int cc = F.tid & 63, tg = F.tid >> 6, c = c0 + cc;
        const float w0 = cw[c], w1 = cw[3072 + c], w2 = cw[6144 + c], bs = cbias[c];
        float o[8];
#pragma unroll
        for (int i = 0; i < 8; ++i) { const int tt = tg * 8 + i; o[i] = bs + w0 * bf2f(raw[tt * 72 + cc]) + w1 * bf2f(raw[(tt + 1) * 72 + cc]) + w2 * bf2f(raw[(tt + 2) * 72 + cc]); }
        v4u w; w.x = pk2(o[0], o[1]); w.y = pk2(o[2], o[3]); w.z = pk2(o[4], o[5]); w.w = pk2(o[6], o[7]);
        *(GAS v4u*)(XT + ((size_t)c * 8 + b) * 2048 + t0 + tg * 8) = w;
    }
    __syncthreads();
}
__device__ __forceinline__ void ph_hy_post_lat(Frame& F) {
    LAS bf16* tile = (LAS bf16*)(F.lds);
    const bf16* YT = (const bf16*)(F.ws + WS_YT); bf16* Y = (bf16*)(F.ws + WS_Y);
    for (int u = F.bid; u < 4096; u += F.G) { const int cb = u & 15, tb = (u >> 4) & 31, b = u >> 9;
        __syncthreads();
        { const int cc = F.tid >> 3, ch = F.tid & 7;
          *(LAS v4u*)(tile + cc * 72 + ch * 8) = *(const GAS v4u*)(YT + ((size_t)(cb * 64 + cc) * 8 + b) * 2048 + tb * 64 + ch * 8); }
        __syncthreads();
        { const int t = F.tid >> 3, ch = F.tid & 7; unsigned short e[8];
#pragma unroll
          for (int i = 0; i < 8; ++i) e[i] = tile[(ch * 8 + i) * 72 + t];
          v4u w; w.x = e[0] | ((unsigned)e[1] << 16); w.y = e[2] | ((unsigned)e[3] << 16); w.z = e[4] | ((unsigned)e[5] << 16); w.w = e[6] | ((unsigned)e[7] << 16);
          *(GAS v4u*)(Y + (size_t)(b * 2048 + tb * 64 + t) * D + cb * 64 + ch * 8) = w; }
    }
    __syncthreads();
}
__device__ __forceinline__ void ph_hy_ftt(Frame& F) {
    LAS float* tile = (LAS float*)(F.lds);
    const float* FTL = (const float*)(F.ws + WS_FTL); bf16* FTT = (bf16*)(F.ws + WS_FTT);
    for (int u = F.bid; u < 2 * 65 * 16; u += F.G) { const int cb = u & 15; const int rb = (u >> 4) % 65; const int o = (u >> 4) / 65;
        __syncthreads();
        for (int i = F.tid; i < 4096; i += NTHR) { const int rr = i >> 6, cc = i & 63; const int r = rb * 64 + rr; const int idx = 4127 - r;
            tile[rr * 65 + cc] = (idx >= 0 && idx <= 4094) ? FTL[((size_t)o * 4095 + idx) * 1024 + cb * 64 + cc] : 0.f; }
        __syncthreads();
        { const int cc = F.tid >> 3, ch = F.tid & 7; float e[8];
#pragma unroll
          for (int i = 0; i < 8; ++i) e[i] = tile[(ch * 8 + i) * 65 + cc];
          v4u w; w.x = pk2(e[0], e[1]); w.y = pk2(e[2], e[3]); w.z = pk2(e[4], e[5]); w.w = pk2(e[6], e[7]);
          *(GAS v4u*)(FTT + ((size_t)o * 1024 + cb * 64 + cc) * 4160 + rb * 64 + ch * 8) = w; }
    }
    __syncthreads();
}
constexpr int HY_XOFF = 2080, HY_RLEN = 4160, HY_KOFF = 32, HY_UROWB = 4192, HY_UCOPYB = 33600, HY_UOFF = 2 * HY_RLEN * 2;
__device__ __forceinline__ void hy_conv_loop(const LAS bf16* Rp, const LAS unsigned* Ud, int wave, int fr, int fq, f32x4 (&acc)[2][4]) {
    const int dl = fr & 7, s = dl & 1;
    const LAS bf16* ap = Rp + 2048 + 8 * fq - 8 * (32 * wave + fr);
    const LAS unsigned* up = Ud + s * (HY_UCOPYB / 4) + (fr >> 3) * (HY_UROWB / 4) + 4 * fq + ((dl - s) >> 1);
#pragma unroll 1
    for (int K0 = 0; K0 < 65; ++K0) {
        bf16x8 af[2];
#pragma unroll
        for (int mt = 0; mt < 2; ++mt) af[mt] = *(const LAS bf16x8*)(ap + 32 * K0 - 128 * mt);
        bf16x8 bfv[4];
#pragma unroll
        for (int nt = 0; nt < 4; ++nt) { const LAS unsigned* q = up + nt * 2 * (HY_UROWB / 4) + 16 * K0; v4u w; w.x = q[0]; w.y = q[1]; w.z = q[2]; w.w = q[3]; bfv[nt] = __builtin_bit_cast(bf16x8, w); }
#pragma unroll
        for (int mt = 0; mt < 2; ++mt)
#pragma unroll
            for (int nt = 0; nt < 4; ++nt) acc[mt][nt] = __builtin_amdgcn_mfma_f32_16x16x32_bf16(af[mt], bfv[nt], acc[mt][nt], 0, 0, 0);
    }
}
__device__ __forceinline__ void ph_hy_conv_lat(Frame& F) {
    LAS bf16* R = (LAS bf16*)(F.lds);
    LAS unsigned char* Ub = F.lds + HY_UOFF;
    LAS bf16* Gs = (LAS bf16*)(F.lds + HY_UOFF + 2 * HY_UCOPYB);
    const bf16* XT = (const bf16*)(F.ws + WS_XT); bf16* YT = (bf16*)(F.ws + WS_YT);
    const bf16* FTT = (const bf16*)(F.ws + WS_FTT);
    const int fr = F.lane & 15, fq = F.lane >> 4;
    for (int c = F.bid; c < 1024; c += F.G) {
        const bf16* X1 = XT + (size_t)c * 8 * 2048; const bf16* X2 = XT + ((size_t)1024 + c) * 8 * 2048; const bf16* XV_ = XT + ((size_t)2048 + c) * 8 * 2048;
        __syncthreads();
        for (int i = F.tid; i < (2 * HY_UCOPYB) / 16; i += NTHR) *(LAS v4u*)(Ub + i * 16) = (v4u){0u, 0u, 0u, 0u};
        for (int i = F.tid; i < 2 * HY_RLEN / 8; i += NTHR) { const int o = (i >= HY_RLEN / 8) ? 1 : 0; const int q = i - o * (HY_RLEN / 8);
            *(LAS v4u*)(R + o * HY_RLEN + q * 8) = *(const GAS v4u*)(FTT + ((size_t)o * 1024 + c) * 4160 + q * 8); }
        for (int i = F.tid; i < 2048; i += NTHR) { const int b = i >> 8, ch = i & 255; *(LAS v4u*)(Gs + b * 2048 + ch * 8) = *(const GAS v4u*)(X1 + (size_t)b * 2048 + ch * 8); }
        __syncthreads();
        for (int i = F.tid; i < 2048; i += NTHR) { const int b = i >> 8, ch = i & 255, t0 = ch * 8; const v4u val = *(const GAS v4u*)(XV_ + (size_t)b * 2048 + t0);
            *(LAS v4u*)(Ub + b * HY_UROWB + (HY_KOFF + t0) * 2) = val;
            LAS bf16* c1 = (LAS bf16*)(Ub + HY_UCOPYB + b * HY_UROWB) + HY_KOFF + t0 - 1;
#pragma unroll
            for (int q = 0; q < 4; ++q) { c1[2 * q] = (bf16)(val[q] & 0xffffu); c1[2 * q + 1] = (bf16)(val[q] >> 16); } }
        __syncthreads();
#pragma unroll 1
        for (int order = 0; order < 2; ++order) {
            f32x4 acc[2][4];
#pragma unroll
            for (int mt = 0; mt < 2; ++mt)
#pragma unroll
                for (int nt = 0; nt < 4; ++nt) acc[mt][nt] = (f32x4){0.f, 0.f, 0.f, 0.f};
            v4u gpre[4];
            if (order == 0) {
#pragma unroll
                for (int x = 0; x < 4; ++x) { const int i = F.tid + NTHR * x; gpre[x] = *(const GAS v4u*)(X2 + (size_t)(i >> 8) * 2048 + (i & 255) * 8); } }
            hy_conv_loop(R + order * HY_RLEN, (const LAS unsigned*)Ub, F.wave, fr, fq, acc);
            __syncthreads();
            const float sk = F.in[I_HBIAS][order * 1024 + c];
#pragma unroll
            for (int mt = 0; mt < 2; ++mt)
#pragma unroll
                for (int nt = 0; nt < 4; ++nt)
#pragma unroll
                    for (int j = 0; j < 4; ++j) { const int m = 32 * F.wave + 16 * mt + 4 * fq + j; const int b = 2 * nt + (fr >> 3); const int t = 8 * m + (fr & 7);
                        LAS bf16* u0 = (LAS bf16*)(Ub + b * HY_UROWB) + HY_KOFF + t; LAS bf16* u1 = (LAS bf16*)(Ub + HY_UCOPYB + b * HY_UROWB) + HY_KOFF + t;
                        const float uv = bf2f(*u0), g = bf2f(Gs[b * 2048 + t]);
                        const bf16 r = (bf16)f2bf(g * (acc[mt][nt][j] + sk * uv));
                        if (order == 0) { *u0 = r; u1[-1] = r; } else { *u1 = r; } }
            __syncthreads();
            if (order == 0) {
#pragma unroll
                for (int x = 0; x < 4; ++x) { const int i = F.tid + NTHR * x; *(LAS v4u*)(Gs + (i >> 8) * 2048 + (i & 255) * 8) = gpre[x]; } }
        }
        for (int i = F.tid; i < 2048; i += NTHR) { const int b = i >> 8, ch = i & 255;
            *(GAS v4u*)(YT + ((size_t)c * 8 + b) * 2048 + ch * 8) = *(const LAS v4u*)(Ub + HY_UCOPYB + b * HY_UROWB + (HY_KOFF + ch * 8) * 2); }
    }
    __syncthreads();
}
__device__ __forceinline__ void ph_ml_prep(Frame& F) {
    const bf16* P = (const bf16*)(F.ws + WS_P); bf16* MQK = (bf16*)(F.ws + WS_MQK); float* MLS = (float*)(F.ws + WS_MLS); float* KEEP = MLS + (size_t)64 * 36 * 320;
    const int gw = F.bid * NWAVES + F.wave, NGW = F.G * NWAVES;
    if (gw < 64) {
        const int sq = gw, dir = sq & 1, h = (sq >> 1) & 3, b = sq >> 3; const int i = F.lane;
        const float igb = F.in[I_MIGB][dir * 4 + h], fgb = F.in[I_MFGB][dir * 4 + h]; float mrun = 0.f;
        for (int c = 0; c < 36; ++c) { const int row = scan_row(b, dir, 64 * c + i);
            const float ig = bf2f(P[(size_t)row * LD1 + C1_G + dir * 8 + h]) + igb;
            const float lf = logsigmoidf_(bf2f(P[(size_t)row * LD1 + C1_G + dir * 8 + 4 + h]) + fgb);
            const float bi = wave_incl_sum(lf, i); const float blast = __shfl(bi, 63);
            const float wend = blast - bi + ig; const float mnew = fmaxf(blast + mrun, wave_max(wend));
            const float keep = __expf(blast + mrun - mnew); const float wi = __expf(wend - mnew);
            const float ai = bi + mrun; const float colv = ig - bi; const float pm = wave_incl_max(colv, i); const float mt = fmaxf(ai, bi + pm);
            float* o = MLS + ((size_t)sq * 36 + c) * 320 + i;
            o[0] = wi; o[64] = bi - mt; o[128] = colv; o[192] = __expf(ai - mt); o[256] = __expf(-mt); if (i == 0) KEEP[sq * 36 + c] = keep;
            mrun = mnew; }
    }
    const float* cw = F.in[I_MCW]; const float* cbias = F.in[I_MCB];
    const bool scanw = (NGW > 128) && (gw < 64);
    const int cgw = (NGW > 128) ? gw - 64 : gw, CNGW = (NGW > 128) ? NGW - 64 : NGW;
    f32x4 w0[4][2], w1[4][2], w2[4][2], bs[4][2];
    if (!scanw) {
#pragma unroll
        for (int i = 0; i < 4; ++i)
#pragma unroll
            for (int hh = 0; hh < 2; ++hh) { const int c = 8 * (F.lane + 64 * i) + 4 * hh;
                w0[i][hh] = *(const GAS f32x4*)(cw + c); w1[i][hh] = *(const GAS f32x4*)(cw + 2048 + c); w2[i][hh] = *(const GAS f32x4*)(cw + 4096 + c); bs[i][hh] = *(const GAS f32x4*)(cbias + c); } }
    for (int r = scanw ? M_ALL : cgw; r < M_ALL; r += CNGW) {
        const int t = (r < M_LAT) ? (r & 2047) : ((r - M_LAT) & 255); const int L = (r < M_LAT) ? 2048 : 256; const bool hp = t > 0, hn = t < L - 1;
#pragma unroll
        for (int i = 0; i < 4; ++i) { const int c = 8 * (F.lane + 64 * i); const v4u z = {0u, 0u, 0u, 0u};
            const v4u a = hp ? *(const GAS v4u*)(P + (size_t)(r - 1) * LD1 + c) : z; const v4u b2 = *(const GAS v4u*)(P + (size_t)r * LD1 + c); const v4u d = hn ? *(const GAS v4u*)(P + (size_t)(r + 1) * LD1 + c) : z;
            const float ksc = (c < 1024) ? 1.f : 0.0625f; float o[8];
#pragma unroll
            for (int q = 0; q < 4; ++q) { const int hh = q >> 1, e0 = 2 * (q & 1);
                o[2 * q] = siluf(bs[i][hh][e0] + w0[i][hh][e0] * bflo(a[q]) + w1[i][hh][e0] * bflo(b2[q]) + w2[i][hh][e0] * bflo(d[q])) * ksc;
                o[2 * q + 1] = siluf(bs[i][hh][e0 + 1] + w0[i][hh][e0 + 1] * bfhi(a[q]) + w1[i][hh][e0 + 1] * bfhi(b2[q]) + w2[i][hh][e0 + 1] * bfhi(d[q])) * ksc; }
            v4u w; w.x = pk2(o[0], o[1]); w.y = pk2(o[2], o[3]); w.z = pk2(o[4], o[5]); w.w = pk2(o[6], o[7]);
            *(GAS v4u*)(MQK + (size_t)r * 2048 + c) = w; }
    }
}
__device__ __forceinline__ void ph_ml_scan2(Frame& F) {
    constexpr int QLD = 272, VLD = 88, SLD = 72;
    LAS bf16* Qn = (LAS bf16*)(F.lds); LAS bf16* Kn = Qn + 64 * QLD; LAS bf16* Cb = Kn + 64 * QLD; LAS bf16* Vn = Cb + 80 * QLD; LAS bf16* VWn = Vn + 64 * VLD; LAS bf16* SC = VWn + 64 * VLD;
    LAS float* sS = (LAS float*)(SC + 64 * SLD);
    LAS float* sW = sS; LAS float* sRow = sS + 64; LAS float* sCol = sS + 128; LAS float* sAw = sS + 192; LAS float* sEinv = sS + 256;
    const bf16* P = (const bf16*)(F.ws + WS_P); float* OM = (float*)(F.ws + WS_OG);
    const bf16* MQK = (const bf16*)(F.ws + WS_MQK); const float* MLS = (const float*)(F.ws + WS_MLS); const float* KEEP = MLS + (size_t)64 * 36 * 320;
    const int fr = F.lane & 15, fq = F.lane >> 4;
    for (int u0 = F.bid; u0 < 256; u0 += F.G) {
        const int u = (F.G == 256) ? ((((u0 & 7) * 8 + (u0 >> 5)) << 2) | ((u0 >> 3) & 3)) : u0;
        const int vsl = u & 3, dir = (u >> 2) & 1, h = (u >> 3) & 3, b = u >> 5; const int sq = (b * 4 + h) * 2 + dir; const int sgn = dir ? -1 : 1;
        __syncthreads();
        for (int i = F.tid; i < (80 * QLD + 2 * 64 * VLD) / 8; i += NTHR) *(LAS v4u*)(Cb + i * 8) = (v4u){0u, 0u, 0u, 0u};
        __syncthreads();
        if (F.tid < 64) Vn[F.tid * VLD + 64] = (bf16)0x3F80;
        f32x4 st[5][2];
#pragma unroll
        for (int vt = 0; vt < 5; ++vt) { st[vt][0] = (f32x4){0.f, 0.f, 0.f, 0.f}; st[vt][1] = (f32x4){0.f, 0.f, 0.f, 0.f}; }
        v4u rq[4], rk[4], rv; float rs = 0.f, keepn = 0.f;
#define ML_LOAD(cc) do { const int row0_ = scan_row(b, dir, 64 * (cc)); \
            _Pragma("unroll") for (int x = 0; x < 4; ++x) { const int p = F.tid + NTHR * x; const size_t o = (size_t)(row0_ + sgn * (p >> 5)) * 2048 + h * 256 + (p & 31) * 8; \
                rq[x] = *(const GAS v4u*)(MQK + o); rk[x] = *(const GAS v4u*)(MQK + o + 1024); } \
            rv = *(const GAS v4u*)(P + (size_t)(row0_ + sgn * (F.tid >> 3)) * LD1 + C1_MV + h * 256 + vsl * 64 + (F.tid & 7) * 8); \
            if (F.tid < 320) rs = MLS[((size_t)sq * 36 + (cc)) * 320 + F.tid]; keepn = KEEP[sq * 36 + (cc)]; } while (0)
        ML_LOAD(0);
#pragma unroll 1
        for (int c = 0; c < 36; ++c) {
            const bool emit = c >= 4;
#pragma unroll
            for (int x = 0; x < 4; ++x) { const int p = F.tid + NTHR * x; *(LAS v4u*)(Qn + (p >> 5) * QLD + (p & 31) * 8) = rq[x]; *(LAS v4u*)(Kn + (p >> 5) * QLD + (p & 31) * 8) = rk[x]; }
            *(LAS v4u*)(Vn + (F.tid >> 3) * VLD + (F.tid & 7) * 8) = rv;
            if (F.tid < 320) sS[F.tid] = rs;
            const float keep = keepn;
            __syncthreads();
            if (c + 1 < 36) ML_LOAD(c + 1);
            { const int i = F.tid >> 3, cv = F.tid & 7; const float wv = sW[i]; const v4u x = *(const LAS v4u*)(Vn + i * VLD + cv * 8); v4u y;
#pragma unroll
              for (int q = 0; q < 4; ++q) y[q] = pk2(bflo(x[q]) * wv, bfhi(x[q]) * wv);
              *(LAS v4u*)(VWn + i * VLD + cv * 8) = y; if (cv == 0) VWn[i * VLD + 64] = (bf16)f2bf(wv); }
            if (emit) {
                const int it_ = F.wave >> 1;
#pragma unroll
                for (int x = 0; x < 2; ++x) { const int jt = 2 * (F.wave & 1) + x;
                    f32x4 a = {0.f, 0.f, 0.f, 0.f};
                    if (jt <= it_) {
#pragma unroll
                        for (int ks = 0; ks < 8; ++ks) { const bf16x8 af = *(const LAS bf16x8*)(Qn + (16 * it_ + fr) * QLD + 32 * ks + 8 * fq); const bf16x8 bf = *(const LAS bf16x8*)(Kn + (16 * jt + fr) * QLD + 32 * ks + 8 * fq);
                            a = __builtin_amdgcn_mfma_f32_16x16x32_bf16(af, bf, a, 0, 0, 0); } }
                    const int j = 16 * jt + fr; const float cj = sCol[j];
#pragma unroll
                    for (int jj = 0; jj < 4; ++jj) { const int i = 16 * it_ + 4 * fq + jj; const float val = (j <= i) ? a[jj] * __expf(sRow[i] + cj) : 0.f; SC[i * SLD + j] = (bf16)f2bf(val); } }
            }
            __syncthreads();
            if (emit) {
                const int it_ = F.wave & 3, vt0 = 2 * (F.wave >> 2);
                f32x4 acc[3];
#pragma unroll
                for (int x = 0; x < 3; ++x) acc[x] = (f32x4){0.f, 0.f, 0.f, 0.f};
#pragma unroll
                for (int ks = 0; ks < 8; ++ks) { const bf16x8 af = *(const LAS bf16x8*)(Qn + (16 * it_ + fr) * QLD + 32 * ks + 8 * fq);
#pragma unroll
                    for (int x = 0; x < 3; ++x) { const int vt = (x < 2) ? vt0 + x : 4; const bf16x8 bf = *(const LAS bf16x8*)(Cb + (16 * vt + fr) * QLD + 32 * ks + 8 * fq); acc[x] = __builtin_amdgcn_mfma_f32_16x16x32_bf16(af, bf, acc[x], 0, 0, 0); } }
#pragma unroll
                for (int jj = 0; jj < 4; ++jj) { const float awv = sAw[16 * it_ + 4 * fq + jj];
#pragma unroll
                    for (int x = 0; x < 3; ++x) acc[x][jj] *= awv; }
#pragma unroll
                for (int js = 0; js < 2; ++js) { const bf16x8 af = *(const LAS bf16x8*)(SC + (16 * it_ + fr) * SLD + 32 * js + 8 * fq);
#pragma unroll
                    for (int x = 0; x < 3; ++x) { const int vt = (x < 2) ? vt0 + x : 4; const bf16x8 bf = tr_frag(Vn, VLD, 32 * js, 16 * vt, F.lane); acc[x] = __builtin_amdgcn_mfma_f32_16x16x32_bf16(af, bf, acc[x], 0, 0, 0); } }
                const int row0 = scan_row(b, dir, 64 * c);
#pragma unroll
                for (int jj = 0; jj < 4; ++jj) { const int i = 16 * it_ + 4 * fq + jj; const float den = __shfl(acc[2][jj], F.lane & 48); const float dd = fmaxf(fabsf(den), sEinv[i]);
                    const float rdd = __builtin_amdgcn_rcpf(dd);
                    const int row = row0 + sgn * i; bf16* op = (bf16*)OM + ((size_t)dir * M_LAT + row) * 1024 + h * 256 + vsl * 64 + fr;
                    op[16 * vt0] = (bf16)f2bf(acc[0][jj] * rdd); op[16 * vt0 + 16] = (bf16)f2bf(acc[1][jj] * rdd); }
            }
            {
#pragma unroll
              for (int vt = 0; vt < 5; ++vt) { st[vt][0] *= keep; st[vt][1] *= keep; }
#pragma unroll
              for (int is = 0; is < 2; ++is) { bf16x8 kb[2];
#pragma unroll
                  for (int x = 0; x < 2; ++x) kb[x] = tr_frag(Kn, QLD, 32 * is, 16 * (2 * F.wave + x), F.lane);
#pragma unroll
                  for (int vt = 0; vt < 5; ++vt) { const bf16x8 af = tr_frag(VWn, VLD, 32 * is, 16 * vt, F.lane);
                      st[vt][0] = __builtin_amdgcn_mfma_f32_16x16x32_bf16(af, kb[0], st[vt][0], 0, 0, 0); st[vt][1] = __builtin_amdgcn_mfma_f32_16x16x32_bf16(af, kb[1], st[vt][1], 0, 0, 0); } } }
            __syncthreads();
#pragma unroll
            for (int vt = 0; vt < 5; ++vt)
#pragma unroll
                for (int x = 0; x < 2; ++x)
#pragma unroll
                    for (int jj = 0; jj < 4; ++jj) Cb[(16 * vt + 4 * fq + jj) * QLD + 16 * (2 * F.wave + x) + fr] = (bf16)f2bf(st[vt][x][jj]);
        }
#undef ML_LOAD
    }
    __syncthreads();
}
__device__ __forceinline__ void ph_gla_prep(Frame& F) {
    LAS float* sCode = (LAS float*)(F.lds);
    LAS float* sGT = sCode + 1024;
    const bf16* P = (const bf16*)(F.ws + WS_P);
    bf16* GQD = (bf16*)(F.ws + WS_GQ); bf16* GKI = GQD + (size_t)2 * M_ALL * 512; bf16* GKD = GKI + (size_t)2 * M_ALL * 512; float* DEC = (float*)(F.ws + WS_GDEC);
    const int k = F.tid & 127, tg = F.tid >> 7;
    for (int u = F.bid; u < 2304; u += F.G) {
        const int c = u % 36, sq = u / 36; const int dir = sq & 1, h = (sq >> 1) & 3, b = sq >> 3;
        const int n0 = 64 * c; const int row0 = scan_row(b, dir, n0); const int sgn = dir ? -1 : 1;
        __syncthreads();
#pragma unroll
        for (int x = 0; x < 2; ++x) { const int i = F.tid + NTHR * x; sCode[i] = bf2f(P[(size_t)(row0 + sgn * (i >> 4)) * LD0 + C0_CODE + dir * 16 + (i & 15)]); }
        float w2c[16];
#pragma unroll
        for (int r = 0; r < 16; ++r) w2c[r] = F.in[I_GGW2][(size_t)(dir * 16 + r) * 512 + h * 128 + k];
        const float gbk = F.in[I_GGB][dir * 512 + h * 128 + k];
        const bf16* pq = P + (size_t)(row0 + sgn * 16 * tg) * LD0 + C0_GQ + h * 128 + k; const long pstep = (long)sgn * LD0;
        unsigned short qr[16], kr[16]; float bc[16];
#pragma unroll
        for (int x = 0; x < 16; ++x) { qr[x] = pq[x * pstep]; kr[x] = pq[x * pstep + 512]; }
        __syncthreads();
        float run = 0.f;
#pragma unroll
        for (int x = 0; x < 16; ++x) { float lg = gbk; const LAS float* cd = sCode + (16 * tg + x) * 16;
            f32x4 l4 = {0.f, 0.f, 0.f, 0.f};
#pragma unroll
            for (int r = 0; r < 16; r += 4) { const f32x4 cv = *(const LAS f32x4*)(cd + r); l4 += cv * (f32x4){w2c[r], w2c[r + 1], w2c[r + 2], w2c[r + 3]}; }
            lg += (l4[0] + l4[1]) + (l4[2] + l4[3]);
            run += logsigmoidf_(lg) * (1.f / 16.f); bc[x] = run; }
        sGT[tg * 128 + k] = run;
        __syncthreads();
        float off = 0.f, tot = 0.f;
#pragma unroll
        for (int g = 0; g < 4; ++g) { const float t = sGT[g * 128 + k]; tot += t; off += (g < tg) ? t : 0.f; }
        if (tg == 0) DEC[(size_t)u * 128 + k] = __expf(tot);
        const size_t o0 = ((size_t)dir * M_ALL + (row0 + sgn * 16 * tg)) * 512 + h * 128 + k; const long ostep = (long)sgn * 512;
#pragma unroll
        for (int x = 0; x < 16; ++x) { const float bb = bc[x] + off; const float qv = bf2f(qr[x]) * 0.08838834764831845f, kv = bf2f(kr[x]);
            GQD[o0 + x * ostep] = (bf16)f2bf(qv * __expf(bb)); GKI[o0 + x * ostep] = (bf16)f2bf(kv * __expf(-bb)); GKD[o0 + x * ostep] = (bf16)f2bf(kv * __expf(tot - bb)); }
    }
    __syncthreads();
}
__device__ __forceinline__ void ph_gla_scan2(Frame& F) {
    constexpr int KLD = 136, VLD = 72;
    LAS bf16* QD = (LAS bf16*)(F.lds); LAS bf16* KI = QD + 64 * KLD; LAS bf16* KD = KI + 64 * KLD; LAS bf16* Sb = KD + 64 * KLD; LAS bf16* Vn = Sb + 64 * KLD; LAS bf16* ATT = Vn + 64 * VLD;
    const bf16* P = (const bf16*)(F.ws + WS_P); float* OG = (float*)(F.ws + WS_OG);
    const bf16* GQD = (const bf16*)(F.ws + WS_GQ); const bf16* GKI = GQD + (size_t)2 * M_ALL * 512; const bf16* GKD = GKI + (size_t)2 * M_ALL * 512; const float* DEC = (const float*)(F.ws + WS_GDEC);
    const int fr = F.lane & 15, fq = F.lane >> 4;
    for (int u0 = F.bid; u0 < 256; u0 += F.G) {
        const int u = (F.G == 256) ? ((((u0 & 7) * 8 + (u0 >> 5)) << 2) | ((u0 >> 3) & 3)) : u0;
        const int vsl = u & 3, dir = (u >> 2) & 1, h = (u >> 3) & 3, b = u >> 5; const int sq = (b * 4 + h) * 2 + dir; const int sgn = dir ? -1 : 1;
        __syncthreads();
        for (int i = F.tid; i < 64 * KLD / 8; i += NTHR) *(LAS v4u*)(Sb + i * 8) = (v4u){0u, 0u, 0u, 0u};
        f32x4 st[4];
#pragma unroll
        for (int vt = 0; vt < 4; ++vt) st[vt] = (f32x4){0.f, 0.f, 0.f, 0.f};
        v4u rq[2], rk[2], rd[2], rv; float dkn;
#define GLA_LOAD(cc) do { const int row0_ = scan_row(b, dir, 64 * (cc)); \
            _Pragma("unroll") for (int x = 0; x < 2; ++x) { const int p = F.tid + NTHR * x; const size_t o = ((size_t)dir * M_ALL + (row0_ + sgn * (p >> 4))) * 512 + h * 128 + (p & 15) * 8; \
                rq[x] = *(const GAS v4u*)(GQD + o); rk[x] = *(const GAS v4u*)(GKI + o); rd[x] = *(const GAS v4u*)(GKD + o); } \
            rv = *(const GAS v4u*)(P + (size_t)(row0_ + sgn * (F.tid >> 3)) * LD0 + C0_GV + h * 256 + vsl * 64 + (F.tid & 7) * 8); \
            dkn = DEC[((size_t)sq * 36 + (cc)) * 128 + 16 * F.wave + fr]; } while (0)
#define GLA_PUT_QK() do { _Pragma("unroll") for (int x = 0; x < 2; ++x) { const int p = F.tid + NTHR * x; *(LAS v4u*)(QD + (p >> 4) * KLD + (p & 15) * 8) = rq[x]; *(LAS v4u*)(KI + (p >> 4) * KLD + (p & 15) * 8) = rk[x]; } } while (0)
        GLA_LOAD(0);
        GLA_PUT_QK();
#pragma unroll 1
        for (int c = 0; c < 36; ++c) {
            __syncthreads();
#pragma unroll
            for (int x = 0; x < 2; ++x) { const int p = F.tid + NTHR * x; *(LAS v4u*)(KD + (p >> 4) * KLD + (p & 15) * 8) = rd[x]; }
            *(LAS v4u*)(Vn + (F.tid >> 3) * VLD + (F.tid & 7) * 8) = rv;
            const float dk = dkn;
            if (c + 1 < 36) GLA_LOAD(c + 1);
            { const int it_ = F.wave >> 1;
#pragma unroll
              for (int x = 0; x < 2; ++x) { const int jt = 2 * (F.wave & 1) + x; f32x4 a = {0.f, 0.f, 0.f, 0.f};
                  if (jt <= it_) {
#pragma unroll
                      for (int ks = 0; ks < 4; ++ks) { const bf16x8 af = *(const LAS bf16x8*)(QD + (16 * it_ + fr) * KLD + 32 * ks + 8 * fq); const bf16x8 bf = *(const LAS bf16x8*)(KI + (16 * jt + fr) * KLD + 32 * ks + 8 * fq);
                          a = __builtin_amdgcn_mfma_f32_16x16x32_bf16(af, bf, a, 0, 0, 0); } }
                  const int j = 16 * jt + fr;
#pragma unroll
                  for (int jj = 0; jj < 4; ++jj) { const int i = 16 * it_ + 4 * fq + jj; ATT[i * VLD + j] = (bf16)f2bf((j <= i) ? a[jj] : 0.f); } } }
            const int ot = F.wave & 3, vt0 = 2 * (F.wave >> 2);
            f32x4 oa[2] = {(f32x4){0.f, 0.f, 0.f, 0.f}, (f32x4){0.f, 0.f, 0.f, 0.f}};
#pragma unroll
            for (int ks = 0; ks < 4; ++ks) { const bf16x8 af = *(const LAS bf16x8*)(QD + (16 * ot + fr) * KLD + 32 * ks + 8 * fq);
#pragma unroll
                for (int x = 0; x < 2; ++x) { const bf16x8 bf = *(const LAS bf16x8*)(Sb + (16 * (vt0 + x) + fr) * KLD + 32 * ks + 8 * fq); oa[x] = __builtin_amdgcn_mfma_f32_16x16x32_bf16(af, bf, oa[x], 0, 0, 0); } }
            __syncthreads();
#pragma unroll
            for (int js = 0; js < 2; ++js) { const bf16x8 af = *(const LAS bf16x8*)(ATT + (16 * ot + fr) * VLD + 32 * js + 8 * fq);
#pragma unroll
                for (int x = 0; x < 2; ++x) { const bf16x8 bf = tr_frag(Vn, VLD, 32 * js, 16 * (vt0 + x), F.lane); oa[x] = __builtin_amdgcn_mfma_f32_16x16x32_bf16(af, bf, oa[x], 0, 0, 0); } }
            { const int row0 = scan_row(b, dir, 64 * c);
#pragma unroll
              for (int jj = 0; jj < 4; ++jj) { const int i = 16 * ot + 4 * fq + jj; const int row = row0 + sgn * i;
                  bf16* op = (bf16*)OG + ((size_t)dir * M_ALL + row) * 1024 + h * 256 + vsl * 64 + fr; op[16 * vt0] = (bf16)f2bf(oa[0][jj]); op[16 * vt0 + 16] = (bf16)f2bf(oa[1][jj]); } }
            {
#pragma unroll
              for (int vt = 0; vt < 4; ++vt) st[vt] *= dk;
#pragma unroll
              for (int js = 0; js < 2; ++js) { const bf16x8 kb = tr_frag(KD, KLD, 32 * js, 16 * F.wave, F.lane);
#pragma unroll
                  for (int vt = 0; vt < 4; ++vt) { const bf16x8 af = tr_frag(Vn, VLD, 32 * js, 16 * vt, F.lane); st[vt] = __builtin_amdgcn_mfma_f32_16x16x32_bf16(af, kb, st[vt], 0, 0, 0); } }
#pragma unroll
              for (int vt = 0; vt < 4; ++vt)
#pragma unroll
                  for (int jj = 0; jj < 4; ++jj) Sb[(16 * vt + 4 * fq + jj) * KLD + 16 * F.wave + fr] = (bf16)f2bf(st[vt][jj]); }
            if (c + 1 < 36) GLA_PUT_QK();
        }
#undef GLA_LOAD
#undef GLA_PUT_QK
    }
    __syncthreads();
}
__device__ __forceinline__ float vmax3(float a, float b, float c) { float r; asm("v_max3_f32 %0, %1, %2, %3" : "=v"(r) : "v"(a), "v"(b), "v"(c)); return r; }
__device__ __forceinline__ void ph_da_attn2(Frame& F) {
    constexpr int TLD = 144, TILE = 64 * TLD;
    LAS bf16* buf = (LAS bf16*)(F.lds);
    const bf16* P = (const bf16*)(F.ws + WS_P); bf16* Y = (bf16*)(F.ws + WS_Y);
    const float lam_init = 0.35550906759096927f;
    float lam;
    { const float* lv = F.in[I_DLAM]; float s01 = 0.f, s23 = 0.f; for (int i = 0; i < 64; ++i) { s01 += lv[i] * lv[64 + i]; s23 += lv[128 + i] * lv[192 + i]; } lam = expf(s01) - expf(s23) + lam_init; }
    const int fr = F.lane & 15, fq = F.lane >> 4, tq = (F.lane & 15) >> 2, tp = F.lane & 3;
    const int nround = (F.G == 256) ? 4 : (1024 + F.G - 1) / F.G;
    for (int rnd = 0; rnd < nround; ++rnd) {
        int u;
        if (F.G == 256) { const int xcd = F.bid & 7, slot = F.bid >> 3; const int pair = xcd + 8 * (2 * rnd + (slot >> 4)); u = pair * 16 + (slot & 15); }
        else { u = F.bid + rnd * F.G; if (u >= 1024) break; }
        const int qb = u & 15, h = (u >> 4) & 7, b = u >> 7;
        const int qrow = b * 2048 + qb * 128 + F.wave * 16 + fr;
        bf16x8 qf[2][2];
#pragma unroll
        for (int c = 0; c < 2; ++c)
#pragma unroll
            for (int ks = 0; ks < 2; ++ks) qf[c][ks] = *(const GAS bf16x8*)(P + (size_t)qrow * LD1 + C1_DQ + h * 128 + c * 64 + ks * 32 + 8 * fq);
        f32x4 Oa[2][8], Ol[2]; float mst[2] = {0.f, 0.f};
#pragma unroll
        for (int c = 0; c < 2; ++c)
#pragma unroll
            for (int vt = 0; vt < 8; ++vt) Oa[c][vt] = (f32x4){0.f, 0.f, 0.f, 0.f};
        Ol[0] = (f32x4){0.f, 0.f, 0.f, 0.f}; Ol[1] = (f32x4){0.f, 0.f, 0.f, 0.f};
        const bf16x8 ones = (bf16x8){0x3F80, 0x3F80, 0x3F80, 0x3F80, 0x3F80, 0x3F80, 0x3F80, 0x3F80};
        v4u kn[2], vn[2];
        const int skey = F.tid >> 4, sch = F.tid & 15;
#define DA_TB(t) ((const char*)P + (size_t)(((t) < 4) ? (M_LAT + b * 256 + 64 * (t)) : (b * 2048 + 64 * ((t) - 4))) * (LD1 * 2))
        const unsigned vo0 = (unsigned)(skey * LD1 + C1_DK + h * 128 + sch * 8) * 2u, vo1 = vo0 + 32u * LD1 * 2u;
#define DA_LD(t) do { const char* tb_ = DA_TB(t); kn[0] = *(const GAS v4u*)(tb_ + vo0); vn[0] = *(const GAS v4u*)(tb_ + vo0 + (C1_DV - C1_DK) * 2); kn[1] = *(const GAS v4u*)(tb_ + vo1); vn[1] = *(const GAS v4u*)(tb_ + vo1 + (C1_DV - C1_DK) * 2); } while (0)
        DA_LD(0);
        __syncthreads();
#pragma unroll
        for (int i = 0; i < 2; ++i) { *(LAS v4u*)(buf + (skey + 32 * i) * TLD + sch * 8) = kn[i]; *(LAS v4u*)(buf + TILE + (skey + 32 * i) * TLD + sch * 8) = vn[i]; }
        DA_LD(1);
        __syncthreads();
#pragma unroll 1
        for (int kt = 0; kt < 36; ++kt) {
            const LAS bf16* Kc = buf + (kt & 1) * 2 * TILE; const LAS bf16* Vc = Kc + TILE;
            if (kt + 1 < 36) {
                LAS bf16* Kn_ = buf + ((kt + 1) & 1) * 2 * TILE;
#pragma unroll
                for (int i = 0; i < 2; ++i) { *(LAS v4u*)(Kn_ + (skey + 32 * i) * TLD + sch * 8) = kn[i]; *(LAS v4u*)(Kn_ + TILE + (skey + 32 * i) * TLD + sch * 8) = vn[i]; }
                if (kt + 2 < 36) DA_LD(kt + 2); }
            bf16x8 pf[2][2];
            f32x4 S[2][4];
#pragma unroll
            for (int c = 0; c < 2; ++c)
#pragma unroll
                for (int nt = 0; nt < 4; ++nt) { const float nm = -mst[c]; f32x4 a = {nm, nm, nm, nm};
#pragma unroll
                    for (int ks = 0; ks < 2; ++ks) { const bf16x8 kf = *(const LAS bf16x8*)(Kc + (nt * 16 + fr) * TLD + c * 64 + ks * 32 + 8 * fq); a = __builtin_amdgcn_mfma_f32_16x16x32_bf16(kf, qf[c][ks], a, 0, 0, 0); }
                    S[c][nt] = a; }
            float mx[2];
            asm volatile("s_nop 7\n\ts_nop 3\n\t"
                         "v_max3_f32 %0, %2, %3, %4\n\tv_max3_f32 %1, %18, %19, %20\n\t"
                         "v_max3_f32 %0, %0, %5, %6\n\tv_max3_f32 %1, %1, %21, %22\n\t"
                         "v_max3_f32 %0, %0, %7, %8\n\tv_max3_f32 %1, %1, %23, %24\n\t"
                         "v_max3_f32 %0, %0, %9, %10\n\tv_max3_f32 %1, %1, %25, %26\n\t"
                         "v_max3_f32 %0, %0, %11, %12\n\tv_max3_f32 %1, %1, %27, %28\n\t"
                         "v_max3_f32 %0, %0, %13, %14\n\tv_max3_f32 %1, %1, %29, %30\n\t"
                         "v_max3_f32 %0, %0, %15, %16\n\tv_max3_f32 %1, %1, %31, %32\n\t"
                         "v_max_f32 %0, %0, %17\n\tv_max_f32 %1, %1, %33"
                         : "=&v"(mx[0]), "=&v"(mx[1])
                         : "v"(S[0][0][0]), "v"(S[0][0][1]), "v"(S[0][0][2]), "v"(S[0][0][3]), "v"(S[0][1][0]), "v"(S[0][1][1]), "v"(S[0][1][2]), "v"(S[0][1][3]),
                           "v"(S[0][2][0]), "v"(S[0][2][1]), "v"(S[0][2][2]), "v"(S[0][2][3]), "v"(S[0][3][0]), "v"(S[0][3][1]), "v"(S[0][3][2]), "v"(S[0][3][3]),
                           "v"(S[1][0][0]), "v"(S[1][0][1]), "v"(S[1][0][2]), "v"(S[1][0][3]), "v"(S[1][1][0]), "v"(S[1][1][1]), "v"(S[1][1][2]), "v"(S[1][1][3]),
                           "v"(S[1][2][0]), "v"(S[1][2][1]), "v"(S[1][2][2]), "v"(S[1][2][3]), "v"(S[1][3][0]), "v"(S[1][3][1]), "v"(S[1][3][2]), "v"(S[1][3][3]));
            { float a0 = mx[0], b0 = mx[0], a1 = mx[1], b1 = mx[1];
              asm volatile("s_nop 1\n\tv_permlane16_swap_b32 %0, %1\n\tv_permlane16_swap_b32 %2, %3\n\ts_nop 1\n\tv_max_f32 %0, %0, %1\n\tv_max_f32 %2, %2, %3\n\tv_mov_b32 %1, %0\n\tv_mov_b32 %3, %2\n\ts_nop 1\n\t"
                           "v_permlane32_swap_b32 %0, %1\n\tv_permlane32_swap_b32 %2, %3\n\ts_nop 1\n\tv_max_f32 %0, %0, %1\n\tv_max_f32 %2, %2, %3"
                           : "+v"(a0), "+v"(b0), "+v"(a1), "+v"(b1));
              mx[0] = a0; mx[1] = a1; }
            const bool up0 = (kt == 0) || (mx[0] > 8.f), up1 = (kt == 0) || (mx[1] > 8.f);
            if (__any(up0 || up1)) {
#pragma unroll
                for (int c = 0; c < 2; ++c) { const float d = (c ? up1 : up0) ? mx[c] : 0.f; const float al = __builtin_amdgcn_exp2f(-d); mst[c] += d; Ol[c] *= al;
#pragma unroll
                    for (int vt = 0; vt < 8; ++vt) Oa[c][vt] *= al;
#pragma unroll
                    for (int nt = 0; nt < 4; ++nt) S[c][nt] -= d; } }
#pragma unroll
            for (int c = 0; c < 2; ++c) {
#pragma unroll
                for (int nt = 0; nt < 4; ++nt)
#pragma unroll
                    for (int j = 0; j < 4; ++j) S[c][nt][j] = __builtin_amdgcn_exp2f(S[c][nt][j]);
#pragma unroll
                for (int kp = 0; kp < 2; ++kp) { v4u w; w.x = pk2(S[c][2 * kp][0], S[c][2 * kp][1]); w.y = pk2(S[c][2 * kp][2], S[c][2 * kp][3]); w.z = pk2(S[c][2 * kp + 1][0], S[c][2 * kp + 1][1]); w.w = pk2(S[c][2 * kp + 1][2], S[c][2 * kp + 1][3]);
                    pf[c][kp] = __builtin_bit_cast(bf16x8, w); } }
#pragma unroll
            for (int kp = 0; kp < 2; ++kp) { Ol[0] = __builtin_amdgcn_mfma_f32_16x16x32_bf16(ones, pf[0][kp], Ol[0], 0, 0, 0); Ol[1] = __builtin_amdgcn_mfma_f32_16x16x32_bf16(ones, pf[1][kp], Ol[1], 0, 0, 0); }
#pragma unroll
            for (int kp = 0; kp < 2; ++kp)
#pragma unroll
                for (int vt = 0; vt < 8; ++vt) { const LAS bf16* a0 = Vc + (32 * kp + 4 * fq + tq) * TLD + 16 * vt + 4 * tp;
                    const s16x4 lo = __builtin_amdgcn_ds_read_tr16_b64_v4i16((LAS s16x4*)a0); const s16x4 hi = __builtin_amdgcn_ds_read_tr16_b64_v4i16((LAS s16x4*)(a0 + 16 * TLD));
                    const bf16x8 vf = (bf16x8){lo[0], lo[1], lo[2], lo[3], hi[0], hi[1], hi[2], hi[3]};
                    Oa[0][vt] = __builtin_amdgcn_mfma_f32_16x16x32_bf16(vf, pf[0][kp], Oa[0][vt], 0, 0, 0); Oa[1][vt] = __builtin_amdgcn_mfma_f32_16x16x32_bf16(vf, pf[1][kp], Oa[1][vt], 0, 0, 0); }
            __syncthreads();
        }
#undef DA_TB
#undef DA_LD
        { const float i0 = 1.f / Ol[0][0], i1 = lam / Ol[1][0]; float ss = 0.f;
#pragma unroll
          for (int vt = 0; vt < 8; ++vt) { Oa[0][vt] = Oa[0][vt] * i0 - Oa[1][vt] * i1; ss += (Oa[0][vt][0] * Oa[0][vt][0] + Oa[0][vt][1] * Oa[0][vt][1]) + (Oa[0][vt][2] * Oa[0][vt][2] + Oa[0][vt][3] * Oa[0][vt][3]); }
          ss = xrow_sum(ss);
          const float rsn = (1.f - lam_init) / sqrtf(ss * (1.f / 128.f) + EPS);
#pragma unroll
          for (int vt = 0; vt < 8; ++vt) { const f32x4 g = *(const GAS f32x4*)(F.in[I_DNG] + 16 * vt + 4 * fq); const f32x4 o = Oa[0][vt] * rsn * g;
              v2u w; w.x = pk2(o[0], o[1]); w.y = pk2(o[2], o[3]);
              *(GAS v2u*)(Y + (size_t)qrow * D + 1024 + h * 128 + 16 * vt + 4 * fq) = w; } }
    }
    __syncthreads();
}
struct Args { const float* in[35]; float* out; unsigned char* ws; int ph_lo, ph_hi; };
__device__ __forceinline__ bool frame_refresh(Frame& F) { int tz = threadIdx.x; asm volatile("" : "+v"(tz)); F.tid = tz; F.lane = tz & 63; F.wave = __builtin_amdgcn_readfirstlane(tz >> 6);
    const __attribute__((address_space(4))) char* kp = (const __attribute__((address_space(4))) char*)__builtin_amdgcn_kernarg_segment_ptr(); asm volatile("" : "+s"(kp));
    const __attribute__((address_space(4))) Args* ap = (const __attribute__((address_space(4))) Args*)kp;
#pragma unroll
    for (int i = 0; i < 35; ++i) F.in[i] = ap->in[i];
    F.out = ap->out; F.ws = ap->ws; F.ctl = (gu32*)(ap->ws + WS_CTL); return true; }
constexpr int NPHASE = 24;
__global__ void __launch_bounds__(NTHR, 2) skel_fwd(Args args) {
    extern __shared__ __attribute__((aligned(16))) unsigned char lds[];
    Frame F;
    F.lds = (LAS unsigned char*)lds;
    F.MISC = (volatile LAS unsigned*)(F.lds + MISC_OFF);
    F.tid = threadIdx.x; F.lane = F.tid & 63; F.wave = __builtin_amdgcn_readfirstlane(F.tid >> 6);
    F.G = gridDim.x; F.bid = blockIdx.x;
    F.ws = args.ws; F.out = args.out; F.ctl = (gu32*)(args.ws + WS_CTL);
    for (int u = F.tid; u < (LDS_BYTES - LDSCTL_OFF) / 4; u += NTHR) ((LAS unsigned*)(F.lds + LDSCTL_OFF))[u] = 0u;
    __syncthreads();
    const int lo = args.ph_lo, hi = args.ph_hi;
    XcdBarrier bar; bar.bar = (unsigned*)(F.ctl + CW_BAR); bar.x = 0; bar.st = nullptr;
    if (hi - lo > 1) bar = xcd_barrier_post((unsigned*)(F.ctl + CW_BAR), F.MISC + 8);
#define IN(k) (lo <= (k) && (k) < hi && frame_refresh(F))
#define SEAM(k) do { if (lo <= (k) && (k) + 1 < hi) xcd_barrier(bar); } while (0)
#define MOD ((const float*)(F.ws + WS_MOD))
#define Abuf ((bf16*)(F.ws + WS_A))
#define Pbuf ((bf16*)(F.ws + WS_P))
#define Ybuf ((bf16*)(F.ws + WS_Y))
#define Hbuf ((float*)(F.ws + WS_H))
#define XS ((bf16*)(F.ws + WS_XS))
#define HID ((bf16*)(F.ws + WS_HID))
#define YS ((bf16*)(F.ws + WS_YS))
    if (IN(0)) { p0_adaln(F); __syncthreads(); p0_filters(F); __syncthreads(); p0_convert(F); } SEAM(0);
    if (IN(1)) { ph_norm1_l0(F); ph_hy_ftt(F); } SEAM(1);
    if (IN(2)) { pg8::Gemm g{Abuf, (const bf16*)(F.ws + WS_WIN0), M_ALL, 6144, D}; pg8::StaticOrder S; S.init(M_ALL, 6144, F.G, F.bid);
        pg8::EpiStore E{Pbuf, LD0, 24, 1.f};
        pg8::gemm_phase<pg8::EpiStore, pg8::StaticOrder, PG8_ALIGN, PG8_SP2>(F.lds + RING_OFF, g, S, E); ph_codes_skinny(F); cvt_late(F, CVT_L0_END - CVT_LATE0, 192, 10); } SEAM(2);
    if (IN(3)) { ph_gla_prep(F); ph_hy_shortconv(F); ph_hy_prep_lat(F); } SEAM(3);
    if (IN(4)) { ph_gla_scan2(F); ph_hy_conv_lat(F); ph_hy_longconv(F, 0); } SEAM(4);
    if (IN(5)) { ph_hy_longconv(F, 1); ph_hy_post_lat(F); const bf16* OG = (const bf16*)(F.ws + WS_OG);
        ph_mix_combine<0>(F, M_ALL, OG, OG + (size_t)M_ALL * 1024, Pbuf, LD0, C0_GR, F.in[I_GNG], 1024); } SEAM(5);
    if (IN(6)) { pg8::Gemm g{Ybuf, (const bf16*)(F.ws + WS_WOUT), M_ALL, D, D}; pg8::StaticOrder S; S.init(M_ALL, D, F.G, F.bid);
        pg8::EpiRes E{F.in[I_X], F.in[I_CTX], Hbuf, MOD + 2 * 2048};
        pg8::gemm_phase<pg8::EpiRes, pg8::StaticOrder, PG8_ALIGN, PG8_SP2>(F.lds + RING_OFF, g, S, E);  cvt_late(F, CVT_L0_END - CVT_LATE0 + 64 * 10, 64, 14); } SEAM(6);
    if (IN(7)) { ph_norm2_router2(F, 0, M_ALL); } SEAM(7);
    if (IN(8)) { ph_topk2(F, 256, ME0); } SEAM(8);
    if (IN(10)) { pg8::Gemm g{(const bf16*)(F.ws + WS_A), (const bf16*)(F.ws + WS_W13), 16 * ME0, 4096, D, (const int*)(F.ws + WS_TOK)}; pg8::GroupedOrder S; S.init(ME0 / 256, 16, F.G, F.bid);
        pg8::EpiSwiglu E{(unsigned char*)HID};
        pg8::gemm_phase<pg8::EpiSwiglu, pg8::GroupedOrder, PG8_ALIGN, PG8_SP2, true, true>(F.lds + RING_OFF, g, S, E); } SEAM(10);
    if (IN(11)) { pg8::Gemm g{HID, (const bf16*)(F.ws + WS_W2), 16 * ME0, 2048, D}; pg8::GroupedOrder S; S.init(ME0 / 256, 8, F.G, F.bid);
        pg8::EpiStore E{YS, D, 8, 1.f / 64.f};
        pg8::gemm_phase<pg8::EpiStore, pg8::GroupedOrder, PG8_ALIGN, PG8_SP2, true>(F.lds + RING_OFF, g, S, E);  cvt_late(F, CVT_L1_END - CVT_LATE1, 128, 5); } SEAM(11);
    if (IN(12)) { ph_combine<0>(F, 0, M_ALL); } SEAM(12);
    if (IN(13)) { pg8::Gemm g{Abuf, (const bf16*)(F.ws + WS_WIN1), M_ALL, LD1, D}; pg8::In1Order S; S.init(F.G, F.bid);
        pg8::EpiStore E{Pbuf, LD1, LD1 / 256, 1.f};
        pg8::gemm_phase<pg8::EpiStore, pg8::In1Order, PG8_ALIGN, PG8_SP2>(F.lds + RING_OFF, g, S, E);  cvt_late(F, CVT_L1_END - CVT_LATE1 + 128 * 5, 200, 10); } SEAM(13);
    if (IN(14)) { ph_ml_prep(F); ph_da_rope(F); } SEAM(14);
    if (IN(15)) { ph_ml_scan2(F); ph_da_attn2(F); } SEAM(15);
    if (IN(16)) { const bf16* OM = (const bf16*)(F.ws + WS_OG);
        ph_mix_combine<1>(F, M_LAT, OM, OM + (size_t)M_LAT * 1024, Pbuf, LD1, C1_MO, F.in[I_MNG], 0); } SEAM(16);
    if (IN(17)) { pg8::Gemm g{Ybuf, (const bf16*)(F.ws + WS_WOUT) + (size_t)D * D, M_LAT, D, D}; pg8::StaticOrder S; S.init(M_LAT, D, F.G, F.bid);
        pg8::EpiRes E{Hbuf, Hbuf, Hbuf, MOD + 9 * 12288 + 2 * 2048};
        pg8::gemm_phase<pg8::EpiRes, pg8::StaticOrder, PG8_ALIGN, PG8_SP2>(F.lds + RING_OFF, g, S, E); } SEAM(17);
    if (IN(18)) { ph_norm2_router2(F, 1, M_LAT); } SEAM(18);
    if (IN(19)) { ph_topk2(F, 128, ME1); } SEAM(19);
    if (IN(21)) { pg8::Gemm g{(const bf16*)(F.ws + WS_A), (const bf16*)(F.ws + WS_W13) + (size_t)16 * 4096 * 1024, 16 * ME1, 4096, D, (const int*)(F.ws + WS_TOK)}; pg8::GroupedOrder S; S.init(ME1 / 256, 16, F.G, F.bid);
        pg8::EpiSwiglu E{(unsigned char*)HID};
        pg8::gemm_phase<pg8::EpiSwiglu, pg8::GroupedOrder, PG8_ALIGN, PG8_SP2, true, true>(F.lds + RING_OFF, g, S, E); } SEAM(21);
    if (IN(22)) { pg8::Gemm g{HID, (const bf16*)(F.ws + WS_W2) + (size_t)16 * 2048 * 1024, 16 * ME1, 2048, D}; pg8::GroupedOrder S; S.init(ME1 / 256, 8, F.G, F.bid);
        pg8::EpiStore E{YS, D, 8, 1.f / 64.f};
        pg8::gemm_phase<pg8::EpiStore, pg8::GroupedOrder, PG8_ALIGN, PG8_SP2, true>(F.lds + RING_OFF, g, S, E); } SEAM(22);
    if (IN(23)) { ph_combine<1>(F, 1, M_LAT); }
#undef IN
#undef SEAM
#undef MOD
#undef Abuf
#undef Pbuf
#undef Ybuf
#undef Hbuf
#undef XS
#undef HID
#undef YS
}

extern "C" void kernel_launch(void* const* d_in, const int* in_sizes, int n_in, void* d_out, int out_size, void* d_ws, size_t ws_size, hipStream_t stream) {
    static int grid = 0;
    if (grid == 0) {
        if (n_in != 35 || ws_size < WS_END) { fprintf(stderr, "kernel_launch: unexpected n_in %d / ws_size %zu\n", n_in, ws_size); grid = -1; return; }
        int dev = 0, cus = 0, per_cu = 0;
        if (hipGetDevice(&dev) != hipSuccess || hipDeviceGetAttribute(&cus, hipDeviceAttributeMultiprocessorCount, dev) != hipSuccess) { grid = -1; return; }
        if (hipFuncSetAttribute((const void*)skel_fwd, hipFuncAttributeMaxDynamicSharedMemorySize, LDS_BYTES) != hipSuccess) { fprintf(stderr, "kernel_launch: hipFuncSetAttribute failed\n"); grid = -1; return; }
        if (hipOccupancyMaxActiveBlocksPerMultiprocessor(&per_cu, (const void*)skel_fwd, NTHR, LDS_BYTES) != hipSuccess || per_cu < 1) fprintf(stderr, "kernel_launch: occupancy query says %d\n", per_cu);
        (void)hipGetLastError();
        grid = cus;
    }
    if (grid < 0) return;
    if (hipMemsetAsync((char*)d_ws + WS_CTL, 0, CTL_ZERO_BYTES, stream) != hipSuccess) return;
    Args a{};
    for (int i = 0; i < 35; ++i) a.in[i] = (const float*)d_in[i];
    a.out = (float*)d_out; a.ws = (unsigned char*)d_ws;
#if MK_ONE_LAUNCH
    a.ph_lo = 0; a.ph_hi = NPHASE;
    hipLaunchKernelGGL(skel_fwd, dim3(grid), dim3(NTHR), LDS_BYTES, stream, a);
#else
    for (int k = 0; k < NPHASE; ++k) { a.ph_lo = k; a.ph_hi = k + 1; hipLaunchKernelGGL(skel_fwd, dim3(grid), dim3(NTHR), LDS_BYTES, stream, a); }
#endif
}
```

```cpp
#include <hip/hip_runtime.h>
#include <cstdio>
#include <cstdint>
namespace pg8 {
#define PG8_LAS __attribute__((address_space(3)))
typedef unsigned short bf16_t;
typedef short bf16x8 __attribute__((ext_vector_type(8)));
typedef float f32x4 __attribute__((ext_vector_type(4)));
typedef unsigned u32x4 __attribute__((ext_vector_type(4)));
constexpr int BM = 256, BK = 64, HALF = 128, HTB = HALF * BK * 2  , STAGE_BYTES = 8 * HTB, NXCD = 8, WGM = 8;

__host__ __device__ __forceinline__ int lds_byte(int r, int c) { const int st = (r >> 4) * 2 + (c >> 5), rr = r & 15, cc = c & 31, ob = rr * 64 + cc * 2; return st * 1024 + (ob ^ (((ob >> 9) & 1) << 5)); }
__host__ __device__ __forceinline__ void stage_rc(int b, int& R, int& C) { const int st = b / 1024, sb = b % 1024, swz = sb ^ (((sb >> 9) & 1) << 5); R = (st >> 1) * 16 + swz / 64; C = (st & 1) * 32 + (swz % 64) / 2; }
__host__ __device__ __forceinline__ int perm32(int rho) { const int n = rho >> 4, i = rho & 15; return 8 * (i >> 2) + 4 * n + (i & 3); }

struct Unit { int pm, pn; };
struct Gemm { const bf16_t* A; const bf16_t* Bt; int M, N, K; const int* arow = nullptr; };

struct StaticOrder {
    int nM, nN, nwg, G, c;
    __host__ __device__ void init(int M, int N, int G_, int c_) { nM = M / BM; nN = N / BM; nwg = nM * nN; G = G_; c = c_; }
    __host__ __device__ bool next(int i, Unit& u) const {
        const long L = (long)i * G + c; if (L >= nwg) return false;
        int wgid = (int)L; { const int q = nwg / NXCD, r = nwg % NXCD, xcd = wgid % NXCD, off = wgid / NXCD; wgid = (xcd < r ? xcd * (q + 1) : r * (q + 1) + (xcd - r) * q) + off; }
        const int nig = WGM * nN, gid = wgid / nig, fm = gid * WGM, gsz = (nM - fm) < WGM ? (nM - fm) : WGM;
        u.pm = fm + ((wgid % nig) % gsz); u.pn = (wgid % nig) / gsz; return true;
    }
    __device__ __forceinline__ void a_ready(const Unit&) const {}
    __device__ __forceinline__ void done(const Unit&) const {}
};

__device__ __forceinline__ unsigned cvt_pk_bf16(float lo, float hi) { unsigned r; asm volatile("v_cvt_pk_bf16_f32 %0, %1, %2" : "=v"(r) : "v"(lo), "v"(hi)); return r; }
typedef float f32x2 __attribute__((ext_vector_type(2)));
__device__ __forceinline__ f32x2 gelu_pk(f32x2 v) {
    const f32x2 av = __builtin_elementwise_abs(v), d = av * 0.2316418882f + 1.0f;
    f32x2 t; t.x = __builtin_amdgcn_rcpf(d.x); t.y = __builtin_amdgcn_rcpf(d.y);
    f32x2 q = t * 0.5307027145f + (-0.7265760135f); q = q * t + 0.7107068705f; q = q * t + (-0.142248368f); q = q * t + 0.127414796f; q = q * t;
    const f32x2 s = (v * v) * (-0.72134752044f);
    f32x2 e; e.x = __builtin_amdgcn_exp2f(s.x); e.y = __builtin_amdgcn_exp2f(s.y);
    const f32x2 m = v * (q * e), r = v - m;
    f32x2 o; o.x = v.x < 0.f ? m.x : r.x; o.y = v.y < 0.f ? m.y : r.y; return o;
}

typedef int v8i32 __attribute__((ext_vector_type(8)));
template <class Epi, class Sched, bool ALIGN_EPI = false, bool SP2 = false, bool FP8 = false, bool IDXA = false>
__device__ __forceinline__ void gemm_phase(PG8_LAS unsigned char* lds, const Gemm g, const Sched& S, const Epi& E) {
    int tid_ = threadIdx.x; asm volatile("" : "+v"(tid_));
    const int tid = tid_, wid = __builtin_amdgcn_readfirstlane(tid >> 6), lane = tid & 63, wr = wid >> 2, wc = wid & 3, fr = lane & 15, fq = lane >> 4;
    const int K = FP8 ? g.K / 2 : g.K, nt = K / BK;
    unsigned voffA[2], voffB[2]; int Rv[2], Cv[2];
#pragma unroll
    for (int i = 0; i < 2; ++i) { int R, C; stage_rc(tid * 16 + i * 8192, R, C); const int Rb = Epi::PERM ? ((R & ~31) + perm32(R & 31)) : R; Rv[i] = R; Cv[i] = C;
        voffA[i] = (unsigned)(R * K + C) * 2u; voffB[i] = (unsigned)(Rb * K + C) * 2u; }
    static_assert(!IDXA || SP2, "IDXA is written for the SP2 loop");
    unsigned vAc[2][2], vAn[2][2];
#define PG8_IDX(u_, vo) do { _Pragma("unroll") for (int h_ = 0; h_ < 2; ++h_) _Pragma("unroll") for (int i_ = 0; i_ < 2; ++i_) { const int row_ = g.arow[(u_).pm * BM + h_ * HALF + Rv[i_]]; vo[h_][i_] = (unsigned)(row_ * K + Cv[i_]) * 2u; } } while (0)
    const size_t kstep = (size_t)(BK * 2);
    const size_t hstep = (size_t)HALF * K * 2;
    const size_t tstep = 2 * hstep;
    const unsigned ldsw = (unsigned)wid * 1024u;
    const int aoff = lds_byte(wr * 64 + fr, fq * 8), boff = lds_byte(wc * 32 + fr, fq * 8);
#define PG8_SA(b, h) (((b) * 2 + (h)) * HTB)
#define PG8_SB(b, h) ((4 + (b) * 2 + (h)) * HTB)
#define PG8_STAGE(bufoff, gbase, voff) do { _Pragma("unroll") for (int _i = 0; _i < 2; ++_i) \
        __builtin_amdgcn_global_load_lds((const unsigned*)((const char*)(gbase) + (voff)[_i]), (PG8_LAS unsigned*)(lds + (bufoff) + ldsw + _i * 8192), 16, 0, 0); } while (0)
#define PG8_STAGE_A(bufoff, gbase, h, sel) do { if constexpr (IDXA) { _Pragma("unroll") for (int _i = 0; _i < 2; ++_i) { const unsigned vo_ = (sel) ? vAn[h][_i] : vAc[h][_i]; \
        __builtin_amdgcn_global_load_lds((const unsigned*)((const char*)(gbase) + vo_), (PG8_LAS unsigned*)(lds + (bufoff) + ldsw + _i * 8192), 16, 0, 0); } } \
        else PG8_STAGE(bufoff, (gbase) + (h) * hstep, voffA); } while (0)
#define PG8_LDA(dst, b, h) do { _Pragma("unroll") for (int m = 0; m < 4; ++m) _Pragma("unroll") for (int k = 0; k < 2; ++k) dst[m][k] = *(const PG8_LAS bf16x8*)(lds + PG8_SA(b, h) + aoff + m * 2048 + k * 1024); } while (0)
#define PG8_LDB(dst, b, h) do { _Pragma("unroll") for (int n = 0; n < 2; ++n) _Pragma("unroll") for (int k = 0; k < 2; ++k) dst[n][k] = *(const PG8_LAS bf16x8*)(lds + PG8_SB(b, h) + boff + n * 2048 + k * 1024); } while (0)
#define PG8_MMA(ai, bj, At, Bt) do { __builtin_amdgcn_s_setprio(1); _Pragma("unroll") for (int m = 0; m < 4; ++m) _Pragma("unroll") for (int n = 0; n < 2; ++n) { \
        if constexpr (FP8) { typedef int i32x4_ __attribute__((ext_vector_type(4))); \
            const v8i32 _bv = __builtin_shufflevector(__builtin_bit_cast(i32x4_, Bt[n][0]), __builtin_bit_cast(i32x4_, Bt[n][1]), 0, 1, 2, 3, 4, 5, 6, 7); \
            const v8i32 _av = __builtin_shufflevector(__builtin_bit_cast(i32x4_, At[m][0]), __builtin_bit_cast(i32x4_, At[m][1]), 0, 1, 2, 3, 4, 5, 6, 7); \
            asm volatile("s_nop 1\n\tv_mfma_scale_f32_16x16x128_f8f6f4 %0, %1, %2, %0, %3, %3 op_sel_hi:[0,0,0]" : "+v"(acc[ai][bj][m][n]) : "v"(_bv), "v"(_av), "v"(0x7f7f7f7f)); } \
        else { _Pragma("unroll") for (int k = 0; k < 2; ++k) acc[ai][bj][m][n] = __builtin_amdgcn_mfma_f32_16x16x32_bf16(Bt[n][k], At[m][k], acc[ai][bj][m][n], 0, 0, 0); } } \
        __builtin_amdgcn_s_setprio(0); } while (0)
#define PG8_WAIT_V(n) asm volatile("s_waitcnt vmcnt(" #n ")" ::: "memory")
#define PG8_WAIT_L(n) asm volatile("s_waitcnt lgkmcnt(" #n ")" ::: "memory")
#define PG8_BAR __builtin_amdgcn_s_barrier()
#define PG8_SCHED __builtin_amdgcn_sched_barrier(0)
    Unit cur, nxt; int ui = 0;
    if (!S.next(0, cur)) return;
    f32x4 acc[2][2][4][2];
#pragma unroll
    for (int a = 0; a < 2; ++a)
#pragma unroll
        for (int b = 0; b < 2; ++b)
#pragma unroll
            for (int m = 0; m < 4; ++m)
#pragma unroll
                for (int n = 0; n < 2; ++n) acc[a][b][m][n] = (f32x4){0.f, 0.f, 0.f, 0.f};
    bf16x8 At[4][2], B0[2][2], B1[2][2];
    const char* cA = (const char*)g.A + (IDXA ? (size_t)0 : (size_t)cur.pm * tstep); const char* cB = (const char*)g.Bt + (size_t)cur.pn * tstep;
    if constexpr (IDXA) PG8_IDX(cur, vAc);
    S.a_ready(cur);
    if constexpr (SP2) {
        PG8_STAGE(PG8_SB(0, 0), cB, voffB); PG8_STAGE(PG8_SB(0, 1), cB + hstep, voffB); PG8_STAGE_A(PG8_SA(0, 0), cA, 0, false); PG8_STAGE_A(PG8_SA(0, 1), cA, 1, false);
        if (wr == 1) PG8_BAR;
        PG8_WAIT_V(2); PG8_BAR;
        PG8_STAGE(PG8_SB(1, 0), cB + kstep, voffB); PG8_STAGE_A(PG8_SA(1, 0), cA + kstep, 0, false); PG8_STAGE(PG8_SB(1, 1), cB + hstep + kstep, voffB);
        PG8_WAIT_V(6); PG8_BAR;
    } else {
        PG8_STAGE(PG8_SB(0, 0), cB, voffB); PG8_STAGE(PG8_SA(0, 0), cA, voffA); PG8_STAGE(PG8_SB(0, 1), cB + hstep, voffB); PG8_STAGE(PG8_SA(0, 1), cA + hstep, voffA);
        if (wr == 1) PG8_BAR;
        PG8_WAIT_V(4); PG8_BAR;
        PG8_STAGE(PG8_SB(1, 0), cB + kstep, voffB); PG8_STAGE(PG8_SA(1, 0), cA + kstep, voffA); PG8_STAGE(PG8_SB(1, 1), cB + hstep + kstep, voffB);
        PG8_WAIT_V(6); PG8_BAR;
    }
    for (;;) {
        const bool has_next = S.next(ui + 1, nxt);
        if constexpr (IDXA) { if (has_next) PG8_IDX(nxt, vAn); }
        const char* nA = (has_next && !IDXA) ? (const char*)g.A + (size_t)nxt.pm * tstep : cA; const char* nB = has_next ? (const char*)g.Bt + (size_t)nxt.pn * tstep : cB;
        for (int t = 0; t < nt; t += 2) {
            const bool last = (t == nt - 2);
            const char* a1 = cA + (size_t)(t + 1) * kstep;
            const char* a2 = last ? nA : cA + (size_t)(t + 2) * kstep; const char* b2 = last ? nB : cB + (size_t)(t + 2) * kstep;
            const char* a3 = a2 + kstep; const char* b3 = b2 + kstep;
            const bool nsel = last && has_next;
            if (last && has_next) S.a_ready(nxt);
            if constexpr (SP2) {
            PG8_LDB(B0, 0, 0); PG8_LDB(B1, 0, 1); PG8_SCHED; PG8_LDA(At, 0, 0); PG8_STAGE_A(PG8_SA(1, 1), a1, 1, false);
            PG8_WAIT_V(8); PG8_WAIT_L(0); PG8_BAR; PG8_MMA(0, 0, At, B0); PG8_MMA(0, 1, At, B1); PG8_BAR; PG8_SCHED;
            PG8_LDA(At, 0, 1); PG8_STAGE(PG8_SB(0, 0), b2, voffB); PG8_STAGE(PG8_SB(0, 1), b2 + hstep, voffB); PG8_STAGE_A(PG8_SA(0, 0), a2, 0, nsel);
            PG8_WAIT_V(8); PG8_WAIT_L(0); PG8_BAR; PG8_MMA(1, 0, At, B0); PG8_MMA(1, 1, At, B1); PG8_BAR; PG8_SCHED;
            PG8_LDB(B0, 1, 0); PG8_LDB(B1, 1, 1); PG8_SCHED; PG8_LDA(At, 1, 0); PG8_STAGE_A(PG8_SA(0, 1), a2, 1, nsel);
            PG8_WAIT_V(8); PG8_WAIT_L(0); PG8_BAR; PG8_MMA(0, 0, At, B0); PG8_MMA(0, 1, At, B1); PG8_BAR; PG8_SCHED;
            PG8_LDA(At, 1, 1); PG8_STAGE(PG8_SB(1, 0), b3, voffB); PG8_STAGE(PG8_SB(1, 1), b3 + hstep, voffB); PG8_STAGE_A(PG8_SA(1, 0), a3, 0, nsel);
            PG8_WAIT_V(8); PG8_WAIT_L(0); PG8_BAR; PG8_MMA(1, 0, At, B0); PG8_MMA(1, 1, At, B1); PG8_BAR; PG8_SCHED;
            } else {
            PG8_LDB(B0, 0, 0); PG8_SCHED; PG8_LDA(At, 0, 0); PG8_STAGE(PG8_SA(1, 1), a1 + hstep, voffA);
            PG8_WAIT_L(8); PG8_BAR; PG8_WAIT_L(0); PG8_MMA(0, 0, At, B0); PG8_BAR; PG8_SCHED;
            PG8_LDB(B1, 0, 1); PG8_STAGE(PG8_SB(0, 0), b2, voffB);
            PG8_BAR; PG8_WAIT_L(0); PG8_MMA(0, 1, At, B1); PG8_BAR;
            PG8_LDA(At, 0, 1); PG8_STAGE(PG8_SA(0, 0), a2, voffA);
            PG8_BAR; PG8_WAIT_L(0); PG8_MMA(1, 0, At, B0); PG8_BAR; PG8_SCHED;
            PG8_STAGE(PG8_SB(0, 1), b2 + hstep, voffB);
            PG8_WAIT_V(6); PG8_BAR; PG8_MMA(1, 1, At, B1); PG8_BAR;
            PG8_LDB(B0, 1, 0); PG8_SCHED; PG8_LDA(At, 1, 0); PG8_STAGE(PG8_SA(0, 1), a2 + hstep, voffA);
            PG8_WAIT_L(8); PG8_BAR; PG8_WAIT_L(0); PG8_MMA(0, 0, At, B0); PG8_BAR; PG8_SCHED;
            PG8_LDB(B1, 1, 1); PG8_STAGE(PG8_SB(1, 0), b3, voffB);
            PG8_BAR; PG8_WAIT_L(0); PG8_MMA(0, 1, At, B1); PG8_BAR;
            PG8_LDA(At, 1, 1); PG8_STAGE(PG8_SA(1, 0), a3, voffA);
            PG8_BAR; PG8_WAIT_L(0); PG8_MMA(1, 0, At, B0); PG8_BAR; PG8_SCHED;
            PG8_STAGE(PG8_SB(1, 1), b3 + hstep, voffB);
            PG8_WAIT_V(6); PG8_BAR; PG8_MMA(1, 1, At, B1); PG8_BAR;
            }
        }
        if constexpr (FP8) asm volatile("s_nop 15" ::: "memory");
        if constexpr (ALIGN_EPI) { if (wr == 0) PG8_BAR; }
        if constexpr (!Epi::AFTER_DRAIN) { E(acc, cur, wr, wc, fr, fq); S.done(cur); }
        if (!has_next) break;
#pragma unroll
        for (int a = 0; a < 2; ++a)
#pragma unroll
            for (int b = 0; b < 2; ++b)
#pragma unroll
                for (int m = 0; m < 4; ++m)
#pragma unroll
                    for (int n = 0; n < 2; ++n) acc[a][b][m][n] = (f32x4){0.f, 0.f, 0.f, 0.f};
        cur = nxt; cA = nA; cB = nB; ++ui;
        if constexpr (IDXA) { vAc[0][0] = vAn[0][0]; vAc[0][1] = vAn[0][1]; vAc[1][0] = vAn[1][0]; vAc[1][1] = vAn[1][1]; }
        if constexpr (ALIGN_EPI) { if (wr == 1) PG8_BAR; }
    }
    PG8_WAIT_V(0);
    if constexpr (!ALIGN_EPI) { if (wr == 0) PG8_BAR; }
    PG8_BAR;
    if constexpr (Epi::AFTER_DRAIN) { E.fused(acc, cur, wr, wc, fr, fq, lds, wid, lane); S.done(cur); }
#undef PG8_SA
#undef PG8_SB
#undef PG8_STAGE
#undef PG8_STAGE_A
#undef PG8_IDX
#undef PG8_LDA
#undef PG8_LDB
#undef PG8_MMA
#undef PG8_WAIT_V
#undef PG8_WAIT_L
#undef PG8_BAR
#undef PG8_SCHED
}
}
namespace pg8 {
struct GroupedOrder {
    int nMe, nNe, per, nwg, G, c;
    __host__ __device__ void init(int nMe_, int nNe_, int G_, int c_) { nMe = nMe_; nNe = nNe_; per = nMe * nNe; nwg = 16 * per; G = G_; c = c_; }
    __host__ __device__ bool next(int i, Unit& u) const {
        const long L = (long)i * G + c; if (L >= nwg) return false;
        int wgid = (int)L; { const int q = nwg / NXCD, r = nwg % NXCD, xcd = wgid % NXCD, off = wgid / NXCD; wgid = (xcd < r ? xcd * (q + 1) : r * (q + 1) + (xcd - r) * q) + off; }
        const int e = wgid / per, l = wgid % per;
        u.pm = e * nMe + (l % nMe); u.pn = e * nNe + (l / nMe); return true;
    }
    __device__ __forceinline__ void a_ready(const Unit&) const {}
    __device__ __forceinline__ void done(const Unit&) const {}
};
struct In1Order {
    StaticOrder S0; int G, c;
    __host__ __device__ void init(int G_, int c_) { S0.init(16384, 29 * 256, G_, c_); G = G_; c = c_; }
    __host__ __device__ bool next(int i, Unit& u) const {
        const long L = (long)i * G + c;
        if (L < 1856) return S0.next(i, u);
        const int q = (int)L - 1856; if (q >= 136) return false;
        const int t = q % 17; u.pm = 64 + q / 17; u.pn = (t < 8) ? 4 + t : ((t < 16) ? 12 + t : 28); return true;
    }
    __device__ __forceinline__ void a_ready(const Unit&) const {}
    __device__ __forceinline__ void done(const Unit&) const {}
};
struct EpiStore {
    static constexpr bool PERM = true, AFTER_DRAIN = false;
    bf16_t* O; int ldc; int nNt; float sc;
    __device__ __forceinline__ void operator()(const f32x4 (&acc)[2][2][4][2], const Unit& u, int wr, int wc, int fr, int fq) const {
        const int row0 = u.pm * BM + wr * 64 + fr; const int col0 = (u.pn % nNt) * BM + wc * 32 + 8 * fq;
#pragma unroll
        for (int ai = 0; ai < 2; ++ai)
#pragma unroll
            for (int m = 0; m < 4; ++m) { bf16_t* rowp = O + (size_t)(row0 + ai * HALF + m * 16) * ldc + col0;
#pragma unroll
                for (int bj = 0; bj < 2; ++bj) { const f32x4 v0 = acc[ai][bj][m][0] * sc, v1 = acc[ai][bj][m][1] * sc;
                    u32x4 w; w.x = cvt_pk_bf16(v0[0], v0[1]); w.y = cvt_pk_bf16(v0[2], v0[3]); w.z = cvt_pk_bf16(v1[0], v1[1]); w.w = cvt_pk_bf16(v1[2], v1[3]);
                    *(u32x4*)(rowp + bj * HALF) = w; } }
    }
};
struct EpiSwiglu {
    static constexpr bool PERM = true, AFTER_DRAIN = false;
    unsigned char* O;
    __device__ __forceinline__ float sg(float a, float b) const { const float x = a * (1.f / 64.f); const float r = x * __builtin_amdgcn_rcpf(1.f + __expf(-x)) * (b * (1.f / 64.f)); return fminf(fmaxf(r, -448.f), 448.f); }
    __device__ __forceinline__ void operator()(const f32x4 (&acc)[2][2][4][2], const Unit& u, int wr, int wc, int fr, int fq) const {
        const int row0 = u.pm * BM + wr * 64 + fr; const int col0 = (u.pn % 16) * HALF + wc * 32 + 8 * fq;
#pragma unroll
        for (int ai = 0; ai < 2; ++ai)
#pragma unroll
            for (int m = 0; m < 4; ++m) { unsigned char* rowp = O + (size_t)(row0 + ai * HALF + m * 16) * 2048 + col0;
                const f32x4 a0 = acc[ai][0][m][0], a1 = acc[ai][0][m][1], b0 = acc[ai][1][m][0], b1 = acc[ai][1][m][1];
                int lo = 0, hi = 0;
                lo = __builtin_amdgcn_cvt_pk_fp8_f32(sg(a0[0], b0[0]), sg(a0[1], b0[1]), lo, false); lo = __builtin_amdgcn_cvt_pk_fp8_f32(sg(a0[2], b0[2]), sg(a0[3], b0[3]), lo, true);
                hi = __builtin_amdgcn_cvt_pk_fp8_f32(sg(a1[0], b1[0]), sg(a1[1], b1[1]), hi, false); hi = __builtin_amdgcn_cvt_pk_fp8_f32(sg(a1[2], b1[2]), sg(a1[3], b1[3]), hi, true);
                typedef unsigned u32x2 __attribute__((ext_vector_type(2)));
                *(u32x2*)rowp = (u32x2){(unsigned)lo, (unsigned)hi}; }
    }
};
struct EpiRes {
    static constexpr bool PERM = false, AFTER_DRAIN = false;
    const float* Xlat; const float* Xctx; float* H; const float* gate;
    __device__ __forceinline__ void operator()(const f32x4 (&acc)[2][2][4][2], const Unit& u, int wr, int wc, int fr, int fq) const {
        const int row0 = u.pm * BM + wr * 64 + fr, col0 = u.pn * BM + wc * 32 + 4 * fq;
        const float* gp = gate + (size_t)((u.pm < 64) ? (u.pm >> 3) : 8) * 12288 + col0;
        f32x4 g[2][2];
#pragma unroll
        for (int bj = 0; bj < 2; ++bj)
#pragma unroll
            for (int n = 0; n < 2; ++n) g[bj][n] = *(const f32x4*)(gp + bj * HALF + n * 16);
        const float* sbase = (u.pm < 64) ? Xlat : Xctx - (size_t)16384 * 2048;
#pragma unroll
        for (int ai = 0; ai < 2; ++ai)
#pragma unroll
            for (int m = 0; m < 4; ++m) { const int row = row0 + ai * HALF + m * 16;
                const float* src = sbase + (size_t)row * 2048 + col0; float* dst = H + (size_t)row * 2048 + col0;
#pragma unroll
                for (int bj = 0; bj < 2; ++bj)
#pragma unroll
                    for (int n = 0; n < 2; ++n) { const int c = bj * HALF + n * 16;
                        const f32x4 x = *(const f32x4*)(src + c);
                        *(f32x4*)(dst + c) = x + g[bj][n] * acc[ai][bj][m][n]; } }
    }
};
}
#ifndef PG8_SP2
#define PG8_SP2 true
#endif
#ifndef PG8_ALIGN
#define PG8_ALIGN true
#endif
constexpr int NWAVES = 8;
constexpr int NTHR = NWAVES * 64;
#ifndef MK_ONE_LAUNCH
#define MK_ONE_LAUNCH 1
#endif
constexpr int D = 2048, NB = 8, SEQ = 2048, CTXL = 256;
constexpr int M_LAT = NB * SEQ, M_CTX = NB * CTXL, M_ALL = M_LAT + M_CTX;
constexpr int LD0 = 6400, LD1 = 7424;
constexpr int EV_IN = 6176, OD_IN = 7184;
constexpr int NE_ = 16, FF = 2048;
constexpr int ME0 = 2304, ME1 = 2048;
constexpr float EPS = 1e-6f;
constexpr int C0_X1 = 0, C0_X2 = 1024, C0_V = 2048, C0_GQ = 3072, C0_GK = 3584, C0_GV = 4096, C0_GR = 5120, C0_CODE = 6144;
constexpr int C1_MQ = 0, C1_MK = 1024, C1_MV = 2048, C1_MO = 3072, C1_DQ = 4096, C1_DK = 5120, C1_DV = 6144, C1_G = 7168;
constexpr size_t MiB = 1u << 20;
constexpr size_t WS_CTL = 0, CTL_ZERO_BYTES = 1 * MiB;
constexpr size_t WS_MOD = 1 * MiB;
constexpr size_t WS_AFF = 2 * MiB;
constexpr size_t WS_SEL = 4 * MiB;
constexpr size_t WS_TOK = 6 * MiB;
constexpr size_t WS_GW  = 7 * MiB;
constexpr size_t WS_FTL = 8 * MiB;
constexpr size_t WS_FTC = 40 * MiB;
constexpr size_t WS_WIN0 = 44 * MiB;
constexpr size_t WS_WIN1 = 69 * MiB;
constexpr size_t WS_WOUT = 98 * MiB;
constexpr size_t WS_W13 = 114 * MiB;
constexpr size_t WS_W2 = 626 * MiB;
constexpr size_t WS_H = 882 * MiB;
constexpr size_t WS_A = 1026 * MiB;
constexpr size_t WS_Y = 1098 * MiB;
constexpr size_t WS_P = 1170 * MiB;
constexpr size_t WS_XS = WS_P, WS_YS = WS_P;
constexpr size_t WS_MIX = 1431 * MiB;
constexpr size_t WS_XV = WS_MIX, WS_Z = WS_MIX + 108 * MiB, WS_OG = WS_MIX + 144 * MiB;
constexpr size_t WS_HID = WS_MIX;
constexpr size_t WS_XT = 1719 * MiB;
constexpr size_t WS_YT = 1815 * MiB;
constexpr size_t WS_FTT = 1847 * MiB;
constexpr size_t WS_GQ = 1864 * MiB;
constexpr size_t WS_GDEC = 1972 * MiB;
constexpr size_t WS_MQK = WS_GQ;
constexpr size_t WS_MLS = WS_GQ + 80 * MiB;
constexpr size_t WS_END = 1974 * MiB;
constexpr int CW_BAR = 4096;
constexpr int RING_OFF = 0, RING_BYTES = 131072;
constexpr int LDSCTL_OFF = 146432, MISC_OFF = LDSCTL_OFF + 320;
constexpr int LDS_BYTES = 147456;
#define GAS __attribute__((address_space(1)))
#define LAS __attribute__((address_space(3)))
typedef unsigned short bf16;
typedef unsigned v4u __attribute__((ext_vector_type(4)));
typedef unsigned v2u __attribute__((ext_vector_type(2)));
typedef float f32x4 __attribute__((ext_vector_type(4)));
typedef short bf16x8 __attribute__((ext_vector_type(8)));
typedef GAS unsigned gu32;
#define RLX_AGENT __ATOMIC_RELAXED, __HIP_MEMORY_SCOPE_AGENT
#define LDS_WAIT() asm volatile("s_waitcnt lgkmcnt(0)" ::: "memory")
#define VM_WAIT() asm volatile("s_waitcnt vmcnt(0)" ::: "memory")
typedef float f32x2v_ __attribute__((ext_vector_type(2)));
typedef __bf16 bf16x2v_ __attribute__((ext_vector_type(2)));
__device__ __forceinline__ unsigned pk2(float lo, float hi) { return __builtin_bit_cast(unsigned, __builtin_convertvector((f32x2v_){lo, hi}, bf16x2v_)); }
__device__ __forceinline__ unsigned f2bf(float f) { return pk2(f, 0.f) & 0xffffu; }
__device__ __forceinline__ unsigned pk4_fp8(float a, float b, float c, float d) { int r = 0; r = __builtin_amdgcn_cvt_pk_fp8_f32(a, b, r, false); r = __builtin_amdgcn_cvt_pk_fp8_f32(c, d, r, true); return (unsigned)r; }
__device__ __forceinline__ float bf2f(unsigned short b) { return __builtin_bit_cast(float, ((unsigned)b) << 16); }
__device__ __forceinline__ float bflo(unsigned w) { return __builtin_bit_cast(float, w << 16); }
__device__ __forceinline__ float bfhi(unsigned w) { return __builtin_bit_cast(float, w & 0xffff0000u); }
__device__ __forceinline__ float siluf(float x) { return x * __builtin_amdgcn_rcpf(1.f + __expf(-x)); }
__device__ __forceinline__ float sigmoidf_(float x) { return __builtin_amdgcn_rcpf(1.f + __expf(-x)); }
__device__ __forceinline__ float logsigmoidf_(float x) { return fminf(x, 0.f) - __logf(1.f + __expf(-fabsf(x))); }
template <int CTRL> __device__ __forceinline__ float dppmov(float v) { return __builtin_bit_cast(float, __builtin_amdgcn_update_dpp(0, __builtin_bit_cast(int, v), CTRL, 0xf, 0xf, true)); }
__device__ __forceinline__ float row16_sum(float v) { v += dppmov<0xB1>(v); v += dppmov<0x4E>(v); v += dppmov<0x124>(v); v += dppmov<0x128>(v); return v; }
__device__ __forceinline__ float row16_max(float v) { v = fmaxf(v, dppmov<0xB1>(v)); v = fmaxf(v, dppmov<0x4E>(v)); v = fmaxf(v, dppmov<0x124>(v)); v = fmaxf(v, dppmov<0x128>(v)); return v; }
__device__ __forceinline__ float xrow_sum(float v) {
    float a = v, b = v; asm volatile("s_nop 1\n\tv_permlane16_swap_b32 %0, %1" : "+v"(a), "+v"(b)); v = a + b; a = v; b = v;
    asm volatile("s_nop 1\n\tv_permlane32_swap_b32 %0, %1" : "+v"(a), "+v"(b)); return a + b; }
__device__ __forceinline__ float xrow_max(float v) {
    float a = v, b = v; asm volatile("s_nop 1\n\tv_permlane16_swap_b32 %0, %1" : "+v"(a), "+v"(b)); v = fmaxf(a, b); a = v; b = v;
    asm volatile("s_nop 1\n\tv_permlane32_swap_b32 %0, %1" : "+v"(a), "+v"(b)); return fmaxf(a, b); }
__device__ __forceinline__ float wave_sum(float v) { return xrow_sum(row16_sum(v)); }
#define XB_TMO      128
#define XB_XCNT(j)  (256  + 64 * (j))
#define XB_XSUB(j)  (1280 + 64 * (j))
#define XB_XGEN(j)  (2304 + 64 * (j))
#define XB_TOP      3328
#define XB_TOPGEN   3392
#define XCD_BAR_WORDS 3456
#define XB_SPIN_CAP (1u << 18)

__device__ __forceinline__ unsigned xb_ld(unsigned* p)              { return __hip_atomic_load(p, __ATOMIC_RELAXED, __HIP_MEMORY_SCOPE_AGENT); }
__device__ __forceinline__ unsigned xb_add(unsigned* p, unsigned v) { return __hip_atomic_fetch_add(p, v, __ATOMIC_RELAXED, __HIP_MEMORY_SCOPE_AGENT); }
__device__ __forceinline__ unsigned xb_xcc_id() { return (unsigned)__builtin_amdgcn_s_getreg((3 << 11) | 20) & 0xFu; }
#define XB_SPIN(cond, bar) do { unsigned _sp = 0; while (cond) { __builtin_amdgcn_s_sleep(1); \
    if ((++_sp & 255u) == 0u) { if (xb_ld(&(bar)[XB_TMO])) break; if (_sp > XB_SPIN_CAP) { atomicAdd(&(bar)[XB_TMO], 1u); break; } } } } while (0)

struct XcdBarrier {
    unsigned* bar; unsigned x;
    volatile LAS unsigned* st;
};

__device__ __forceinline__ XcdBarrier xcd_barrier_post(unsigned* bar, volatile LAS unsigned* st) {
    XcdBarrier b; b.bar = bar; b.x = xb_xcc_id(); b.st = st;
    if (threadIdx.x == 0) (void)xb_add(&bar[XB_XCNT(b.x)], 1u);
    return b;
}
__device__ __forceinline__ void xcd_barrier_complete(unsigned* bar, unsigned x, unsigned& nloc, unsigned& nx) {
    const unsigned G = gridDim.x * gridDim.y * gridDim.z;
    unsigned sum, cnt, mine, sp = 0u;
    for (;;) {
        sum = 0u; cnt = 0u; mine = 0u;
#pragma unroll
        for (unsigned j = 0; j < 16; ++j) { const unsigned c = xb_ld(&bar[XB_XCNT(j)]); sum += c; cnt += (c > 0u) ? 1u : 0u; mine = (j == x) ? c : mine; }
        if (sum == G) break;
        __builtin_amdgcn_s_sleep(1);
        if ((++sp & 255u) == 0u) { if (xb_ld(&bar[XB_TMO])) break; if (sp > XB_SPIN_CAP) { atomicAdd(&bar[XB_TMO], 1u); break; } }
    }
    nloc = mine > 0u ? mine : 1u; nx = cnt > 0u ? cnt : 1u;
}

__device__ __forceinline__ void xcd_barrier(const XcdBarrier& b) {
    asm volatile("s_waitcnt vmcnt(0)" ::: "memory");
    __syncthreads();
    if (threadIdx.x == 0) {
        unsigned* bar = b.bar;
        __builtin_amdgcn_s_waitcnt(0);
        unsigned nloc = b.st[0], nx = b.st[1];
        if (nloc == 0u) { xcd_barrier_complete(bar, b.x, nloc, nx); b.st[0] = nloc; b.st[1] = nx; }
        const unsigned old = xb_add(&bar[XB_XSUB(b.x)], 1u);
        const unsigned gen = old / nloc;
        if (old + 1u == (gen + 1u) * nloc) {
            __builtin_amdgcn_fence(__ATOMIC_RELEASE, "agent");
            asm volatile("s_waitcnt vmcnt(0)" ::: "memory");
            const unsigned og = xb_add(&bar[XB_TOP], 1u);
            const unsigned tg = og / nx;
            if (og + 1u == (tg + 1u) * nx) xb_add(&bar[XB_TOPGEN], 1u);
            else XB_SPIN(xb_ld(&bar[XB_TOPGEN]) == tg, bar);
            __builtin_amdgcn_fence(__ATOMIC_ACQUIRE, "agent");
            xb_add(&bar[XB_XGEN(b.x)], 1u);
            asm volatile("s_waitcnt vmcnt(0)" ::: "memory");
        } else {
            XB_SPIN(xb_ld(&bar[XB_XGEN(b.x)]) == gen, bar);
            __builtin_amdgcn_fence(__ATOMIC_ACQUIRE, "agent");
            asm volatile("s_waitcnt vmcnt(0)" ::: "memory");
        }
    }
    __syncthreads();
}

typedef short s16x4 __attribute__((ext_vector_type(4)));
__device__ __forceinline__ bf16x8 tr_frag(const LAS bf16* T, int ld, int r0, int c0, int lane) {
    const int g = lane >> 4, q = (lane & 15) >> 2, p = lane & 3;
    const LAS bf16* a = T + (r0 + 8 * g + q) * ld + c0 + 4 * p;
    const s16x4 lo = __builtin_amdgcn_ds_read_tr16_b64_v4i16((LAS s16x4*)a);
    const s16x4 hi = __builtin_amdgcn_ds_read_tr16_b64_v4i16((LAS s16x4*)(a + 4 * ld));
    return (bf16x8){lo[0], lo[1], lo[2], lo[3], hi[0], hi[1], hi[2], hi[3]};
}
__device__ __forceinline__ float wave_incl_sum(float v, int lane) {
#pragma unroll
    for (int o = 1; o < 64; o <<= 1) { const float t = __shfl_up(v, o); v = (lane >= o) ? v + t : v; }
    return v;
}
__device__ __forceinline__ float wave_incl_max(float v, int lane) {
#pragma unroll
    for (int o = 1; o < 64; o <<= 1) { const float t = __shfl_up(v, o); v = (lane >= o) ? fmaxf(v, t) : v; }
    return v;
}
__device__ __forceinline__ float wave_max(float v) { return xrow_max(row16_max(v)); }
struct Frame {
    LAS unsigned char* lds;
    volatile LAS unsigned* MISC;
    gu32* ctl;
    int tid, lane, wave;
    int bid, G;
    const float* in[35];
    float* out;
    unsigned char* ws;
};
enum { I_X = 0, I_C, I_CTX, I_CCTX, I_ADAW, I_ADAB, I_N1G, I_N2G, I_OUTW, I_RTW, I_W1, I_W3, I_W2, I_FING, I_EVW, I_HCW, I_HCB, I_HPW1, I_HPB1, I_HFREQ, I_HPW2, I_HPB2, I_HPW3, I_HBIAS,
       I_GGW2, I_GGB, I_GNG, I_ODW, I_MCW, I_MCB, I_MIGB, I_MFGB, I_MNG, I_DLAM, I_DNG };

__device__ __forceinline__ float grp16_max(float v) { return row16_max(v); }
__device__ __forceinline__ float grp16_sum(float v) { return row16_sum(v); }
constexpr int CW_CVT = 64;
typedef unsigned u32x4_ __attribute__((ext_vector_type(4)));
struct CvtItem { const float* src; int ldn, c0, ncols, k0; bf16* dst; int d0, dstep, fp8; };
__device__ __forceinline__ CvtItem cvt_decode(Frame& F, int it) {
    CvtItem c; c.dstep = 128; c.ncols = 256; c.fp8 = 0;
    bf16* Win0 = (bf16*)(F.ws + WS_WIN0); bf16* Win1 = (bf16*)(F.ws + WS_WIN1); bf16* Wout = (bf16*)(F.ws + WS_WOUT); bf16* W13 = (bf16*)(F.ws + WS_W13); bf16* W2t = (bf16*)(F.ws + WS_W2);
    constexpr int N_IN0 = 16 * 25, N_IN1 = 16 * 29, N_OUT = 2 * 16 * 8;
    if (it < N_IN0) { const int kb = it / 25, cb = it % 25; c.src = F.in[I_EVW]; c.ldn = EV_IN; c.k0 = kb * 128; c.dst = Win0; c.c0 = cb * 256; c.d0 = cb * 256; if (cb == 24) c.ncols = 32; return c; }
    it -= N_IN0;
    if (it < N_IN1) { const int kb = it / 29, cb = it % 29; c.src = F.in[I_ODW]; c.ldn = OD_IN; c.k0 = kb * 128; c.dst = Win1;
        if (cb < 16) { c.c0 = cb * 256; c.d0 = cb * 256; } else if (cb < 28) { c.c0 = 4112 + (cb - 16) * 256; c.d0 = 4096 + (cb - 16) * 256; } else { c.c0 = 4096; c.d0 = 7168; c.ncols = 16; }
        return c; }
    it -= N_IN1;
    if (it < N_OUT) { const int l = it >> 7, q = it & 127, kb = q >> 3, cb = q & 7; c.src = F.in[I_OUTW] + (size_t)l * 2048 * 2048; c.ldn = 2048; c.k0 = kb * 128; c.dst = Wout + (size_t)l * 2048 * 2048; c.c0 = cb * 256; c.d0 = cb * 256; return c; }
    it -= N_OUT;
    { const int cb = it & 7; it >>= 3; const int kb = it & 15; it >>= 4; const int which = it % 3; it /= 3; const int e = it & 15, l = it >> 4;
      const size_t so = ((size_t)l * 16 + e) * 2048 * 2048; c.ldn = 2048; c.k0 = kb * 128; c.c0 = cb * 256; c.fp8 = 1;
      if (which == 0) { c.src = F.in[I_W1] + so; c.dst = W13 + ((size_t)l * 16 + e) * 4096 * 1024; c.d0 = cb * 512; c.dstep = 256; }
      else if (which == 1) { c.src = F.in[I_W3] + so; c.dst = W13 + ((size_t)l * 16 + e) * 4096 * 1024; c.d0 = cb * 512 + 128; c.dstep = 256; }
      else { c.src = F.in[I_W2] + so; c.dst = W2t + ((size_t)l * 16 + e) * 2048 * 1024; c.d0 = cb * 256; }
      return c; }
}
__device__ __forceinline__ void cvt_load(const CvtItem& c, int wave, int lane, f32x4 (&v)[16]) {
    const bool ok = 4 * lane < c.ncols;
#pragma unroll
    for (int i = 0; i < 16; ++i) v[i] = ok ? *(const GAS f32x4*)(c.src + (size_t)(c.k0 + 16 * wave + i) * c.ldn + c.c0 + 4 * lane) : (f32x4){0.f, 0.f, 0.f, 0.f};
}
constexpr int CVT_NPRE = 16 * 25 + 16 * 29 + 2 * 16 * 8, CVT_L0_END = CVT_NPRE + 6144, CVT_L1_END = CVT_NPRE + 12288;
constexpr int CVT_LATE0 = 64 * 10 + 192 * 14, CVT_LATE1 = 128 * 5 + 56 * 10;
constexpr int CVT_NEARLY = CVT_NPRE + 12288 - CVT_LATE0 - CVT_LATE1;
__device__ __forceinline__ int cvt_early_item(int j) {
    if (j < CVT_L0_END - CVT_LATE0) return j;
    return j + CVT_LATE0;
}
template <bool DYN> __device__ __forceinline__ void cvt_run(Frame& F, int first, int cnt) {
    constexpr int TLD = 264;
    LAS bf16* T = (LAS bf16*)(F.lds);
    LAS int* nxt = (LAS int*)(F.lds + 128 * TLD * 2);
    const int NIT = DYN ? CVT_NEARLY : cnt;
    __syncthreads();
    int jn = 0;
    if (DYN) { if (F.tid == 0) nxt[0] = (int)__hip_atomic_fetch_add((unsigned*)(F.ctl + CW_CVT), 1u, __ATOMIC_RELAXED, __HIP_MEMORY_SCOPE_AGENT);
        __syncthreads(); jn = nxt[0]; }
    int j = jn;
    f32x4 v[16];
    CvtItem cur = cvt_decode(F, j < NIT ? (DYN ? cvt_early_item(j) : first + j) : 0);
    if (j < NIT) cvt_load(cur, F.wave, F.lane, v);
    while (j < NIT) {
        __syncthreads();
        if (DYN) { if (F.tid == 0) nxt[0] = (int)__hip_atomic_fetch_add((unsigned*)(F.ctl + CW_CVT), 1u, __ATOMIC_RELAXED, __HIP_MEMORY_SCOPE_AGENT); }
        { const float wsc = cur.fp8 ? 64.f : 1.f;
#pragma unroll
        for (int i = 0; i < 16; ++i) { v2u w; w.x = pk2(v[i][0] * wsc, v[i][1] * wsc); w.y = pk2(v[i][2] * wsc, v[i][3] * wsc); *(LAS v2u*)(T + (16 * F.wave + i) * TLD + 4 * F.lane) = w; } }
        __syncthreads();
        const int jnext = DYN ? nxt[0] : j + 1;
        const CvtItem me = cur;
        if (jnext < NIT) { cur = cvt_decode(F, DYN ? cvt_early_item(jnext) : first + jnext); cvt_load(cur, F.wave, F.lane, v); }
        const int fr = F.lane & 15, fq = F.lane >> 4;
#pragma unroll
        for (int x = 0; x < 2; ++x) { const int jc = 32 * F.wave + 16 * x + fr; const int drow = me.d0 + (jc >> 7) * me.dstep + (jc & 127);
#pragma unroll
            for (int r = 0; r < 4; ++r) { const bf16x8 f = tr_frag(T, TLD, 32 * r, 32 * F.wave + 16 * x, F.lane);
                if (me.fp8) { const u32x4_ fw = __builtin_bit_cast(u32x4_, f); v2u o8; o8.x = pk4_fp8(bflo(fw.x), bfhi(fw.x), bflo(fw.y), bfhi(fw.y)); o8.y = pk4_fp8(bflo(fw.z), bfhi(fw.z), bflo(fw.w), bfhi(fw.w));
                    *(GAS v2u*)((unsigned char*)me.dst + (size_t)drow * 2048 + me.k0 + 32 * r + 8 * fq) = o8; }
                else if (jc < me.ncols) *(GAS bf16x8*)(me.dst + (size_t)drow * 2048 + me.k0 + 32 * r + 8 * fq) = f; } }
        j = jnext;
    }
    __syncthreads();
}
__device__ __forceinline__ void p0_convert(Frame& F) {
    { bf16* Win0 = (bf16*)(F.ws + WS_WIN0); bf16* Win1 = (bf16*)(F.ws + WS_WIN1);
      const int gt = F.bid * NTHR + F.tid, NT = F.G * NTHR; const v4u z = {0u, 0u, 0u, 0u};
      for (int i = gt; i < (LD0 - EV_IN) * 256; i += NT) *(GAS v4u*)(Win0 + (size_t)EV_IN * 2048 + (size_t)i * 8) = z;
      for (int i = gt; i < (LD1 - OD_IN) * 256; i += NT) *(GAS v4u*)(Win1 + (size_t)OD_IN * 2048 + (size_t)i * 8) = z; }
    if (F.G == 256) cvt_run<true>(F, 0, 0);
    else { cvt_run<true>(F, 0, 0); if (F.bid == 0) { cvt_run<false>(F, CVT_L0_END - CVT_LATE0, CVT_LATE0); cvt_run<false>(F, CVT_L1_END - CVT_LATE1, CVT_LATE1); } }
}
__device__ __forceinline__ void cvt_late(Frame& F, int first, int w0, int per) {
    if (F.G != 256 || F.bid < w0) return;
    cvt_run<false>(F, first + (F.bid - w0) * per, per);
}
__device__ __forceinline__ void p0_adaln(Frame& F) {
    if (F.bid >= 192) return;
    LAS float* s = (LAS float*)(F.lds);
    LAS float* red = (LAS float*)(F.lds + 9 * 2048 * 4);
    { float t_[36];
#pragma unroll
      for (int x = 0; x < 32; ++x) t_[x] = F.in[I_C][F.tid + NTHR * x];
#pragma unroll
      for (int x = 0; x < 4; ++x) t_[32 + x] = F.in[I_CCTX][F.tid + NTHR * x];
#pragma unroll
      for (int x = 0; x < 36; ++x) s[F.tid + NTHR * x] = siluf(t_[x]); }
    __syncthreads();
    float* MOD = (float*)(F.ws + WS_MOD);
    const int jq = F.tid & 31, kg = F.tid >> 5;
    for (int u = F.bid; u < 192; u += F.G) {
        const int l = u / 96, j0 = (u % 96) * 128;
        const float* W = F.in[I_ADAW] + (size_t)l * 2048 * 12288 + j0 + 4 * jq;
        f32x4 acc[9];
#pragma unroll
        for (int r = 0; r < 9; ++r) acc[r] = (f32x4){0.f, 0.f, 0.f, 0.f};
#pragma unroll 1
        for (int k0 = kg * 128; k0 < kg * 128 + 128; k0 += 8) {
            f32x4 w[8];
#pragma unroll
            for (int q = 0; q < 8; ++q) w[q] = *(const GAS f32x4*)(W + (size_t)(k0 + q) * 12288);
#pragma unroll
            for (int r = 0; r < 9; ++r) { const f32x4 s0 = *(const LAS f32x4*)(s + r * 2048 + k0), s1 = *(const LAS f32x4*)(s + r * 2048 + k0 + 4);
                acc[r] += w[0] * s0[0] + w[1] * s0[1] + w[2] * s0[2] + w[3] * s0[3] + w[4] * s1[0] + w[5] * s1[1] + w[6] * s1[2] + w[7] * s1[3]; }
        }
#pragma unroll
        for (int r = 0; r < 9; ++r)
#pragma unroll
            for (int c = 0; c < 4; ++c) acc[r][c] += __shfl_xor(acc[r][c], 32);
        if (F.lane < 32) {
#pragma unroll
            for (int r = 0; r < 9; ++r) *(LAS f32x4*)(red + (F.wave * 9 + r) * 128 + 4 * jq) = acc[r]; }
        __syncthreads();
        for (int i = F.tid; i < 9 * 128; i += NTHR) { const int r = i >> 7, j = i & 127; float t = F.in[I_ADAB][l * 12288 + j0 + j];
#pragma unroll
            for (int ww = 0; ww < 8; ++ww) t += red[(ww * 9 + r) * 128 + j];
            MOD[((size_t)l * 9 + r) * 12288 + j0 + j] = t; }
        __syncthreads();
    }
}
__device__ __forceinline__ void p0_filters(Frame& F) {
    LAS float* h1 = (LAS float*)(F.lds);
    LAS float* h2 = h1 + 512;
    LAS float* ft = h2 + 512;
    LAS float* w1s = ft + 8 * 36;
    LAS float* w2s = w1s + 33 * 64;
    __syncthreads();
    { float t1[5], t2[8];
#pragma unroll
      for (int x = 0; x < 5; ++x) { const int i = F.tid + NTHR * x; t1[x] = (i < 33 * 64) ? F.in[I_HPW1][i] : 0.f; }
#pragma unroll
      for (int x = 0; x < 8; ++x) t2[x] = F.in[I_HPW2][F.tid + NTHR * x];
#pragma unroll
      for (int x = 0; x < 5; ++x) { const int i = F.tid + NTHR * x; if (i < 33 * 64) w1s[i] = t1[x]; }
#pragma unroll
      for (int x = 0; x < 8; ++x) w2s[F.tid + NTHR * x] = t2[x]; }
    const float pb1 = F.in[I_HPB1][F.tid & 63], pb2 = F.in[I_HPB2][F.tid & 63], fq1 = F.in[I_HFREQ][F.tid & 63], fq2 = F.in[I_HFREQ][64 + (F.tid & 63)];
    for (int uu = F.bid; uu < 2304; uu += F.G) {
        const int jb = uu & 7, u = uu >> 3;
        const bool lat = u < 256; const int L = lat ? 2048 : 256; const int p0 = (lat ? u : u - 256) * 8;
        float* FT = (float*)(F.ws + (lat ? WS_FTL : WS_FTC));
        __syncthreads();
        if (F.tid < 8 * 33) { const int pp = F.tid / 33, i = F.tid % 33; const float pos = (float)(p0 + pp);
            float v;
            if (i == 0) v = pos / (float)(L - 1);
            else { const int bi = (i - 1) & 15; const float band = 1e-4f + (float)bi * ((15.f - 1e-4f) / 15.f); const float ang = (6.283185307179586f / (float)L) * pos * band; v = (i <= 16) ? cosf(ang) : -sinf(ang); }
            ft[pp * 36 + i] = v; }
        __syncthreads();
        { const int pp = F.tid >> 6, j = F.tid & 63; float a = pb1;
#pragma unroll 11
          for (int i = 0; i < 33; ++i) a += ft[pp * 36 + i] * w1s[i * 64 + j];
          h1[pp * 64 + j] = sinf(fq1 * a); }
        __syncthreads();
        { const int pp = F.tid >> 6, j = F.tid & 63; float a = pb2;
#pragma unroll 16
          for (int i = 0; i < 64; ++i) a += h1[pp * 64 + i] * w2s[i * 64 + j];
          h2[pp * 64 + j] = sinf(fq2 * a); }
        __syncthreads();
        { const int j = jb * 512 + F.tid;
            float acc[8];
#pragma unroll
            for (int pp = 0; pp < 8; ++pp) acc[pp] = 0.f;
#pragma unroll 16
            for (int i = 0; i < 64; ++i) { const float w = F.in[I_HPW3][(size_t)i * 4096 + j];
#pragma unroll
                for (int pp = 0; pp < 8; ++pp) acc[pp] += h2[pp * 64 + i] * w; }
            const int order = j >> 11, dir = (j >> 10) & 1, ch = j & 1023;
            const float da = -3.0701134573253945f, db = -15.350567286626973f;
            const float delta = fabsf(da + (float)ch * ((db - da) / 1023.f));
#pragma unroll
            for (int pp = 0; pp < 8; ++pp) { const int p = p0 + pp; const float t = (float)p / (float)(L - 1); const float val = acc[pp] * __expf(-t * delta);
                if (dir == 0) FT[((size_t)order * (2 * L - 1) + (L - 1 + p)) * 1024 + ch] = val;
                else if (p >= 1) FT[((size_t)order * (2 * L - 1) + (L - 1 - p)) * 1024 + ch] = val; }
        }
    }
    __syncthreads();
}

__device__ __forceinline__ void load_row(const float* p, int lane, f32x4 (&v)[8]) {
#pragma unroll
    for (int i = 0; i < 8; ++i) v[i] = *(const GAS f32x4*)(p + 4 * (lane + 64 * i));
}
__device__ __forceinline__ float row_rstd(const f32x4 (&v)[8]) {
    float s = 0.f;
#pragma unroll
    for (int i = 0; i < 8; ++i) s += (v[i][0] * v[i][0] + v[i][1] * v[i][1]) + (v[i][2] * v[i][2] + v[i][3] * v[i][3]);
    return 1.f / sqrtf(wave_sum(s) * (1.f / 2048.f) + EPS);
}
__device__ __forceinline__ void modulate_store(f32x4 (&v)[8], float rstd, const float* g, const float* shift, const float* scale, bf16* orow, int lane) {
#pragma unroll
    for (int i = 0; i < 8; ++i) { const int c = 4 * (lane + 64 * i);
        const f32x4 gg = *(const GAS f32x4*)(g + c), sh = *(const GAS f32x4*)(shift + c), sc = *(const GAS f32x4*)(scale + c);
        v[i] = (v[i] * rstd * gg) * (sc + 1.f) + sh;
        v2u w; w.x = pk2(v[i][0], v[i][1]); w.y = pk2(v[i][2], v[i][3]);
        *(GAS v2u*)(orow + c) = w; }
}
__device__ __forceinline__ void modulate_store8(f32x4 (&v)[8], float rstd, const float* g, const float* shift, const float* scale, unsigned char* orow, int lane) {
#pragma unroll
    for (int i = 0; i < 8; ++i) { const int c = 4 * (lane + 64 * i);
        const f32x4 gg = *(const GAS f32x4*)(g + c), sh = *(const GAS f32x4*)(shift + c), sc = *(const GAS f32x4*)(scale + c);
        v[i] = (v[i] * rstd * gg) * (sc + 1.f) + sh;
        *(GAS unsigned*)(orow + c) = pk4_fp8(v[i][0], v[i][1], v[i][2], v[i][3]); }
}
__device__ __forceinline__ const float* xrow_ptr(Frame& F, int r) { return (r < M_LAT) ? F.in[I_X] + (size_t)r * D : F.in[I_CTX] + (size_t)(r - M_LAT) * D; }
__device__ __forceinline__ int row_b(int r) { return (r < M_LAT) ? (r >> 11) : 8; }

__device__ __forceinline__ void mod_params(const float* g, const float* shift, const float* scale, int lane, f32x4 (&gs)[8], f32x4 (&sh)[8]) {
#pragma unroll
    for (int i = 0; i < 8; ++i) { const int c = 4 * (lane + 64 * i); gs[i] = *(const GAS f32x4*)(g + c) * (*(const GAS f32x4*)(scale + c) + 1.f); sh[i] = *(const GAS f32x4*)(shift + c); }
}
__device__ __forceinline__ void ph_norm1_l0(Frame& F) {
    const int gw = F.bid * NWAVES + F.wave, NGW = F.G * NWAVES;
    const float* MOD = (const float*)(F.ws + WS_MOD); bf16* A = (bf16*)(F.ws + WS_A);
    const int per = (M_ALL + NGW - 1) / NGW, r0 = gw * per, r1 = (r0 + per < M_ALL) ? r0 + per : M_ALL;
    f32x4 v[8], gs[8], sh[8]; int curb = -1;
    if (r0 < r1) load_row(xrow_ptr(F, r0), F.lane, v);
    for (int r = r0; r < r1; ++r) { f32x4 nv[8]; if (r + 1 < r1) load_row(xrow_ptr(F, r + 1), F.lane, nv);
        const int bb = row_b(r); if (bb != curb) { const float* m = MOD + (size_t)bb * 12288; mod_params(F.in[I_N1G], m, m + 2048, F.lane, gs, sh); curb = bb; }
        const float rs = row_rstd(v);
        bf16* orow = A + (size_t)r * D;
#pragma unroll
        for (int i = 0; i < 8; ++i) { const f32x4 o = (v[i] * rs) * gs[i] + sh[i]; v2u w; w.x = pk2(o[0], o[1]); w.y = pk2(o[2], o[3]); *(GAS v2u*)(orow + 4 * (F.lane + 64 * i)) = w; }
#pragma unroll
        for (int i = 0; i < 8; ++i) v[i] = nv[i]; }
}
__device__ __forceinline__ void ph_codes_skinny(Frame& F) {
    constexpr int WLD = 2056;
    LAS bf16* W = (LAS bf16*)(F.lds);
    const bf16* A = (const bf16*)(F.ws + WS_A); const bf16* Wc = (const bf16*)(F.ws + WS_WIN0) + (size_t)6144 * 2048; bf16* P = (bf16*)(F.ws + WS_P);
    __syncthreads();
    { v4u t_[16];
#pragma unroll
      for (int x = 0; x < 16; ++x) { const int i = F.tid + NTHR * x; t_[x] = *(const GAS v4u*)(Wc + (size_t)(i >> 8) * 2048 + (i & 255) * 8); }
#pragma unroll
      for (int x = 0; x < 16; ++x) { const int i = F.tid + NTHR * x; *(LAS v4u*)(W + (i >> 8) * WLD + (i & 255) * 8) = t_[x]; } }
    __syncthreads();
    const int gw = F.bid * NWAVES + F.wave, NGW = F.G * NWAVES; const int fr = F.lane & 15, fq = F.lane >> 4;
    for (int task = gw; task < M_ALL / 16; task += NGW) { const int r0 = task * 16;
        f32x4 acc[2] = {(f32x4){0.f, 0.f, 0.f, 0.f}, (f32x4){0.f, 0.f, 0.f, 0.f}};
        const bf16* ap = A + (size_t)(r0 + fr) * 2048 + 8 * fq;
#pragma unroll 16
        for (int ks = 0; ks < 64; ++ks) { const bf16x8 af = *(const GAS bf16x8*)(ap + 32 * ks);
#pragma unroll
            for (int nt = 0; nt < 2; ++nt) { const bf16x8 bf = *(const LAS bf16x8*)(W + (16 * nt + fr) * WLD + 32 * ks + 8 * fq); acc[nt] = __builtin_amdgcn_mfma_f32_16x16x32_bf16(af, bf, acc[nt], 0, 0, 0); } }
#pragma unroll
        for (int nt = 0; nt < 2; ++nt)
#pragma unroll
            for (int j = 0; j < 4; ++j) P[(size_t)(r0 + 4 * fq + j) * LD0 + C0_CODE + 16 * nt + fr] = (bf16)f2bf(acc[nt][j]);
    }
    __syncthreads();
}
__device__ __forceinline__ void ph_norm2_router(Frame& F, int l, int nrows) {
    LAS float* rwT = (LAS float*)(F.lds);
    __syncthreads();
    for (int i = F.tid; i < 2048 * 16; i += NTHR) { const int j = i >> 4, e = i & 15; rwT[e * 2048 + j] = F.in[I_RTW][(size_t)l * 2048 * 16 + i]; }
    __syncthreads();
    const int gw = F.bid * NWAVES + F.wave, NGW = F.G * NWAVES;
    const float* MOD = (const float*)(F.ws + WS_MOD) + (size_t)l * 9 * 12288; const float* H = (const float*)(F.ws + WS_H);
    bf16* A = (bf16*)(F.ws + WS_A); float* AFF = (float*)(F.ws + WS_AFF); int* SEL = (int*)(F.ws + WS_SEL);
    const int per = (nrows + NGW - 1) / NGW, r0 = gw * per, r1 = (r0 + per < nrows) ? r0 + per : nrows;
    f32x4 v[8], gs[8], sh[8]; int curb = -1;
    if (r0 < r1) load_row(H + (size_t)r0 * D, F.lane, v);
    for (int r = r0; r < r1; ++r) { f32x4 nv[8]; if (r + 1 < r1) load_row(H + (size_t)(r + 1) * D, F.lane, nv);
        const int bb = row_b(r); if (bb != curb) { const float* m = MOD + (size_t)bb * 12288; mod_params(F.in[I_N2G] + l * 2048, m + 3 * 2048, m + 4 * 2048, F.lane, gs, sh); curb = bb; }
        const float rs = row_rstd(v);
        { unsigned char* orow = (unsigned char*)A + (size_t)r * D;
#pragma unroll
          for (int i = 0; i < 8; ++i) { v[i] = (v[i] * rs) * gs[i] + sh[i]; *(GAS unsigned*)(orow + 4 * (F.lane + 64 * i)) = pk4_fp8(v[i][0], v[i][1], v[i][2], v[i][3]); } }
        float pa[16];
#pragma unroll
        for (int e = 0; e < 16; ++e) { const LAS float* wp = rwT + e * 2048 + 4 * F.lane; f32x4 a4 = {0.f, 0.f, 0.f, 0.f};
#pragma unroll
            for (int i = 0; i < 8; ++i) { const f32x4 w = *(const LAS f32x4*)(wp + 256 * i); a4 += v[i] * w; }
            pa[e] = (a4[0] + a4[1]) + (a4[2] + a4[3]); }
        float s1[8], s2[4];
#pragma unroll
        for (int e = 0; e < 8; ++e) { float x = pa[e], y = pa[e + 8]; asm volatile("s_nop 1\n\tv_permlane32_swap_b32 %0, %1" : "+v"(x), "+v"(y)); s1[e] = x + y; }
#pragma unroll
        for (int e = 0; e < 4; ++e) { float x = s1[e], y = s1[e + 4]; asm volatile("s_nop 1\n\tv_permlane16_swap_b32 %0, %1" : "+v"(x), "+v"(y)); s2[e] = row16_sum(x + y); }
        { float mx = fmaxf(fmaxf(s2[0], s2[1]), fmaxf(s2[2], s2[3])); mx = xrow_max(mx);
          float ex[4], se = 0.f;
#pragma unroll
          for (int e = 0; e < 4; ++e) { ex[e] = expf(s2[e] - mx); se += ex[e]; }
          se = xrow_sum(se); const float inv = 1.f / se;
          if ((F.lane & 15) == 0) { const int R = F.lane >> 4; const int eb = 4 * (R & 1) + 8 * (R >> 1);
#pragma unroll
              for (int e = 0; e < 4; ++e) AFF[(size_t)(eb + e) * M_ALL + r] = ex[e] * inv; }
          if (F.lane < 16) SEL[(size_t)r * 16 + F.lane] = -1; }
#pragma unroll
        for (int i = 0; i < 8; ++i) v[i] = nv[i];
    }
    __syncthreads();
}
__device__ __forceinline__ void ph_norm2_router2(Frame& F, int l, int nrows) {
    constexpr int WLD = 2064;
    LAS bf16* Wh = (LAS bf16*)(F.lds); LAS bf16* Wl = Wh + 16 * WLD;
    LAS float* red = (LAS float*)(F.lds + 4 * 16 * WLD);
    LAS float* ssq = red + 8 * 256;
    LAS float* cb = ssq + 128;
    const float* MOD = (const float*)(F.ws + WS_MOD) + (size_t)l * 9 * 12288; const float* H = (const float*)(F.ws + WS_H);
    unsigned char* A8 = (unsigned char*)(F.ws + WS_A); float* AFF = (float*)(F.ws + WS_AFF); int* SEL = (int*)(F.ws + WS_SEL);
    float* GSB = (float*)(F.ws + WS_XT) + (size_t)F.bid * 4 * 4096;
    const int fr = F.lane & 15, fq = F.lane >> 4;
    const int ntile = nrows >> 4; const int t0 = (int)(((long)F.bid * ntile) / F.G), t1 = (int)(((long)(F.bid + 1) * ntile) / F.G);
    const int colw = 256 * F.wave + 8 * fq;
    int curb = -1, nreb = 0; const float* gsb = GSB;
    f32x4 x[8][2];
#define RT_LOAD(dst, tile) do { const float* p_ = H + (size_t)((tile) * 16 + fr) * D + colw; _Pragma("unroll") for (int ks = 0; ks < 8; ++ks) { dst[ks][0] = *(const GAS f32x4*)(p_ + 32 * ks); dst[ks][1] = *(const GAS f32x4*)(p_ + 32 * ks + 4); } } while (0)
    if (t0 < t1) RT_LOAD(x, t0);
    for (int t = t0; t < t1; ++t) {
        const int rbase = t * 16; const int bb = row_b(rbase);
        if (bb != curb) {
            const float* m = MOD + (size_t)bb * 12288; const float* g = F.in[I_N2G] + l * 2048; const float* shp = m + 3 * 2048; const float* scp = m + 4 * 2048;
            float* gw_ = GSB + (size_t)(nreb & 3) * 4096;
            __syncthreads();
#pragma unroll
            for (int x = 0; x < 4; ++x) { const int k = F.tid + NTHR * x; gw_[k] = g[k] * (scp[k] + 1.f); gw_[2048 + k] = shp[k]; }
            const float* rw = F.in[I_RTW] + (size_t)l * 2048 * 16; const int e0 = 4 * (F.tid & 3); f32x4 cacc = {0.f, 0.f, 0.f, 0.f};
#pragma unroll 1
            for (int it = 0; it < 16; it += 4) { f32x4 wv[4]; float gk[4], sk[4], hk[4];
#pragma unroll
                for (int u = 0; u < 4; ++u) { const int i4 = F.tid + NTHR * (it + u); const int k = i4 >> 2; wv[u] = *(const GAS f32x4*)(rw + 4 * (size_t)i4); gk[u] = g[k]; sk[u] = scp[k]; hk[u] = shp[k]; }
#pragma unroll
                for (int u = 0; u < 4; ++u) { const int k = (F.tid + NTHR * (it + u)) >> 2; const float gsk = gk[u] * (sk[u] + 1.f);
#pragma unroll
                    for (int c = 0; c < 4; ++c) { const float val = wv[u][c] * gsk; const unsigned short hi = (unsigned short)f2bf(val); const unsigned short lo = (unsigned short)f2bf(val - bf2f(hi));
                        Wh[(e0 + c) * WLD + k] = (bf16)hi; Wl[(e0 + c) * WLD + k] = (bf16)lo; }
                    cacc += wv[u] * hk[u]; } }
#pragma unroll
            for (int c = 0; c < 4; ++c) { float v_ = cacc[c]; v_ += dppmov<0x124>(v_); v_ += dppmov<0x128>(v_); cacc[c] = xrow_sum(v_); }
            if (F.lane < 4) {
#pragma unroll
                for (int c = 0; c < 4; ++c) red[F.wave * 16 + 4 * F.lane + c] = cacc[c]; }
            __syncthreads();
            if (F.tid < 16) { float c_ = 0.f;
#pragma unroll
                for (int ww = 0; ww < 8; ++ww) c_ += red[ww * 16 + F.tid];
                cb[F.tid] = c_; }
            __syncthreads();
            curb = bb; gsb = gw_; ++nreb; }
        f32x4 nx[8][2];
        if (t + 1 < t1) RT_LOAD(nx, t + 1);
        float ss = 0.f; f32x4 acc = {0.f, 0.f, 0.f, 0.f};
#pragma unroll
        for (int ks = 0; ks < 8; ++ks) { const f32x4 a = x[ks][0], b = x[ks][1];
            ss += (a[0] * a[0] + a[1] * a[1]) + (a[2] * a[2] + a[3] * a[3]) + (b[0] * b[0] + b[1] * b[1]) + (b[2] * b[2] + b[3] * b[3]);
            v4u h, lo_; h.x = pk2(a[0], a[1]); h.y = pk2(a[2], a[3]); h.z = pk2(b[0], b[1]); h.w = pk2(b[2], b[3]);
            lo_.x = pk2(a[0] - bflo(h.x), a[1] - bfhi(h.x)); lo_.y = pk2(a[2] - bflo(h.y), a[3] - bfhi(h.y)); lo_.z = pk2(b[0] - bflo(h.z), b[1] - bfhi(h.z)); lo_.w = pk2(b[2] - bflo(h.w), b[3] - bfhi(h.w));
            const bf16x8 ah = __builtin_bit_cast(bf16x8, h), al = __builtin_bit_cast(bf16x8, lo_);
            const bf16x8 bh = *(const LAS bf16x8*)(Wh + fr * WLD + colw + 32 * ks), bl = *(const LAS bf16x8*)(Wl + fr * WLD + colw + 32 * ks);
            acc = __builtin_amdgcn_mfma_f32_16x16x32_bf16(ah, bh, acc, 0, 0, 0); acc = __builtin_amdgcn_mfma_f32_16x16x32_bf16(al, bh, acc, 0, 0, 0); acc = __builtin_amdgcn_mfma_f32_16x16x32_bf16(ah, bl, acc, 0, 0, 0); }
        ss = xrow_sum(ss);
        if (fq == 0) ssq[F.wave * 16 + fr] = ss;
#pragma unroll
        for (int j = 0; j < 4; ++j) red[(F.wave * 16 + 4 * fq + j) * 16 + fr] = acc[j];
        __syncthreads();
        { float tot = 0.f;
#pragma unroll
          for (int ww = 0; ww < 8; ++ww) tot += ssq[ww * 16 + fr];
          const float rs = 1.f / sqrtf(tot * (1.f / 2048.f) + EPS);
          unsigned char* orow = A8 + (size_t)(rbase + fr) * D + colw;
#pragma unroll
          for (int ks = 0; ks < 8; ++ks) { const f32x4 g0 = *(const GAS f32x4*)(gsb + colw + 32 * ks), g1 = *(const GAS f32x4*)(gsb + colw + 32 * ks + 4), s0 = *(const GAS f32x4*)(gsb + 2048 + colw + 32 * ks), s1 = *(const GAS f32x4*)(gsb + 2048 + colw + 32 * ks + 4);
              const f32x4 o0 = (x[ks][0] * rs) * g0 + s0, o1 = (x[ks][1] * rs) * g1 + s1;
              v2u w8; w8.x = pk4_fp8(o0[0], o0[1], o0[2], o0[3]); w8.y = pk4_fp8(o1[0], o1[1], o1[2], o1[3]);
              *(GAS v2u*)(orow + 32 * ks) = w8; } }
        if (F.lane < 32) {
            const int row = 2 * F.wave + (F.lane >> 4), e = F.lane & 15; float lg = 0.f, tot = 0.f;
#pragma unroll
            for (int ww = 0; ww < 8; ++ww) { lg += red[(ww * 16 + row) * 16 + e]; tot += ssq[ww * 16 + row]; }
            lg = lg * (1.f / sqrtf(tot * (1.f / 2048.f) + EPS)) + cb[e];
            const float mx = row16_max(lg); const float ex = expf(lg - mx); const float se = row16_sum(ex);
            AFF[(size_t)e * M_ALL + rbase + row] = ex / se; SEL[(size_t)(rbase + row) * 16 + e] = -1; }
        __syncthreads();
#pragma unroll
        for (int ks = 0; ks < 8; ++ks) { x[ks][0] = nx[ks][0]; x[ks][1] = nx[ks][1]; }
    }
#undef RT_LOAD
    __syncthreads();
}
__device__ __forceinline__ void ph_topk(Frame& F, int nprob, int Me) {
    typedef unsigned long long u64; typedef u64 u64x2 __attribute__((ext_vector_type(2)));
    LAS u64* keys = (LAS u64*)(F.lds);
    const float* AFF = (const float*)(F.ws + WS_AFF); int* SEL = (int*)(F.ws + WS_SEL); float* GW = (float*)(F.ws + WS_GW);
    int* TOK = (int*)(F.ws + WS_TOK);
    const int nunits = 512 + (nprob - 128);
    for (int u = F.bid; u < nunits; u += F.G) {
        const bool lat = u < 512; const int q = lat ? (u >> 2) : (u - 512); const int part = lat ? (u & 3) : 0; const int b = q >> 4, e = q & 15;
        const int T = lat ? 2048 : 256, cap = lat ? 256 : 32, r0 = lat ? b * 2048 : M_LAT + b * 256;
        __syncthreads();
        for (int i = F.tid; i < T; i += NTHR) keys[i] = ((u64)__builtin_bit_cast(unsigned, AFF[(size_t)e * M_ALL + r0 + i]) << 32) | (u64)(0xFFFFFFFFu - (unsigned)i);
        __syncthreads();
        const int i = part * 512 + F.tid;
        if (i < T) { const u64 ki = keys[i]; int rank = 0;
#pragma unroll 8
            for (int j = 0; j < T; j += 2) { const u64x2 kj = *(const LAS u64x2*)(keys + j); rank += (kj.x > ki) ? 1 : 0; rank += (kj.y > ki) ? 1 : 0; }
            if (rank < cap) { const int slot = e * Me + (lat ? b * 256 + rank : 2048 + b * 32 + rank);
                GW[slot] = __builtin_bit_cast(float, (unsigned)(ki >> 32)); SEL[(size_t)(r0 + i) * 16 + e] = slot; TOK[slot] = r0 + i; } }
    }
    __syncthreads();
}
__device__ __forceinline__ void ph_topk2(Frame& F, int nprob, int Me) {
    LAS unsigned* hist = (LAS unsigned*)(F.lds);
    LAS unsigned* ctl = hist + 256;
    LAS unsigned* wcnt = ctl + 8;
    LAS unsigned* tlist = wcnt + 32;
    const float* AFF = (const float*)(F.ws + WS_AFF); int* SEL = (int*)(F.ws + WS_SEL); float* GW = (float*)(F.ws + WS_GW); int* TOK = (int*)(F.ws + WS_TOK);
    for (int u = F.bid; u < nprob; u += F.G) {
        const bool lat = u < 128; const int q = lat ? u : u - 128; const int b = q >> 4, e = q & 15;
        const int T = lat ? 2048 : 256, cap = lat ? 256 : 32, r0 = lat ? b * 2048 : M_LAT + b * 256;
        unsigned v[4]; bool ok[4];
#pragma unroll
        for (int x = 0; x < 4; ++x) { const int i = F.tid + NTHR * x; ok[x] = i < T; v[x] = ok[x] ? __builtin_bit_cast(unsigned, AFF[(size_t)e * M_ALL + r0 + i]) : 0u; }
        unsigned prefix = 0u, want = (unsigned)cap;
#pragma unroll 1
        for (int p = 0; p < 4; ++p) { const int shift = 24 - 8 * p;
            __syncthreads();
            if (F.tid < 256) hist[F.tid] = 0u;
            __syncthreads();
#pragma unroll
            for (int x = 0; x < 4; ++x) if (ok[x] && (p == 0 || (v[x] >> (shift + 8)) == prefix)) __hip_atomic_fetch_add(hist + ((v[x] >> shift) & 255u), 1u, __ATOMIC_RELAXED, __HIP_MEMORY_SCOPE_WORKGROUP);
            __syncthreads();
            if (F.wave == 0) {
                const int top = 255 - 4 * F.lane; unsigned c[4];
#pragma unroll
                for (int j = 0; j < 4; ++j) c[j] = hist[top - j];
                const unsigned sgrp = (c[0] + c[1]) + (c[2] + c[3]); unsigned inc = sgrp;
#pragma unroll
                for (int d = 1; d < 64; d <<= 1) { const unsigned t_ = __shfl_up(inc, d); if (F.lane >= d) inc += t_; }
                const unsigned exc = inc - sgrp;
                if (exc < want && want <= inc) { unsigned acc = exc; int dsel = top; unsigned above = exc, cnt = c[0]; bool found = false;
#pragma unroll
                    for (int j = 0; j < 4; ++j) { if (!found) { if (acc + c[j] >= want) { dsel = top - j; above = acc; cnt = c[j]; found = true; } else acc += c[j]; } }
                    ctl[0] = (unsigned)dsel; ctl[1] = want - above; ctl[2] = cnt; } }
            __syncthreads();
            prefix = (prefix << 8) | ctl[0]; want = ctl[1]; }
        const unsigned vstar = prefix, neq = ctl[2];
        bool sel[4];
#pragma unroll
        for (int x = 0; x < 4; ++x) sel[x] = ok[x] && (v[x] >= vstar);
        if (neq != want) {
            __syncthreads();
            if (F.tid == 0) ctl[3] = 0u;
            __syncthreads();
#pragma unroll
            for (int x = 0; x < 4; ++x) if (ok[x] && v[x] == vstar) { const unsigned p_ = __hip_atomic_fetch_add(ctl + 3, 1u, __ATOMIC_RELAXED, __HIP_MEMORY_SCOPE_WORKGROUP); tlist[p_] = (unsigned)(F.tid + NTHR * x); }
            __syncthreads();
#pragma unroll
            for (int x = 0; x < 4; ++x) if (ok[x] && v[x] == vstar) { const unsigned me = (unsigned)(F.tid + NTHR * x); unsigned lower = 0u; for (unsigned j = 0; j < neq; ++j) lower += (tlist[j] < me) ? 1u : 0u; sel[x] = lower < want; } }
        unsigned lpre[4];
#pragma unroll
        for (int x = 0; x < 4; ++x) { const unsigned long long bal = __ballot(sel[x]); lpre[x] = (unsigned)__popcll(bal & ((1ull << F.lane) - 1ull)); if (F.lane == 0) wcnt[x * 8 + F.wave] = (unsigned)__popcll(bal); }
        __syncthreads();
        if (F.tid < 32) { unsigned o_ = 0u; for (int k = 0; k < F.tid; ++k) o_ += wcnt[k]; tlist[F.tid] = o_; }
        __syncthreads();
#pragma unroll
        for (int x = 0; x < 4; ++x) if (sel[x]) { const int pos = (int)(tlist[x * 8 + F.wave] + lpre[x]); const int i = F.tid + NTHR * x;
            const int slot = e * Me + (lat ? b * 256 + pos : 2048 + b * 32 + pos);
            GW[slot] = __builtin_bit_cast(float, v[x]); SEL[(size_t)(r0 + i) * 16 + e] = slot; TOK[slot] = r0 + i; }
    }
    __syncthreads();
}
__device__ __forceinline__ void ph_gather(Frame& F, int nslots) {
    const int gw = F.bid * NWAVES + F.wave, NGW = F.G * NWAVES;
    const unsigned char* A = (const unsigned char*)(F.ws + WS_A); unsigned char* XS = (unsigned char*)(F.ws + WS_XS); const int* TOK = (const int*)(F.ws + WS_TOK);
    for (int s = gw; s < nslots; s += NGW) { const int r = TOK[s];
        const GAS v4u* src = (const GAS v4u*)(A + (size_t)r * D); GAS v4u* dst = (GAS v4u*)(XS + (size_t)s * D);
#pragma unroll
        for (int i = 0; i < 2; ++i) dst[F.lane + 64 * i] = src[F.lane + 64 * i]; }
}
template <int MODE> __device__ __forceinline__ void ph_combine(Frame& F, int l, int nrows) {
    const int gw = F.bid * NWAVES + F.wave, NGW = F.G * NWAVES;
    const float* MODl = (const float*)(F.ws + WS_MOD) + (size_t)l * 9 * 12288; const float* MODn = (const float*)(F.ws + WS_MOD) + (size_t)1 * 9 * 12288;
    float* H = (float*)(F.ws + WS_H); const bf16* YS = (const bf16*)(F.ws + WS_YS); const int* SEL = (const int*)(F.ws + WS_SEL); const float* GW = (const float*)(F.ws + WS_GW);
    bf16* A = (bf16*)(F.ws + WS_A);
    f32x4 v[8]; int sel = -1;
    if (gw < nrows) { load_row(H + (size_t)gw * D, F.lane, v); sel = SEL[(size_t)gw * 16 + (F.lane & 15)]; }
    for (int r = gw; r < nrows; r += NGW) { f32x4 nv[8]; int nsel = -1; const int rn = r + NGW;
        if (rn < nrows) { load_row(H + (size_t)rn * D, F.lane, nv); nsel = SEL[(size_t)rn * 16 + (F.lane & 15)]; }
        f32x4 acc[8];
#pragma unroll
        for (int i = 0; i < 8; ++i) acc[i] = (f32x4){0.f, 0.f, 0.f, 0.f};
        const float gsel = (sel >= 0) ? GW[sel] : 0.f;
        unsigned long long mask = __ballot(sel >= 0) & 0xffffull;
        while (mask) { const int e = __builtin_ctzll(mask); mask &= mask - 1;
            const int s = __shfl(sel, e); const float g = __shfl(gsel, e); const bf16* yr = YS + (size_t)s * D;
#pragma unroll
            for (int i = 0; i < 8; ++i) { const v2u w = *(const GAS v2u*)(yr + 4 * (F.lane + 64 * i));
                acc[i][0] += g * bflo(w.x); acc[i][1] += g * bfhi(w.x); acc[i][2] += g * bflo(w.y); acc[i][3] += g * bfhi(w.y); } }
        const float* m5 = MODl + (size_t)row_b(r) * 12288 + 5 * 2048;
#pragma unroll
        for (int i = 0; i < 8; ++i) { const f32x4 g5 = *(const GAS f32x4*)(m5 + 4 * (F.lane + 64 * i)); v[i] = v[i] + g5 * acc[i]; }
        const float rs = row_rstd(v);
        if (MODE == 0) {
#pragma unroll
            for (int i = 0; i < 8; ++i) *(GAS f32x4*)(H + (size_t)r * D + 4 * (F.lane + 64 * i)) = v[i];
            const float* m = MODn + (size_t)row_b(r) * 12288;
            modulate_store(v, rs, F.in[I_N1G] + 2048, m, m + 2048, A + (size_t)r * D, F.lane);
        } else {
#pragma unroll
            for (int i = 0; i < 8; ++i) { const int c = 4 * (F.lane + 64 * i); const f32x4 gg = *(const GAS f32x4*)(F.in[I_FING] + c);
                *(GAS f32x4*)(F.out + (size_t)r * D + c) = v[i] * rs * gg; }
        }
#pragma unroll
        for (int i = 0; i < 8; ++i) v[i] = nv[i];
        sel = nsel;
    }
}
__device__ __forceinline__ void ph_hy_shortconv(Frame& F) {
    const int gw = F.bid * NWAVES + F.wave, NGW = F.G * NWAVES;
    const bf16* P = (const bf16*)(F.ws + WS_P); bf16* XV = (bf16*)(F.ws + WS_XV);
    const float* cw = F.in[I_HCW]; const float* cb = F.in[I_HCB];
    for (int r = M_LAT + gw; r < M_ALL; r += NGW) {
        const int t = (r < M_LAT) ? (r & 2047) : ((r - M_LAT) & 255); const int L = (r < M_LAT) ? 2048 : 256;
        const bool hp = t > 0, hn = t < L - 1;
        v4u a[6], b[6], d[6]; const v4u z = {0u, 0u, 0u, 0u};
#pragma unroll
        for (int i = 0; i < 6; ++i) { const int c = 8 * (F.lane + 64 * i);
            a[i] = hp ? *(const GAS v4u*)(P + (size_t)(r - 1) * LD0 + c) : z; b[i] = *(const GAS v4u*)(P + (size_t)r * LD0 + c); d[i] = hn ? *(const GAS v4u*)(P + (size_t)(r + 1) * LD0 + c) : z; }
#pragma unroll
        for (int i = 0; i < 6; ++i) { const int c = 8 * (F.lane + 64 * i);
            float o[8];
#pragma unroll
            for (int hh = 0; hh < 2; ++hh) { const int cc = c + 4 * hh;
                const f32x4 bs = *(const GAS f32x4*)(cb + cc), t0 = *(const GAS f32x4*)(cw + cc), t1 = *(const GAS f32x4*)(cw + 3072 + cc), t2 = *(const GAS f32x4*)(cw + 6144 + cc);
#pragma unroll
                for (int q2 = 0; q2 < 2; ++q2) { const int q = 2 * hh + q2, e0 = 2 * q2;
                    o[2 * q] = bs[e0] + t0[e0] * bflo(a[i][q]) + t1[e0] * bflo(b[i][q]) + t2[e0] * bflo(d[i][q]);
                    o[2 * q + 1] = bs[e0 + 1] + t0[e0 + 1] * bfhi(a[i][q]) + t1[e0 + 1] * bfhi(b[i][q]) + t2[e0 + 1] * bfhi(d[i][q]); } }
            v4u w; w.x = pk2(o[0], o[1]); w.y = pk2(o[2], o[3]); w.z = pk2(o[4], o[5]); w.w = pk2(o[6], o[7]);
            *(GAS v4u*)(XV + (size_t)r * 3072 + c) = w; }
    }
}
__device__ __forceinline__ void ph_hy_longconv(Frame& F, int order) {
    const bf16* XV = (const bf16*)(F.ws + WS_XV); bf16* Z = (bf16*)(F.ws + WS_Z); bf16* Y = (bf16*)(F.ws + WS_Y);
    const bf16* U = (order == 0) ? XV + C0_V : Z; const int ldu = (order == 0) ? 3072 : 1024;
    const bf16* Gt = XV + ((order == 0) ? C0_X1 : C0_X2);
    bf16* O = (order == 0) ? Z : Y; const int ldo = (order == 0) ? 1024 : 2048;
    const float* skip = F.in[I_HBIAS] + order * 1024;
    for (int u = 2048 + F.bid; u < 2304; u += F.G) {
        const bool lat = u < 2048; const int q = lat ? u : u - 2048;
        int b, cbk, tb, L, r0;
        if (lat) { tb = q & 127; cbk = (q >> 7) & 1; b = q >> 8; L = 2048; r0 = b * 2048; } else { tb = q & 15; cbk = (q >> 4) & 1; b = q >> 5; L = 256; r0 = M_LAT + b * 256; }
        const float* FT = (const float*)(F.ws + (lat ? WS_FTL : WS_FTC)) + (size_t)order * (2 * L - 1) * 1024;
        const int c = cbk * 512 + F.tid, t0 = tb * 16;
        float acc[16];
#pragma unroll
        for (int a = 0; a < 16; ++a) acc[a] = 0.f;
        for (int s0 = 0; s0 < L; s0 += 16) {
            float uu[16], ff[31];
#pragma unroll
            for (int i = 0; i < 16; ++i) uu[i] = bf2f(U[(size_t)(r0 + s0 + i) * ldu + c]);
            const int base = t0 - s0 + L - 1 - 15;
#pragma unroll
            for (int j = 0; j < 31; ++j) ff[j] = FT[(size_t)(base + j) * 1024 + c];
#pragma unroll
            for (int a = 0; a < 16; ++a)
#pragma unroll
                for (int i = 0; i < 16; ++i) acc[a] += ff[a - i + 15] * uu[i];
        }
        const float sk = skip[c];
#pragma unroll
        for (int a = 0; a < 16; ++a) { const size_t r = (size_t)(r0 + t0 + a);
            const float uv = bf2f(U[r * ldu + c]), g = bf2f(Gt[r * 3072 + c]);
            O[r * ldo + c] = (bf16)f2bf(g * (acc[a] + sk * uv)); }
    }
}
__device__ __forceinline__ int scan_row(int b, int dir, int n) {
    if (n < 256) { const int tc = dir ? 255 - n : n; return M_LAT + b * 256 + tc; }
    const int tl = n - 256; const int t = dir ? 2047 - tl : tl; return b * 2048 + t;
}
__device__ __forceinline__ void ph_gla_scan(Frame& F) {
    LAS float* W2s = (LAS float*)(F.lds);
    LAS float* gbs = W2s + 2048;
    LAS float* cds = gbs + 128;
    LAS float* as_ = cds + 256;
    LAS float* ks = as_ + 2048;
    LAS float* qs = ks + 2048;
    LAS float* vs_ = qs + 2048;
    LAS float* red = vs_ + 1024;
    const bf16* P = (const bf16*)(F.ws + WS_P); float* OG = (float*)(F.ws + WS_OG);
    for (int u = F.bid; u < 256; u += F.G) {
        const int vsl = u & 3, dir = (u >> 2) & 1, h = (u >> 3) & 3, b = u >> 5;
        const int v = F.tid & 63, kg = F.tid >> 6;
        __syncthreads();
        for (int i = F.tid; i < 2048; i += NTHR) W2s[i] = F.in[I_GGW2][(size_t)(dir * 16 + (i >> 7)) * 512 + h * 128 + (i & 127)];
        if (F.tid < 128) gbs[F.tid] = F.in[I_GGB][dir * 512 + h * 128 + F.tid];
        float S[16];
#pragma unroll
        for (int j = 0; j < 16; ++j) S[j] = 0.f;
        for (int n0 = 0; n0 < 2304; n0 += 16) {
            __syncthreads();
            if (F.tid < 256) { const int tk = F.tid >> 4, rr = F.tid & 15; const int row = scan_row(b, dir, n0 + tk); cds[F.tid] = bf2f(P[(size_t)row * LD0 + C0_CODE + dir * 16 + rr]); }
            for (int i = F.tid; i < 1024; i += NTHR) { const int tk = i >> 6, vx = i & 63; const int row = scan_row(b, dir, n0 + tk); vs_[i] = bf2f(P[(size_t)row * LD0 + C0_GV + h * 256 + vsl * 64 + vx]); }
            __syncthreads();
            for (int i = F.tid; i < 2048; i += NTHR) { const int tk = i >> 7, kx = i & 127; const int row = scan_row(b, dir, n0 + tk);
                qs[i] = bf2f(P[(size_t)row * LD0 + C0_GQ + h * 128 + kx]) * 0.08838834764831845f;
                ks[i] = bf2f(P[(size_t)row * LD0 + C0_GK + h * 128 + kx]);
                float lg = gbs[kx];
#pragma unroll
                for (int rr = 0; rr < 16; ++rr) lg += cds[tk * 16 + rr] * W2s[rr * 128 + kx];
                as_[i] = __expf(logsigmoidf_(lg) * (1.f / 16.f)); }
            __syncthreads();
            for (int tk = 0; tk < 16; ++tk) {
                const float vv = vs_[tk * 64 + v]; float part = 0.f;
#pragma unroll
                for (int j = 0; j < 16; ++j) { const int k = tk * 128 + kg * 16 + j; S[j] = as_[k] * S[j] + ks[k] * vv; part += qs[k] * S[j]; }
                red[((tk & 1) * 8 + kg) * 64 + v] = part;
                __syncthreads();
                if (kg == 0) { float o = 0.f;
#pragma unroll
                    for (int g = 0; g < 8; ++g) o += red[((tk & 1) * 8 + g) * 64 + v];
                    const int row = scan_row(b, dir, n0 + tk);
                    OG[((size_t)dir * M_ALL + row) * 1024 + h * 256 + vsl * 64 + v] = o; }
            }
        }
    }
    __syncthreads();
}
template <int ACT> __device__ __forceinline__ void ph_mix_combine(Frame& F, int nrows, const bf16* O0, const bf16* O1, const bf16* P, int ldp, int gcol, const float* ng, int ycol) {
    const int gw = F.bid * NWAVES + F.wave, NGW = F.G * NWAVES;
    bf16* Y = (bf16*)(F.ws + WS_Y);
    for (int r = gw; r < nrows; r += NGW) {
#pragma unroll
        for (int h = 0; h < 4; ++h) { const int c = h * 256 + 4 * F.lane;
            const v2u a = *(const GAS v2u*)(O0 + (size_t)r * 1024 + c), b2 = *(const GAS v2u*)(O1 + (size_t)r * 1024 + c);
            const f32x4 o = {bflo(a.x) + bflo(b2.x), bfhi(a.x) + bfhi(b2.x), bflo(a.y) + bflo(b2.y), bfhi(a.y) + bfhi(b2.y)};
            const float ss = wave_sum((o[0] * o[0] + o[1] * o[1]) + (o[2] * o[2] + o[3] * o[3]));
            const float rs = 1.f / sqrtf(ss * (1.f / 256.f) + EPS);
            const f32x4 gg = *(const GAS f32x4*)(ng + 4 * F.lane);
            const v2u gw2 = *(const GAS v2u*)(P + (size_t)r * ldp + gcol + c);
            float gt[4] = {bflo(gw2.x), bfhi(gw2.x), bflo(gw2.y), bfhi(gw2.y)};
            float y[4];
#pragma unroll
            for (int q = 0; q < 4; ++q) y[q] = o[q] * rs * gg[q] * (ACT == 0 ? siluf(gt[q]) : sigmoidf_(gt[q]));
            v2u w; w.x = pk2(y[0], y[1]); w.y = pk2(y[2], y[3]);
            *(GAS v2u*)(Y + (size_t)r * D + ycol + c) = w; }
    }
}
__device__ __forceinline__ void ph_ml_scan(Frame& F) {
    LAS float* qs = (LAS float*)(F.lds);
    LAS float* ks = qs + 2048;
    LAS float* vs_ = ks + 2048;
    LAS float* gts = vs_ + 512;
    LAS float* red = gts + 16;
    LAS float* redd = red + 1024;
    const bf16* P = (const bf16*)(F.ws + WS_P); float* OM = (float*)(F.ws + WS_OG);
    const float* cw = F.in[I_MCW]; const float* cb = F.in[I_MCB];
    for (int u = F.bid; u < 256; u += F.G) {
        const int vsl = u & 3, dir = (u >> 2) & 1, h = (u >> 3) & 3, b = u >> 5;
        const int v = F.tid & 63, kg = F.tid >> 6;
        float C[32], nn[32]; float m = 0.f;
#pragma unroll
        for (int j = 0; j < 32; ++j) { C[j] = 0.f; nn[j] = 0.f; }
        const float igb = F.in[I_MIGB][dir * 4 + h], fgb = F.in[I_MFGB][dir * 4 + h];
        for (int n0 = 0; n0 < 2304; n0 += 8) {
            __syncthreads();
            for (int i = F.tid; i < 4096; i += NTHR) { const int tk = i >> 9, col = i & 511; const int row = scan_row(b, dir, n0 + tk);
                const int pc = (col < 256) ? (h * 256 + col) : (1024 + h * 256 + (col - 256));
                const int t = (row < M_LAT) ? (row & 2047) : ((row - M_LAT) & 255); const int L = (row < M_LAT) ? 2048 : 256;
                float a = cb[pc] + cw[2048 + pc] * bf2f(P[(size_t)row * LD1 + pc]);
                if (t > 0) a += cw[pc] * bf2f(P[(size_t)(row - 1) * LD1 + pc]);
                if (t < L - 1) a += cw[4096 + pc] * bf2f(P[(size_t)(row + 1) * LD1 + pc]);
                a = siluf(a);
                if (col < 256) qs[tk * 256 + col] = a; else ks[tk * 256 + col - 256] = a * 0.0625f; }
            { const int tk = F.tid >> 6, vx = F.tid & 63; const int row = scan_row(b, dir, n0 + tk); vs_[F.tid] = bf2f(P[(size_t)row * LD1 + C1_MV + h * 256 + vsl * 64 + vx]); }
            if (F.tid < 8) { const int row = scan_row(b, dir, n0 + F.tid);
                gts[F.tid * 2 + 0] = bf2f(P[(size_t)row * LD1 + C1_G + dir * 8 + h]) + igb;
                gts[F.tid * 2 + 1] = logsigmoidf_(bf2f(P[(size_t)row * LD1 + C1_G + dir * 8 + 4 + h]) + fgb); }
            __syncthreads();
            for (int tk = 0; tk < 8; ++tk) {
                const float ig = gts[tk * 2], lf = gts[tk * 2 + 1];
                const float mn = fmaxf(lf + m, ig); const float fk = __expf(lf + m - mn), ik = __expf(ig - mn); m = mn;
                const float vv = vs_[tk * 64 + v] * ik; float part = 0.f, dpart = 0.f;
#pragma unroll
                for (int j = 0; j < 32; ++j) { const int k = tk * 256 + kg * 32 + j; const float kv = ks[k], qv = qs[k];
                    C[j] = fk * C[j] + vv * kv; nn[j] = fk * nn[j] + ik * kv; part += C[j] * qv; dpart += nn[j] * qv; }
                red[((tk & 1) * 8 + kg) * 64 + v] = part; if (v == 0) redd[(tk & 1) * 8 + kg] = dpart;
                __syncthreads();
                if (kg == 0 && n0 >= 256) { float num = 0.f, den = 0.f;
#pragma unroll
                    for (int g = 0; g < 8; ++g) { num += red[((tk & 1) * 8 + g) * 64 + v]; den += redd[(tk & 1) * 8 + g]; }
                    const int row = scan_row(b, dir, n0 + tk);
                    OM[((size_t)dir * M_LAT + row) * 1024 + h * 256 + vsl * 64 + v] = num / fmaxf(fabsf(den), __expf(-m)); }
            }
        }
    }
    __syncthreads();
}
__device__ __forceinline__ void ph_da_rope(Frame& F) {
    const int gw = F.bid * NWAVES + F.wave, NGW = F.G * NWAVES;
    bf16* P = (bf16*)(F.ws + WS_P);
    const int f = F.lane & 15, axis = (F.lane >> 4) & 1;
    const float inv = exp2f(-(float)f * (13.287712379549449f / 16.f));
    for (int r = gw; r < M_LAT; r += NGW) { const int t = r & 2047;
        const float pos = (float)(axis ? (t & 63) : (t >> 6));
        const float ang = pos * inv; const float cs = cosf(ang), sn = sinf(ang);
        bf16* row = P + (size_t)r * LD1;
        bf16 xa[16], xb[16];
#pragma unroll
        for (int i = 0; i < 16; ++i) { const int pi = F.lane + 64 * i; const int which = pi >> 9, vec = (pi >> 5) & 15; const int col = (which ? C1_DK : C1_DQ) + vec * 64 + axis * 32 + f;
            xa[i] = row[col]; xb[i] = row[col + 16]; }
#pragma unroll
        for (int i = 0; i < 16; ++i) { const int pi = F.lane + 64 * i; const int which = pi >> 9, vec = (pi >> 5) & 15; const int col = (which ? C1_DK : C1_DQ) + vec * 64 + axis * 32 + f;
            const float a = bf2f(xa[i]), b = bf2f(xb[i]);
            const float sc = which ? 1.f : 0.18033688011112042f;
            row[col] = (bf16)f2bf((a * cs - b * sn) * sc); row[col + 16] = (bf16)f2bf((b * cs + a * sn) * sc); }
    }
}
__device__ __forceinline__ void ph_da_attn(Frame& F) {
    constexpr int KS_LD = 136, VT_LD = 72, PW_LD = 72;
    LAS bf16* Ks = (LAS bf16*)(F.lds);
    LAS bf16* VT = Ks + 64 * KS_LD;
    LAS bf16* Pw = VT + 128 * VT_LD + (F.wave * 2) * 16 * PW_LD;
    const bf16* P = (const bf16*)(F.ws + WS_P); bf16* Y = (bf16*)(F.ws + WS_Y);
    const float lam_init = 0.35550906759096927f;
    float lam;
    { const float* lv = F.in[I_DLAM]; float s01 = 0.f, s23 = 0.f; for (int i = 0; i < 64; ++i) { s01 += lv[i] * lv[64 + i]; s23 += lv[128 + i] * lv[192 + i]; } lam = expf(s01) - expf(s23) + lam_init; }
    const int fr = F.lane & 15, fq = F.lane >> 4;
    for (int u = F.bid; u < 1024; u += F.G) {
        const int qb = u & 15, h = (u >> 4) & 7, b = u >> 7;
        const int qrow0 = b * 2048 + qb * 128 + F.wave * 16;
        bf16x8 qf[2][2];
#pragma unroll
        for (int c = 0; c < 2; ++c)
#pragma unroll
            for (int ks = 0; ks < 2; ++ks) qf[c][ks] = *(const GAS bf16x8*)(P + (size_t)(qrow0 + fr) * LD1 + C1_DQ + h * 128 + c * 64 + ks * 32 + 8 * fq);
        f32x4 Oa[2][8]; float mrun[2][4], lrun[2][4];
#pragma unroll
        for (int c = 0; c < 2; ++c) {
#pragma unroll
            for (int vt = 0; vt < 8; ++vt) Oa[c][vt] = (f32x4){0.f, 0.f, 0.f, 0.f};
#pragma unroll
            for (int j = 0; j < 4; ++j) { mrun[c][j] = -1e30f; lrun[c][j] = 0.f; } }
        for (int kt = 0; kt < 36; ++kt) {
            __syncthreads();
#pragma unroll
            for (int i = 0; i < 2; ++i) { const int id = F.tid + 512 * i; const int key = id >> 4, ch = id & 15; const int kk = kt * 64 + key;
                const size_t krow = (kk < 256) ? (size_t)(M_LAT + b * 256 + kk) : (size_t)(b * 2048 + kk - 256);
                const v4u kv = *(const GAS v4u*)(P + krow * LD1 + C1_DK + h * 128 + ch * 8);
                *(LAS v4u*)(Ks + key * KS_LD + ch * 8) = kv;
                const v4u vv = *(const GAS v4u*)(P + krow * LD1 + C1_DV + h * 128 + ch * 8);
#pragma unroll
                for (int q = 0; q < 4; ++q) { VT[(ch * 8 + 2 * q) * VT_LD + key] = (bf16)(vv[q] & 0xffffu); VT[(ch * 8 + 2 * q + 1) * VT_LD + key] = (bf16)(vv[q] >> 16); } }
            __syncthreads();
#pragma unroll
            for (int c = 0; c < 2; ++c) {
                f32x4 S[4];
#pragma unroll
                for (int nt = 0; nt < 4; ++nt) { f32x4 a = {0.f, 0.f, 0.f, 0.f};
#pragma unroll
                    for (int ks = 0; ks < 2; ++ks) { const bf16x8 bf = *(const LAS bf16x8*)(Ks + (nt * 16 + fr) * KS_LD + c * 64 + ks * 32 + 8 * fq); a = __builtin_amdgcn_mfma_f32_16x16x32_bf16(qf[c][ks], bf, a, 0, 0, 0); }
                    S[nt] = a; }
#pragma unroll
                for (int j = 0; j < 4; ++j) {
                    float mx = fmaxf(fmaxf(S[0][j], S[1][j]), fmaxf(S[2][j], S[3][j])); mx = grp16_max(mx);
                    const float mn = fmaxf(mrun[c][j], mx); const float alpha = __expf(mrun[c][j] - mn); mrun[c][j] = mn;
                    float rsum = 0.f;
#pragma unroll
                    for (int nt = 0; nt < 4; ++nt) { const float p = __expf(S[nt][j] - mn); rsum += p; Pw[(c * 16 + 4 * fq + j) * PW_LD + nt * 16 + fr] = (bf16)f2bf(p); }
                    rsum = grp16_sum(rsum); lrun[c][j] = lrun[c][j] * alpha + rsum;
#pragma unroll
                    for (int vt = 0; vt < 8; ++vt) Oa[c][vt][j] *= alpha; }
            }
            __syncthreads();
#pragma unroll
            for (int c = 0; c < 2; ++c)
#pragma unroll
                for (int ks = 0; ks < 2; ++ks) { const bf16x8 af = *(const LAS bf16x8*)(Pw + (c * 16 + fr) * PW_LD + ks * 32 + 8 * fq);
#pragma unroll
                    for (int vt = 0; vt < 8; ++vt) { const bf16x8 bf = *(const LAS bf16x8*)(VT + (vt * 16 + fr) * VT_LD + ks * 32 + 8 * fq); Oa[c][vt] = __builtin_amdgcn_mfma_f32_16x16x32_bf16(af, bf, Oa[c][vt], 0, 0, 0); } }
        }
#pragma unroll
        for (int j = 0; j < 4; ++j) { const float i0 = 1.f / lrun[0][j], i1 = lam / lrun[1][j]; float o[8]; float ss = 0.f;
#pragma unroll
            for (int vt = 0; vt < 8; ++vt) { o[vt] = Oa[0][vt][j] * i0 - Oa[1][vt][j] * i1; ss += o[vt] * o[vt]; }
            ss = grp16_sum(ss); const float rs = (1.f - lam_init) / sqrtf(ss * (1.f / 128.f) + EPS);
#pragma unroll
            for (int vt = 0; vt < 8; ++vt) Y[(size_t)(qrow0 + 4 * fq + j) * D + 1024 + h * 128 + vt * 16 + fr] = (bf16)f2bf(o[vt] * rs * F.in[I_DNG][vt * 16 + fr]); }
    }
    __syncthreads();
}
__device__ __forceinline__ void ph_hy_prep_lat(Frame& F) {
    constexpr int RS = 66;
    LAS bf16* raw = (LAS bf16*)(F.lds) + F.wave * (66 * RS);
    const bf16* P = (const bf16*)(F.ws + WS_P); bf16* XT = (bf16*)(F.ws + WS_XT);
    const float* cw = F.in[I_HCW]; const float* cbias = F.in[I_HCB];
    const int gw = F.bid * NWAVES + F.wave, NGW = F.G * NWAVES;
    const int cs = F.lane >> 3, tgp = F.lane & 7;
    __syncthreads();
    v4u pv[9];
#define HP_LOAD(uu) do { const int cb_ = (uu) & 15, tb_ = ((uu) >> 4) & 31, b_ = ((uu) >> 9) & 7, wh_ = (uu) >> 12; const int c0_ = wh_ * 1024 + cb_ * 64, t0_ = tb_ * 64; \
        _Pragma("unroll") for (int x = 0; x < 9; ++x) { const int id = F.lane + 64 * x; const int rr = id >> 3, ch = id & 7; const int t = t0_ - 1 + rr; \
            pv[x] = (id < 528 && t >= 0 && t < 2048) ? *(const GAS v4u*)(P + (size_t)(b_ * 2048 + t) * LD0 + c0_ + ch * 8) : (v4u){0u, 0u, 0u, 0u}; } } while (0)
    if (gw < 12288) HP_LOAD(gw);
    for (int u = gw; u < 12288; u += NGW) {
        const int cb = u & 15, tb = (u >> 4) & 31, b = (u >> 9) & 7, which = u >> 12;
        const int c0 = which * 1024 + cb * 64, t0 = tb * 64;
#pragma unroll
        for (int x = 0; x < 9; ++x) { const int id = F.lane + 64 * x; if (id < 528) { typedef unsigned __attribute__((may_alias)) u32a; LAS u32a* d = (LAS u32a*)(raw + (id >> 3) * RS + (id & 7) * 8); d[0] = pv[x].x; d[1] = pv[x].y; d[2] = pv[x].z; d[3] = pv[x].w; } }
        asm volatile("" ::: "memory");
        if (u + NGW < 12288) HP_LOAD(u + NGW);
#pragma unroll 2
        for (int cg = 0; cg < 8; ++cg) { const int cc = cg * 8 + cs, c = c0 + cc;
            const float w0 = cw[c], w1 = cw[3072 + c], w2 = cw[6144 + c], bs = cbias[c];
            float r_[10];
#pragma unroll
            for (int i = 0; i < 10; ++i) r_[i] = bf2f(raw[(tgp * 8 + i) * RS + cc]);
            float o[8];
#pragma unroll
            for (int i = 0; i < 8; ++i) o[i] = bs + w0 * r_[i] + w1 * r_[i + 1] + w2 * r_[i + 2];
            v4u w; w.x = pk2(o[0], o[1]); w.y = pk2(o[2], o[3]); w.z = pk2(o[4], o[5]); w.w = pk2(o[6], o[7]);
            *(GAS v4u*)(XT + ((size_t)c * 8 + b) * 2048 + t0 + tgp * 8) = w; }
        asm volatile("" ::: "memory");
    }
#undef HP_LOAD
    __syncthreads();
}
__device__ __forceinline__ void ph_hy_post_lat(Frame& F) {
    LAS bf16* tile = (LAS bf16*)(F.lds) + F.wave * (64 * 72);
    const bf16* YT = (const bf16*)(F.ws + WS_YT); bf16* Y = (bf16*)(F.ws + WS_Y);
    const int gw = F.bid * NWAVES + F.wave, NGW = F.G * NWAVES;
    __syncthreads();
    v4u pv[8];
#define HQ_LOAD(uu) do { const int cb_ = (uu) & 15, tb_ = ((uu) >> 4) & 31, b_ = (uu) >> 9; \
        _Pragma("unroll") for (int x = 0; x < 8; ++x) { const int p = F.lane + 64 * x; pv[x] = *(const GAS v4u*)(YT + ((size_t)(cb_ * 64 + (p >> 3)) * 8 + b_) * 2048 + tb_ * 64 + (p & 7) * 8); } } while (0)
    if (gw < 4096) HQ_LOAD(gw);
    for (int u = gw; u < 4096; u += NGW) { const int cb = u & 15, tb = (u >> 4) & 31, b = u >> 9;
#pragma unroll
        for (int x = 0; x < 8; ++x) { const int p = F.lane + 64 * x; *(LAS v4u*)(tile + (p >> 3) * 72 + (p & 7) * 8) = pv[x]; }
        asm volatile("" ::: "memory");
        if (u + NGW < 4096) HQ_LOAD(u + NGW);
#pragma unroll 2
        for (int x = 0; x < 8; ++x) { const int p = F.lane + 64 * x; const int t = p >> 3, ch = p & 7; unsigned short e[8];
#pragma unroll
            for (int i = 0; i < 8; ++i) e[i] = tile[(ch * 8 + i) * 72 + t];
            v4u w; w.x = e[0] | ((unsigned)e[1] << 16); w.y = e[2] | ((unsigned)e[3] << 16); w.z = e[4] | ((unsigned)e[5] << 16); w.w = e[6] | ((unsigned)e[7] << 16);
            *(GAS v4u*)(Y + (size_t)(b * 2048 + tb * 64 + t) * D + cb * 64 + ch * 8) = w; }
        asm volatile("" ::: "memory");
    }
#undef HQ_LOAD
    __syncthreads();
}
__device__ __forceinline__ void ph_hy_ftt(Frame& F) {
    LAS float* tile = (LAS float*)(F.lds);
    const float* FTL = (const float*)(F.ws + WS_FTL); bf16* FTT = (bf16*)(F.ws + WS_FTT);
    for (int u = F.bid; u < 2 * 65 * 16; u += F.G) { const int cb = u & 15; const int rb = (u >> 4) % 65; const int o = (u >> 4) / 65;
        __syncthreads();
        { float t_[8];
#pragma unroll
          for (int x = 0; x < 8; ++x) { const int i = F.tid + NTHR * x; const int rr = i >> 6, cc = i & 63; const int idx = 4127 - (rb * 64 + rr);
              t_[x] = (idx >= 0 && idx <= 4094) ? FTL[((size_t)o * 4095 + idx) * 1024 + cb * 64 + cc] : 0.f; }
#pragma unroll
          for (int x = 0; x < 8; ++x) { const int i = F.tid + NTHR * x; tile[(i >> 6) * 65 + (i & 63)] = t_[x]; } }
        __syncthreads();
        { const int cc = F.tid >> 3, ch = F.tid & 7; float e[8];
#pragma unroll
          for (int i = 0; i < 8; ++i) e[i] = tile[(ch * 8 + i) * 65 + cc];
          v4u w; w.x = pk2(e[0], e[1]); w.y = pk2(e[2], e[3]); w.z = pk2(e[4], e[5]); w.w = pk2(e[6], e[7]);
          *(GAS v4u*)(FTT + ((size_t)o * 1024 + cb * 64 + cc) * 4160 + rb * 64 + ch * 8) = w; }
    }
    __syncthreads();
}
constexpr int HY_XOFF = 2080, HY_RLEN = 4160, HY_KOFF = 32, HY_UROWB = 4192, HY_UCOPYB = 33600, HY_UOFF = 2 * HY_RLEN * 2;
__device__ __forceinline__ void hy_conv_loop(const LAS bf16* Rp, const LAS unsigned* Ud, int wave, int fr, int fq, f32x4 (&acc)[2][4]) {
    const int dl = fr & 7, s = dl & 1;
    const LAS bf16* ap = Rp + 2048 + 8 * fq - 8 * (32 * wave + fr);
    const LAS unsigned* up = Ud + s * (HY_UCOPYB / 4) + (fr >> 3) * (HY_UROWB / 4) + 4 * fq + ((dl - s) >> 1);
#pragma unroll 1
    for (int K0 = 0; K0 < 65; ++K0) {
        bf16x8 af[2];
#pragma unroll
        for (int mt = 0; mt < 2; ++mt) af[mt] = *(const LAS bf16x8*)(ap + 32 * K0 - 128 * mt);
        bf16x8 bfv[4];
#pragma unroll
        for (int nt = 0; nt < 4; ++nt) { const LAS unsigned* q = up + nt * 2 * (HY_UROWB / 4) + 16 * K0; v4u w; w.x = q[0]; w.y = q[1]; w.z = q[2]; w.w = q[3]; bfv[nt] = __builtin_bit_cast(bf16x8, w); }
#pragma unroll
        for (int mt = 0; mt < 2; ++mt)
#pragma unroll
            for (int nt = 0; nt < 4; ++nt) acc[mt][nt] = __builtin_amdgcn_mfma_f32_16x16x32_bf16(af[mt], bfv[nt], acc[mt][nt], 0, 0, 0);
    }
}
__device__ __forceinline__ void ph_hy_conv_lat(Frame& F) {
    LAS bf16* R = (LAS bf16*)(F.lds);
    LAS unsigned char* Ub = F.lds + HY_UOFF;
    LAS bf16* Gs = (LAS bf16*)(F.lds + HY_UOFF + 2 * HY_UCOPYB);
    const bf16* XT = (const bf16*)(F.ws + WS_XT); bf16* YT = (bf16*)(F.ws + WS_YT);
    const bf16* FTT = (const bf16*)(F.ws + WS_FTT);
    const int fr = F.lane & 15, fq = F.lane >> 4;
    v4u rR[3], rG[4], rX[4];
#define HYC_LOAD(cc) do { const bf16* X1_ = XT + (size_t)(cc) * 8 * 2048; const bf16* XV2_ = XT + ((size_t)2048 + (cc)) * 8 * 2048; \
        _Pragma("unroll") for (int x = 0; x < 3; ++x) { const int i = F.tid + NTHR * x; if (i < 2 * HY_RLEN / 8) { const int o = (i >= HY_RLEN / 8) ? 1 : 0; const int q = i - o * (HY_RLEN / 8); rR[x] = *(const GAS v4u*)(FTT + ((size_t)o * 1024 + (cc)) * 4160 + q * 8); } } \
        _Pragma("unroll") for (int x = 0; x < 4; ++x) { const int i = F.tid + NTHR * x; const int b = i >> 8, ch = i & 255; rG[x] = *(const GAS v4u*)(X1_ + (size_t)b * 2048 + ch * 8); rX[x] = *(const GAS v4u*)(XV2_ + (size_t)b * 2048 + ch * 8); } } while (0)
    if (F.bid < 1024) HYC_LOAD(F.bid);
    for (int c = F.bid; c < 1024; c += F.G) {
        const bf16* X2 = XT + ((size_t)1024 + c) * 8 * 2048;
        __syncthreads();
        for (int i = F.tid; i < (2 * HY_UCOPYB) / 16; i += NTHR) *(LAS v4u*)(Ub + i * 16) = (v4u){0u, 0u, 0u, 0u};
#pragma unroll
        for (int x = 0; x < 3; ++x) { const int i = F.tid + NTHR * x; if (i < 2 * HY_RLEN / 8) { const int o = (i >= HY_RLEN / 8) ? 1 : 0; const int q = i - o * (HY_RLEN / 8); *(LAS v4u*)(R + o * HY_RLEN + q * 8) = rR[x]; } }
#pragma unroll
        for (int x = 0; x < 4; ++x) { const int i = F.tid + NTHR * x; *(LAS v4u*)(Gs + (i >> 8) * 2048 + (i & 255) * 8) = rG[x]; }
        __syncthreads();
#pragma unroll
        for (int x = 0; x < 4; ++x) { const int i = F.tid + NTHR * x; const int b = i >> 8, ch = i & 255, t0 = ch * 8; const v4u val = rX[x];
            *(LAS v4u*)(Ub + b * HY_UROWB + (HY_KOFF + t0) * 2) = val;
            LAS bf16* c1 = (LAS bf16*)(Ub + HY_UCOPYB + b * HY_UROWB) + HY_KOFF + t0 - 1;
#pragma unroll
            for (int q = 0; q < 4; ++q) { c1[2 * q] = (bf16)(val[q] & 0xffffu); c1[2 * q + 1] = (bf16)(val[q] >> 16); } }
        __syncthreads();
        if (c + F.G < 1024) HYC_LOAD(c + F.G);
#pragma unroll 1
        for (int order = 0; order < 2; ++order) {
            f32x4 acc[2][4];
#pragma unroll
            for (int mt = 0; mt < 2; ++mt)
#pragma unroll
                for (int nt = 0; nt < 4; ++nt) acc[mt][nt] = (f32x4){0.f, 0.f, 0.f, 0.f};
            v4u gpre[4];
            if (order == 0) {
#pragma unroll
                for (int x = 0; x < 4; ++x) { const int i = F.tid + NTHR * x; gpre[x] = *(const GAS v4u*)(X2 + (size_t)(i >> 8) * 2048 + (i & 255) * 8); } }
            hy_conv_loop(R + order * HY_RLEN, (const LAS unsigned*)Ub, F.wave, fr, fq, acc);
            __syncthreads();
            const float sk = F.in[I_HBIAS][order * 1024 + c];
#pragma unroll
            for (int mt = 0; mt < 2; ++mt)
#pragma unroll
                for (int nt = 0; nt < 4; ++nt)
#pragma unroll
                    for (int j = 0; j < 4; ++j) { const int m = 32 * F.wave + 16 * mt + 4 * fq + j; const int b = 2 * nt + (fr >> 3); const int t = 8 * m + (fr & 7);
                        LAS bf16* u0 = (LAS bf16*)(Ub + b * HY_UROWB) + HY_KOFF + t; LAS bf16* u1 = (LAS bf16*)(Ub + HY_UCOPYB + b * HY_UROWB) + HY_KOFF + t;
                        const float uv = bf2f(*u0), g = bf2f(Gs[b * 2048 + t]);
                        const bf16 r = (bf16)f2bf(g * (acc[mt][nt][j] + sk * uv));
                        if (order == 0) { *u0 = r; u1[-1] = r; } else { *u1 = r; } }
            __syncthreads();
            if (order == 0) {
#pragma unroll
                for (int x = 0; x < 4; ++x) { const int i = F.tid + NTHR * x; *(LAS v4u*)(Gs + (i >> 8) * 2048 + (i & 255) * 8) = gpre[x]; } }
        }
        for (int i = F.tid; i < 2048; i += NTHR) { const int b = i >> 8, ch = i & 255;
            *(GAS v4u*)(YT + ((size_t)c * 8 + b) * 2048 + ch * 8) = *(const LAS v4u*)(Ub + HY_UCOPYB + b * HY_UROWB + (HY_KOFF + ch * 8) * 2); }
    }
    __syncthreads();
#undef HYC_LOAD
}
__device__ __forceinline__ void ph_ml_prep(Frame& F) {
    const bf16* P = (const bf16*)(F.ws + WS_P); bf16* MQK = (bf16*)(F.ws + WS_MQK); float* MLS = (float*)(F.ws + WS_MLS); float* KEEP = MLS + (size_t)64 * 36 * 320;
    const int gw = F.bid * NWAVES + F.wave, NGW = F.G * NWAVES;
    if (gw < 64) {
        const int sq = gw, dir = sq & 1, h = (sq >> 1) & 3, b = sq >> 3; const int i = F.lane;
        const float igb = F.in[I_MIGB][dir * 4 + h], fgb = F.in[I_MFGB][dir * 4 + h]; float mrun = 0.f;
        for (int c = 0; c < 36; ++c) { const int row = scan_row(b, dir, 64 * c + i);
            const float ig = bf2f(P[(size_t)row * LD1 + C1_G + dir * 8 + h]) + igb;
            const float lf = logsigmoidf_(bf2f(P[(size_t)row * LD1 + C1_G + dir * 8 + 4 + h]) + fgb);
            const float bi = wave_incl_sum(lf, i); const float blast = __shfl(bi, 63);
            const float wend = blast - bi + ig; const float mnew = fmaxf(blast + mrun, wave_max(wend));
            const float keep = __expf(blast + mrun - mnew); const float wi = __expf(wend - mnew);
            const float ai = bi + mrun; const float colv = ig - bi; const float pm = wave_incl_max(colv, i); const float mt = fmaxf(ai, bi + pm);
            float* o = MLS + ((size_t)sq * 36 + c) * 320 + i;
            o[0] = wi; o[64] = bi - mt; o[128] = colv; o[192] = __expf(ai - mt); o[256] = __expf(-mt); if (i == 0) KEEP[sq * 36 + c] = keep;
            mrun = mnew; }
    }
    const float* cw = F.in[I_MCW]; const float* cbias = F.in[I_MCB];
    const bool scanw = (NGW > 128) && (gw < 64);
    const int cgw = (NGW > 128) ? gw - 64 : gw, CNGW = (NGW > 128) ? NGW - 64 : NGW;
    f32x4 w0[4][2], w1[4][2], w2[4][2], bs[4][2];
    if (!scanw) {
#pragma unroll
        for (int i = 0; i < 4; ++i)
#pragma unroll
            for (int hh = 0; hh < 2; ++hh) { const int c = 8 * (F.lane + 64 * i) + 4 * hh;
                w0[i][hh] = *(const GAS f32x4*)(cw + c); w1[i][hh] = *(const GAS f32x4*)(cw + 2048 + c); w2[i][hh] = *(const GAS f32x4*)(cw + 4096 + c); bs[i][hh] = *(const GAS f32x4*)(cbias + c); } }
    for (int r = scanw ? M_ALL : cgw; r < M_ALL; r += CNGW) {
        const int t = (r < M_LAT) ? (r & 2047) : ((r - M_LAT) & 255); const int L = (r < M_LAT) ? 2048 : 256; const bool hp = t > 0, hn = t < L - 1;
#pragma unroll
        for (int i = 0; i < 4; ++i) { const int c = 8 * (F.lane + 64 * i); const v4u z = {0u, 0u, 0u, 0u};
            const v4u a = hp ? *(const GAS v4u*)(P + (size_t)(r - 1) * LD1 + c) : z; const v4u b2 = *(const GAS v4u*)(P + (size_t)r * LD1 + c); const v4u d = hn ? *(const GAS v4u*)(P + (size_t)(r + 1) * LD1 + c) : z;
            const float ksc = (c < 1024) ? 1.f : 0.0625f; float o[8];
#pragma unroll
            for (int q = 0; q < 4; ++q) { const int hh = q >> 1, e0 = 2 * (q & 1);
                o[2 * q] = siluf(bs[i][hh][e0] + w0[i][hh][e0] * bflo(a[q]) + w1[i][hh][e0] * bflo(b2[q]) + w2[i][hh][e0] * bflo(d[q])) * ksc;
                o[2 * q + 1] = siluf(bs[i][hh][e0 + 1] + w0[i][hh][e0 + 1] * bfhi(a[q]) + w1[i][hh][e0 + 1] * bfhi(b2[q]) + w2[i][hh][e0 + 1] * bfhi(d[q])) * ksc; }
            v4u w; w.x = pk2(o[0], o[1]); w.y = pk2(o[2], o[3]); w.z = pk2(o[4], o[5]); w.w = pk2(o[6], o[7]);
            *(GAS v4u*)(MQK + (size_t)r * 2048 + c) = w; }
    }
}
__device__ __forceinline__ void ph_ml_scan2(Frame& F) {
    constexpr int QLD = 272, VLD = 88, SLD = 72;
    LAS bf16* Qn = (LAS bf16*)(F.lds); LAS bf16* Kn = Qn + 64 * QLD; LAS bf16* Cb = Kn + 64 * QLD; LAS bf16* Vn = Cb + 80 * QLD; LAS bf16* VWn = Vn + 64 * VLD; LAS bf16* SC = VWn + 64 * VLD;
    LAS float* sS = (LAS float*)(SC + 64 * SLD);
    LAS float* sW = sS; LAS float* sRow = sS + 64; LAS float* sCol = sS + 128; LAS float* sAw = sS + 192; LAS float* sEinv = sS + 256;
    const bf16* P = (const bf16*)(F.ws + WS_P); float* OM = (float*)(F.ws + WS_OG);
    const bf16* MQK = (const bf16*)(F.ws + WS_MQK); const float* MLS = (const float*)(F.ws + WS_MLS); const float* KEEP = MLS + (size_t)64 * 36 * 320;
    const int fr = F.lane & 15, fq = F.lane >> 4;
    for (int u0 = F.bid; u0 < 256; u0 += F.G) {
        const int u = (F.G == 256) ? ((((u0 & 7) * 8 + (u0 >> 5)) << 2) | ((u0 >> 3) & 3)) : u0;
        const int vsl = u & 3, dir = (u >> 2) & 1, h = (u >> 3) & 3, b = u >> 5; const int sq = (b * 4 + h) * 2 + dir; const int sgn = dir ? -1 : 1;
        __syncthreads();
        for (int i = F.tid; i < (80 * QLD + 2 * 64 * VLD) / 8; i += NTHR) *(LAS v4u*)(Cb + i * 8) = (v4u){0u, 0u, 0u, 0u};
        __syncthreads();
        if (F.tid < 64) Vn[F.tid * VLD + 64] = (bf16)0x3F80;
        f32x4 st[5][2];
#pragma unroll
        for (int vt = 0; vt < 5; ++vt) { st[vt][0] = (f32x4){0.f, 0.f, 0.f, 0.f}; st[vt][1] = (f32x4){0.f, 0.f, 0.f, 0.f}; }
        v4u rq[4], rk[4], rv; float rs = 0.f, keepn = 0.f;
#define ML_LOAD(cc) do { const int row0_ = scan_row(b, dir, 64 * (cc)); \
            _Pragma("unroll") for (int x = 0; x < 4; ++x) { const int p = F.tid + NTHR * x; const size_t o = (size_t)(row0_ + sgn * (p >> 5)) * 2048 + h * 256 + (p & 31) * 8; \
                rq[x] = *(const GAS v4u*)(MQK + o); rk[x] = *(const GAS v4u*)(MQK + o + 1024); } \
            rv = *(const GAS v4u*)(P + (size_t)(row0_ + sgn * (F.tid >> 3)) * LD1 + C1_MV + h * 256 + vsl * 64 + (F.tid & 7) * 8); \
            if (F.tid < 320) rs = MLS[((size_t)sq * 36 + (cc)) * 320 + F.tid]; keepn = KEEP[sq * 36 + (cc)]; } while (0)
        ML_LOAD(0);
#pragma unroll 1
        for (int c = 0; c < 36; ++c) {
            const bool emit = c >= 4;
#pragma unroll
            for (int x = 0; x < 4; ++x) { const int p = F.tid + NTHR * x; *(LAS v4u*)(Qn + (p >> 5) * QLD + (p & 31) * 8) = rq[x]; *(LAS v4u*)(Kn + (p >> 5) * QLD + (p & 31) * 8) = rk[x]; }
            *(LAS v4u*)(Vn + (F.tid >> 3) * VLD + (F.tid & 7) * 8) = rv;
            if (F.tid < 320) sS[F.tid] = rs;
            const float keep = keepn;
            __syncthreads();
            if (c + 1 < 36) ML_LOAD(c + 1);
            { const int i = F.tid >> 3, cv = F.tid & 7; const float wv = sW[i]; const v4u x = *(const LAS v4u*)(Vn + i * VLD + cv * 8); v4u y;
#pragma unroll
              for (int q = 0; q < 4; ++q) y[q] = pk2(bflo(x[q]) * wv, bfhi(x[q]) * wv);
              *(LAS v4u*)(VWn + i * VLD + cv * 8) = y; if (cv == 0) VWn[i * VLD + 64] = (bf16)f2bf(wv); }
            if (emit) {
                const int it_ = F.wave >> 1;
#pragma unroll
                for (int x = 0; x < 2; ++x) { const int jt = 2 * (F.wave & 1) + x;
                    f32x4 a = {0.f, 0.f, 0.f, 0.f};
                    if (jt <= it_) {
#pragma unroll
                        for (int ks = 0; ks < 8; ++ks) { const bf16x8 af = *(const LAS bf16x8*)(Qn + (16 * it_ + fr) * QLD + 32 * ks + 8 * fq); const bf16x8 bf = *(const LAS bf16x8*)(Kn + (16 * jt + fr) * QLD + 32 * ks + 8 * fq);
                            a = __builtin_amdgcn_mfma_f32_16x16x32_bf16(af, bf, a, 0, 0, 0); } }
                    const int j = 16 * jt + fr; const float cj = sCol[j];
#pragma unroll
                    for (int jj = 0; jj < 4; ++jj) { const int i = 16 * it_ + 4 * fq + jj; const float val = (j <= i) ? a[jj] * __expf(sRow[i] + cj) : 0.f; SC[i * SLD + j] = (bf16)f2bf(val); } }
            }
            __syncthreads();
            if (emit) {
                const int it_ = F.wave & 3, vt0 = 2 * (F.wave >> 2);
                f32x4 acc[3];
#pragma unroll
                for (int x = 0; x < 3; ++x) acc[x] = (f32x4){0.f, 0.f, 0.f, 0.f};
#pragma unroll
                for (int ks = 0; ks < 8; ++ks) { const bf16x8 af = *(const LAS bf16x8*)(Qn + (16 * it_ + fr) * QLD + 32 * ks + 8 * fq);
#pragma unroll
                    for (int x = 0; x < 3; ++x) { const int vt = (x < 2) ? vt0 + x : 4; const bf16x8 bf = *(const LAS bf16x8*)(Cb + (16 * vt + fr) * QLD + 32 * ks + 8 * fq); acc[x] = __builtin_amdgcn_mfma_f32_16x16x32_bf16(af, bf, acc[x], 0, 0, 0); } }
#pragma unroll
                for (int jj = 0; jj < 4; ++jj) { const float awv = sAw[16 * it_ + 4 * fq + jj];
#pragma unroll
                    for (int x = 0; x < 3; ++x) acc[x][jj] *= awv; }
#pragma unroll
                for (int js = 0; js < 2; ++js) { const bf16x8 af = *(const LAS bf16x8*)(SC + (16 * it_ + fr) * SLD + 32 * js + 8 * fq);
#pragma unroll
                    for (int x = 0; x < 3; ++x) { const int vt = (x < 2) ? vt0 + x : 4; const bf16x8 bf = tr_frag(Vn, VLD, 32 * js, 16 * vt, F.lane); acc[x] = __builtin_amdgcn_mfma_f32_16x16x32_bf16(af, bf, acc[x], 0, 0, 0); } }
                const int row0 = scan_row(b, dir, 64 * c);
#pragma unroll
                for (int jj = 0; jj < 4; ++jj) { const int i = 16 * it_ + 4 * fq + jj; const float den = __shfl(acc[2][jj], F.lane & 48); const float dd = fmaxf(fabsf(den), sEinv[i]);
                    const float rdd = __builtin_amdgcn_rcpf(dd);
                    const int row = row0 + sgn * i; bf16* op = (bf16*)OM + ((size_t)dir * M_LAT + row) * 1024 + h * 256 + vsl * 64 + fr;
                    op[16 * vt0] = (bf16)f2bf(acc[0][jj] * rdd); op[16 * vt0 + 16] = (bf16)f2bf(acc[1][jj] * rdd); }
            }
            {
#pragma unroll
              for (int vt = 0; vt < 5; ++vt) { st[vt][0] *= keep; st[vt][1] *= keep; }
#pragma unroll
              for (int is = 0; is < 2; ++is) { bf16x8 kb[2];
#pragma unroll
                  for (int x = 0; x < 2; ++x) kb[x] = tr_frag(Kn, QLD, 32 * is, 16 * (2 * F.wave + x), F.lane);
#pragma unroll
                  for (int vt = 0; vt < 5; ++vt) { const bf16x8 af = tr_frag(VWn, VLD, 32 * is, 16 * vt, F.lane);
                      st[vt][0] = __builtin_amdgcn_mfma_f32_16x16x32_bf16(af, kb[0], st[vt][0], 0, 0, 0); st[vt][1] = __builtin_amdgcn_mfma_f32_16x16x32_bf16(af, kb[1], st[vt][1], 0, 0, 0); } } }
            __syncthreads();
#pragma unroll
            for (int vt = 0; vt < 5; ++vt)
#pragma unroll
                for (int x = 0; x < 2; ++x)
#pragma unroll
                    for (int jj = 0; jj < 4; ++jj) Cb[(16 * vt + 4 * fq + jj) * QLD + 16 * (2 * F.wave + x) + fr] = (bf16)f2bf(st[vt][x][jj]);
        }
#undef ML_LOAD
    }
    __syncthreads();
}
__device__ __forceinline__ void ph_gla_prep(Frame& F) {
    LAS float* sCode = (LAS float*)(F.lds);
    LAS float* sGT = sCode + 1024;
    const bf16* P = (const bf16*)(F.ws + WS_P);
    bf16* GQD = (bf16*)(F.ws + WS_GQ); bf16* GKI = GQD + (size_t)2 * M_ALL * 512; bf16* GKD = GKI + (size_t)2 * M_ALL * 512; float* DEC = (float*)(F.ws + WS_GDEC);
    const int k = F.tid & 127, tg = F.tid >> 7;
    for (int u = F.bid; u < 2304; u += F.G) {
        const int c = u % 36, sq = u / 36; const int dir = sq & 1, h = (sq >> 1) & 3, b = sq >> 3;
        const int n0 = 64 * c; const int row0 = scan_row(b, dir, n0); const int sgn = dir ? -1 : 1;
        __syncthreads();
#pragma unroll
        for (int x = 0; x < 2; ++x) { const int i = F.tid + NTHR * x; sCode[i] = bf2f(P[(size_t)(row0 + sgn * (i >> 4)) * LD0 + C0_CODE + dir * 16 + (i & 15)]); }
        float w2c[16];
#pragma unroll
        for (int r = 0; r < 16; ++r) w2c[r] = F.in[I_GGW2][(size_t)(dir * 16 + r) * 512 + h * 128 + k];
        const float gbk = F.in[I_GGB][dir * 512 + h * 128 + k];
        const bf16* pq = P + (size_t)(row0 + sgn * 16 * tg) * LD0 + C0_GQ + h * 128 + k; const long pstep = (long)sgn * LD0;
        unsigned short qr[16], kr[16]; float bc[16];
#pragma unroll
        for (int x = 0; x < 16; ++x) { qr[x] = pq[x * pstep]; kr[x] = pq[x * pstep + 512]; }
        __syncthreads();
        float run = 0.f;
#pragma unroll
        for (int x = 0; x < 16; ++x) { float lg = gbk; const LAS float* cd = sCode + (16 * tg + x) * 16;
            f32x4 l4 = {0.f, 0.f, 0.f, 0.f};
#pragma unroll
            for (int r = 0; r < 16; r += 4) { const f32x4 cv = *(const LAS f32x4*)(cd + r); l4 += cv * (f32x4){w2c[r], w2c[r + 1], w2c[r + 2], w2c[r + 3]}; }
            lg += (l4[0] + l4[1]) + (l4[2] + l4[3]);
            run += logsigmoidf_(lg) * (1.f / 16.f); bc[x] = run; }
        sGT[tg * 128 + k] = run;
        __syncthreads();
        float off = 0.f, tot = 0.f;
#pragma unroll
        for (int g = 0; g < 4; ++g) { const float t = sGT[g * 128 + k]; tot += t; off += (g < tg) ? t : 0.f; }
        if (tg == 0) DEC[(size_t)u * 128 + k] = __expf(tot);
        const size_t o0 = ((size_t)dir * M_ALL + (row0 + sgn * 16 * tg)) * 512 + h * 128 + k; const long ostep = (long)sgn * 512;
#pragma unroll
        for (int x = 0; x < 16; ++x) { const float bb = bc[x] + off; const float qv = bf2f(qr[x]) * 0.08838834764831845f, kv = bf2f(kr[x]);
            GQD[o0 + x * ostep] = (bf16)f2bf(qv * __expf(bb)); GKI[o0 + x * ostep] = (bf16)f2bf(kv * __expf(-bb)); GKD[o0 + x * ostep] = (bf16)f2bf(kv * __expf(tot - bb)); }
    }
    __syncthreads();
}
__device__ __forceinline__ void ph_gla_scan2(Frame& F) {
    constexpr int KLD = 136, VLD = 72;
    LAS bf16* QD = (LAS bf16*)(F.lds); LAS bf16* KI = QD + 64 * KLD; LAS bf16* KD = KI + 64 * KLD; LAS bf16* Sb = KD + 64 * KLD; LAS bf16* Vn = Sb + 64 * KLD; LAS bf16* ATT = Vn + 64 * VLD;
    const bf16* P = (const bf16*)(F.ws + WS_P); float* OG = (float*)(F.ws + WS_OG);
    const bf16* GQD = (const bf16*)(F.ws + WS_GQ); const bf16* GKI = GQD + (size_t)2 * M_ALL * 512; const bf16* GKD = GKI + (size_t)2 * M_ALL * 512; const float* DEC = (const float*)(F.ws + WS_GDEC);
    const int fr = F.lane & 15, fq = F.lane >> 4;
    for (int u0 = F.bid; u0 < 256; u0 += F.G) {
        const int u = (F.G == 256) ? ((((u0 & 7) * 8 + (u0 >> 5)) << 2) | ((u0 >> 3) & 3)) : u0;
        const int vsl = u & 3, dir = (u >> 2) & 1, h = (u >> 3) & 3, b = u >> 5; const int sq = (b * 4 + h) * 2 + dir; const int sgn = dir ? -1 : 1;
        __syncthreads();
        for (int i = F.tid; i < 64 * KLD / 8; i += NTHR) *(LAS v4u*)(Sb + i * 8) = (v4u){0u, 0u, 0u, 0u};
        f32x4 st[4];
#pragma unroll
        for (int vt = 0; vt < 4; ++vt) st[vt] = (f32x4){0.f, 0.f, 0.f, 0.f};
        v4u rq[2], rk[2], rd[2], rv; float dkn;
#define GLA_LOAD(cc) do { const int row0_ = scan_row(b, dir, 64 * (cc)); \
            _Pragma("unroll") for (int x = 0; x < 2; ++x) { const int p = F.tid + NTHR * x; const size_t o = ((size_t)dir * M_ALL + (row0_ + sgn * (p >> 4))) * 512 + h * 128 + (p & 15) * 8; \
                rq[x] = *(const GAS v4u*)(GQD + o); rk[x] = *(const GAS v4u*)(GKI + o); rd[x] = *(const GAS v4u*)(GKD + o); } \
            rv = *(const GAS v4u*)(P + (size_t)(row0_ + sgn * (F.tid >> 3)) * LD0 + C0_GV + h * 256 + vsl * 64 + (F.tid & 7) * 8); \
            dkn = DEC[((size_t)sq * 36 + (cc)) * 128 + 16 * F.wave + fr]; } while (0)
#define GLA_PUT_QK() do { _Pragma("unroll") for (int x = 0; x < 2; ++x) { const int p = F.tid + NTHR * x; *(LAS v4u*)(QD + (p >> 4) * KLD + (p & 15) * 8) = rq[x]; *(LAS v4u*)(KI + (p >> 4) * KLD + (p & 15) * 8) = rk[x]; } } while (0)
        GLA_LOAD(0);
        GLA_PUT_QK();
#pragma unroll 1
        for (int c = 0; c < 36; ++c) {
            __syncthreads();
#pragma unroll
            for (int x = 0; x < 2; ++x) { const int p = F.tid + NTHR * x; *(LAS v4u*)(KD + (p >> 4) * KLD + (p & 15) * 8) = rd[x]; }
            *(LAS v4u*)(Vn + (F.tid >> 3) * VLD + (F.tid & 7) * 8) = rv;
            const float dk = dkn;
            if (c + 1 < 36) GLA_LOAD(c + 1);
            { const int it_ = F.wave >> 1;
#pragma unroll
              for (int x = 0; x < 2; ++x) { const int jt = 2 * (F.wave & 1) + x; f32x4 a = {0.f, 0.f, 0.f, 0.f};
                  if (jt <= it_) {
#pragma unroll
                      for (int ks = 0; ks < 4; ++ks) { const bf16x8 af = *(const LAS bf16x8*)(QD + (16 * it_ + fr) * KLD + 32 * ks + 8 * fq); const bf16x8 bf = *(const LAS bf16x8*)(KI + (16 * jt + fr) * KLD + 32 * ks + 8 * fq);
                          a = __builtin_amdgcn_mfma_f32_16x16x32_bf16(af, bf, a, 0, 0, 0); } }
                  const int j = 16 * jt + fr;
#pragma unroll
                  for (int jj = 0; jj < 4; ++jj) { const int i = 16 * it_ + 4 * fq + jj; ATT[i * VLD + j] = (bf16)f2bf((j <= i) ? a[jj] : 0.f); } } }
            const int ot = F.wave & 3, vt0 = 2 * (F.wave >> 2);
            f32x4 oa[2] = {(f32x4){0.f, 0.f, 0.f, 0.f}, (f32x4){0.f, 0.f, 0.f, 0.f}};
#pragma unroll
            for (int ks = 0; ks < 4; ++ks) { const bf16x8 af = *(const LAS bf16x8*)(QD + (16 * ot + fr) * KLD + 32 * ks + 8 * fq);
#pragma unroll
                for (int x = 0; x < 2; ++x) { const bf16x8 bf = *(const LAS bf16x8*)(Sb + (16 * (vt0 + x) + fr) * KLD + 32 * ks + 8 * fq); oa[x] = __builtin_amdgcn_mfma_f32_16x16x32_bf16(af, bf, oa[x], 0, 0, 0); } }
            __syncthreads();
#pragma unroll
            for (int js = 0; js < 2; ++js) { const bf16x8 af = *(const LAS bf16x8*)(ATT + (16 * ot + fr) * VLD + 32 * js + 8 * fq);
#pragma unroll
                for (int x = 0; x < 2; ++x) { const bf16x8 bf = tr_frag(Vn, VLD, 32 * js, 16 * (vt0 + x), F.lane); oa[x] = __builtin_amdgcn_mfma_f32_16x16x32_bf16(af, bf, oa[x], 0, 0, 0); } }
            { const int row0 = scan_row(b, dir, 64 * c);
#pragma unroll
              for (int jj = 0; jj < 4; ++jj) { const int i = 16 * ot + 4 * fq + jj; const int row = row0 + sgn * i;
                  bf16* op = (bf16*)OG + ((size_t)dir * M_ALL + row) * 1024 + h * 256 + vsl * 64 + fr; op[16 * vt0] = (bf16)f2bf(oa[0][jj]); op[16 * vt0 + 16] = (bf16)f2bf(oa[1][jj]); } }
            {
#pragma unroll
              for (int vt = 0; vt < 4; ++vt) st[vt] *= dk;
#pragma unroll
              for (int js = 0; js < 2; ++js) { const bf16x8 kb = tr_frag(KD, KLD, 32 * js, 16 * F.wave, F.lane);
#pragma unroll
                  for (int vt = 0; vt < 4; ++vt) { const bf16x8 af = tr_frag(Vn, VLD, 32 * js, 16 * vt, F.lane); st[vt] = __builtin_amdgcn_mfma_f32_16x16x32_bf16(af, kb, st[vt], 0, 0, 0); } }
#pragma unroll
              for (int vt = 0; vt < 4; ++vt)
#pragma unroll
                  for (int jj = 0; jj < 4; ++jj) Sb[(16 * vt + 4 * fq + jj) * KLD + 16 * F.wave + fr] = (bf16)f2bf(st[vt][jj]); }
            if (c + 1 < 36) GLA_PUT_QK();
        }
#undef GLA_LOAD
#undef GLA_PUT_QK
    }
    __syncthreads();
}
__device__ __forceinline__ float vmax3(float a, float b, float c) { float r; asm("v_max3_f32 %0, %1, %2, %3" : "=v"(r) : "v"(a), "v"(b), "v"(c)); return r; }
__device__ __forceinline__ void ph_da_attn2(Frame& F) {
    constexpr int TLD = 144, TILE = 64 * TLD;
    LAS bf16* buf = (LAS bf16*)(F.lds);
    const bf16* P = (const bf16*)(F.ws + WS_P); bf16* Y = (bf16*)(F.ws + WS_Y);
    const float lam_init = 0.35550906759096927f;
    float lam;
    { const float* lv = F.in[I_DLAM]; float s01 = 0.f, s23 = 0.f; for (int i = 0; i < 64; ++i) { s01 += lv[i] * lv[64 + i]; s23 += lv[128 + i] * lv[192 + i]; } lam = expf(s01) - expf(s23) + lam_init; }
    const int fr = F.lane & 15, fq = F.lane >> 4, tq = (F.lane & 15) >> 2, tp = F.lane & 3;
    const int nround = (F.G == 256) ? 4 : (1024 + F.G - 1) / F.G;
    for (int rnd = 0; rnd < nround; ++rnd) {
        int u;
        if (F.G == 256) { const int xcd = F.bid & 7, slot = F.bid >> 3; const int pair = xcd + 8 * (2 * rnd + (slot >> 4)); u = pair * 16 + (slot & 15); }
        else { u = F.bid + rnd * F.G; if (u >= 1024) break; }
        const int qb = u & 15, h = (u >> 4) & 7, b = u >> 7;
        const int qrow = b * 2048 + qb * 128 + F.wave * 16 + fr;
        bf16x8 qf[2][2];
#pragma unroll
        for (int c = 0; c < 2; ++c)
#pragma unroll
            for (int ks = 0; ks < 2; ++ks) qf[c][ks] = *(const GAS bf16x8*)(P + (size_t)qrow * LD1 + C1_DQ + h * 128 + c * 64 + ks * 32 + 8 * fq);
        f32x4 Oa[2][8], Ol[2]; float mst[2] = {0.f, 0.f};
#pragma unroll
        for (int c = 0; c < 2; ++c)
#pragma unroll
            for (int vt = 0; vt < 8; ++vt) Oa[c][vt] = (f32x4){0.f, 0.f, 0.f, 0.f};
        Ol[0] = (f32x4){0.f, 0.f, 0.f, 0.f}; Ol[1] = (f32x4){0.f, 0.f, 0.f, 0.f};
        const bf16x8 ones = (bf16x8){0x3F80, 0x3F80, 0x3F80, 0x3F80, 0x3F80, 0x3F80, 0x3F80, 0x3F80};
        v4u kn[2], vn[2];
        const int skey = F.tid >> 4, sch = F.tid & 15;
#define DA_TB(t) ((const char*)P + (size_t)(((t) < 4) ? (M_LAT + b * 256 + 64 * (t)) : (b * 2048 + 64 * ((t) - 4))) * (LD1 * 2))
        const unsigned vo0 = (unsigned)(skey * LD1 + C1_DK + h * 128 + sch * 8) * 2u, vo1 = vo0 + 32u * LD1 * 2u;
#define DA_LD(t) do { const char* tb_ = DA_TB(t); kn[0] = *(const GAS v4u*)(tb_ + vo0); vn[0] = *(const GAS v4u*)(tb_ + vo0 + (C1_DV - C1_DK) * 2); kn[1] = *(const GAS v4u*)(tb_ + vo1); vn[1] = *(const GAS v4u*)(tb_ + vo1 + (C1_DV - C1_DK) * 2); } while (0)
        DA_LD(0);
        __syncthreads();
#pragma unroll
        for (int i = 0; i < 2; ++i) { *(LAS v4u*)(buf + (skey + 32 * i) * TLD + sch * 8) = kn[i]; *(LAS v4u*)(buf + TILE + (skey + 32 * i) * TLD + sch * 8) = vn[i]; }
        DA_LD(1);
        __syncthreads();
#pragma unroll 1
        for (int kt = 0; kt < 36; ++kt) {
            const LAS bf16* Kc = buf + (kt & 1) * 2 * TILE; const LAS bf16* Vc = Kc + TILE;
            if (kt + 1 < 36) {
                LAS bf16* Kn_ = buf + ((kt + 1) & 1) * 2 * TILE;
#pragma unroll
                for (int i = 0; i < 2; ++i) { *(LAS v4u*)(Kn_ + (skey + 32 * i) * TLD + sch * 8) = kn[i]; *(LAS v4u*)(Kn_ + TILE + (skey + 32 * i) * TLD + sch * 8) = vn[i]; }
                if (kt + 2 < 36) DA_LD(kt + 2); }
            bf16x8 pf[2][2];
            f32x4 S[2][4];
#pragma unroll
            for (int c = 0; c < 2; ++c)
#pragma unroll
                for (int nt = 0; nt < 4; ++nt) { const float nm = -mst[c]; f32x4 a = {nm, nm, nm, nm};
#pragma unroll
                    for (int ks = 0; ks < 2; ++ks) { const bf16x8 kf = *(const LAS bf16x8*)(Kc + (nt * 16 + fr) * TLD + c * 64 + ks * 32 + 8 * fq); a = __builtin_amdgcn_mfma_f32_16x16x32_bf16(kf, qf[c][ks], a, 0, 0, 0); }
                    S[c][nt] = a; }
            float mx[2];
            asm volatile("s_nop 7\n\ts_nop 3\n\t"
                         "v_max3_f32 %0, %2, %3, %4\n\tv_max3_f32 %1, %18, %19, %20\n\t"
                         "v_max3_f32 %0, %0, %5, %6\n\tv_max3_f32 %1, %1, %21, %22\n\t"
                         "v_max3_f32 %0, %0, %7, %8\n\tv_max3_f32 %1, %1, %23, %24\n\t"
                         "v_max3_f32 %0, %0, %9, %10\n\tv_max3_f32 %1, %1, %25, %26\n\t"
                         "v_max3_f32 %0, %0, %11, %12\n\tv_max3_f32 %1, %1, %27, %28\n\t"
                         "v_max3_f32 %0, %0, %13, %14\n\tv_max3_f32 %1, %1, %29, %30\n\t"
                         "v_max3_f32 %0, %0, %15, %16\n\tv_max3_f32 %1, %1, %31, %32\n\t"
                         "v_max_f32 %0, %0, %17\n\tv_max_f32 %1, %1, %33"
                         : "=&v"(mx[0]), "=&v"(mx[1])
                         : "v"(S[0][0][0]), "v"(S[0][0][1]), "v"(S[0][0][2]), "v"(S[0][0][3]), "v"(S[0][1][0]), "v"(S[0][1][1]), "v"(S[0][1][2]), "v"(S[0][1][3]),
                           "v"(S[0][2][0]), "v"(S[0][2][1]), "v"(S[0][2][2]), "v"(S[0][2][3]), "v"(S[0][3][0]), "v"(S[0][3][1]), "v"(S[0][3][2]), "v"(S[0][3][3]),
                           "v"(S[1][0][0]), "v"(S[1][0][1]), "v"(S[1][0][2]), "v"(S[1][0][3]), "v"(S[1][1][0]), "v"(S[1][1][1]), "v"(S[1][1][2]), "v"(S[1][1][3]),
                           "v"(S[1][2][0]), "v"(S[1][2][1]), "v"(S[1][2][2]), "v"(S[1][2][3]), "v"(S[1][3][0]), "v"(S[1][3][1]), "v"(S[1][3][2]), "v"(S[1][3][3]));
            { float a0 = mx[0], b0 = mx[0], a1 = mx[1], b1 = mx[1];
              asm volatile("s_nop 1\n\tv_permlane16_swap_b32 %0, %1\n\tv_permlane16_swap_b32 %2, %3\n\ts_nop 1\n\tv_max_f32 %0, %0, %1\n\tv_max_f32 %2, %2, %3\n\tv_mov_b32 %1, %0\n\tv_mov_b32 %3, %2\n\ts_nop 1\n\t"
                           "v_permlane32_swap_b32 %0, %1\n\tv_permlane32_swap_b32 %2, %3\n\ts_nop 1\n\tv_max_f32 %0, %0, %1\n\tv_max_f32 %2, %2, %3"
                           : "+v"(a0), "+v"(b0), "+v"(a1), "+v"(b1));
              mx[0] = a0; mx[1] = a1; }
            const bool up0 = (kt == 0) || (mx[0] > 8.f), up1 = (kt == 0) || (mx[1] > 8.f);
            if (__any(up0 || up1)) {
#pragma unroll
                for (int c = 0; c < 2; ++c) { const float d = (c ? up1 : up0) ? mx[c] : 0.f; const float al = __builtin_amdgcn_exp2f(-d); mst[c] += d; Ol[c] *= al;
#pragma unroll
                    for (int vt = 0; vt < 8; ++vt) Oa[c][vt] *= al;
#pragma unroll
                    for (int nt = 0; nt < 4; ++nt) S[c][nt] -= d; } }
#pragma unroll
            for (int c = 0; c < 2; ++c) {
#pragma unroll
                for (int nt = 0; nt < 4; ++nt)
#pragma unroll
                    for (int j = 0; j < 4; ++j) S[c][nt][j] = __builtin_amdgcn_exp2f(S[c][nt][j]);
#pragma unroll
                for (int kp = 0; kp < 2; ++kp) { v4u w; w.x = pk2(S[c][2 * kp][0], S[c][2 * kp][1]); w.y = pk2(S[c][2 * kp][2], S[c][2 * kp][3]); w.z = pk2(S[c][2 * kp + 1][0], S[c][2 * kp + 1][1]); w.w = pk2(S[c][2 * kp + 1][2], S[c][2 * kp + 1][3]);
                    pf[c][kp] = __builtin_bit_cast(bf16x8, w); } }
#pragma unroll
            for (int kp = 0; kp < 2; ++kp) { Ol[0] = __builtin_amdgcn_mfma_f32_16x16x32_bf16(ones, pf[0][kp], Ol[0], 0, 0, 0); Ol[1] = __builtin_amdgcn_mfma_f32_16x16x32_bf16(ones, pf[1][kp], Ol[1], 0, 0, 0); }
#pragma unroll
            for (int kp = 0; kp < 2; ++kp)
#pragma unroll
                for (int vt = 0; vt < 8; ++vt) { const LAS bf16* a0 = Vc + (32 * kp + 4 * fq + tq) * TLD + 16 * vt + 4 * tp;
                    const s16x4 lo = __builtin_amdgcn_ds_read_tr16_b64_v4i16((LAS s16x4*)a0); const s16x4 hi = __builtin_amdgcn_ds_read_tr16_b64_v4i16((LAS s16x4*)(a0 + 16 * TLD));
                    const bf16x8 vf = (bf16x8){lo[0], lo[1], lo[2], lo[3], hi[0], hi[1], hi[2], hi[3]};
                    Oa[0][vt] = __builtin_amdgcn_mfma_f32_16x16x32_bf16(vf, pf[0][kp], Oa[0][vt], 0, 0, 0); Oa[1][vt] = __builtin_amdgcn_mfma_f32_16x16x32_bf16(vf, pf[1][kp], Oa[1][vt], 0, 0, 0); }
            __syncthreads();
        }
#undef DA_TB
#undef DA_LD
        { const float i0 = 1.f / Ol[0][0], i1 = lam / Ol[1][0]; float ss = 0.f;
#pragma unroll
          for (int vt = 0; vt < 8; ++vt) { Oa[0][vt] = Oa[0][vt] * i0 - Oa[1][vt] * i1; ss += (Oa[0][vt][0] * Oa[0][vt][0] + Oa[0][vt][1] * Oa[0][vt][1]) + (Oa[0][vt][2] * Oa[0][vt][2] + Oa[0][vt][3] * Oa[0][vt][3]); }
          ss = xrow_sum(ss);
          const float rsn = (1.f - lam_init) / sqrtf(ss * (1.f / 128.f) + EPS);
#pragma unroll
          for (int vt = 0; vt < 8; ++vt) { const f32x4 g = *(const GAS f32x4*)(F.in[I_DNG] + 16 * vt + 4 * fq); const f32x4 o = Oa[0][vt] * rsn * g;
              v2u w; w.x = pk2(o[0], o[1]); w.y = pk2(o[2], o[3]);
              *(GAS v2u*)(Y + (size_t)qrow * D + 1024 + h * 128 + 16 * vt + 4 * fq) = w; } }
    }
    __syncthreads();
}
struct Args { const float* in[35]; float* out; unsigned char* ws; int ph_lo, ph_hi; };
__device__ __forceinline__ bool frame_refresh(Frame& F) { int tz = threadIdx.x; asm volatile("" : "+v"(tz)); F.tid = tz; F.lane = tz & 63; F.wave = __builtin_amdgcn_readfirstlane(tz >> 6);
    const __attribute__((address_space(4))) char* kp = (const __attribute__((address_space(4))) char*)__builtin_amdgcn_kernarg_segment_ptr(); asm volatile("" : "+s"(kp));
    const __attribute__((address_space(4))) Args* ap = (const __attribute__((address_space(4))) Args*)kp;
#pragma unroll
    for (int i = 0; i < 35; ++i) F.in[i] = ap->in[i];
    F.out = ap->out; F.ws = ap->ws; F.ctl = (gu32*)(ap->ws + WS_CTL); return true; }
constexpr int NPHASE = 24;
__global__ void __launch_bounds__(NTHR, 2) skel_fwd(Args args) {
    extern __shared__ __attribute__((aligned(16))) unsigned char lds[];
    Frame F;
    F.lds = (LAS unsigned char*)lds;
    F.MISC = (volatile LAS unsigned*)(F.lds + MISC_OFF);
    F.tid = threadIdx.x; F.lane = F.tid & 63; F.wave = __builtin_amdgcn_readfirstlane(F.tid >> 6);
    F.G = gridDim.x; F.bid = blockIdx.x;
    F.ws = args.ws; F.out = args.out; F.ctl = (gu32*)(args.ws + WS_CTL);
    for (int u = F.tid; u < (LDS_BYTES - LDSCTL_OFF) / 4; u += NTHR) ((LAS unsigned*)(F.lds + LDSCTL_OFF))[u] = 0u;
    __syncthreads();
    const int lo = args.ph_lo, hi = args.ph_hi;
    XcdBarrier bar; bar.bar = (unsigned*)(F.ctl + CW_BAR); bar.x = 0; bar.st = nullptr;
    if (hi - lo > 1) bar = xcd_barrier_post((unsigned*)(F.ctl + CW_BAR), F.MISC + 8);
#define IN(k) (lo <= (k) && (k) < hi && frame_refresh(F))
#define SEAM(k) do { if (lo <= (k) && (k) + 1 < hi) xcd_barrier(bar); } while (0)
#define MOD ((const float*)(F.ws + WS_MOD))
#define Abuf ((bf16*)(F.ws + WS_A))
#define Pbuf ((bf16*)(F.ws + WS_P))
#define Ybuf ((bf16*)(F.ws + WS_Y))
#define Hbuf ((float*)(F.ws + WS_H))
#define XS ((bf16*)(F.ws + WS_XS))
#define HID ((bf16*)(F.ws + WS_HID))
#define YS ((bf16*)(F.ws + WS_YS))
    if (IN(0)) { p0_adaln(F); __syncthreads(); p0_filters(F); __syncthreads(); p0_convert(F); } SEAM(0);
    if (IN(1)) { ph_norm1_l0(F); ph_hy_ftt(F); } SEAM(1);
    if (IN(2)) { pg8::Gemm g{Abuf, (const bf16*)(F.ws + WS_WIN0), M_ALL, 6144, D}; pg8::StaticOrder S; S.init(M_ALL, 6144, F.G, F.bid);
        pg8::EpiStore E{Pbuf, LD0, 24, 1.f};
        pg8::gemm_phase<pg8::EpiStore, pg8::StaticOrder, PG8_ALIGN, PG8_SP2>(F.lds + RING_OFF, g, S, E); ph_codes_skinny(F); cvt_late(F, CVT_L0_END - CVT_LATE0, 192, 10); } SEAM(2);
    if (IN(3)) { ph_gla_prep(F); ph_hy_shortconv(F); ph_hy_prep_lat(F); } SEAM(3);
    if (IN(4)) { ph_gla_scan2(F); ph_hy_conv_lat(F); ph_hy_longconv(F, 0); } SEAM(4);
    if (IN(5)) { ph_hy_longconv(F, 1); ph_hy_post_lat(F); const bf16* OG = (const bf16*)(F.ws + WS_OG);
        ph_mix_combine<0>(F, M_ALL, OG, OG + (size_t)M_ALL * 1024, Pbuf, LD0, C0_GR, F.in[I_GNG], 1024); } SEAM(5);
    if (IN(6)) { pg8::Gemm g{Ybuf, (const bf16*)(F.ws + WS_WOUT), M_ALL, D, D}; pg8::StaticOrder S; S.init(M_ALL, D, F.G, F.bid);
        pg8::EpiRes E{F.in[I_X], F.in[I_CTX], Hbuf, MOD + 2 * 2048};
        pg8::gemm_phase<pg8::EpiRes, pg8::StaticOrder, PG8_ALIGN, PG8_SP2>(F.lds + RING_OFF, g, S, E);  cvt_late(F, CVT_L0_END - CVT_LATE0 + 64 * 10, 64, 14); } SEAM(6);
    if (IN(7)) { ph_norm2_router2(F, 0, M_ALL); } SEAM(7);
    if (IN(8)) { ph_topk2(F, 256, ME0); } SEAM(8);
    if (IN(10)) { pg8::Gemm g{(const bf16*)(F.ws + WS_A), (const bf16*)(F.ws + WS_W13), 16 * ME0, 4096, D, (const int*)(F.ws + WS_TOK)}; pg8::GroupedOrder S; S.init(ME0 / 256, 16, F.G, F.bid);
        pg8::EpiSwiglu E{(unsigned char*)HID};
        pg8::gemm_phase<pg8::EpiSwiglu, pg8::GroupedOrder, PG8_ALIGN, PG8_SP2, true, true>(F.lds + RING_OFF, g, S, E); } SEAM(10);
    if (IN(11)) { pg8::Gemm g{HID, (const bf16*)(F.ws + WS_W2), 16 * ME0, 2048, D}; pg8::GroupedOrder S; S.init(ME0 / 256, 8, F.G, F.bid);
        pg8::EpiStore E{YS, D, 8, 1.f / 64.f};
        pg8::gemm_phase<pg8::EpiStore, pg8::GroupedOrder, false, PG8_SP2, true>(F.lds + RING_OFF, g, S, E);  cvt_late(F, CVT_L1_END - CVT_LATE1, 128, 5); } SEAM(11);
    if (IN(12)) { ph_combine<0>(F, 0, M_ALL); } SEAM(12);
    if (IN(13)) { pg8::Gemm g{Abuf, (const bf16*)(F.ws + WS_WIN1), M_ALL, LD1, D}; pg8::In1Order S; S.init(F.G, F.bid);
        pg8::EpiStore E{Pbuf, LD1, LD1 / 256, 1.f};
        pg8::gemm_phase<pg8::EpiStore, pg8::In1Order, PG8_ALIGN, PG8_SP2>(F.lds + RING_OFF, g, S, E);  cvt_late(F, CVT_L1_END - CVT_LATE1 + 128 * 5, 200, 10); } SEAM(13);
    if (IN(14)) { ph_ml_prep(F); ph_da_rope(F); } SEAM(14);
    if (IN(15)) { ph_ml_scan2(F); ph_da_attn2(F); } SEAM(15);
    if (IN(16)) { const bf16* OM = (const bf16*)(F.ws + WS_OG);
        ph_mix_combine<1>(F, M_LAT, OM, OM + (size_t)M_LAT * 1024, Pbuf, LD1, C1_MO, F.in[I_MNG], 0); } SEAM(16);
    if (IN(17)) { pg8::Gemm g{Ybuf, (const bf16*)(F.ws + WS_WOUT) + (size_t)D * D, M_LAT, D, D}; pg8::StaticOrder S; S.init(M_LAT, D, F.G, F.bid);
        pg8::EpiRes E{Hbuf, Hbuf, Hbuf, MOD + 9 * 12288 + 2 * 2048};
        pg8::gemm_phase<pg8::EpiRes, pg8::StaticOrder, PG8_ALIGN, PG8_SP2>(F.lds + RING_OFF, g, S, E); } SEAM(17);
    if (IN(18)) { ph_norm2_router2(F, 1, M_LAT); } SEAM(18);
    if (IN(19)) { ph_topk2(F, 128, ME1); } SEAM(19);
    if (IN(21)) { pg8::Gemm g{(const bf16*)(F.ws + WS_A), (const bf16*)(F.ws + WS_W13) + (size_t)16 * 4096 * 1024, 16 * ME1, 4096, D, (const int*)(F.ws + WS_TOK)}; pg8::GroupedOrder S; S.init(ME1 / 256, 16, F.G, F.bid);
        pg8::EpiSwiglu E{(unsigned char*)HID};
        pg8::gemm_phase<pg8::EpiSwiglu, pg8::GroupedOrder, PG8_ALIGN, PG8_SP2, true, true>(F.lds + RING_OFF, g, S, E); } SEAM(21);
    if (IN(22)) { pg8::Gemm g{HID, (const bf16*)(F.ws + WS_W2) + (size_t)16 * 2048 * 1024, 16 * ME1, 2048, D}; pg8::GroupedOrder S; S.init(ME1 / 256, 8, F.G, F.bid);
        pg8::EpiStore E{YS, D, 8, 1.f / 64.f};
        pg8::gemm_phase<pg8::EpiStore, pg8::GroupedOrder, false, PG8_SP2, true>(F.lds + RING_OFF, g, S, E); } SEAM(22);
    if (IN(23)) { ph_combine<1>(F, 1, M_LAT); }
#undef IN
#undef SEAM
#undef MOD
#undef Abuf
#undef Pbuf
#undef Ybuf
#undef Hbuf
#undef XS
#undef HID
#undef YS
}

extern "C" void kernel_launch(void* const* d_in, const int* in_sizes, int n_in, void* d_out, int out_size, void* d_ws, size_t ws_size, hipStream_t stream) {
    static int grid = 0;
    if (grid == 0) {
        if (n_in != 35 || ws_size < WS_END) { fprintf(stderr, "kernel_launch: unexpected n_in %d / ws_size %zu\n", n_in, ws_size); grid = -1; return; }
        int dev = 0, cus = 0, per_cu = 0;
        if (hipGetDevice(&dev) != hipSuccess || hipDeviceGetAttribute(&cus, hipDeviceAttributeMultiprocessorCount, dev) != hipSuccess) { grid = -1; return; }
        if (hipFuncSetAttribute((const void*)skel_fwd, hipFuncAttributeMaxDynamicSharedMemorySize, LDS_BYTES) != hipSuccess) { fprintf(stderr, "kernel_launch: hipFuncSetAttribute failed\n"); grid = -1; return; }
        if (hipOccupancyMaxActiveBlocksPerMultiprocessor(&per_cu, (const void*)skel_fwd, NTHR, LDS_BYTES) != hipSuccess || per_cu < 1) fprintf(stderr, "kernel_launch: occupancy query says %d\n", per_cu);
        (void)hipGetLastError();
        grid = cus;
    }
    if (grid < 0) return;
    if (hipMemsetAsync((char*)d_ws + WS_CTL, 0, CTL_ZERO_BYTES, stream) != hipSuccess) return;
    Args a{};
    for (int i = 0; i < 35; ++i) a.in[i] = (const float*)d_in[i];
    a.out = (float*)d_out; a.ws = (unsigned char*)d_ws;
#if MK_ONE_LAUNCH
    a.ph_lo = 0; a.ph_hi = NPHASE;
    hipLaunchKernelGGL(skel_fwd, dim3(grid), dim3(NTHR), LDS_BYTES, stream, a);
#else
    for (int k = 0; k < NPHASE; ++k) { a.ph_lo = k; a.ph_hi = k + 1; hipLaunchKernelGGL(skel_fwd, dim3(grid), dim3(NTHR), LDS_BYTES, stream, a); }
#endif
}
```
